# Optimizing an MI355X kernel written in HIP

```python
import math
import jax, jax.numpy as jnp
from jax import lax
import numpy as np

D_MODEL = 1024
BATCH = 16
SEQ = 2048
DEPTH = 2

GRID_W = 64
CTX_LEN = 256
MIX_WIDTH = D_MODEL
DA_WIDTH = MIX_WIDTH // 2
DA_HEADS = 4
DA_VDIM = DA_WIDTH // DA_HEADS
DA_HEAD_DIM = DA_VDIM // 2
SG_WIDTH = MIX_WIDTH - DA_WIDTH
SG_GROUPS = 4
SG_GROUP_DIM = SG_WIDTH // SG_GROUPS
CHUNK = 128
Q_BLOCK = 128
ROPE_BASE = 10000.0
D_FF = 2816
N_EXPERTS = 8
TOP_K = 2
D_EXPERT = 3584
N_DENSE = (DEPTH + 1) // 2
N_MOE = DEPTH // 2
EPS = 1e-6
IN_COLS = 3 * DA_WIDTH + 2 * SG_WIDTH

kernel_name = "hybrid_diffattn_sgu_moe_dit"


def rmsnorm(x, g):
    xf = x.astype(jnp.float32)
    y = xf * lax.rsqrt(jnp.mean(xf * xf, axis=-1, keepdims=True) + EPS)
    return (y * g.astype(jnp.float32)).astype(x.dtype)


def layernorm(x, g, b):
    xf = x.astype(jnp.float32)
    mu = jnp.mean(xf, axis=-1, keepdims=True)
    var = jnp.mean(jnp.square(xf - mu), axis=-1, keepdims=True)
    y = (xf - mu) * lax.rsqrt(var + EPS)
    return (y * g.astype(jnp.float32) + b.astype(jnp.float32)).astype(x.dtype)


def modulate(h, shift, scale):
    return h * (1 + scale) + shift


def axial_rope_tables(n_tokens, dtype):
    rows = n_tokens // GRID_W
    row = jnp.repeat(jnp.arange(rows, dtype=jnp.float32), GRID_W)
    col = jnp.tile(jnp.arange(GRID_W, dtype=jnp.float32), rows)
    half = DA_HEAD_DIM // 2
    inv = ROPE_BASE ** (-jnp.arange(0, half, 2, dtype=jnp.float32) / half)
    ang_r = row[:, None] * inv
    ang_c = col[:, None] * inv
    ang = jnp.concatenate([ang_r, ang_r, ang_c, ang_c], axis=-1)
    return jnp.cos(ang).astype(dtype), jnp.sin(ang).astype(dtype)


def apply_rope(x, cos, sin):
    xs = x.reshape(x.shape[:-1] + (2, 2, DA_HEAD_DIM // 4))
    rot = jnp.concatenate([-xs[..., 1:2, :], xs[..., 0:1, :]], axis=-2).reshape(x.shape)
    return x * cos[:, None, None, :] + rot * sin[:, None, None, :]


def diff_attention(q, k, v, lam):
    b, sq = q.shape[0], q.shape[1]
    nb = sq // Q_BLOCK
    qb = q.reshape(b, nb, Q_BLOCK, DA_HEADS, 2, DA_HEAD_DIM).transpose(1, 0, 2, 3, 4, 5)
    scale = DA_HEAD_DIM ** -0.5

    def block(qi):
        s = jnp.einsum('bqhmd,bkhmd->bhmqk', qi, k).astype(jnp.float32) * scale
        p = jax.nn.softmax(s, axis=-1)
        w = p[:, :, 0] - lam.astype(jnp.float32) * p[:, :, 1]
        return jnp.einsum('bhqk,bkhe->bqhe', w.astype(v.dtype), v)

    out = lax.map(block, qb)
    return out.transpose(1, 0, 2, 3, 4).reshape(b, sq, DA_HEADS, DA_VDIM)


def diff_head_out(o, subln_g, lambda_init):
    o = rmsnorm(o, subln_g) * (1.0 - lambda_init)
    return o.reshape(o.shape[0], o.shape[1], DA_WIDTH)


def spatial_gating(u, gv, ln_g, ln_b, w_s, b_s):
    b, s, _ = u.shape
    vn = layernorm(gv, ln_g, ln_b)
    vc = vn.reshape(b, s // CHUNK, CHUNK, SG_GROUPS, SG_GROUP_DIM)
    mixed = jnp.einsum('gpq,bcqge->bcpge', w_s, vc) + b_s.T[None, None, :, :, None]
    return u * mixed.reshape(b, s, SG_WIDTH)


def swiglu(h, w1, w3, w2):
    return (jax.nn.silu(h @ w1) * (h @ w3)) @ w2


def moe_swiglu(h, router_w, w1, w3, w2):
    shp = h.shape
    t = h.reshape(-1, shp[-1])
    logits = (t @ router_w).astype(jnp.float32)
    top_v, top_i = lax.top_k(logits, TOP_K)
    top_w = jax.nn.softmax(top_v, axis=-1)
    gates = jnp.sum(jax.nn.one_hot(top_i, N_EXPERTS, dtype=jnp.float32) * top_w[..., None], axis=1)
    gates = gates.astype(h.dtype)
    y = jnp.zeros_like(t)
    for e in range(N_EXPERTS):
        y = y + gates[:, e:e + 1] * swiglu(t, w1[e], w3[e], w2[e])
    return y.reshape(shp)


def split_heads_qkv(p):
    q, k, v = p[..., :DA_WIDTH], p[..., DA_WIDTH:2 * DA_WIDTH], p[..., 2 * DA_WIDTH:3 * DA_WIDTH]
    b, s = p.shape[0], p.shape[1]
    q = q.reshape(b, s, DA_HEADS, 2, DA_HEAD_DIM)
    k = k.reshape(b, s, DA_HEADS, 2, DA_HEAD_DIM)
    v = v.reshape(b, s, DA_HEADS, DA_VDIM)
    return q, k, v


def setup_inputs(seed: int = 0) -> dict:
    key = jax.random.key(seed)
    ks = jax.random.split(key, 28)
    f32 = jnp.float32
    nrm = lambda k, shape, s: (jax.random.normal(k, shape, f32) * s)
    gain = lambda k, shape: 1.0 + 0.05 * jax.random.normal(k, shape, f32)
    D = D_MODEL
    return {
        "x": nrm(ks[0], (BATCH, SEQ, D), 1.0),
        "c": nrm(ks[1], (BATCH, D), 1.0),
        "ctx": nrm(ks[2], (BATCH, CTX_LEN, D), 1.0),
        "c_ctx": nrm(ks[3], (D,), 1.0),
        "ada_w": nrm(ks[4], (DEPTH, D, 6 * D), 0.5 * D ** -0.5),
        "ada_b": nrm(ks[5], (DEPTH, 6 * D), 0.02),
        "pre_mix_g": gain(ks[6], (DEPTH, D)),
        "post_mix_g": gain(ks[7], (DEPTH, D)),
        "pre_ffn_g": gain(ks[8], (DEPTH, D)),
        "post_ffn_g": gain(ks[9], (DEPTH, D)),
        "w_in": nrm(ks[10], (DEPTH, D, IN_COLS), D ** -0.5),
        "w_out": nrm(ks[11], (DEPTH, MIX_WIDTH, D), MIX_WIDTH ** -0.5),
        "lam_q1": nrm(ks[12], (DEPTH, DA_HEAD_DIM), 0.1),
        "lam_k1": nrm(ks[13], (DEPTH, DA_HEAD_DIM), 0.1),
        "lam_q2": nrm(ks[14], (DEPTH, DA_HEAD_DIM), 0.1),
        "lam_k2": nrm(ks[15], (DEPTH, DA_HEAD_DIM), 0.1),
        "subln_g": gain(ks[16], (DEPTH, DA_VDIM)),
        "sg_ln_g": gain(ks[17], (DEPTH, SG_WIDTH)),
        "sg_ln_b": nrm(ks[18], (DEPTH, SG_WIDTH), 0.02),
        "sg_w": nrm(ks[19], (DEPTH, SG_GROUPS, CHUNK, CHUNK), CHUNK ** -0.5),
        "sg_b": 1.0 + nrm(ks[20], (DEPTH, SG_GROUPS, CHUNK), 0.02),
        "ffn_w1": nrm(ks[21], (N_DENSE, D, D_FF), D ** -0.5),
        "ffn_w3": nrm(ks[22], (N_DENSE, D, D_FF), D ** -0.5),
        "ffn_w2": nrm(ks[23], (N_DENSE, D_FF, D), D_FF ** -0.5),
        "router_w": nrm(ks[24], (N_MOE, D, N_EXPERTS), D ** -0.5),
        "moe_w1": nrm(ks[25], (N_MOE, N_EXPERTS, D, D_EXPERT), D ** -0.5),
        "moe_w3": nrm(ks[26], (N_MOE, N_EXPERTS, D, D_EXPERT), D ** -0.5),
        "moe_w2": nrm(ks[27], (N_MOE, N_EXPERTS, D_EXPERT, D), D_EXPERT ** -0.5),
    }


def reference(x, c, ctx, c_ctx, ada_w, ada_b, pre_mix_g, post_mix_g, pre_ffn_g, post_ffn_g,
              w_in, w_out, lam_q1, lam_k1, lam_q2, lam_k2, subln_g, sg_ln_g, sg_ln_b, sg_w, sg_b,
              ffn_w1, ffn_w3, ffn_w2, router_w, moe_w1, moe_w3, moe_w2):
    n_lat = x.shape[1]
    cos, sin = axial_rope_tables(n_lat, x.dtype)
    x_lat, x_ctx = x, ctx
    for l in range(DEPTH):
        last = l == DEPTH - 1
        lambda_init = 0.8 - 0.6 * math.exp(-0.3 * l)
        ms = jnp.split(jax.nn.silu(c) @ ada_w[l] + ada_b[l], 6, axis=-1)
        ms = [m[:, None, :] for m in ms]
        mc = jnp.split(jax.nn.silu(c_ctx) @ ada_w[l] + ada_b[l], 6, axis=-1)
        lam = (jnp.exp(jnp.sum(lam_q1[l] * lam_k1[l])) - jnp.exp(jnp.sum(lam_q2[l] * lam_k2[l]))
               + lambda_init)

        h_lat = modulate(rmsnorm(x_lat, pre_mix_g[l]), ms[0], ms[1])
        h_ctx = modulate(rmsnorm(x_ctx, pre_mix_g[l]), mc[0], mc[1])
        p_lat = h_lat @ w_in[l]
        q_l, k_l, v_l = split_heads_qkv(p_lat)
        q_l = apply_rope(q_l, cos, sin)
        k_l = apply_rope(k_l, cos, sin)
        u_l = p_lat[..., 3 * DA_WIDTH:3 * DA_WIDTH + SG_WIDTH]
        g_l = p_lat[..., 3 * DA_WIDTH + SG_WIDTH:]
        if last:
            p_kv = h_ctx @ w_in[l][:, DA_WIDTH:3 * DA_WIDTH]
            bc, sc = p_kv.shape[0], p_kv.shape[1]
            k_c = p_kv[..., :DA_WIDTH].reshape(bc, sc, DA_HEADS, 2, DA_HEAD_DIM)
            v_c = p_kv[..., DA_WIDTH:].reshape(bc, sc, DA_HEADS, DA_VDIM)
        else:
            p_ctx = h_ctx @ w_in[l]
            q_c, k_c, v_c = split_heads_qkv(p_ctx)
        k_all = jnp.concatenate([k_c, k_l], axis=1)
        v_all = jnp.concatenate([v_c, v_l], axis=1)
        a_lat = diff_head_out(diff_attention(q_l, k_all, v_all, lam), subln_g[l], lambda_init)
        s_lat = spatial_gating(u_l, g_l, sg_ln_g[l], sg_ln_b[l], sg_w[l], sg_b[l])
        o_lat = jnp.concatenate([a_lat, s_lat], axis=-1) @ w_out[l]
        x_lat = x_lat + ms[2] * rmsnorm(o_lat, post_mix_g[l])
        if not last:
            u_c = p_ctx[..., 3 * DA_WIDTH:3 * DA_WIDTH + SG_WIDTH]
            g_c = p_ctx[..., 3 * DA_WIDTH + SG_WIDTH:]
            a_ctx = diff_head_out(diff_attention(q_c, k_c, v_c, lam), subln_g[l], lambda_init)
            s_ctx = spatial_gating(u_c, g_c, sg_ln_g[l], sg_ln_b[l], sg_w[l], sg_b[l])
            o_ctx = jnp.concatenate([a_ctx, s_ctx], axis=-1) @ w_out[l]
            x_ctx = x_ctx + mc[2] * rmsnorm(o_ctx, post_mix_g[l])

        f_lat = modulate(rmsnorm(x_lat, pre_ffn_g[l]), ms[3], ms[4])
        if l % 2 == 0:
            i = l // 2
            y_lat = swiglu(f_lat, ffn_w1[i], ffn_w3[i], ffn_w2[i])
        else:
            i = l // 2
            y_lat = moe_swiglu(f_lat, router_w[i], moe_w1[i], moe_w3[i], moe_w2[i])
        x_lat = x_lat + ms[5] * rmsnorm(y_lat, post_ffn_g[l])
        if not last:
            f_ctx = modulate(rmsnorm(x_ctx, pre_ffn_g[l]), mc[3], mc[4])
            i = l // 2
            if l % 2 == 0:
                y_ctx = swiglu(f_ctx, ffn_w1[i], ffn_w3[i], ffn_w2[i])
            else:
                y_ctx = moe_swiglu(f_ctx, router_w[i], moe_w1[i], moe_w3[i], moe_w2[i])
            x_ctx = x_ctx + mc[5] * rmsnorm(y_ctx, post_ffn_g[l])
    return x_lat
```

```cpp
#include <hip/hip_runtime.h>
#include <cstdio>
#include <cstdint>

#ifndef DBG_NO_SG
#define DBG_NO_SG 0
#endif
#ifndef DBG_NO_CTX
#define DBG_NO_CTX 0
#endif
#ifndef DBG_NO_LAT
#define DBG_NO_LAT 0
#endif
#ifndef MK_PER_PHASE
#define MK_PER_PHASE 0
#endif

#define LAS __attribute__((address_space(3)))
#define GAS __attribute__((address_space(1)))
typedef unsigned short bf16_t;
typedef short bf16x8 __attribute__((ext_vector_type(8)));
typedef short s16x4 __attribute__((ext_vector_type(4)));
typedef float f32x2 __attribute__((ext_vector_type(2)));
typedef float f32x4 __attribute__((ext_vector_type(4)));
typedef float f32x16 __attribute__((ext_vector_type(16)));
typedef unsigned u32x2 __attribute__((ext_vector_type(2)));
typedef unsigned u32x4 __attribute__((ext_vector_type(4)));
typedef GAS unsigned gu32;

constexpr int D = 1024, BATCH = 16, SEQ = 2048, CTX = 256;
constexpr int MLAT = BATCH * SEQ;
constexpr int MCTX = BATCH * CTX;
constexpr int MALL = MLAT + MCTX;
constexpr int NIN = 2560;
constexpr int COL_Q = 0, COL_U = 512, COL_K = 1024, COL_V = 1536, COL_G = 2048;
constexpr int DFF = 2816, DEXP = 3584, NEXP = 8;
constexpr float EPS = 1e-6f;
constexpr float LAMBDA_INIT0 = 0.2f, LAMBDA_INIT1 = 0.35550907f;

constexpr size_t MiB = 1u << 20;
constexpr size_t WS_CTL = 0, CTL_ZERO_BYTES = 1 * MiB;
constexpr size_t WS_MS = 1 * MiB;
constexpr size_t WS_ROPE = 2 * MiB;
constexpr size_t WS_ROUTE = 3 * MiB;
constexpr size_t WS_SLOT = 4 * MiB;
constexpr size_t WS_WIN = 5 * MiB;
constexpr size_t WS_WOUT = 15 * MiB;
constexpr size_t WS_SGW = 19 * MiB;
constexpr size_t WS_W13 = 20 * MiB;
constexpr size_t WS_W2 = 31 * MiB;
constexpr size_t WS_MW13 = 37 * MiB;
constexpr size_t WS_MW2 = 149 * MiB;
constexpr size_t WS_XCTX = 205 * MiB;
constexpr size_t WS_HA = 221 * MiB;
constexpr size_t WS_R1 = 293 * MiB;
constexpr size_t WS_OY = 491 * MiB;
constexpr size_t WS_YS = 405 * MiB;
constexpr size_t WS_END = 563 * MiB;

constexpr int CW_BAR = 4096;
constexpr int CW_CNT = 64;

constexpr int RING_BYTES = 131072;
constexpr int LDSCTL_OFF = RING_BYTES, MISC_OFF = LDSCTL_OFF + 320;
constexpr int LDS_BYTES = 147456;
constexpr int NWAVES = 8;

#define RLX_AGENT __ATOMIC_RELAXED, __HIP_MEMORY_SCOPE_AGENT
#define LDS_WAIT() asm volatile("s_waitcnt lgkmcnt(0)" ::: "memory")
#define VM_WAIT() asm volatile("s_waitcnt vmcnt(0)" ::: "memory")
#define SBAR() __builtin_amdgcn_sched_barrier(0)

__device__ __forceinline__ unsigned cvt_pk_bf16(float lo, float hi) { unsigned r; asm volatile("v_cvt_pk_bf16_f32 %0, %1, %2" : "=v"(r) : "v"(lo), "v"(hi)); return r; }
__device__ __forceinline__ float bf2f(unsigned short b) { return __builtin_bit_cast(float, (unsigned)b << 16); }
__device__ __forceinline__ float bflo(unsigned w) { return __builtin_bit_cast(float, w << 16); }
__device__ __forceinline__ float bfhi(unsigned w) { return __builtin_bit_cast(float, w & 0xffff0000u); }
__device__ __forceinline__ float wave_sum(float v) {
#pragma unroll
    for (int o = 1; o < 64; o <<= 1) v += __shfl_xor(v, o);
    return v;
}
__device__ __forceinline__ float silu_f(float v) { return v / (1.f + __expf(-v)); }

namespace pg8 {
constexpr int BM = 256, BK = 64, HALF = 128, HTB = HALF * BK * 2, STAGE_BYTES = 8 * HTB, NXCD = 8, WGM = 8;
__host__ __device__ __forceinline__ int lds_byte(int r, int c) { const int st = (r >> 4) * 2 + (c >> 5), rr = r & 15, cc = c & 31, ob = rr * 64 + cc * 2; return st * 1024 + (ob ^ (((ob >> 9) & 1) << 5)); }
__host__ __device__ __forceinline__ void stage_rc(int b, int& R, int& C) { const int st = b / 1024, sb = b % 1024, swz = sb ^ (((sb >> 9) & 1) << 5); R = (st >> 1) * 16 + swz / 64; C = (st & 1) * 32 + (swz % 64) / 2; }
__host__ __device__ __forceinline__ int perm32(int rho) { const int n = rho >> 4, i = rho & 15; return 8 * (i >> 2) + 4 * n + (i & 3); }

struct Unit { const char* Ap; const char* Bp; int pm, pn, aux, aux2; };

__device__ __forceinline__ void tile_of(int L, int nM, int nN, int& pm, int& pn) {
    const int nwg = nM * nN; int wgid = L;
    { const int q = nwg / NXCD, r = nwg % NXCD, xcd = wgid % NXCD, off = wgid / NXCD; wgid = (xcd < r ? xcd * (q + 1) : r * (q + 1) + (xcd - r) * q) + off; }
    const int nig = WGM * nN, gid = wgid / nig, fm = gid * WGM, gsz = (nM - fm) < WGM ? (nM - fm) : WGM;
    pm = fm + ((wgid % nig) % gsz); pn = (wgid % nig) / gsz;
}

template <class Epi, class Sched, bool ALIGN_EPI>
__device__ __forceinline__ void gemm_phase(LAS unsigned char* lds, const int K, const Sched& S, const Epi& E) {
    const int tid = threadIdx.x, wid = __builtin_amdgcn_readfirstlane(tid >> 6), lane = tid & 63, wr = wid >> 2, wc = wid & 3, fr = lane & 15, fq = lane >> 4;
    const int nt = K / BK;
    int R[2], C[2]; unsigned voffB[2];
#pragma unroll
    for (int i = 0; i < 2; ++i) { stage_rc(tid * 16 + i * 8192, R[i], C[i]); const int Rb = Epi::PERM ? ((R[i] & ~31) + perm32(R[i] & 31)) : R[i]; voffB[i] = (unsigned)(Rb * K + C[i]) * 2u; }
    const size_t kstep = (size_t)(BK * 2);
    const size_t hstepB = (size_t)HALF * K * 2;
    const unsigned ldsw = (unsigned)wid * 1024u;
    const int aoff = lds_byte(wr * 64 + fr, fq * 8), boff = lds_byte(wc * 32 + fr, fq * 8);
#define PG8_SA(b, h) (((b) * 2 + (h)) * HTB)
#define PG8_SB(b, h) ((4 + (b) * 2 + (h)) * HTB)
#define PG8_STAGE(bufoff, gbase, voff) do { _Pragma("unroll") for (int _i = 0; _i < 2; ++_i) \
        __builtin_amdgcn_global_load_lds((const unsigned*)((const char*)(gbase) + (voff)[_i]), (LAS unsigned*)(lds + (bufoff) + ldsw + _i * 8192), 16, 0, 0); } while (0)
#define PG8_LDA(dst, b, h) do { _Pragma("unroll") for (int m = 0; m < 4; ++m) _Pragma("unroll") for (int k = 0; k < 2; ++k) dst[m][k] = *(const LAS bf16x8*)(lds + PG8_SA(b, h) + aoff + m * 2048 + k * 1024); } while (0)
#define PG8_LDB(dst, b, h) do { _Pragma("unroll") for (int n = 0; n < 2; ++n) _Pragma("unroll") for (int k = 0; k < 2; ++k) dst[n][k] = *(const LAS bf16x8*)(lds + PG8_SB(b, h) + boff + n * 2048 + k * 1024); } while (0)
#define PG8_MMA(ai, bj, At, Bt) do { __builtin_amdgcn_s_setprio(1); _Pragma("unroll") for (int m = 0; m < 4; ++m) _Pragma("unroll") for (int n = 0; n < 2; ++n) _Pragma("unroll") for (int k = 0; k < 2; ++k) \
        acc[ai][bj][m][n] = __builtin_amdgcn_mfma_f32_16x16x32_bf16(Bt[n][k], At[m][k], acc[ai][bj][m][n], 0, 0, 0); __builtin_amdgcn_s_setprio(0); } while (0)
#define PG8_WAIT_V(n) asm volatile("s_waitcnt vmcnt(" #n ")" ::: "memory")
#define PG8_WAIT_L(n) asm volatile("s_waitcnt lgkmcnt(" #n ")" ::: "memory")
#define PG8_BAR __builtin_amdgcn_s_barrier()
#define PG8_SCHED __builtin_amdgcn_sched_barrier(0)
    Unit cur, nxt; int ui = 0;
    if (!S.next(0, cur)) return;
    f32x4 acc[2][2][4][2];
#pragma unroll
    for (int a = 0; a < 2; ++a)
#pragma unroll
        for (int b = 0; b < 2; ++b)
#pragma unroll
            for (int m = 0; m < 4; ++m)
#pragma unroll
                for (int n = 0; n < 2; ++n) acc[a][b][m][n] = (f32x4){0.f, 0.f, 0.f, 0.f};
    bf16x8 At[4][2], B0[2][2], B1[2][2];
    unsigned cO0[2], cO1[2], nO0[2], nO1[2];
    S.aoff(cur, R, C, cO0, cO1);
    const char* cA = cur.Ap; const char* cB = cur.Bp;
    PG8_STAGE(PG8_SB(0, 0), cB, voffB); PG8_STAGE(PG8_SB(0, 1), cB + hstepB, voffB); PG8_STAGE(PG8_SA(0, 0), cA, cO0); PG8_STAGE(PG8_SA(0, 1), cA, cO1);
    if (wr == 1) PG8_BAR;
    PG8_WAIT_V(2); PG8_BAR;
    PG8_STAGE(PG8_SB(1, 0), cB + kstep, voffB); PG8_STAGE(PG8_SA(1, 0), cA + kstep, cO0); PG8_STAGE(PG8_SB(1, 1), cB + hstepB + kstep, voffB);
    PG8_WAIT_V(6); PG8_BAR;
    for (;;) {
        const bool has_next = S.next(ui + 1, nxt);
        if (has_next) S.aoff(nxt, R, C, nO0, nO1); else { nO0[0] = cO0[0]; nO0[1] = cO0[1]; nO1[0] = cO1[0]; nO1[1] = cO1[1]; }
        const char* nA = has_next ? nxt.Ap : cA; const char* nB = has_next ? nxt.Bp : cB;
        for (int t = 0; t < nt; t += 2) {
            const bool last = (t == nt - 2);
            const char* a1 = cA + (size_t)(t + 1) * kstep;
            const char* a2 = last ? nA : cA + (size_t)(t + 2) * kstep; const char* b2 = last ? nB : cB + (size_t)(t + 2) * kstep;
            const char* a3 = a2 + kstep; const char* b3 = b2 + kstep;
            unsigned xO0[2], xO1[2];
            xO0[0] = last ? nO0[0] : cO0[0]; xO0[1] = last ? nO0[1] : cO0[1]; xO1[0] = last ? nO1[0] : cO1[0]; xO1[1] = last ? nO1[1] : cO1[1];
            PG8_LDB(B0, 0, 0); PG8_LDB(B1, 0, 1); PG8_SCHED; PG8_LDA(At, 0, 0); PG8_STAGE(PG8_SA(1, 1), a1, cO1);
            PG8_WAIT_V(8); PG8_WAIT_L(0); PG8_BAR; PG8_MMA(0, 0, At, B0); PG8_MMA(0, 1, At, B1); PG8_BAR; PG8_SCHED;
            PG8_LDA(At, 0, 1); PG8_STAGE(PG8_SB(0, 0), b2, voffB); PG8_STAGE(PG8_SB(0, 1), b2 + hstepB, voffB); PG8_STAGE(PG8_SA(0, 0), a2, xO0);
            PG8_WAIT_V(8); PG8_WAIT_L(0); PG8_BAR; PG8_MMA(1, 0, At, B0); PG8_MMA(1, 1, At, B1); PG8_BAR; PG8_SCHED;
            PG8_LDB(B0, 1, 0); PG8_LDB(B1, 1, 1); PG8_SCHED; PG8_LDA(At, 1, 0); PG8_STAGE(PG8_SA(0, 1), a2, xO1);
            PG8_WAIT_V(8); PG8_WAIT_L(0); PG8_BAR; PG8_MMA(0, 0, At, B0); PG8_MMA(0, 1, At, B1); PG8_BAR; PG8_SCHED;
            PG8_LDA(At, 1, 1); PG8_STAGE(PG8_SB(1, 0), b3, voffB); PG8_STAGE(PG8_SB(1, 1), b3 + hstepB, voffB); PG8_STAGE(PG8_SA(1, 0), a3, xO0);
            PG8_WAIT_V(8); PG8_WAIT_L(0); PG8_BAR; PG8_MMA(1, 0, At, B0); PG8_MMA(1, 1, At, B1); PG8_BAR; PG8_SCHED;
        }
        if constexpr (ALIGN_EPI) { if (wr == 0) PG8_BAR; }
        E(acc, cur, wr, wc, fr, fq);
        if (!has_next) break;
#pragma unroll
        for (int a = 0; a < 2; ++a)
#pragma unroll
            for (int b = 0; b < 2; ++b)
#pragma unroll
                for (int m = 0; m < 4; ++m)
#pragma unroll
                    for (int n = 0; n < 2; ++n) acc[a][b][m][n] = (f32x4){0.f, 0.f, 0.f, 0.f};
        cur = nxt; cA = nA; cB = nB; ++ui;
        cO0[0] = nO0[0]; cO0[1] = nO0[1]; cO1[0] = nO1[0]; cO1[1] = nO1[1];
        if constexpr (ALIGN_EPI) { if (wr == 1) PG8_BAR; }
    }
    PG8_WAIT_V(0);
    if constexpr (!ALIGN_EPI) { if (wr == 0) PG8_BAR; }
    PG8_BAR;
#undef PG8_SA
#undef PG8_SB
#undef PG8_STAGE
#undef PG8_LDA
#undef PG8_LDB
#undef PG8_MMA
#undef PG8_WAIT_V
#undef PG8_WAIT_L
#undef PG8_BAR
#undef PG8_SCHED
}

struct DenseSched {
    const char* A; const char* Bt; int lda, K, G, c;
    int nM0, nN0, arow0_0, pn0_0, nM1, nN1, arow0_1, pn0_1;
    __device__ __forceinline__ bool next(int i, Unit& u) const {
        int L = i * G + c; const int n0 = nM0 * nN0;
        int pm, pn;
        if (L < n0) { tile_of(L, nM0, nN0, pm, pn); u.pm = arow0_0 / 256 + pm; u.pn = pn0_0 + pn; }
        else { L -= n0; if (L >= nM1 * nN1) return false; tile_of(L, nM1, nN1, pm, pn); u.pm = arow0_1 / 256 + pm; u.pn = pn0_1 + pn; }
        u.Ap = A + (size_t)u.pm * 256 * lda * 2; u.Bp = Bt + (size_t)u.pn * 256 * K * 2; u.aux = 0; u.aux2 = 0; return true;
    }
    __device__ __forceinline__ void aoff(const Unit&, const int (&R)[2], const int (&C)[2], unsigned (&o0)[2], unsigned (&o1)[2]) const {
#pragma unroll
        for (int i = 0; i < 2; ++i) { o0[i] = (unsigned)(R[i] * lda + C[i]) * 2u; o1[i] = (unsigned)((HALF + R[i]) * lda + C[i]) * 2u; }
    }
};

struct EpiPlain {
    static constexpr bool PERM = true;
    bf16_t* O; int ldc;
    __device__ __forceinline__ void operator()(const f32x4 (&acc)[2][2][4][2], const Unit& u, int wr, int wc, int fr, int fq) const {
        const int row0 = u.pm * BM + wr * 64 + fr, col0 = u.pn * BM + wc * 32 + 8 * fq;
#pragma unroll
        for (int ai = 0; ai < 2; ++ai)
#pragma unroll
            for (int m = 0; m < 4; ++m) { bf16_t* rowp = O + (size_t)(row0 + ai * HALF + m * 16) * ldc + col0;
#pragma unroll
                for (int bj = 0; bj < 2; ++bj) { const f32x4 v0 = acc[ai][bj][m][0], v1 = acc[ai][bj][m][1];
                    u32x4 w; w.x = cvt_pk_bf16(v0[0], v0[1]); w.y = cvt_pk_bf16(v0[2], v0[3]); w.z = cvt_pk_bf16(v1[0], v1[1]); w.w = cvt_pk_bf16(v1[2], v1[3]);
                    *(u32x4*)(rowp + bj * HALF) = w; } }
    }
};
struct EpiInProj {
    static constexpr bool PERM = true;
    bf16_t* O; const float* ropec; const float* ropes;
    __device__ __forceinline__ void operator()(const f32x4 (&acc)[2][2][4][2], const Unit& u, int wr, int wc, int fr, int fq) const {
        const int row0 = u.pm * BM + wr * 64 + fr, col0 = u.pn * BM + wc * 32 + 8 * fq;
        const bool rope = (u.pm < MLAT / 256) && (u.pn < 2 || (u.pn >= 4 && u.pn < 6));
        const bool colpos = (wc & 1) != 0;
#pragma unroll
        for (int ai = 0; ai < 2; ++ai)
#pragma unroll
            for (int m = 0; m < 4; ++m) { const int row = row0 + ai * HALF + m * 16; bf16_t* rowp = O + (size_t)row * NIN + col0;
                f32x4 cs = {1.f, 1.f, 1.f, 1.f}, sn = {0.f, 0.f, 0.f, 0.f};
                if (rope) { const int t = row & (SEQ - 1), pos = colpos ? (t & 63) : (t >> 6); cs = *(const f32x4*)(ropec + pos * 16 + 4 * fq); sn = *(const f32x4*)(ropes + pos * 16 + 4 * fq); }
#pragma unroll
                for (int bj = 0; bj < 2; ++bj) { const f32x4 a = acc[ai][bj][m][0], b = acc[ai][bj][m][1];
                    const f32x4 v0 = a * cs - b * sn, v1 = b * cs + a * sn;
                    u32x4 w; w.x = cvt_pk_bf16(v0[0], v0[1]); w.y = cvt_pk_bf16(v0[2], v0[3]); w.z = cvt_pk_bf16(v1[0], v1[1]); w.w = cvt_pk_bf16(v1[2], v1[3]);
                    *(u32x4*)(rowp + bj * HALF) = w; } }
    }
};
struct EpiSwiglu {
    static constexpr bool PERM = true;
    bf16_t* O; int ldc;
    __device__ __forceinline__ void operator()(const f32x4 (&acc)[2][2][4][2], const Unit& u, int wr, int wc, int fr, int fq) const {
        const int row0 = u.pm * BM + wr * 64 + fr, col0 = u.pn * HALF + wc * 32 + 8 * fq;
#pragma unroll
        for (int ai = 0; ai < 2; ++ai)
#pragma unroll
            for (int m = 0; m < 4; ++m) { bf16_t* rowp = O + (size_t)(row0 + ai * HALF + m * 16) * ldc + col0;
                f32x4 v[2];
#pragma unroll
                for (int n = 0; n < 2; ++n) { const f32x4 a = acc[ai][0][m][n], b = acc[ai][1][m][n];
#pragma unroll
                    for (int j = 0; j < 4; ++j) v[n][j] = a[j] * __builtin_amdgcn_rcpf(1.f + __builtin_amdgcn_exp2f(-1.4426950408889634f * a[j])) * b[j]; }
                u32x4 w; w.x = cvt_pk_bf16(v[0][0], v[0][1]); w.y = cvt_pk_bf16(v[0][2], v[0][3]); w.z = cvt_pk_bf16(v[1][0], v[1][1]); w.w = cvt_pk_bf16(v[1][2], v[1][3]);
                *(u32x4*)rowp = w; }
    }
};
}

namespace att {
constexpr int LDP = NIN;
constexpr int SHM_V = 64 * 128 * 2, SHM_K = 64 * 128 * 2;
constexpr int OFF_V = 0, OFF_K = 2 * SHM_V, OFF_WS = OFF_K + 2 * SHM_K, OFF_OST = OFF_WS + NWAVES * 64 * 4, ATT_LDS = OFF_OST + 4 * 8192;
static_assert(ATT_LDS <= RING_BYTES, "attention LDS");
constexpr float SCALE = 0.125f;
constexpr float THR = 8.f;
#define KSWZ(row, colB) ((row) * 256 + ((colB) ^ (((row) & 7) << 4)))
__device__ __forceinline__ int crow(int r, int hi) { return (r & 3) + 8 * (r >> 2) + 4 * hi; }

__device__ __forceinline__ void partialSM(f32x16& p0, f32x16& p1, float& m_reg, float& mn, float& alpha) {
    constexpr float C = SCALE * 1.4426950408889634f;
    float pmax = p0[0];
#pragma unroll
    for (int r = 1; r < 16; ++r) pmax = fmaxf(pmax, p0[r]);
#pragma unroll
    for (int r = 0; r < 16; ++r) pmax = fmaxf(pmax, p1[r]);
    { auto rr = __builtin_amdgcn_permlane32_swap(__float_as_uint(pmax), __float_as_uint(pmax), false, false);
      pmax = fmaxf(__uint_as_float(rr[0]), __uint_as_float(rr[1])); }
    if (__builtin_expect(__all(pmax - m_reg <= THR / SCALE), 1)) { mn = m_reg; alpha = 1.f; }
    else { mn = fmaxf(m_reg, pmax); alpha = __builtin_amdgcn_exp2f((m_reg - mn) * C); m_reg = mn; }
    const float mnC = -mn * C;
#pragma unroll
    for (int r = 0; r < 16; ++r) p0[r] = fmaf(p0[r], C, mnC);
#pragma unroll
    for (int r = 0; r < 16; ++r) p1[r] = fmaf(p1[r], C, mnC);
#pragma unroll
    for (int r = 0; r < 16; ++r) p0[r] = __builtin_amdgcn_exp2f(p0[r]);
}
__device__ __forceinline__ void finishSM(f32x16& p0, f32x16& p1, float alpha, float& l_reg, bf16x8& pa0, bf16x8& pa1, bf16x8& pa2, bf16x8& pa3) {
#pragma unroll
    for (int r = 0; r < 16; ++r) p1[r] = __builtin_amdgcn_exp2f(p1[r]);
    float ps = 0;
#pragma unroll
    for (int r = 0; r < 16; ++r) ps += p0[r];
#pragma unroll
    for (int r = 0; r < 16; ++r) ps += p1[r];
    { auto rr = __builtin_amdgcn_permlane32_swap(__float_as_uint(ps), __float_as_uint(ps), false, false);
      ps = __uint_as_float(rr[0]) + __uint_as_float(rr[1]); }
    l_reg = l_reg * alpha + ps;
#define PK4(P, BASE, OUT) do { unsigned a0 = cvt_pk_bf16(P[BASE + 0], P[BASE + 1]), a1 = cvt_pk_bf16(P[BASE + 2], P[BASE + 3]);   \
    unsigned b0 = cvt_pk_bf16(P[BASE + 4], P[BASE + 5]), b1 = cvt_pk_bf16(P[BASE + 6], P[BASE + 7]);                              \
    auto r0 = __builtin_amdgcn_permlane32_swap(a0, b0, false, false); auto r1 = __builtin_amdgcn_permlane32_swap(a1, b1, false, false); \
    u32x4 w = {r0[0], r1[0], r0[1], r1[1]}; OUT = __builtin_bit_cast(bf16x8, w); } while (0)
    PK4(p0, 0, pa0); PK4(p0, 8, pa1); PK4(p1, 0, pa2); PK4(p1, 8, pa3);
#undef PK4
}
__device__ __forceinline__ void qkt(f32x16& p0, f32x16& p1, const char* Ks, const bf16x8 (&qr)[4], int r32, int hi, int cb0) {
    p0 = f32x16{}; p1 = f32x16{};
#pragma unroll
    for (int d0 = 0; d0 < 4; ++d0) { const int cb = cb0 + (d0 * 16 + hi * 8) * 2;
        const bf16x8 b0 = *reinterpret_cast<const bf16x8*>(Ks + KSWZ(r32, cb));
        const bf16x8 b1 = *reinterpret_cast<const bf16x8*>(Ks + KSWZ(32 + r32, cb));
        p0 = __builtin_amdgcn_mfma_f32_32x32x16_bf16(b0, qr[d0], p0, 0, 0, 0);
        p1 = __builtin_amdgcn_mfma_f32_32x32x16_bf16(b1, qr[d0], p1, 0, 0, 0); }
}
__device__ __forceinline__ int v_st(int k, int c) { const int kk = (k & ~0xC) | ((k & 4) << 1) | ((k & 8) >> 1); return ((kk >> 3) * 4 + (c >> 5)) * 512 + ((kk & 7) * 32 + (c & 31)) * 2; }
__device__ __forceinline__ int v_rd_base(int lane) { return ((lane & 3) << 3) | (((lane >> 2) & 3) << 6) | (((lane >> 4) & 1) << 5) | (((lane >> 5) & 1) << 8); }
constexpr int v_rd_off(int d0, int ks, int half) { return d0 * 512 + ks * 4096 + half * 2048; }
template <int OFF> __device__ __forceinline__ s16x4 tr_read(int vb) {
    s16x4 r; asm volatile("ds_read_b64_tr_b16 %0, %1 offset:%2" : "=&v"(r) : "v"(vb), "i"(OFF) : "memory"); return r;
}
template <int D0> __device__ __forceinline__ void pv_one(f32x16& od, int vb, bf16x8 pa0, bf16x8 pa1, bf16x8 pa2, bf16x8 pa3) {
    const s16x4 l0 = tr_read<v_rd_off(D0, 0, 0)>(vb), h0 = tr_read<v_rd_off(D0, 0, 1)>(vb), l1 = tr_read<v_rd_off(D0, 1, 0)>(vb), h1 = tr_read<v_rd_off(D0, 1, 1)>(vb);
    const s16x4 l2 = tr_read<v_rd_off(D0, 2, 0)>(vb), h2 = tr_read<v_rd_off(D0, 2, 1)>(vb), l3 = tr_read<v_rd_off(D0, 3, 0)>(vb), h3 = tr_read<v_rd_off(D0, 3, 1)>(vb);
    asm volatile("s_waitcnt lgkmcnt(0)" ::: "memory"); SBAR();
#define PKV(L, H) (bf16x8){L[0], L[1], L[2], L[3], H[0], H[1], H[2], H[3]}
    od = __builtin_amdgcn_mfma_f32_32x32x16_bf16(pa0, PKV(l0, h0), od, 0, 0, 0);
    od = __builtin_amdgcn_mfma_f32_32x32x16_bf16(pa1, PKV(l1, h1), od, 0, 0, 0);
    od = __builtin_amdgcn_mfma_f32_32x32x16_bf16(pa2, PKV(l2, h2), od, 0, 0, 0);
    od = __builtin_amdgcn_mfma_f32_32x32x16_bf16(pa3, PKV(l3, h3), od, 0, 0, 0);
#undef PKV
}
__device__ __forceinline__ void pv_d0(f32x16* o, int vb, bf16x8 pa0, bf16x8 pa1, bf16x8 pa2, bf16x8 pa3) {
    pv_one<0>(o[0], vb, pa0, pa1, pa2, pa3); pv_one<1>(o[1], vb, pa0, pa1, pa2, pa3); pv_one<2>(o[2], vb, pa0, pa1, pa2, pa3); pv_one<3>(o[3], vb, pa0, pa1, pa2, pa3);
}

__device__ __forceinline__ void attn_unit(const bf16_t* __restrict__ Qb, const bf16_t* __restrict__ Ks0, int nt0, const bf16_t* __restrict__ Ks1, int nt1,
                                          bf16_t* Ob, float lam, float oscale, const float* __restrict__ subg, char* lds) {
    int tid = threadIdx.x; asm volatile("" : "+v"(tid));
    const int wid = __builtin_amdgcn_readfirstlane(tid >> 6), lane = tid & 63, r32 = lane & 31, hi = lane >> 5, map = wid >> 2, w4 = wid & 3;
    char* V_lds = lds + OFF_V; char* K_lds = lds + OFF_K;
    float* ws = (float*)(lds + OFF_WS) + wid * 64; float* li_l = ws; float* al_l = ws + 32;
    float m_reg = -1e30f, l_reg = 0; f32x16 o[4] = {}; bf16x8 qr[4];
    const bf16_t* Qw = Qb + (long)(w4 * 32 + r32) * LDP + map * 64 + hi * 8;
#pragma unroll
    for (int d0 = 0; d0 < 4; ++d0) qr[d0] = *reinterpret_cast<const bf16x8*>(Qw + d0 * 16);
    const int cb0 = map * 128;
    const int sr = tid >> 4, sc = (tid & 15) * 8, vst0 = v_st(sr, sc), vst1 = v_st(32 + sr, sc);
    const int vb0 = (int)(uintptr_t)V_lds + v_rd_base(lane);
    struct { bf16x8 vs0, vs1, ks0, ks1; } sr_[2];
    const int NT = nt0 + nt1;
#define TILEP(j) ((j) < nt0 ? Ks0 + (long)(j) * 64 * LDP : Ks1 + (long)((j) - nt0) * 64 * LDP)
#define SLOAD(i, j) do { const bf16_t* _kb = TILEP(j); sr_[i].vs0 = *reinterpret_cast<const bf16x8*>(_kb + 512 + (long)sr * LDP + sc); sr_[i].vs1 = *reinterpret_cast<const bf16x8*>(_kb + 512 + (long)(32 + sr) * LDP + sc); \
    sr_[i].ks0 = *reinterpret_cast<const bf16x8*>(_kb + (long)sr * LDP + sc); sr_[i].ks1 = *reinterpret_cast<const bf16x8*>(_kb + (long)(32 + sr) * LDP + sc); } while (0)
#define SWRITE(b, i) do { *(bf16x8*)(V_lds + (b) * SHM_V + vst0) = sr_[i].vs0; *(bf16x8*)(V_lds + (b) * SHM_V + vst1) = sr_[i].vs1; const int kc = sc * 2;               \
    *(bf16x8*)(K_lds + (b) * SHM_K + KSWZ(sr, kc)) = sr_[i].ks0; *(bf16x8*)(K_lds + (b) * SHM_K + KSWZ(32 + sr, kc)) = sr_[i].ks1; } while (0)
#define SWAIT() asm volatile("s_waitcnt vmcnt(4)" ::: "memory")
#define RESC(a) do { if (__any((a) < 1.f)) { if (hi == 0) al_l[r32] = (a); asm volatile("s_waitcnt lgkmcnt(0)" ::: "memory"); \
    _Pragma("unroll") for (int d = 0; d < 4; ++d) _Pragma("unroll") for (int r = 0; r < 16; ++r) o[d][r] *= al_l[crow(r, hi)]; } } while (0)
    f32x16 pA0, pA1, pB0, pB1; float mnA, mnB, alA, alB; bf16x8 pa0, pa1, pa2, pa3;
    SLOAD(0, 0); asm volatile("s_waitcnt vmcnt(0)" ::: "memory"); SWRITE(0, 0); __syncthreads();
    qkt(pA0, pA1, K_lds, qr, r32, hi, cb0); partialSM(pA0, pA1, m_reg, mnA, alA);
    SLOAD(1, 1); if (2 < NT) SLOAD(0, 2);
    SWAIT(); SWRITE(1, 1); __syncthreads();
    for (int j = 1; j + 1 < NT; j += 2) {
        SBAR(); qkt(pB0, pB1, K_lds + SHM_K, qr, r32, hi, cb0);
        finishSM(pA0, pA1, alA, l_reg, pa0, pa1, pa2, pa3); SBAR();
        SLOAD(1, j + 2); SBAR();
        pv_d0(o, vb0, pa0, pa1, pa2, pa3); partialSM(pB0, pB1, m_reg, mnB, alB);
        __syncthreads(); SWAIT(); SWRITE(0, 0);
        RESC(alB); __syncthreads();
        SBAR(); qkt(pA0, pA1, K_lds, qr, r32, hi, cb0);
        finishSM(pB0, pB1, alB, l_reg, pa0, pa1, pa2, pa3); SBAR();
        if (j + 3 < NT) SLOAD(0, j + 3); SBAR();
        pv_d0(o, vb0 + SHM_V, pa0, pa1, pa2, pa3); partialSM(pA0, pA1, m_reg, mnA, alA);
        __syncthreads(); SWAIT(); SWRITE(1, 1);
        RESC(alA); __syncthreads();
    }
    SBAR(); qkt(pB0, pB1, K_lds + SHM_K, qr, r32, hi, cb0);
    finishSM(pA0, pA1, alA, l_reg, pa0, pa1, pa2, pa3); SBAR();
    pv_d0(o, vb0, pa0, pa1, pa2, pa3); partialSM(pB0, pB1, m_reg, mnB, alB);
    __syncthreads(); RESC(alB);
    finishSM(pB0, pB1, alB, l_reg, pa0, pa1, pa2, pa3); SBAR();
    pv_d0(o, vb0 + SHM_V, pa0, pa1, pa2, pa3);
    if (hi == 0) li_l[r32] = l_reg; asm volatile("s_waitcnt lgkmcnt(0)" ::: "memory");
    float rli[16];
#pragma unroll
    for (int r = 0; r < 16; ++r) rli[r] = __builtin_amdgcn_rcpf(li_l[crow(r, hi)]) * (map ? lam : 1.f);
    __syncthreads();
    float* X = (float*)lds + w4 * (32 * 128);
    if (map == 1) {
#pragma unroll
        for (int r = 0; r < 16; ++r)
#pragma unroll
            for (int d0 = 0; d0 < 4; ++d0) X[crow(r, hi) * 128 + d0 * 32 + r32] = o[d0][r] * rli[r];
    }
    __syncthreads();
    if (map == 0) {
        float ss[16];
#pragma unroll
        for (int r = 0; r < 16; ++r) { float s = 0.f;
#pragma unroll
            for (int d0 = 0; d0 < 4; ++d0) { const float v = o[d0][r] * rli[r] - X[crow(r, hi) * 128 + d0 * 32 + r32]; o[d0][r] = v; s += v * v; }
            ss[r] = s; }
#pragma unroll
        for (int r = 0; r < 16; ++r) { float s = ss[r]; s += __shfl_xor(s, 1); s += __shfl_xor(s, 2); s += __shfl_xor(s, 4); s += __shfl_xor(s, 8); s += __shfl_xor(s, 16);
            ss[r] = __builtin_amdgcn_rsqf(s * (1.f / 128.f) + EPS) * oscale; }
        bf16_t* Ost = (bf16_t*)(lds + OFF_OST) + w4 * 4096;
#pragma unroll
        for (int d0 = 0; d0 < 4; ++d0) { const float g = subg[d0 * 32 + r32];
#pragma unroll
            for (int r = 0; r < 16; ++r) Ost[crow(r, hi) * 128 + d0 * 32 + r32] = (bf16_t)(cvt_pk_bf16(o[d0][r] * ss[r] * g, 0.f) & 0xffffu); }
        asm volatile("s_waitcnt lgkmcnt(0)" ::: "memory");
#pragma unroll
        for (int it = 0; it < 8; ++it) { const int row = it * 4 + (lane >> 4), ch = lane & 15;
            const u32x4 w = *(const u32x4*)(Ost + row * 128 + ch * 8);
            *(u32x4*)(Ob + (long)(w4 * 32 + row) * LDP + ch * 8) = w; }
    }
    __syncthreads();
#undef TILEP
#undef SLOAD
#undef SWRITE
#undef SWAIT
#undef RESC
}

__device__ __forceinline__ void sg_unit(bf16_t* P0, const bf16_t* __restrict__ sgw, const float* __restrict__ lng, const float* __restrict__ lnb, const float* __restrict__ sgb, char* lds) {
    int tid = threadIdx.x; asm volatile("" : "+v"(tid));
    const int wid = __builtin_amdgcn_readfirstlane(tid >> 6), lane = tid & 63, r32 = lane & 31, hi = lane >> 5;
    float* stat = (float*)(lds + 65536);
    for (int i = 0; i < 16; ++i) { const int tkn = wid * 16 + i;
        const u32x4 w = *(const u32x4*)(P0 + (long)tkn * LDP + COL_G + lane * 8);
        float x[8] = {bflo(w.x), bfhi(w.x), bflo(w.y), bfhi(w.y), bflo(w.z), bfhi(w.z), bflo(w.w), bfhi(w.w)};
        float s = 0.f;
#pragma unroll
        for (int j = 0; j < 8; ++j) s += x[j];
        const float mean = wave_sum(s) * (1.f / 512.f); float q = 0.f;
#pragma unroll
        for (int j = 0; j < 8; ++j) { const float d = x[j] - mean; q += d * d; }
        const float rstd = __builtin_amdgcn_rsqf(wave_sum(q) * (1.f / 512.f) + EPS);
        if (lane == 0) { stat[tkn * 2] = mean; stat[tkn * 2 + 1] = rstd; } }
    __syncthreads();
    const int sr = tid >> 4, sc = (tid & 15) * 8;
    const int vb0 = (int)(uintptr_t)lds + v_rd_base(lane);
    const int mt = wid & 3, eh = wid >> 2;
    for (int g = 0; g < 4; ++g) {
        f32x4 ga = *(const f32x4*)(lng + g * 128 + sc), gb = *(const f32x4*)(lng + g * 128 + sc + 4), ba = *(const f32x4*)(lnb + g * 128 + sc), bb = *(const f32x4*)(lnb + g * 128 + sc + 4);
#pragma unroll
        for (int q4 = 0; q4 < 4; ++q4) { const int tkn = q4 * 32 + sr;
            const u32x4 w = *(const u32x4*)(P0 + (long)tkn * LDP + COL_G + g * 128 + sc);
            const float mean = stat[tkn * 2], rstd = stat[tkn * 2 + 1];
            float x[8] = {bflo(w.x), bfhi(w.x), bflo(w.y), bfhi(w.y), bflo(w.z), bfhi(w.z), bflo(w.w), bfhi(w.w)};
            u32x4 ov;
            ov.x = cvt_pk_bf16((x[0] - mean) * rstd * ga[0] + ba[0], (x[1] - mean) * rstd * ga[1] + ba[1]);
            ov.y = cvt_pk_bf16((x[2] - mean) * rstd * ga[2] + ba[2], (x[3] - mean) * rstd * ga[3] + ba[3]);
            ov.z = cvt_pk_bf16((x[4] - mean) * rstd * gb[0] + bb[0], (x[5] - mean) * rstd * gb[1] + bb[1]);
            ov.w = cvt_pk_bf16((x[6] - mean) * rstd * gb[2] + bb[2], (x[7] - mean) * rstd * gb[3] + bb[3]);
            *(u32x4*)(lds + (tkn >> 6) * SHM_V + v_st(tkn & 63, sc)) = ov; }
        __syncthreads();
        f32x16 oa = {}, ob = {};
        const bf16_t* Wp = sgw + (size_t)g * 128 * 128 + (size_t)(mt * 32 + r32) * 128 + hi * 8;
#pragma unroll
        for (int tq = 0; tq < 2; ++tq) {
            const bf16x8 a0 = *(const bf16x8*)(Wp + tq * 64), a1 = *(const bf16x8*)(Wp + tq * 64 + 16), a2 = *(const bf16x8*)(Wp + tq * 64 + 32), a3 = *(const bf16x8*)(Wp + tq * 64 + 48);
            if (eh == 0) { pv_one<0>(oa, vb0 + tq * SHM_V, a0, a1, a2, a3); pv_one<1>(ob, vb0 + tq * SHM_V, a0, a1, a2, a3); }
            else         { pv_one<2>(oa, vb0 + tq * SHM_V, a0, a1, a2, a3); pv_one<3>(ob, vb0 + tq * SHM_V, a0, a1, a2, a3); }
        }
#pragma unroll
        for (int r = 0; r < 16; ++r) { const int p = mt * 32 + crow(r, hi); const float bs = sgb[g * 128 + p];
            bf16_t* up = P0 + (long)p * LDP + COL_U + g * 128 + eh * 64 + r32;
            const float u0 = bf2f(up[0]), u1 = bf2f(up[32]);
            up[0] = (bf16_t)(cvt_pk_bf16(u0 * (oa[r] + bs), 0.f) & 0xffffu); up[32] = (bf16_t)(cvt_pk_bf16(u1 * (ob[r] + bs), 0.f) & 0xffffu); }
        __syncthreads();
    }
}
}

#define XB_TMO      128
#define XB_XCNT(j)  (256  + 64 * (j))
#define XB_XSUB(j)  (1280 + 64 * (j))
#define XB_XGEN(j)  (2304 + 64 * (j))
#define XB_TOP      3328
#define XB_TOPGEN   3392
#define XCD_BAR_WORDS 3456
#define XB_SPIN_CAP (1u << 18)
__device__ __forceinline__ unsigned xb_ld(unsigned* p)              { return __hip_atomic_load(p, __ATOMIC_RELAXED, __HIP_MEMORY_SCOPE_AGENT); }
__device__ __forceinline__ unsigned xb_add(unsigned* p, unsigned v) { return __hip_atomic_fetch_add(p, v, __ATOMIC_RELAXED, __HIP_MEMORY_SCOPE_AGENT); }
__device__ __forceinline__ unsigned xb_xcc_id() { return (unsigned)__builtin_amdgcn_s_getreg((3 << 11) | 20) & 0xFu; }
#define XB_SPIN(cond, bar) do { unsigned _sp = 0; while (cond) { __builtin_amdgcn_s_sleep(1); \
    if ((++_sp & 255u) == 0u) { if (xb_ld(&(bar)[XB_TMO])) break; if (_sp > XB_SPIN_CAP) { atomicAdd(&(bar)[XB_TMO], 1u); break; } } } } while (0)
struct XcdBarrier { unsigned* bar; unsigned x; volatile LAS unsigned* st; };
__device__ __forceinline__ XcdBarrier xcd_barrier_post(unsigned* bar, volatile LAS unsigned* st) {
    XcdBarrier b; b.bar = bar; b.x = xb_xcc_id(); b.st = st;
    if (threadIdx.x == 0) (void)xb_add(&bar[XB_XCNT(b.x)], 1u);
    return b;
}
__device__ __forceinline__ void xcd_barrier_complete(unsigned* bar, unsigned x, unsigned& nloc, unsigned& nx) {
    const unsigned G = gridDim.x * gridDim.y * gridDim.z;
    unsigned sum, cnt, mine, sp = 0u;
    for (;;) {
        sum = 0u; cnt = 0u; mine = 0u;
#pragma unroll
        for (unsigned j = 0; j < 16; ++j) { const unsigned c = xb_ld(&bar[XB_XCNT(j)]); sum += c; cnt += (c > 0u) ? 1u : 0u; mine = (j == x) ? c : mine; }
        if (sum == G) break;
        __builtin_amdgcn_s_sleep(1);
        if ((++sp & 255u) == 0u) { if (xb_ld(&bar[XB_TMO])) break; if (sp > XB_SPIN_CAP) { atomicAdd(&bar[XB_TMO], 1u); break; } }
    }
    nloc = mine > 0u ? mine : 1u; nx = cnt > 0u ? cnt : 1u;
}
__device__ __forceinline__ void xcd_barrier(const XcdBarrier& b) {
    asm volatile("s_waitcnt vmcnt(0)" ::: "memory");
    __syncthreads();
    if (threadIdx.x == 0) {
        unsigned* bar = b.bar;
        __builtin_amdgcn_s_waitcnt(0);
        unsigned nloc = b.st[0], nx = b.st[1];
        if (nloc == 0u) { xcd_barrier_complete(bar, b.x, nloc, nx); b.st[0] = nloc; b.st[1] = nx; }
        const unsigned old = xb_add(&bar[XB_XSUB(b.x)], 1u);
        const unsigned gen = old / nloc;
        if (old + 1u == (gen + 1u) * nloc) {
            __builtin_amdgcn_fence(__ATOMIC_RELEASE, "agent");
            asm volatile("s_waitcnt vmcnt(0)" ::: "memory");
            const unsigned og = xb_add(&bar[XB_TOP], 1u);
            const unsigned tg = og / nx;
            if (og + 1u == (tg + 1u) * nx) xb_add(&bar[XB_TOPGEN], 1u);
            else XB_SPIN(xb_ld(&bar[XB_TOPGEN]) == tg, bar);
            __builtin_amdgcn_fence(__ATOMIC_ACQUIRE, "agent");
            xb_add(&bar[XB_XGEN(b.x)], 1u);
            asm volatile("s_waitcnt vmcnt(0)" ::: "memory");
        } else {
            XB_SPIN(xb_ld(&bar[XB_XGEN(b.x)]) == gen, bar);
            __builtin_amdgcn_fence(__ATOMIC_ACQUIRE, "agent");
            asm volatile("s_waitcnt vmcnt(0)" ::: "memory");
        }
    }
    __syncthreads();
}

struct Args {
    const float* in[28]; float* out; unsigned char* ws; int ph_lo, ph_hi;
};
struct Frame {
    LAS unsigned char* lds; gu32* ctl; int tid, lane, wave, vcu, G;
};

__device__ __forceinline__ void transpose_item(const float* __restrict__ W, int ldw, int srcg, bool rope, int k0, bf16_t* WT, size_t dst_row0, int K, LAS float* scr, int lane) {
    const int j = lane & 31, sj = rope ? ((j & 3) + 4 * (j >> 3) + 16 * ((j >> 2) & 1)) : j;
    float v[32];
#pragma unroll
    for (int i = 0; i < 32; ++i) { const int kk = 2 * i + (lane >> 5); v[i] = W[(size_t)(k0 + kk) * ldw + srcg + sj]; }
#pragma unroll
    for (int i = 0; i < 32; ++i) { const int kk = 2 * i + (lane >> 5); scr[kk * 33 + j] = v[i]; }
    LDS_WAIT(); asm volatile("" ::: "memory");
    const int c = lane & 7;
#pragma unroll
    for (int jj = 0; jj < 4; ++jj) { const int n = (lane >> 3) + 8 * jj; const LAS float* s = scr + (8 * c) * 33 + n;
        u32x4 o; o.x = cvt_pk_bf16(s[0 * 33], s[1 * 33]); o.y = cvt_pk_bf16(s[2 * 33], s[3 * 33]); o.z = cvt_pk_bf16(s[4 * 33], s[5 * 33]); o.w = cvt_pk_bf16(s[6 * 33], s[7 * 33]);
        *(u32x4*)(WT + (dst_row0 + n) * K + k0 + 8 * c) = o; }
    LDS_WAIT(); asm volatile("" ::: "memory");
}

__device__ __forceinline__ void p0_prologue(Frame& F, const Args& a) {
    unsigned char* ws = a.ws;
    if (blockIdx.x < 192) {
        const int l = blockIdx.x / 96, n0 = (blockIdx.x % 96) * 64;
        LAS float* s = (LAS float*)F.lds;
        LAS float* red = (LAS float*)(F.lds + 73728);
        const float* c = a.in[1]; const float* cc = a.in[3];
        for (int i = F.tid; i < 17 * 1024; i += 512) { const float v = i < 16 * 1024 ? c[i] : cc[i - 16 * 1024]; s[i] = silu_f(v); }
        __syncthreads();
        const float* W = a.in[4] + (size_t)l * D * 6144 + n0 + F.lane;
        float acc[17];
#pragma unroll
        for (int r = 0; r < 17; ++r) acc[r] = 0.f;
        const int kb = F.wave * 128;
        for (int k = 0; k < 128; k += 4) {
            const float w0 = W[(size_t)(kb + k) * 6144], w1 = W[(size_t)(kb + k + 1) * 6144], w2 = W[(size_t)(kb + k + 2) * 6144], w3 = W[(size_t)(kb + k + 3) * 6144];
#pragma unroll
            for (int r = 0; r < 17; ++r) { const f32x4 sv = *(const LAS f32x4*)(s + r * 1024 + kb + k); acc[r] += sv[0] * w0 + sv[1] * w1 + sv[2] * w2 + sv[3] * w3; }
        }
#pragma unroll
        for (int r = 0; r < 17; ++r) red[(F.wave * 17 + r) * 64 + F.lane] = acc[r];
        __syncthreads();
        float* ms = (float*)(ws + WS_MS) + (size_t)l * 17 * 6144;
        const float* bias = a.in[5] + (size_t)l * 6144;
        for (int i = F.tid; i < 17 * 64; i += 512) { const int r = i >> 6, col = i & 63; float v = bias[n0 + col];
#pragma unroll
            for (int w = 0; w < 8; ++w) v += red[(w * 17 + r) * 64 + col];
            ms[(size_t)r * 6144 + n0 + col] = v; }
        __syncthreads();
    }
    if (blockIdx.x == 255) {
        float* rc = (float*)(ws + WS_ROPE); float* rs = rc + 1024;
        for (int i = F.tid; i < 1024; i += 512) { const int pos = i >> 4, j = i & 15; const float inv = powf(10000.0f, -(float)(2 * j) / 32.0f); const float ang = (float)pos * inv; rc[i] = cosf(ang); rs[i] = sinf(ang); }
    }
    { const float* src = a.in[19]; bf16_t* dst = (bf16_t*)(ws + WS_SGW); const int n4 = 2 * 4 * 128 * 128 / 4;
      for (int i = blockIdx.x * 512 + F.tid; i < n4; i += F.G * 512) { const f32x4 v = *(const f32x4*)(src + (size_t)i * 4); u32x2 o; o.x = cvt_pk_bf16(v[0], v[1]); o.y = cvt_pk_bf16(v[2], v[3]); *(u32x2*)(dst + (size_t)i * 4) = o; } }
    LAS float* scr = (LAS float*)(F.lds + F.wave * 16384);
    const int gw = F.vcu * NWAVES + F.wave, NGW = F.G * NWAVES;
    constexpr int I_IN = 16 * 80, I_OUT = 16 * 32, I_F13 = 16 * 176, I_F2 = 44 * 32, I_M13 = 16 * 224, I_M2 = 56 * 32;
    constexpr int NITEMS = 2 * I_IN + 2 * I_OUT + I_F13 + I_F2 + 8 * I_M13 + 8 * I_M2;
    for (int it = gw; it < NITEMS; it += NGW) {
        int r = it;
        if (r < 2 * I_IN) { const int l = r / I_IN; r %= I_IN; const int kb = r / 80, g = r % 80, seg = g >> 4, gi = g & 15;
            const int sseg = seg == 0 ? 0 : seg == 1 ? 3 : seg == 2 ? 1 : seg == 3 ? 2 : 4;
            transpose_item(a.in[10] + (size_t)l * D * NIN, NIN, sseg * 512 + gi * 32, seg == 0 || seg == 2, kb * 64, (bf16_t*)(ws + WS_WIN) + (size_t)l * NIN * D, (size_t)g * 32, D, scr, F.lane); continue; }
        r -= 2 * I_IN;
        if (r < 2 * I_OUT) { const int l = r / I_OUT; r %= I_OUT; const int kb = r / 32, g = r % 32;
            transpose_item(a.in[11] + (size_t)l * D * D, D, g * 32, false, kb * 64, (bf16_t*)(ws + WS_WOUT) + (size_t)l * D * D, (size_t)g * 32, D, scr, F.lane); continue; }
        r -= 2 * I_OUT;
        if (r < I_F13) { const int kb = r / 176, g = r % 176, tile = g >> 3, gi = g & 7;
            const float* src = gi < 4 ? a.in[21] : a.in[22];
            transpose_item(src, DFF, tile * 128 + (gi & 3) * 32, false, kb * 64, (bf16_t*)(ws + WS_W13), (size_t)g * 32, D, scr, F.lane); continue; }
        r -= I_F13;
        if (r < I_F2) { const int kb = r / 32, g = r % 32;
            transpose_item(a.in[23], D, g * 32, false, kb * 64, (bf16_t*)(ws + WS_W2), (size_t)g * 32, DFF, scr, F.lane); continue; }
        r -= I_F2;
        if (r < 8 * I_M13) { const int e = r / I_M13; r %= I_M13; const int kb = r / 224, g = r % 224, tile = g >> 3, gi = g & 7;
            const float* src = (gi < 4 ? a.in[25] : a.in[26]) + (size_t)e * D * DEXP;
            transpose_item(src, DEXP, tile * 128 + (gi & 3) * 32, false, kb * 64, (bf16_t*)(ws + WS_MW13) + (size_t)e * 7168 * D, (size_t)g * 32, D, scr, F.lane); continue; }
        r -= 8 * I_M13;
        { const int e = r / I_M2; r %= I_M2; const int kb = r / 32, g = r % 32;
            transpose_item(a.in[27] + (size_t)e * DEXP * D, D, g * 32, false, kb * 64, (bf16_t*)(ws + WS_MW2) + (size_t)e * D * DEXP, (size_t)g * 32, DEXP, scr, F.lane); }
    }
}

struct Row { f32x4 v[4]; };
__device__ __forceinline__ Row ld_row_f32(const float* p, int lane) { Row r; const f32x4* q = (const f32x4*)p + lane;
#pragma unroll
    for (int j = 0; j < 4; ++j) r.v[j] = q[64 * j]; return r; }
__device__ __forceinline__ void st_row_f32(float* p, int lane, const Row& r) { f32x4* q = (f32x4*)p + lane;
#pragma unroll
    for (int j = 0; j < 4; ++j) q[64 * j] = r.v[j]; }
__device__ __forceinline__ Row ld_row_bf16(const bf16_t* p, int lane) { Row r; const u32x2* q = (const u32x2*)p + lane;
#pragma unroll
    for (int j = 0; j < 4; ++j) { const u32x2 w = q[64 * j]; r.v[j] = (f32x4){bflo(w.x), bfhi(w.x), bflo(w.y), bfhi(w.y)}; } return r; }
__device__ __forceinline__ void st_row_bf16(bf16_t* p, int lane, const Row& r) { u32x2* q = (u32x2*)p + lane;
#pragma unroll
    for (int j = 0; j < 4; ++j) { u32x2 w; w.x = cvt_pk_bf16(r.v[j][0], r.v[j][1]); w.y = cvt_pk_bf16(r.v[j][2], r.v[j][3]); q[64 * j] = w; } }
__device__ __forceinline__ float row_rms_scale(const Row& r) { float s = 0.f;
#pragma unroll
    for (int j = 0; j < 4; ++j) s += (r.v[j][0] * r.v[j][0] + r.v[j][1] * r.v[j][1]) + (r.v[j][2] * r.v[j][2] + r.v[j][3] * r.v[j][3]);
    return __builtin_amdgcn_rsqf(wave_sum(s) * (1.f / D) + EPS); }
__device__ __forceinline__ Row row_modulate(const Row& x, const float* g, const float* shift, const float* scale, int lane) {
    const float rs = row_rms_scale(x); Row h; const f32x4* gq = (const f32x4*)g + lane; const f32x4* sh = (const f32x4*)shift + lane; const f32x4* sc = (const f32x4*)scale + lane;
#pragma unroll
    for (int j = 0; j < 4; ++j) h.v[j] = x.v[j] * rs * gq[64 * j] * (1.f + sc[64 * j]) + sh[64 * j];
    return h; }
__device__ __forceinline__ void row_residual(Row& x, const Row& y, const float* g, const float* gate, int lane) {
    const float rs = row_rms_scale(y); const f32x4* gq = (const f32x4*)g + lane; const f32x4* gt = (const f32x4*)gate + lane;
#pragma unroll
    for (int j = 0; j < 4; ++j) x.v[j] = x.v[j] + gt[64 * j] * (y.v[j] * rs * gq[64 * j]);
}

struct MoeTab { int cnt[8]; int pbase[9]; };
__device__ __forceinline__ void moe_tab(gu32* ctl, MoeTab& T) {
    int p = 0;
#pragma unroll
    for (int e = 0; e < 8; ++e) { const int c = (int)__builtin_amdgcn_readfirstlane(__hip_atomic_load(ctl + CW_CNT + 64 * e, RLX_AGENT)); T.cnt[e] = c; T.pbase[e] = p; p += (c + 255) >> 8; }
    T.pbase[8] = p;
}
__device__ __forceinline__ int moe_expert_of(const MoeTab& T, int panel) { int e = 0;
#pragma unroll
    for (int i = 1; i < 8; ++i) e += (panel >= T.pbase[i]) ? 1 : 0;
    return e; }

struct MoeUpSched {
    const char* A; const char* Bt; const int* slot_token; int G, c, p0, nM; MoeTab T;
    __device__ __forceinline__ bool next(int i, pg8::Unit& u) const {
        const int L = i * G + c; if (L >= nM * 28) return false;
        int pm, pn; pg8::tile_of(L, nM, 28, pm, pn);
        const int panel = p0 + pm, e = moe_expert_of(T, panel);
        u.pm = pm; u.pn = pn; u.aux = e; u.aux2 = panel; u.Ap = A; u.Bp = Bt + ((size_t)e * 7168 + (size_t)pn * 256) * D * 2; return true;
    }
    __device__ __forceinline__ void aoff(const pg8::Unit& u, const int (&R)[2], const int (&C)[2], unsigned (&o0)[2], unsigned (&o1)[2]) const {
        int pb = 0, cn = 0;
#pragma unroll
        for (int e = 0; e < 8; ++e) { pb = (u.aux == e) ? T.pbase[e] : pb; cn = (u.aux == e) ? T.cnt[e] : cn; }
        const int rk0 = (u.aux2 - pb) * 256;
#pragma unroll
        for (int i = 0; i < 2; ++i) {
            const int ra = rk0 + R[i], rb = rk0 + pg8::HALF + R[i];
            const int ta = ra < cn ? slot_token[u.aux * 32768 + ra] : 0, tb = rb < cn ? slot_token[u.aux * 32768 + rb] : 0;
            o0[i] = (unsigned)(ta * D + C[i]) * 2u; o1[i] = (unsigned)(tb * D + C[i]) * 2u; }
    }
};
struct MoeDownSched {
    const char* A; const char* Bt; int G, c, p0, nM; MoeTab T;
    __device__ __forceinline__ bool next(int i, pg8::Unit& u) const {
        const int L = i * G + c; if (L >= nM * 4) return false;
        int pm, pn; pg8::tile_of(L, nM, 4, pm, pn);
        const int panel = p0 + pm, e = moe_expert_of(T, panel);
        u.pm = panel; u.pn = pn; u.aux = e; u.aux2 = 0; u.Ap = A + (size_t)pm * 256 * DEXP * 2; u.Bp = Bt + ((size_t)e * D + (size_t)pn * 256) * DEXP * 2; return true;
    }
    __device__ __forceinline__ void aoff(const pg8::Unit&, const int (&R)[2], const int (&C)[2], unsigned (&o0)[2], unsigned (&o1)[2]) const {
#pragma unroll
        for (int i = 0; i < 2; ++i) { o0[i] = (unsigned)(R[i] * DEXP + C[i]) * 2u; o1[i] = (unsigned)((pg8::HALF + R[i]) * DEXP + C[i]) * 2u; }
    }
};

constexpr int N_PHASES = 24;

__global__ void __launch_bounds__(NWAVES * 64, 2) mk_fwd(Args args) {
    extern __shared__ __attribute__((aligned(16))) unsigned char lds_raw[];
    Frame F;
    F.lds = (LAS unsigned char*)lds_raw;
    F.tid = threadIdx.x; F.lane = F.tid & 63; F.wave = __builtin_amdgcn_readfirstlane(F.tid >> 6);
    F.G = gridDim.x; { const int bx = blockIdx.x; F.vcu = (F.G % 8 == 0) ? (bx % 8) * (F.G / 8) + bx / 8 : bx; }
    unsigned char* ws = args.ws;
    F.ctl = (gu32*)(ws + WS_CTL);
    volatile LAS unsigned* MISC = (volatile LAS unsigned*)(F.lds + MISC_OFF);
    for (int u = F.tid; u < (LDS_BYTES - LDSCTL_OFF) / 4; u += NWAVES * 64) ((LAS unsigned*)(F.lds + LDSCTL_OFF))[u] = 0u;
    __syncthreads();
    XcdBarrier bar; bar.bar = (unsigned*)(F.ctl + CW_BAR); bar.x = 0; bar.st = nullptr;
    if (!MK_PER_PHASE) bar = xcd_barrier_post((unsigned*)(F.ctl + CW_BAR), MISC + 8);
    const int lo = args.ph_lo, hi = args.ph_hi;
#ifndef PH_MASK
#define PH_MASK 0xffffffu
#endif
#define IN(k) ((((PH_MASK) >> (k)) & 1u) && lo <= (k) && (k) < hi)
#define SEAM(k) do { if (IN(k) && IN((k) + 1)) xcd_barrier(bar); } while (0)

    const float* x_in = args.in[0]; const float* ctx_in = args.in[2];
    float* xlat = args.out; float* xctx = (float*)(ws + WS_XCTX);
    bf16_t* HA = (bf16_t*)(ws + WS_HA); bf16_t* P = (bf16_t*)(ws + WS_R1); bf16_t* HFF = (bf16_t*)(ws + WS_R1); bf16_t* OY = (bf16_t*)(ws + WS_OY); bf16_t* YS = (bf16_t*)(ws + WS_YS);
    const float* MS = (const float*)(ws + WS_MS);
    const float* ropec = (const float*)(ws + WS_ROPE); const float* ropes = ropec + 1024;
    int* tok_e = (int*)(ws + WS_ROUTE); float* tok_g = (float*)(ws + WS_ROUTE + 262144); int* tok_rank = (int*)(ws + WS_ROUTE + 524288);
    int* slot_token = (int*)(ws + WS_SLOT);
    const int gw = F.vcu * NWAVES + F.wave, NGW = F.G * NWAVES;
    char* ldsg = (char*)lds_raw;

    if (IN(0)) { p0_prologue(F, args); }
    SEAM(0);

    if (IN(1)) {
        const float* g = args.in[6];
        for (int m = gw; m < MALL; m += NGW) {
            const bool lat = m < MLAT; const int r17 = lat ? (m >> 11) : 16;
            const float* xr = lat ? x_in + (size_t)m * D : ctx_in + (size_t)(m - MLAT) * D;
            const float* msr = MS + (size_t)r17 * 6144;
            const Row x = ld_row_f32(xr, F.lane);
            const Row h = row_modulate(x, g, msr, msr + 1024, F.lane);
            st_row_bf16(HA + (size_t)m * D, F.lane, h);
        }
    }
    SEAM(1);

    if (IN(2)) {
        pg8::DenseSched S{(const char*)HA, (const char*)(ws + WS_WIN), D, D, F.G, (int)blockIdx.x, MALL / 256, 10, 0, 0, 0, 0, 0, 0};
        pg8::EpiInProj E{P, ropec, ropes};
        pg8::gemm_phase<pg8::EpiInProj, pg8::DenseSched, true>(F.lds, D, S, E);
    }
    SEAM(2);

#define ATTN_PHASE(LAYER, WITH_CTX) do { \
        float lam; { const float a1 = args.in[12][(LAYER) * 64 + F.lane] * args.in[13][(LAYER) * 64 + F.lane], a2 = args.in[14][(LAYER) * 64 + F.lane] * args.in[15][(LAYER) * 64 + F.lane]; \
            lam = __expf(wave_sum(a1)) - __expf(wave_sum(a2)) + ((LAYER) ? LAMBDA_INIT1 : LAMBDA_INIT0); } \
        const float oscale = 1.f - ((LAYER) ? LAMBDA_INIT1 : LAMBDA_INIT0); \
        const float* subg = args.in[16] + (LAYER) * 128; \
        const int c = (int)blockIdx.x, xcd = c & 7, jj = c >> 3; \
        if (!DBG_NO_LAT) for (int i = 0; i < 4; ++i) { const int bh = i * 16 + xcd * 2 + (jj >> 4), qb = jj & 15, b = bh >> 2, h = bh & 3; \
            bf16_t* Qb = P + ((size_t)b * SEQ + qb * 128) * NIN + COL_Q + h * 128; \
            const bf16_t* Kc = P + ((size_t)MLAT + b * CTX) * NIN + COL_K + h * 128; const bf16_t* Kl = P + ((size_t)b * SEQ) * NIN + COL_K + h * 128; \
            att::attn_unit(Qb, Kc, 4, Kl, 32, Qb, lam, oscale, subg, ldsg); } \
        int c1 = c; asm volatile("" : "+s"(c1)); \
        if (!DBG_NO_CTX && (WITH_CTX) && c1 < 128) { const int bh = c1 >> 1, qb = c1 & 1, b = bh >> 2, h = bh & 3; \
            bf16_t* Qb = P + ((size_t)MLAT + b * CTX + qb * 128) * NIN + COL_Q + h * 128; const bf16_t* Kc = P + ((size_t)MLAT + b * CTX) * NIN + COL_K + h * 128; \
            att::attn_unit(Qb, Kc, 4, Kc, 0, Qb, lam, oscale, subg, ldsg); } \
        int c2 = c1; asm volatile("" : "+s"(c2)); \
        if (!DBG_NO_SG) { const bf16_t* sgw = (const bf16_t*)(ws + WS_SGW) + (size_t)(LAYER) * 4 * 128 * 128; \
          att::sg_unit(P + (size_t)c2 * 128 * NIN, sgw, args.in[17] + (LAYER) * 512, args.in[18] + (LAYER) * 512, args.in[20] + (LAYER) * 512, ldsg); \
          int c3 = c2; asm volatile("" : "+s"(c3)); \
          if ((WITH_CTX) && c3 >= 128 && c3 < 160) att::sg_unit(P + ((size_t)MLAT + (c3 - 128) * 128) * NIN, sgw, args.in[17] + (LAYER) * 512, args.in[18] + (LAYER) * 512, args.in[20] + (LAYER) * 512, ldsg); } \
    } while (0)
    if (IN(3)) { ATTN_PHASE(0, true); }
    SEAM(3);

    if (IN(4)) {
        pg8::DenseSched S{(const char*)P, (const char*)(ws + WS_WOUT), NIN, D, F.G, (int)blockIdx.x, MALL / 256, 4, 0, 0, 0, 0, 0, 0};
        pg8::EpiPlain E{OY, D};
        pg8::gemm_phase<pg8::EpiPlain, pg8::DenseSched, true>(F.lds, D, S, E);
    }
    SEAM(4);

    if (IN(5)) {
        const float* gpost = args.in[7]; const float* gpre = args.in[8];
        for (int m = gw; m < MALL; m += NGW) {
            const bool lat = m < MLAT; const int r17 = lat ? (m >> 11) : 16;
            const float* xr = lat ? x_in + (size_t)m * D : ctx_in + (size_t)(m - MLAT) * D;
            float* xo = lat ? xlat + (size_t)m * D : xctx + (size_t)(m - MLAT) * D;
            const float* msr = MS + (size_t)r17 * 6144;
            Row x = ld_row_f32(xr, F.lane); const Row o = ld_row_bf16(OY + (size_t)m * D, F.lane);
            row_residual(x, o, gpost, msr + 2 * 1024, F.lane);
            st_row_f32(xo, F.lane, x);
            const Row f = row_modulate(x, gpre, msr + 3 * 1024, msr + 4 * 1024, F.lane);
            st_row_bf16(HA + (size_t)m * D, F.lane, f);
        }
    }
    SEAM(5);

    if (IN(6)) {
        pg8::DenseSched S{(const char*)HA, (const char*)(ws + WS_W13), D, D, F.G, (int)blockIdx.x, MALL / 256, 22, 0, 0, 0, 0, 0, 0};
        pg8::EpiSwiglu E{HFF, DFF};
        pg8::gemm_phase<pg8::EpiSwiglu, pg8::DenseSched, true>(F.lds, D, S, E);
    }
    SEAM(6);

    if (IN(7)) {
        pg8::DenseSched S{(const char*)HFF, (const char*)(ws + WS_W2), DFF, DFF, F.G, (int)blockIdx.x, MALL / 256, 4, 0, 0, 0, 0, 0, 0};
        pg8::EpiPlain E{OY, D};
        pg8::gemm_phase<pg8::EpiPlain, pg8::DenseSched, true>(F.lds, DFF, S, E);
    }
    SEAM(7);

    if (IN(8)) {
        const float* gpost = args.in[9]; const float* gpre = args.in[6] + D;
        for (int m = gw; m < MALL; m += NGW) {
            const bool lat = m < MLAT; const int r17 = lat ? (m >> 11) : 16;
            float* xo = lat ? xlat + (size_t)m * D : xctx + (size_t)(m - MLAT) * D;
            const float* msr = MS + (size_t)r17 * 6144; const float* msr1 = MS + (size_t)(17 + r17) * 6144;
            Row x = ld_row_f32(xo, F.lane); const Row y = ld_row_bf16(OY + (size_t)m * D, F.lane);
            row_residual(x, y, gpost, msr + 5 * 1024, F.lane);
            if (lat) st_row_f32(xo, F.lane, x);
            const Row h = row_modulate(x, gpre, msr1, msr1 + 1024, F.lane);
            st_row_bf16(HA + (size_t)m * D, F.lane, h);
        }
    }
    SEAM(8);

    if (IN(9)) {
        pg8::DenseSched S{(const char*)HA, (const char*)(ws + WS_WIN + (size_t)NIN * D * 2), D, D, F.G, (int)blockIdx.x, MLAT / 256, 10, 0, 0, MCTX / 256, 4, MLAT, 4};
        pg8::EpiInProj E{P, ropec, ropes};
        pg8::gemm_phase<pg8::EpiInProj, pg8::DenseSched, true>(F.lds, D, S, E);
    }
    SEAM(9);

    if (IN(10)) { ATTN_PHASE(1, false); }
    SEAM(10);

    if (IN(11)) {
        pg8::DenseSched S{(const char*)P, (const char*)(ws + WS_WOUT + (size_t)D * D * 2), NIN, D, F.G, (int)blockIdx.x, MLAT / 256, 4, 0, 0, 0, 0, 0, 0};
        pg8::EpiPlain E{OY, D};
        pg8::gemm_phase<pg8::EpiPlain, pg8::DenseSched, true>(F.lds, D, S, E);
    }
    SEAM(11);

    if (IN(12)) {
        const float* gpost = args.in[7] + D; const float* gpre = args.in[8] + D;
        LAS float* rw = (LAS float*)F.lds;
        LAS int* lcnt = (LAS int*)(F.lds + 32768);
        LAS int* rec = (LAS int*)(F.lds + 32768 + 256);
        for (int i = F.tid; i < 8192; i += 512) rw[i] = args.in[24][i];
        if (F.tid < 16) lcnt[F.tid] = 0;
        __syncthreads();
        int nrow = 0;
        for (int m = gw; m < MLAT; m += NGW, ++nrow) {
            const int r17 = m >> 11; const float* msr1 = MS + (size_t)(17 + r17) * 6144;
            float* xo = xlat + (size_t)m * D;
            Row x = ld_row_f32(xo, F.lane); const Row o = ld_row_bf16(OY + (size_t)m * D, F.lane);
            row_residual(x, o, gpost, msr1 + 2 * 1024, F.lane);
            st_row_f32(xo, F.lane, x);
            const Row f = row_modulate(x, gpre, msr1 + 3 * 1024, msr1 + 4 * 1024, F.lane);
            st_row_bf16(HA + (size_t)m * D, F.lane, f);
            float lg[8];
#pragma unroll
            for (int e = 0; e < 8; ++e) lg[e] = 0.f;
#pragma unroll
            for (int j = 0; j < 4; ++j)
#pragma unroll
                for (int q = 0; q < 4; ++q) { const int k = 4 * (F.lane + 64 * j) + q; const f32x4 wa = *(const LAS f32x4*)(rw + k * 8), wb = *(const LAS f32x4*)(rw + k * 8 + 4); const float fv = f.v[j][q];
                    lg[0] += fv * wa[0]; lg[1] += fv * wa[1]; lg[2] += fv * wa[2]; lg[3] += fv * wa[3]; lg[4] += fv * wb[0]; lg[5] += fv * wb[1]; lg[6] += fv * wb[2]; lg[7] += fv * wb[3]; }
#pragma unroll
            for (int e = 0; e < 8; ++e) lg[e] = wave_sum(lg[e]);
            int e1 = 0; float v1 = lg[0];
#pragma unroll
            for (int e = 1; e < 8; ++e) if (lg[e] > v1) { v1 = lg[e]; e1 = e; }
            int e2 = -1; float v2 = -3.0e38f;
#pragma unroll
            for (int e = 0; e < 8; ++e) if (e != e1 && lg[e] > v2) { v2 = lg[e]; e2 = e; }
            if (F.lane == 0) {
                const float w1 = 1.f / (1.f + __expf(v2 - v1));
                tok_e[m * 2] = e1; tok_e[m * 2 + 1] = e2; tok_g[m * 2] = w1; tok_g[m * 2 + 1] = 1.f - w1;
                const int l1 = __hip_atomic_fetch_add(lcnt + e1, 1, __ATOMIC_RELAXED, __HIP_MEMORY_SCOPE_WORKGROUP), l2 = __hip_atomic_fetch_add(lcnt + e2, 1, __ATOMIC_RELAXED, __HIP_MEMORY_SCOPE_WORKGROUP);
                LAS int* rr = rec + (F.wave * 32 + nrow) * 4; rr[0] = e1; rr[1] = e2; rr[2] = l1; rr[3] = l2;
            }
        }
        __syncthreads();
        if (F.tid < 8) lcnt[8 + F.tid] = (int)__hip_atomic_fetch_add(F.ctl + CW_CNT + 64 * F.tid, (unsigned)lcnt[F.tid], RLX_AGENT);
        __syncthreads();
        if (F.lane == 0) { int k = 0;
            for (int m = gw; m < MLAT; m += NGW, ++k) { const LAS int* rr = rec + (F.wave * 32 + k) * 4;
                const int r1 = lcnt[8 + rr[0]] + rr[2], r2 = lcnt[8 + rr[1]] + rr[3];
                tok_rank[m * 2] = r1; tok_rank[m * 2 + 1] = r2; slot_token[rr[0] * 32768 + r1] = m; slot_token[rr[1] * 32768 + r2] = m; } }
    }
    SEAM(12);

    {
        MoeTab T; T.pbase[8] = 0;
        if (hi > 13 && lo < 23) moe_tab(F.ctl, T);
        const int ptot = T.pbase[8];
        for (int ch = 0; ch < 5; ++ch) {
            const int p0 = ch * 64; const int nM = (ptot - p0) < 64 ? (ptot - p0) : 64;
            if (IN(13 + 2 * ch) && nM > 0) {
                MoeUpSched S{(const char*)HA, (const char*)(ws + WS_MW13), slot_token, F.G, (int)blockIdx.x, p0, nM, T};
                pg8::EpiSwiglu E{HFF, DEXP};
                pg8::gemm_phase<pg8::EpiSwiglu, MoeUpSched, true>(F.lds, D, S, E);
            }
            if (IN(13 + 2 * ch) && IN(14 + 2 * ch) && nM > 0) xcd_barrier(bar);
            if (IN(14 + 2 * ch) && nM > 0) {
                MoeDownSched S{(const char*)HFF, (const char*)(ws + WS_MW2), F.G, (int)blockIdx.x, p0, nM, T};
                pg8::EpiPlain E{YS, D};
                pg8::gemm_phase<pg8::EpiPlain, MoeDownSched, true>(F.lds, DEXP, S, E);
            }
            if (IN(14 + 2 * ch) && IN(15 + 2 * ch) && nM > 0) xcd_barrier(bar);
        }
    }

    if (IN(23)) {
        MoeTab T; moe_tab(F.ctl, T);
        const float* gpost = args.in[9] + D;
        for (int m = gw; m < MLAT; m += NGW) {
            const int r17 = m >> 11; const float* msr1 = MS + (size_t)(17 + r17) * 6144;
            const int e1 = tok_e[m * 2], e2 = tok_e[m * 2 + 1]; const float g1 = tok_g[m * 2], g2 = tok_g[m * 2 + 1];
            int pb1 = 0, pb2 = 0;
#pragma unroll
            for (int e = 0; e < 8; ++e) { pb1 = (e1 == e) ? T.pbase[e] : pb1; pb2 = (e2 == e) ? T.pbase[e] : pb2; }
            const size_t s1 = (size_t)pb1 * 256 + tok_rank[m * 2], s2 = (size_t)pb2 * 256 + tok_rank[m * 2 + 1];
            float* xo = xlat + (size_t)m * D;
            Row x = ld_row_f32(xo, F.lane); const Row ya = ld_row_bf16(YS + s1 * D, F.lane), yb = ld_row_bf16(YS + s2 * D, F.lane);
            Row y;
#pragma unroll
            for (int j = 0; j < 4; ++j) y.v[j] = ya.v[j] * g1 + yb.v[j] * g2;
            row_residual(x, y, gpost, msr1 + 5 * 1024, F.lane);
            st_row_f32(xo, F.lane, x);
        }
    }
#undef IN
#undef SEAM
#undef ATTN_PHASE
}

extern "C" void kernel_launch(void* const* d_in, const int* in_sizes, int n_in, void* d_out, int out_size, void* d_ws, size_t ws_size, hipStream_t stream) {
    static int grid = 0;
    if (grid == 0) {
        if (n_in != 28 || out_size != MLAT * D || ws_size < WS_END) { fprintf(stderr, "kernel_launch: unexpected shapes (n_in %d, out %d, ws %zu)\n", n_in, out_size, ws_size); grid = -1; return; }
        int dev = 0, cus = 0, per_cu = 0;
        if (hipGetDevice(&dev) != hipSuccess || hipDeviceGetAttribute(&cus, hipDeviceAttributeMultiprocessorCount, dev) != hipSuccess) { grid = -1; return; }
        if (hipFuncSetAttribute((const void*)mk_fwd, hipFuncAttributeMaxDynamicSharedMemorySize, LDS_BYTES) != hipSuccess) { fprintf(stderr, "kernel_launch: hipFuncSetAttribute failed\n"); grid = -1; return; }
        if (hipOccupancyMaxActiveBlocksPerMultiprocessor(&per_cu, (const void*)mk_fwd, NWAVES * 64, LDS_BYTES) != hipSuccess || per_cu < 1) { fprintf(stderr, "kernel_launch: occupancy query says %d\n", per_cu); (void)hipGetLastError(); }
        grid = cus;
        if (grid != 256) { fprintf(stderr, "kernel_launch: built for 256 CUs, found %d\n", grid); grid = -1; return; }
    }
    if (grid < 0) return;
    (void)hipMemsetAsync((char*)d_ws + WS_CTL, 0, CTL_ZERO_BYTES, stream);
    Args a{};
    for (int i = 0; i < 28; ++i) a.in[i] = (const float*)d_in[i];
    a.out = (float*)d_out; a.ws = (unsigned char*)d_ws;
#if MK_PER_PHASE
    for (int p = 0; p < N_PHASES; ++p) { a.ph_lo = p; a.ph_hi = p + 1; hipLaunchKernelGGL(mk_fwd, dim3(grid), dim3(NWAVES * 64), LDS_BYTES, stream, a); }
#else
    a.ph_lo = 0; a.ph_hi = N_PHASES;
    hipLaunchKernelGGL(mk_fwd, dim3(grid), dim3(NWAVES * 64), LDS_BYTES, stream, a);
#endif
}
```

```cpp
#include <hip/hip_runtime.h>
#include <cstdio>
#include <cstdint>

#ifndef DBG_NO_SG
#define DBG_NO_SG 0
#endif
#ifndef DBG_NO_CTX
#define DBG_NO_CTX 0
#endif
#ifndef DBG_NO_LAT
#define DBG_NO_LAT 0
#endif
#ifndef MK_PER_PHASE
#define MK_PER_PHASE 0
#endif

#define LAS __attribute__((address_space(3)))
#define GAS __attribute__((address_space(1)))
typedef unsigned short bf16_t;
typedef short bf16x8 __attribute__((ext_vector_type(8)));
typedef short s16x4 __attribute__((ext_vector_type(4)));
typedef float f32x2 __attribute__((ext_vector_type(2)));
typedef float f32x4 __attribute__((ext_vector_type(4)));
typedef float f32x16 __attribute__((ext_vector_type(16)));
typedef unsigned u32x2 __attribute__((ext_vector_type(2)));
typedef unsigned u32x4 __attribute__((ext_vector_type(4)));
typedef GAS unsigned gu32;
typedef int v8i __attribute__((ext_vector_type(8)));
typedef int v4i __attribute__((ext_vector_type(4)));

constexpr int D = 1024, BATCH = 16, SEQ = 2048, CTX = 256;
constexpr int MLAT = BATCH * SEQ;
constexpr int MCTX = BATCH * CTX;
constexpr int MALL = MLAT + MCTX;
constexpr int NIN = 2560;
constexpr int COL_Q = 0, COL_U = 512, COL_K = 1024, COL_V = 1536, COL_G = 2048;
constexpr int DFF = 2816, DEXP = 3584, NEXP = 8;
constexpr float EPS = 1e-6f;
constexpr float LAMBDA_INIT0 = 0.2f, LAMBDA_INIT1 = 0.35550907f;

constexpr size_t MiB = 1u << 20;
constexpr size_t WS_CTL = 0, CTL_ZERO_BYTES = 1 * MiB;
constexpr size_t WS_MS = 1 * MiB;
constexpr size_t WS_ROPE = 2 * MiB;
constexpr size_t WS_ROUTE = 3 * MiB;
constexpr size_t WS_SLOT = 4 * MiB;
constexpr size_t WS_WIN = 5 * MiB;
constexpr size_t WS_WOUT = 15 * MiB;
constexpr size_t WS_SGW = 19 * MiB;
constexpr size_t WS_W13 = 20 * MiB;
constexpr size_t WS_W2 = 31 * MiB;
constexpr size_t WS_MW13 = 37 * MiB;
constexpr size_t WS_MW2 = 149 * MiB;
constexpr size_t WS_XCTX = 205 * MiB;
constexpr size_t WS_HA = 221 * MiB;
constexpr size_t WS_R1 = 293 * MiB;
constexpr size_t WS_OY = 491 * MiB;
constexpr size_t WS_YS = 405 * MiB;
constexpr size_t WS_END = 563 * MiB;

constexpr int CW_BAR = 4096;
constexpr int CW_CNT = 64;

constexpr int RING_BYTES = 131072;
constexpr int LDSCTL_OFF = RING_BYTES, MISC_OFF = LDSCTL_OFF + 320;
constexpr int LDS_BYTES = 147456;
constexpr int NWAVES = 8;

#define RLX_AGENT __ATOMIC_RELAXED, __HIP_MEMORY_SCOPE_AGENT
#define LDS_WAIT() asm volatile("s_waitcnt lgkmcnt(0)" ::: "memory")
#define VM_WAIT() asm volatile("s_waitcnt vmcnt(0)" ::: "memory")
#define SBAR() __builtin_amdgcn_sched_barrier(0)

__device__ __forceinline__ unsigned cvt_pk_bf16(float lo, float hi) { unsigned r; asm volatile("v_cvt_pk_bf16_f32 %0, %1, %2" : "=v"(r) : "v"(lo), "v"(hi)); return r; }
__device__ __forceinline__ float bf2f(unsigned short b) { return __builtin_bit_cast(float, (unsigned)b << 16); }
__device__ __forceinline__ float bflo(unsigned w) { return __builtin_bit_cast(float, w << 16); }
__device__ __forceinline__ float bfhi(unsigned w) { return __builtin_bit_cast(float, w & 0xffff0000u); }
__device__ __forceinline__ float wave_sum(float v) {
#pragma unroll
    for (int o = 1; o < 64; o <<= 1) v += __shfl_xor(v, o);
    return v;
}
__device__ __forceinline__ float silu_f(float v) { return v / (1.f + __expf(-v)); }

namespace pg8 {
constexpr int BM = 256, BK = 64, HALF = 128, HTB = HALF * BK * 2, STAGE_BYTES = 8 * HTB, NXCD = 8, WGM = 8;
__host__ __device__ __forceinline__ int lds_byte(int r, int c) { const int st = (r >> 4) * 2 + (c >> 5), rr = r & 15, cc = c & 31, ob = rr * 64 + cc * 2; return st * 1024 + (ob ^ (((ob >> 9) & 1) << 5)); }
__host__ __device__ __forceinline__ void stage_rc(int b, int& R, int& C) { const int st = b / 1024, sb = b % 1024, swz = sb ^ (((sb >> 9) & 1) << 5); R = (st >> 1) * 16 + swz / 64; C = (st & 1) * 32 + (swz % 64) / 2; }
__host__ __device__ __forceinline__ int perm32(int rho) { const int n = rho >> 4, i = rho & 15; return 8 * (i >> 2) + 4 * n + (i & 3); }

struct Unit { const char* Ap; const char* Bp; int pm, pn, aux, aux2; };

__device__ __forceinline__ void tile_of(int L, int nM, int nN, int& pm, int& pn) {
    const int nwg = nM * nN; int wgid = L;
    { const int q = nwg / NXCD, r = nwg % NXCD, xcd = wgid % NXCD, off = wgid / NXCD; wgid = (xcd < r ? xcd * (q + 1) : r * (q + 1) + (xcd - r) * q) + off; }
    const int nig = WGM * nN, gid = wgid / nig, fm = gid * WGM, gsz = (nM - fm) < WGM ? (nM - fm) : WGM;
    pm = fm + ((wgid % nig) % gsz); pn = (wgid % nig) / gsz;
}

template <class Epi, class Sched, bool ALIGN_EPI, bool FP8 = false>
__device__ __forceinline__ void gemm_phase(LAS unsigned char* lds, const int K, const Sched& S, const Epi& E) {
    const int tid = threadIdx.x, wid = __builtin_amdgcn_readfirstlane(tid >> 6), lane = tid & 63, wr = wid >> 2, wc = wid & 3, fr = lane & 15, fq = lane >> 4;
    const int kbytes = FP8 ? K : 2 * K;
    const int nt = kbytes / 128;
    int R[2], C[2]; unsigned voffB[2];
#pragma unroll
    for (int i = 0; i < 2; ++i) { stage_rc(tid * 16 + i * 8192, R[i], C[i]); const int Rb = Epi::PERM ? ((R[i] & ~31) + perm32(R[i] & 31)) : R[i]; voffB[i] = (unsigned)(Rb * kbytes + C[i] * 2); }
    const size_t kstep = (size_t)(BK * 2);
    const size_t hstepB = (size_t)HALF * kbytes;
    const unsigned ldsw = (unsigned)wid * 1024u;
    const int aoff = lds_byte(wr * 64 + fr, fq * 8), boff = lds_byte(wc * 32 + fr, fq * 8);
#define PG8_SA(b, h) (((b) * 2 + (h)) * HTB)
#define PG8_SB(b, h) ((4 + (b) * 2 + (h)) * HTB)
#define PG8_STAGE(bufoff, gbase, voff) do { _Pragma("unroll") for (int _i = 0; _i < 2; ++_i) \
        __builtin_amdgcn_global_load_lds((const unsigned*)((const char*)(gbase) + (voff)[_i]), (LAS unsigned*)(lds + (bufoff) + ldsw + _i * 8192), 16, 0, 0); } while (0)
#define PG8_LDA(dst, b, h) do { _Pragma("unroll") for (int m = 0; m < 4; ++m) { const v4i _lo = *(const LAS v4i*)(lds + PG8_SA(b, h) + aoff + m * 2048), _hi = *(const LAS v4i*)(lds + PG8_SA(b, h) + aoff + m * 2048 + 1024); \
        dst[m] = __builtin_shufflevector(_lo, _hi, 0, 1, 2, 3, 4, 5, 6, 7); } } while (0)
#define PG8_LDB(dst, b, h) do { _Pragma("unroll") for (int n = 0; n < 2; ++n) { const v4i _lo = *(const LAS v4i*)(lds + PG8_SB(b, h) + boff + n * 2048), _hi = *(const LAS v4i*)(lds + PG8_SB(b, h) + boff + n * 2048 + 1024); \
        dst[n] = __builtin_shufflevector(_lo, _hi, 0, 1, 2, 3, 4, 5, 6, 7); } } while (0)
#define PG8_LO(x) __builtin_bit_cast(bf16x8, __builtin_shufflevector(x, x, 0, 1, 2, 3))
#define PG8_HI(x) __builtin_bit_cast(bf16x8, __builtin_shufflevector(x, x, 4, 5, 6, 7))
#define PG8_MMA(ai, bj, At, Bt) do { __builtin_amdgcn_s_setprio(1); \
        if constexpr (FP8) { _Pragma("unroll") for (int m = 0; m < 4; ++m) _Pragma("unroll") for (int n = 0; n < 2; ++n) \
            asm volatile("v_mfma_f32_16x16x128_f8f6f4 %0, %1, %2, %0" : "+v"(acc[ai][bj][m][n]) : "v"(Bt[n]), "v"(At[m])); } \
        else { _Pragma("unroll") for (int m = 0; m < 4; ++m) _Pragma("unroll") for (int n = 0; n < 2; ++n) { \
            acc[ai][bj][m][n] = __builtin_amdgcn_mfma_f32_16x16x32_bf16(PG8_LO(Bt[n]), PG8_LO(At[m]), acc[ai][bj][m][n], 0, 0, 0); \
            acc[ai][bj][m][n] = __builtin_amdgcn_mfma_f32_16x16x32_bf16(PG8_HI(Bt[n]), PG8_HI(At[m]), acc[ai][bj][m][n], 0, 0, 0); } } \
        __builtin_amdgcn_s_setprio(0); } while (0)
#define PG8_WAIT_V(n) asm volatile("s_waitcnt vmcnt(" #n ")" ::: "memory")
#define PG8_WAIT_L(n) asm volatile("s_waitcnt lgkmcnt(" #n ")" ::: "memory")
#define PG8_BAR __builtin_amdgcn_s_barrier()
#define PG8_SCHED __builtin_amdgcn_sched_barrier(0)
    Unit cur, nxt; int ui = 0;
    if (!S.next(0, cur)) return;
    f32x4 acc[2][2][4][2];
#pragma unroll
    for (int a = 0; a < 2; ++a)
#pragma unroll
        for (int b = 0; b < 2; ++b)
#pragma unroll
            for (int m = 0; m < 4; ++m)
#pragma unroll
                for (int n = 0; n < 2; ++n) acc[a][b][m][n] = (f32x4){0.f, 0.f, 0.f, 0.f};
    v8i At[4], B0[2], B1[2];
    unsigned cO0[2], cO1[2], nO0[2], nO1[2];
    S.aoff(cur, R, C, cO0, cO1);
    const char* cA = cur.Ap; const char* cB = cur.Bp;
    PG8_STAGE(PG8_SB(0, 0), cB, voffB); PG8_STAGE(PG8_SB(0, 1), cB + hstepB, voffB); PG8_STAGE(PG8_SA(0, 0), cA, cO0); PG8_STAGE(PG8_SA(0, 1), cA, cO1);
    if (wr == 1) PG8_BAR;
    PG8_WAIT_V(2); PG8_BAR;
    PG8_STAGE(PG8_SB(1, 0), cB + kstep, voffB); PG8_STAGE(PG8_SA(1, 0), cA + kstep, cO0); PG8_STAGE(PG8_SB(1, 1), cB + hstepB + kstep, voffB);
    PG8_WAIT_V(6); PG8_BAR;
    for (;;) {
        const bool has_next = S.next(ui + 1, nxt);
        if (has_next) S.aoff(nxt, R, C, nO0, nO1); else { nO0[0] = cO0[0]; nO0[1] = cO0[1]; nO1[0] = cO1[0]; nO1[1] = cO1[1]; }
        const char* nA = has_next ? nxt.Ap : cA; const char* nB = has_next ? nxt.Bp : cB;
        for (int t = 0; t < nt; t += 2) {
            const bool last = (t == nt - 2);
            const char* a1 = cA + (size_t)(t + 1) * kstep;
            const char* a2 = last ? nA : cA + (size_t)(t + 2) * kstep; const char* b2 = last ? nB : cB + (size_t)(t + 2) * kstep;
            const char* a3 = a2 + kstep; const char* b3 = b2 + kstep;
            unsigned xO0[2], xO1[2];
            xO0[0] = last ? nO0[0] : cO0[0]; xO0[1] = last ? nO0[1] : cO0[1]; xO1[0] = last ? nO1[0] : cO1[0]; xO1[1] = last ? nO1[1] : cO1[1];
            PG8_LDB(B0, 0, 0); PG8_LDB(B1, 0, 1); PG8_SCHED; PG8_LDA(At, 0, 0); PG8_STAGE(PG8_SA(1, 1), a1, cO1);
            PG8_WAIT_V(8); PG8_WAIT_L(0); PG8_BAR; PG8_MMA(0, 0, At, B0); PG8_MMA(0, 1, At, B1); PG8_BAR; PG8_SCHED;
            PG8_LDA(At, 0, 1); PG8_STAGE(PG8_SB(0, 0), b2, voffB); PG8_STAGE(PG8_SB(0, 1), b2 + hstepB, voffB); PG8_STAGE(PG8_SA(0, 0), a2, xO0);
            PG8_WAIT_V(8); PG8_WAIT_L(0); PG8_BAR; PG8_MMA(1, 0, At, B0); PG8_MMA(1, 1, At, B1); PG8_BAR; PG8_SCHED;
            PG8_LDB(B0, 1, 0); PG8_LDB(B1, 1, 1); PG8_SCHED; PG8_LDA(At, 1, 0); PG8_STAGE(PG8_SA(0, 1), a2, xO1);
            PG8_WAIT_V(8); PG8_WAIT_L(0); PG8_BAR; PG8_MMA(0, 0, At, B0); PG8_MMA(0, 1, At, B1); PG8_BAR; PG8_SCHED;
            PG8_LDA(At, 1, 1); PG8_STAGE(PG8_SB(1, 0), b3, voffB); PG8_STAGE(PG8_SB(1, 1), b3 + hstepB, voffB); PG8_STAGE(PG8_SA(1, 0), a3, xO0);
            PG8_WAIT_V(8); PG8_WAIT_L(0); PG8_BAR; PG8_MMA(1, 0, At, B0); PG8_MMA(1, 1, At, B1); PG8_BAR; PG8_SCHED;
        }
        if constexpr (ALIGN_EPI) { if (wr == 0) PG8_BAR; }
        if constexpr (FP8) asm volatile("s_nop 15\n\ts_nop 15\n\ts_nop 15\n\ts_nop 15\n\ts_nop 15\n\ts_nop 15" ::: "memory");
        E(acc, cur, wr, wc, fr, fq);
        if (!has_next) break;
#pragma unroll
        for (int a = 0; a < 2; ++a)
#pragma unroll
            for (int b = 0; b < 2; ++b)
#pragma unroll
                for (int m = 0; m < 4; ++m)
#pragma unroll
                    for (int n = 0; n < 2; ++n) acc[a][b][m][n] = (f32x4){0.f, 0.f, 0.f, 0.f};
        cur = nxt; cA = nA; cB = nB; ++ui;
        cO0[0] = nO0[0]; cO0[1] = nO0[1]; cO1[0] = nO1[0]; cO1[1] = nO1[1];
        if constexpr (ALIGN_EPI) { if (wr == 1) PG8_BAR; }
    }
    PG8_WAIT_V(0);
    if constexpr (!ALIGN_EPI) { if (wr == 0) PG8_BAR; }
    PG8_BAR;
#undef PG8_SA
#undef PG8_SB
#undef PG8_STAGE
#undef PG8_LDA
#undef PG8_LDB
#undef PG8_MMA
#undef PG8_LO
#undef PG8_HI
#undef PG8_WAIT_V
#undef PG8_WAIT_L
#undef PG8_BAR
#undef PG8_SCHED
}

struct DenseSched {
    const char* A; const char* Bt; int lda, K, G, c;
    int nM0, nN0, arow0_0, pn0_0, nM1, nN1, arow0_1, pn0_1;
    __device__ __forceinline__ bool next(int i, Unit& u) const {
        int L = i * G + c; const int n0 = nM0 * nN0;
        int pm, pn;
        if (L < n0) { tile_of(L, nM0, nN0, pm, pn); u.pm = arow0_0 / 256 + pm; u.pn = pn0_0 + pn; }
        else { L -= n0; if (L >= nM1 * nN1) return false; tile_of(L, nM1, nN1, pm, pn); u.pm = arow0_1 / 256 + pm; u.pn = pn0_1 + pn; }
        u.Ap = A + (size_t)u.pm * 256 * lda * 2; u.Bp = Bt + (size_t)u.pn * 256 * K * 2; u.aux = 0; u.aux2 = 0; return true;
    }
    __device__ __forceinline__ void aoff(const Unit&, const int (&R)[2], const int (&C)[2], unsigned (&o0)[2], unsigned (&o1)[2]) const {
#pragma unroll
        for (int i = 0; i < 2; ++i) { o0[i] = (unsigned)(R[i] * lda + C[i]) * 2u; o1[i] = (unsigned)((HALF + R[i]) * lda + C[i]) * 2u; }
    }
};

struct EpiPlain {
    static constexpr bool PERM = true;
    bf16_t* O; int ldc; float sc;
    __device__ __forceinline__ void operator()(const f32x4 (&acc)[2][2][4][2], const Unit& u, int wr, int wc, int fr, int fq) const {
        const int row0 = u.pm * BM + wr * 64 + fr, col0 = u.pn * BM + wc * 32 + 8 * fq;
#pragma unroll
        for (int ai = 0; ai < 2; ++ai)
#pragma unroll
            for (int m = 0; m < 4; ++m) { bf16_t* rowp = O + (size_t)(row0 + ai * HALF + m * 16) * ldc + col0;
#pragma unroll
                for (int bj = 0; bj < 2; ++bj) { const f32x4 v0 = acc[ai][bj][m][0] * sc, v1 = acc[ai][bj][m][1] * sc;
                    u32x4 w; w.x = cvt_pk_bf16(v0[0], v0[1]); w.y = cvt_pk_bf16(v0[2], v0[3]); w.z = cvt_pk_bf16(v1[0], v1[1]); w.w = cvt_pk_bf16(v1[2], v1[3]);
                    *(u32x4*)(rowp + bj * HALF) = w; } }
    }
};
struct EpiInProj {
    static constexpr bool PERM = true;
    bf16_t* O; const float* ropec; const float* ropes;
    __device__ __forceinline__ void operator()(const f32x4 (&acc)[2][2][4][2], const Unit& u, int wr, int wc, int fr, int fq) const {
        const int row0 = u.pm * BM + wr * 64 + fr, col0 = u.pn * BM + wc * 32 + 8 * fq;
        const bool rope = (u.pm < MLAT / 256) && (u.pn < 2 || (u.pn >= 4 && u.pn < 6));
        const bool colpos = (wc & 1) != 0;
#pragma unroll
        for (int ai = 0; ai < 2; ++ai)
#pragma unroll
            for (int m = 0; m < 4; ++m) { const int row = row0 + ai * HALF + m * 16; bf16_t* rowp = O + (size_t)row * NIN + col0;
                f32x4 cs = {1.f, 1.f, 1.f, 1.f}, sn = {0.f, 0.f, 0.f, 0.f};
                if (rope) { const int t = row & (SEQ - 1), pos = colpos ? (t & 63) : (t >> 6); cs = *(const f32x4*)(ropec + pos * 16 + 4 * fq); sn = *(const f32x4*)(ropes + pos * 16 + 4 * fq); }
#pragma unroll
                for (int bj = 0; bj < 2; ++bj) { const f32x4 a = acc[ai][bj][m][0], b = acc[ai][bj][m][1];
                    const f32x4 v0 = a * cs - b * sn, v1 = b * cs + a * sn;
                    u32x4 w; w.x = cvt_pk_bf16(v0[0], v0[1]); w.y = cvt_pk_bf16(v0[2], v0[3]); w.z = cvt_pk_bf16(v1[0], v1[1]); w.w = cvt_pk_bf16(v1[2], v1[3]);
                    *(u32x4*)(rowp + bj * HALF) = w; } }
    }
};
struct EpiSwiglu {
    static constexpr bool PERM = true;
    bf16_t* O; int ldc;
    __device__ __forceinline__ void operator()(const f32x4 (&acc)[2][2][4][2], const Unit& u, int wr, int wc, int fr, int fq) const {
        const int row0 = u.pm * BM + wr * 64 + fr, col0 = u.pn * HALF + wc * 32 + 8 * fq;
#pragma unroll
        for (int ai = 0; ai < 2; ++ai)
#pragma unroll
            for (int m = 0; m < 4; ++m) { bf16_t* rowp = O + (size_t)(row0 + ai * HALF + m * 16) * ldc + col0;
                f32x4 v[2];
#pragma unroll
                for (int n = 0; n < 2; ++n) { const f32x4 a = acc[ai][0][m][n], b = acc[ai][1][m][n];
#pragma unroll
                    for (int j = 0; j < 4; ++j) v[n][j] = a[j] * __builtin_amdgcn_rcpf(1.f + __builtin_amdgcn_exp2f(-1.4426950408889634f * a[j])) * b[j]; }
                u32x4 w; w.x = cvt_pk_bf16(v[0][0], v[0][1]); w.y = cvt_pk_bf16(v[0][2], v[0][3]); w.z = cvt_pk_bf16(v[1][0], v[1][1]); w.w = cvt_pk_bf16(v[1][2], v[1][3]);
                *(u32x4*)rowp = w; }
    }
};
__device__ __forceinline__ unsigned pk_fp8x4(float a, float b, float c, float d) {
    a = __builtin_amdgcn_fmed3f(a, -448.f, 448.f); b = __builtin_amdgcn_fmed3f(b, -448.f, 448.f); c = __builtin_amdgcn_fmed3f(c, -448.f, 448.f); d = __builtin_amdgcn_fmed3f(d, -448.f, 448.f);
    int p = __builtin_amdgcn_cvt_pk_fp8_f32(a, b, 0, false); p = __builtin_amdgcn_cvt_pk_fp8_f32(c, d, p, true); return (unsigned)p; }
struct EpiSwigluF8 {
    static constexpr bool PERM = true;
    unsigned char* O; int ldc;
    __device__ __forceinline__ void operator()(const f32x4 (&acc)[2][2][4][2], const Unit& u, int wr, int wc, int fr, int fq) const {
        const int row0 = u.pm * BM + wr * 64 + fr, col0 = u.pn * HALF + wc * 32 + 8 * fq;
#pragma unroll
        for (int ai = 0; ai < 2; ++ai)
#pragma unroll
            for (int m = 0; m < 4; ++m) { unsigned char* rowp = O + (size_t)(row0 + ai * HALF + m * 16) * ldc + col0;
                f32x4 v[2];
#pragma unroll
                for (int n = 0; n < 2; ++n) { const f32x4 a = acc[ai][0][m][n] * (1.f / 512.f), b = acc[ai][1][m][n] * (4.f / 512.f);
#pragma unroll
                    for (int j = 0; j < 4; ++j) v[n][j] = a[j] * __builtin_amdgcn_rcpf(1.f + __builtin_amdgcn_exp2f(-1.4426950408889634f * a[j])) * b[j]; }
                u32x2 w; w.x = pk_fp8x4(v[0][0], v[0][1], v[0][2], v[0][3]); w.y = pk_fp8x4(v[1][0], v[1][1], v[1][2], v[1][3]);
                *(u32x2*)rowp = w; }
    }
};
}

namespace att {
constexpr int LDP = NIN;
constexpr int SHM_V = 64 * 128 * 2, SHM_K = 64 * 128 * 2;
constexpr int OFF_V = 0, OFF_K = 2 * SHM_V, OFF_WS = OFF_K + 2 * SHM_K, OFF_OST = OFF_WS + NWAVES * 64 * 4, ATT_LDS = OFF_OST + 4 * 8192;
static_assert(ATT_LDS <= RING_BYTES, "attention LDS");
constexpr float SCALE = 0.125f;
constexpr float THR = 8.f;
#define KSWZ(row, colB) ((row) * 256 + ((colB) ^ (((row) & 7) << 4)))
__device__ __forceinline__ int crow(int r, int hi) { return (r & 3) + 8 * (r >> 2) + 4 * hi; }

__device__ __forceinline__ void partialSM(f32x16& p0, f32x16& p1, float& m_reg, float& mn, float& alpha) {
    constexpr float C = SCALE * 1.4426950408889634f;
    float pmax = p0[0];
#pragma unroll
    for (int r = 1; r < 16; ++r) pmax = fmaxf(pmax, p0[r]);
#pragma unroll
    for (int r = 0; r < 16; ++r) pmax = fmaxf(pmax, p1[r]);
    { auto rr = __builtin_amdgcn_permlane32_swap(__float_as_uint(pmax), __float_as_uint(pmax), false, false);
      pmax = fmaxf(__uint_as_float(rr[0]), __uint_as_float(rr[1])); }
    if (__builtin_expect(__all(pmax - m_reg <= THR / SCALE), 1)) { mn = m_reg; alpha = 1.f; }
    else { mn = fmaxf(m_reg, pmax); alpha = __builtin_amdgcn_exp2f((m_reg - mn) * C); m_reg = mn; }
    const float mnC = -mn * C;
#pragma unroll
    for (int r = 0; r < 16; ++r) p0[r] = fmaf(p0[r], C, mnC);
#pragma unroll
    for (int r = 0; r < 16; ++r) p1[r] = fmaf(p1[r], C, mnC);
#pragma unroll
    for (int r = 0; r < 16; ++r) p0[r] = __builtin_amdgcn_exp2f(p0[r]);
}
__device__ __forceinline__ void finishSM(f32x16& p0, f32x16& p1, float alpha, float& l_reg, bf16x8& pa0, bf16x8& pa1, bf16x8& pa2, bf16x8& pa3) {
#pragma unroll
    for (int r = 0; r < 16; ++r) p1[r] = __builtin_amdgcn_exp2f(p1[r]);
    float ps = 0;
#pragma unroll
    for (int r = 0; r < 16; ++r) ps += p0[r];
#pragma unroll
    for (int r = 0; r < 16; ++r) ps += p1[r];
    { auto rr = __builtin_amdgcn_permlane32_swap(__float_as_uint(ps), __float_as_uint(ps), false, false);
      ps = __uint_as_float(rr[0]) + __uint_as_float(rr[1]); }
    l_reg = l_reg * alpha + ps;
#define PK4(P, BASE, OUT) do { unsigned a0 = cvt_pk_bf16(P[BASE + 0], P[BASE + 1]), a1 = cvt_pk_bf16(P[BASE + 2], P[BASE + 3]);   \
    unsigned b0 = cvt_pk_bf16(P[BASE + 4], P[BASE + 5]), b1 = cvt_pk_bf16(P[BASE + 6], P[BASE + 7]);                              \
    auto r0 = __builtin_amdgcn_permlane32_swap(a0, b0, false, false); auto r1 = __builtin_amdgcn_permlane32_swap(a1, b1, false, false); \
    u32x4 w = {r0[0], r1[0], r0[1], r1[1]}; OUT = __builtin_bit_cast(bf16x8, w); } while (0)
    PK4(p0, 0, pa0); PK4(p0, 8, pa1); PK4(p1, 0, pa2); PK4(p1, 8, pa3);
#undef PK4
}
__device__ __forceinline__ void qkt(f32x16& p0, f32x16& p1, const char* Ks, const bf16x8 (&qr)[4], int r32, int hi, int cb0) {
    p0 = f32x16{}; p1 = f32x16{};
#pragma unroll
    for (int d0 = 0; d0 < 4; ++d0) { const int cb = cb0 + (d0 * 16 + hi * 8) * 2;
        const bf16x8 b0 = *reinterpret_cast<const bf16x8*>(Ks + KSWZ(r32, cb));
        const bf16x8 b1 = *reinterpret_cast<const bf16x8*>(Ks + KSWZ(32 + r32, cb));
        p0 = __builtin_amdgcn_mfma_f32_32x32x16_bf16(b0, qr[d0], p0, 0, 0, 0);
        p1 = __builtin_amdgcn_mfma_f32_32x32x16_bf16(b1, qr[d0], p1, 0, 0, 0); }
}
__device__ __forceinline__ int v_st(int k, int c) { const int kk = (k & ~0xC) | ((k & 4) << 1) | ((k & 8) >> 1); return ((kk >> 3) * 4 + (c >> 5)) * 512 + ((kk & 7) * 32 + (c & 31)) * 2; }
__device__ __forceinline__ int v_rd_base(int lane) { return ((lane & 3) << 3) | (((lane >> 2) & 3) << 6) | (((lane >> 4) & 1) << 5) | (((lane >> 5) & 1) << 8); }
constexpr int v_rd_off(int d0, int ks, int half) { return d0 * 512 + ks * 4096 + half * 2048; }
template <int OFF> __device__ __forceinline__ s16x4 tr_read(int vb) {
    s16x4 r; asm volatile("ds_read_b64_tr_b16 %0, %1 offset:%2" : "=&v"(r) : "v"(vb), "i"(OFF) : "memory"); return r;
}
template <int D0> __device__ __forceinline__ void pv_one(f32x16& od, int vb, bf16x8 pa0, bf16x8 pa1, bf16x8 pa2, bf16x8 pa3) {
    const s16x4 l0 = tr_read<v_rd_off(D0, 0, 0)>(vb), h0 = tr_read<v_rd_off(D0, 0, 1)>(vb), l1 = tr_read<v_rd_off(D0, 1, 0)>(vb), h1 = tr_read<v_rd_off(D0, 1, 1)>(vb);
    const s16x4 l2 = tr_read<v_rd_off(D0, 2, 0)>(vb), h2 = tr_read<v_rd_off(D0, 2, 1)>(vb), l3 = tr_read<v_rd_off(D0, 3, 0)>(vb), h3 = tr_read<v_rd_off(D0, 3, 1)>(vb);
    asm volatile("s_waitcnt lgkmcnt(0)" ::: "memory"); SBAR();
#define PKV(L, H) (bf16x8){L[0], L[1], L[2], L[3], H[0], H[1], H[2], H[3]}
    od = __builtin_amdgcn_mfma_f32_32x32x16_bf16(pa0, PKV(l0, h0), od, 0, 0, 0);
    od = __builtin_amdgcn_mfma_f32_32x32x16_bf16(pa1, PKV(l1, h1), od, 0, 0, 0);
    od = __builtin_amdgcn_mfma_f32_32x32x16_bf16(pa2, PKV(l2, h2), od, 0, 0, 0);
    od = __builtin_amdgcn_mfma_f32_32x32x16_bf16(pa3, PKV(l3, h3), od, 0, 0, 0);
#undef PKV
}
__device__ __forceinline__ void pv_d0(f32x16* o, int vb, bf16x8 pa0, bf16x8 pa1, bf16x8 pa2, bf16x8 pa3) {
    pv_one<0>(o[0], vb, pa0, pa1, pa2, pa3); pv_one<1>(o[1], vb, pa0, pa1, pa2, pa3); pv_one<2>(o[2], vb, pa0, pa1, pa2, pa3); pv_one<3>(o[3], vb, pa0, pa1, pa2, pa3);
}

__device__ __forceinline__ void attn_unit(const bf16_t* __restrict__ Qb, const bf16_t* __restrict__ Ks0, int nt0, const bf16_t* __restrict__ Ks1, int nt1,
                                          bf16_t* Ob, float lam, float oscale, const float* __restrict__ subg, char* lds) {
    int tid = threadIdx.x; asm volatile("" : "+v"(tid));
    const int wid = __builtin_amdgcn_readfirstlane(tid >> 6), lane = tid & 63, r32 = lane & 31, hi = lane >> 5, map = wid >> 2, w4 = wid & 3;
    char* V_lds = lds + OFF_V; char* K_lds = lds + OFF_K;
    float* ws = (float*)(lds + OFF_WS) + wid * 64; float* li_l = ws; float* al_l = ws + 32;
    float m_reg = -1e30f, l_reg = 0; f32x16 o[4] = {}; bf16x8 qr[4];
    const bf16_t* Qw = Qb + (long)(w4 * 32 + r32) * LDP + map * 64 + hi * 8;
#pragma unroll
    for (int d0 = 0; d0 < 4; ++d0) qr[d0] = *reinterpret_cast<const bf16x8*>(Qw + d0 * 16);
    const int cb0 = map * 128;
    const int sr = tid >> 4, sc = (tid & 15) * 8, vst0 = v_st(sr, sc), vst1 = v_st(32 + sr, sc);
    const int vb0 = (int)(uintptr_t)V_lds + v_rd_base(lane);
    struct { bf16x8 vs0, vs1, ks0, ks1; } sr_[1];
    const int NT = nt0 + nt1;
#define TILEP(j) ((j) < nt0 ? Ks0 + (long)(j) * 64 * LDP : Ks1 + (long)((j) - nt0) * 64 * LDP)
#define SLOAD(i, j) do { const bf16_t* _kb = TILEP(j); sr_[i].vs0 = *reinterpret_cast<const bf16x8*>(_kb + 512 + (long)sr * LDP + sc); sr_[i].vs1 = *reinterpret_cast<const bf16x8*>(_kb + 512 + (long)(32 + sr) * LDP + sc); \
    sr_[i].ks0 = *reinterpret_cast<const bf16x8*>(_kb + (long)sr * LDP + sc); sr_[i].ks1 = *reinterpret_cast<const bf16x8*>(_kb + (long)(32 + sr) * LDP + sc); } while (0)
#define SWRITE(b, i) do { *(bf16x8*)(V_lds + (b) * SHM_V + vst0) = sr_[i].vs0; *(bf16x8*)(V_lds + (b) * SHM_V + vst1) = sr_[i].vs1; const int kc = sc * 2;               \
    *(bf16x8*)(K_lds + (b) * SHM_K + KSWZ(sr, kc)) = sr_[i].ks0; *(bf16x8*)(K_lds + (b) * SHM_K + KSWZ(32 + sr, kc)) = sr_[i].ks1; } while (0)
#define SWAIT() asm volatile("s_waitcnt vmcnt(0)" ::: "memory")
#define RESC(a) do { if (__any((a) < 1.f)) { if (hi == 0) al_l[r32] = (a); asm volatile("s_waitcnt lgkmcnt(0)" ::: "memory"); \
    _Pragma("unroll") for (int d = 0; d < 4; ++d) _Pragma("unroll") for (int r = 0; r < 16; ++r) o[d][r] *= al_l[crow(r, hi)]; } } while (0)
    f32x16 pA0, pA1, pB0, pB1; float mnA, mnB, alA, alB; bf16x8 pa0, pa1, pa2, pa3;
    SLOAD(0, 0); asm volatile("s_waitcnt vmcnt(0)" ::: "memory"); SWRITE(0, 0); __syncthreads();
    qkt(pA0, pA1, K_lds, qr, r32, hi, cb0); partialSM(pA0, pA1, m_reg, mnA, alA);
    SLOAD(0, 1);
    SWAIT(); SWRITE(1, 0); __syncthreads();
    for (int j = 1; j + 1 < NT; j += 2) {
        SBAR(); qkt(pB0, pB1, K_lds + SHM_K, qr, r32, hi, cb0);
        finishSM(pA0, pA1, alA, l_reg, pa0, pa1, pa2, pa3); SBAR();
        SLOAD(0, j + 1); SBAR();
        pv_d0(o, vb0, pa0, pa1, pa2, pa3); partialSM(pB0, pB1, m_reg, mnB, alB);
        __syncthreads(); SWAIT(); SWRITE(0, 0);
        RESC(alB); __syncthreads();
        SBAR(); qkt(pA0, pA1, K_lds, qr, r32, hi, cb0);
        finishSM(pB0, pB1, alB, l_reg, pa0, pa1, pa2, pa3); SBAR();
        SLOAD(0, j + 2); SBAR();
        pv_d0(o, vb0 + SHM_V, pa0, pa1, pa2, pa3); partialSM(pA0, pA1, m_reg, mnA, alA);
        __syncthreads(); SWAIT(); SWRITE(1, 0);
        RESC(alA); __syncthreads();
    }
    SBAR(); qkt(pB0, pB1, K_lds + SHM_K, qr, r32, hi, cb0);
    finishSM(pA0, pA1, alA, l_reg, pa0, pa1, pa2, pa3); SBAR();
    pv_d0(o, vb0, pa0, pa1, pa2, pa3); partialSM(pB0, pB1, m_reg, mnB, alB);
    __syncthreads(); RESC(alB);
    finishSM(pB0, pB1, alB, l_reg, pa0, pa1, pa2, pa3); SBAR();
    pv_d0(o, vb0 + SHM_V, pa0, pa1, pa2, pa3);
    if (hi == 0) li_l[r32] = l_reg; asm volatile("s_waitcnt lgkmcnt(0)" ::: "memory");
    float rli[16];
#pragma unroll
    for (int r = 0; r < 16; ++r) rli[r] = __builtin_amdgcn_rcpf(li_l[crow(r, hi)]) * (map ? lam : 1.f);
    __syncthreads();
    float* X = (float*)lds + w4 * (32 * 128);
    if (map == 1) {
#pragma unroll
        for (int r = 0; r < 16; ++r)
#pragma unroll
            for (int d0 = 0; d0 < 4; ++d0) X[crow(r, hi) * 128 + d0 * 32 + r32] = o[d0][r] * rli[r];
    }
    __syncthreads();
    if (map == 0) {
        float ss[16];
#pragma unroll
        for (int r = 0; r < 16; ++r) { float s = 0.f;
#pragma unroll
            for (int d0 = 0; d0 < 4; ++d0) { const float v = o[d0][r] * rli[r] - X[crow(r, hi) * 128 + d0 * 32 + r32]; o[d0][r] = v; s += v * v; }
            ss[r] = s; }
#pragma unroll
        for (int r = 0; r < 16; ++r) { float s = ss[r]; s += __shfl_xor(s, 1); s += __shfl_xor(s, 2); s += __shfl_xor(s, 4); s += __shfl_xor(s, 8); s += __shfl_xor(s, 16);
            ss[r] = __builtin_amdgcn_rsqf(s * (1.f / 128.f) + EPS) * oscale; }
        bf16_t* Ost = (bf16_t*)(lds + OFF_OST) + w4 * 4096;
#pragma unroll
        for (int d0 = 0; d0 < 4; ++d0) { const float g = subg[d0 * 32 + r32];
#pragma unroll
            for (int r = 0; r < 16; ++r) Ost[crow(r, hi) * 128 + d0 * 32 + r32] = (bf16_t)(cvt_pk_bf16(o[d0][r] * ss[r] * g, 0.f) & 0xffffu); }
        asm volatile("s_waitcnt lgkmcnt(0)" ::: "memory");
#pragma unroll
        for (int it = 0; it < 8; ++it) { const int row = it * 4 + (lane >> 4), ch = lane & 15;
            const u32x4 w = *(const u32x4*)(Ost + row * 128 + ch * 8);
            *(u32x4*)(Ob + (long)(w4 * 32 + row) * LDP + ch * 8) = w; }
    }
    __syncthreads();
#undef TILEP
#undef SLOAD
#undef SWRITE
#undef SWAIT
#undef RESC
}

__device__ __forceinline__ void sg_unit(bf16_t* P0, const bf16_t* __restrict__ sgw, const float* __restrict__ lng, const float* __restrict__ lnb, const float* __restrict__ sgb, char* lds) {
    int tid = threadIdx.x; asm volatile("" : "+v"(tid));
    const int wid = __builtin_amdgcn_readfirstlane(tid >> 6), lane = tid & 63, r32 = lane & 31, hi = lane >> 5;
    float* stat = (float*)(lds + 65536);
    for (int i = 0; i < 16; ++i) { const int tkn = wid * 16 + i;
        const u32x4 w = *(const u32x4*)(P0 + (long)tkn * LDP + COL_G + lane * 8);
        float x[8] = {bflo(w.x), bfhi(w.x), bflo(w.y), bfhi(w.y), bflo(w.z), bfhi(w.z), bflo(w.w), bfhi(w.w)};
        float s = 0.f;
#pragma unroll
        for (int j = 0; j < 8; ++j) s += x[j];
        const float mean = wave_sum(s) * (1.f / 512.f); float q = 0.f;
#pragma unroll
        for (int j = 0; j < 8; ++j) { const float d = x[j] - mean; q += d * d; }
        const float rstd = __builtin_amdgcn_rsqf(wave_sum(q) * (1.f / 512.f) + EPS);
        if (lane == 0) { stat[tkn * 2] = mean; stat[tkn * 2 + 1] = rstd; } }
    __syncthreads();
    const int sr = tid >> 4, sc = (tid & 15) * 8;
    const int vb0 = (int)(uintptr_t)lds + v_rd_base(lane);
    const int mt = wid & 3, eh = wid >> 2;
    for (int g = 0; g < 4; ++g) {
        f32x4 ga = *(const f32x4*)(lng + g * 128 + sc), gb = *(const f32x4*)(lng + g * 128 + sc + 4), ba = *(const f32x4*)(lnb + g * 128 + sc), bb = *(const f32x4*)(lnb + g * 128 + sc + 4);
#pragma unroll
        for (int q4 = 0; q4 < 4; ++q4) { const int tkn = q4 * 32 + sr;
            const u32x4 w = *(const u32x4*)(P0 + (long)tkn * LDP + COL_G + g * 128 + sc);
            const float mean = stat[tkn * 2], rstd = stat[tkn * 2 + 1];
            float x[8] = {bflo(w.x), bfhi(w.x), bflo(w.y), bfhi(w.y), bflo(w.z), bfhi(w.z), bflo(w.w), bfhi(w.w)};
            u32x4 ov;
            ov.x = cvt_pk_bf16((x[0] - mean) * rstd * ga[0] + ba[0], (x[1] - mean) * rstd * ga[1] + ba[1]);
            ov.y = cvt_pk_bf16((x[2] - mean) * rstd * ga[2] + ba[2], (x[3] - mean) * rstd * ga[3] + ba[3]);
            ov.z = cvt_pk_bf16((x[4] - mean) * rstd * gb[0] + bb[0], (x[5] - mean) * rstd * gb[1] + bb[1]);
            ov.w = cvt_pk_bf16((x[6] - mean) * rstd * gb[2] + bb[2], (x[7] - mean) * rstd * gb[3] + bb[3]);
            *(u32x4*)(lds + (tkn >> 6) * SHM_V + v_st(tkn & 63, sc)) = ov; }
        __syncthreads();
        f32x16 oa = {}, ob = {};
        const bf16_t* Wp = sgw + (size_t)g * 128 * 128 + (size_t)(mt * 32 + r32) * 128 + hi * 8;
#pragma unroll
        for (int tq = 0; tq < 2; ++tq) {
            const bf16x8 a0 = *(const bf16x8*)(Wp + tq * 64), a1 = *(const bf16x8*)(Wp + tq * 64 + 16), a2 = *(const bf16x8*)(Wp + tq * 64 + 32), a3 = *(const bf16x8*)(Wp + tq * 64 + 48);
            if (eh == 0) { pv_one<0>(oa, vb0 + tq * SHM_V, a0, a1, a2, a3); pv_one<1>(ob, vb0 + tq * SHM_V, a0, a1, a2, a3); }
            else         { pv_one<2>(oa, vb0 + tq * SHM_V, a0, a1, a2, a3); pv_one<3>(ob, vb0 + tq * SHM_V, a0, a1, a2, a3); }
        }
#pragma unroll
        for (int r = 0; r < 16; ++r) { const int p = mt * 32 + crow(r, hi); const float bs = sgb[g * 128 + p];
            bf16_t* up = P0 + (long)p * LDP + COL_U + g * 128 + eh * 64 + r32;
            const float u0 = bf2f(up[0]), u1 = bf2f(up[32]);
            up[0] = (bf16_t)(cvt_pk_bf16(u0 * (oa[r] + bs), 0.f) & 0xffffu); up[32] = (bf16_t)(cvt_pk_bf16(u1 * (ob[r] + bs), 0.f) & 0xffffu); }
        __syncthreads();
    }
}
}

#define XB_TMO      128
#define XB_XCNT(j)  (256  + 64 * (j))
#define XB_XSUB(j)  (1280 + 64 * (j))
#define XB_XGEN(j)  (2304 + 64 * (j))
#define XB_TOP      3328
#define XB_TOPGEN   3392
#define XCD_BAR_WORDS 3456
#define XB_SPIN_CAP (1u << 18)
__device__ __forceinline__ unsigned xb_ld(unsigned* p)              { return __hip_atomic_load(p, __ATOMIC_RELAXED, __HIP_MEMORY_SCOPE_AGENT); }
__device__ __forceinline__ unsigned xb_add(unsigned* p, unsigned v) { return __hip_atomic_fetch_add(p, v, __ATOMIC_RELAXED, __HIP_MEMORY_SCOPE_AGENT); }
__device__ __forceinline__ unsigned xb_xcc_id() { return (unsigned)__builtin_amdgcn_s_getreg((3 << 11) | 20) & 0xFu; }
#define XB_SPIN(cond, bar) do { unsigned _sp = 0; while (cond) { __builtin_amdgcn_s_sleep(1); \
    if ((++_sp & 255u) == 0u) { if (xb_ld(&(bar)[XB_TMO])) break; if (_sp > XB_SPIN_CAP) { atomicAdd(&(bar)[XB_TMO], 1u); break; } } } } while (0)
struct XcdBarrier { unsigned* bar; unsigned x; volatile LAS unsigned* st; };
__device__ __forceinline__ XcdBarrier xcd_barrier_post(unsigned* bar, volatile LAS unsigned* st) {
    XcdBarrier b; b.bar = bar; b.x = xb_xcc_id(); b.st = st;
    if (threadIdx.x == 0) (void)xb_add(&bar[XB_XCNT(b.x)], 1u);
    return b;
}
__device__ __forceinline__ void xcd_barrier_complete(unsigned* bar, unsigned x, unsigned& nloc, unsigned& nx) {
    const unsigned G = gridDim.x * gridDim.y * gridDim.z;
    unsigned sum, cnt, mine, sp = 0u;
    for (;;) {
        sum = 0u; cnt = 0u; mine = 0u;
#pragma unroll
        for (unsigned j = 0; j < 16; ++j) { const unsigned c = xb_ld(&bar[XB_XCNT(j)]); sum += c; cnt += (c > 0u) ? 1u : 0u; mine = (j == x) ? c : mine; }
        if (sum == G) break;
        __builtin_amdgcn_s_sleep(1);
        if ((++sp & 255u) == 0u) { if (xb_ld(&bar[XB_TMO])) break; if (sp > XB_SPIN_CAP) { atomicAdd(&bar[XB_TMO], 1u); break; } }
    }
    nloc = mine > 0u ? mine : 1u; nx = cnt > 0u ? cnt : 1u;
}
__device__ __forceinline__ void xcd_barrier(const XcdBarrier& b) {
    asm volatile("s_waitcnt vmcnt(0)" ::: "memory");
    __syncthreads();
    if (threadIdx.x == 0) {
        unsigned* bar = b.bar;
        __builtin_amdgcn_s_waitcnt(0);
        unsigned nloc = b.st[0], nx = b.st[1];
        if (nloc == 0u) { xcd_barrier_complete(bar, b.x, nloc, nx); b.st[0] = nloc; b.st[1] = nx; }
        const unsigned old = xb_add(&bar[XB_XSUB(b.x)], 1u);
        const unsigned gen = old / nloc;
        if (old + 1u == (gen + 1u) * nloc) {
            __builtin_amdgcn_fence(__ATOMIC_RELEASE, "agent");
            asm volatile("s_waitcnt vmcnt(0)" ::: "memory");
            const unsigned og = xb_add(&bar[XB_TOP], 1u);
            const unsigned tg = og / nx;
            if (og + 1u == (tg + 1u) * nx) xb_add(&bar[XB_TOPGEN], 1u);
            else XB_SPIN(xb_ld(&bar[XB_TOPGEN]) == tg, bar);
            __builtin_amdgcn_fence(__ATOMIC_ACQUIRE, "agent");
            xb_add(&bar[XB_XGEN(b.x)], 1u);
            asm volatile("s_waitcnt vmcnt(0)" ::: "memory");
        } else {
            XB_SPIN(xb_ld(&bar[XB_XGEN(b.x)]) == gen, bar);
            __builtin_amdgcn_fence(__ATOMIC_ACQUIRE, "agent");
            asm volatile("s_waitcnt vmcnt(0)" ::: "memory");
        }
    }
    __syncthreads();
}

struct Args {
    const float* in[28]; float* out; unsigned char* ws; int ph_lo, ph_hi;
};
struct Frame {
    LAS unsigned char* lds; gu32* ctl; int tid, lane, wave, vcu, G;
};

__device__ __forceinline__ void transpose_item(const float* __restrict__ W, int ldw, int srcg, bool rope, int k0, bf16_t* WT, size_t dst_row0, int K, LAS float* scr, int lane) {
    const int j = lane & 31, sj = rope ? ((j & 3) + 4 * (j >> 3) + 16 * ((j >> 2) & 1)) : j;
    float v[32];
#pragma unroll
    for (int i = 0; i < 32; ++i) { const int kk = 2 * i + (lane >> 5); v[i] = W[(size_t)(k0 + kk) * ldw + srcg + sj]; }
#pragma unroll
    for (int i = 0; i < 32; ++i) { const int kk = 2 * i + (lane >> 5); scr[kk * 33 + j] = v[i]; }
    LDS_WAIT(); asm volatile("" ::: "memory");
    const int c = lane & 7;
#pragma unroll
    for (int jj = 0; jj < 4; ++jj) { const int n = (lane >> 3) + 8 * jj; const LAS float* s = scr + (8 * c) * 33 + n;
        u32x4 o; o.x = cvt_pk_bf16(s[0 * 33], s[1 * 33]); o.y = cvt_pk_bf16(s[2 * 33], s[3 * 33]); o.z = cvt_pk_bf16(s[4 * 33], s[5 * 33]); o.w = cvt_pk_bf16(s[6 * 33], s[7 * 33]);
        *(u32x4*)(WT + (dst_row0 + n) * K + k0 + 8 * c) = o; }
    LDS_WAIT(); asm volatile("" ::: "memory");
}

__device__ __forceinline__ void transpose_item_f8(const float* __restrict__ W, int ldw, int srcg, int k0, unsigned char* WT, size_t dst_row0, int K, LAS float* scr, int lane) {
    const int j = lane & 31;
    float v[32];
#pragma unroll
    for (int i = 0; i < 32; ++i) { const int kk = 2 * i + (lane >> 5); v[i] = W[(size_t)(k0 + kk) * ldw + srcg + j]; }
#pragma unroll
    for (int i = 0; i < 32; ++i) { const int kk = 2 * i + (lane >> 5); scr[kk * 33 + j] = v[i] * 128.f; }
    LDS_WAIT(); asm volatile("" ::: "memory");
    const int n = lane >> 1, hf = lane & 1; const LAS float* s = scr + (32 * hf) * 33 + n;
    u32x4 o0, o1;
    o0.x = pg8::pk_fp8x4(s[0 * 33], s[1 * 33], s[2 * 33], s[3 * 33]);     o0.y = pg8::pk_fp8x4(s[4 * 33], s[5 * 33], s[6 * 33], s[7 * 33]);
    o0.z = pg8::pk_fp8x4(s[8 * 33], s[9 * 33], s[10 * 33], s[11 * 33]);   o0.w = pg8::pk_fp8x4(s[12 * 33], s[13 * 33], s[14 * 33], s[15 * 33]);
    o1.x = pg8::pk_fp8x4(s[16 * 33], s[17 * 33], s[18 * 33], s[19 * 33]); o1.y = pg8::pk_fp8x4(s[20 * 33], s[21 * 33], s[22 * 33], s[23 * 33]);
    o1.z = pg8::pk_fp8x4(s[24 * 33], s[25 * 33], s[26 * 33], s[27 * 33]); o1.w = pg8::pk_fp8x4(s[28 * 33], s[29 * 33], s[30 * 33], s[31 * 33]);
    unsigned char* d = WT + (dst_row0 + n) * K + k0 + 32 * hf;
    *(u32x4*)d = o0; *(u32x4*)(d + 16) = o1;
    LDS_WAIT(); asm volatile("" ::: "memory");
}

__device__ __forceinline__ void p0_prologue(Frame& F, const Args& a) {
    unsigned char* ws = a.ws;
    if (blockIdx.x < 192) {
        const int l = blockIdx.x / 96, n0 = (blockIdx.x % 96) * 64;
        LAS float* s = (LAS float*)F.lds;
        LAS float* red = (LAS float*)(F.lds + 73728);
        const float* c = a.in[1]; const float* cc = a.in[3];
        for (int i = F.tid; i < 17 * 1024; i += 512) { const float v = i < 16 * 1024 ? c[i] : cc[i - 16 * 1024]; s[i] = silu_f(v); }
        __syncthreads();
        const float* W = a.in[4] + (size_t)l * D * 6144 + n0 + F.lane;
        float acc[17];
#pragma unroll
        for (int r = 0; r < 17; ++r) acc[r] = 0.f;
        const int kb = F.wave * 128;
        for (int k = 0; k < 128; k += 4) {
            const float w0 = W[(size_t)(kb + k) * 6144], w1 = W[(size_t)(kb + k + 1) * 6144], w2 = W[(size_t)(kb + k + 2) * 6144], w3 = W[(size_t)(kb + k + 3) * 6144];
#pragma unroll
            for (int r = 0; r < 17; ++r) { const f32x4 sv = *(const LAS f32x4*)(s + r * 1024 + kb + k); acc[r] += sv[0] * w0 + sv[1] * w1 + sv[2] * w2 + sv[3] * w3; }
        }
#pragma unroll
        for (int r = 0; r < 17; ++r) red[(F.wave * 17 + r) * 64 + F.lane] = acc[r];
        __syncthreads();
        float* ms = (float*)(ws + WS_MS) + (size_t)l * 17 * 6144;
        const float* bias = a.in[5] + (size_t)l * 6144;
        for (int i = F.tid; i < 17 * 64; i += 512) { const int r = i >> 6, col = i & 63; float v = bias[n0 + col];
#pragma unroll
            for (int w = 0; w < 8; ++w) v += red[(w * 17 + r) * 64 + col];
            ms[(size_t)r * 6144 + n0 + col] = v; }
        __syncthreads();
    }
    if (blockIdx.x == 255) {
        float* rc = (float*)(ws + WS_ROPE); float* rs = rc + 1024;
        for (int i = F.tid; i < 1024; i += 512) { const int pos = i >> 4, j = i & 15; const float inv = powf(10000.0f, -(float)(2 * j) / 32.0f); const float ang = (float)pos * inv; rc[i] = cosf(ang); rs[i] = sinf(ang); }
    }
    { const float* src = a.in[19]; bf16_t* dst = (bf16_t*)(ws + WS_SGW); const int n4 = 2 * 4 * 128 * 128 / 4;
      for (int i = blockIdx.x * 512 + F.tid; i < n4; i += F.G * 512) { const f32x4 v = *(const f32x4*)(src + (size_t)i * 4); u32x2 o; o.x = cvt_pk_bf16(v[0], v[1]); o.y = cvt_pk_bf16(v[2], v[3]); *(u32x2*)(dst + (size_t)i * 4) = o; } }
    LAS float* scr = (LAS float*)(F.lds + F.wave * 16384);
    const int gw = F.vcu * NWAVES + F.wave, NGW = F.G * NWAVES;
    constexpr int I_IN = 16 * 80, I_OUT = 16 * 32, I_F13 = 16 * 176, I_F2 = 44 * 32, I_M13 = 16 * 224, I_M2 = 56 * 32;
    constexpr int NITEMS = 2 * I_IN + 2 * I_OUT + I_F13 + I_F2 + 8 * I_M13 + 8 * I_M2;
    for (int it = gw; it < NITEMS; it += NGW) {
        int r = it;
        if (r < 2 * I_IN) { const int l = r / I_IN; r %= I_IN; const int kb = r / 80, g = r % 80, seg = g >> 4, gi = g & 15;
            const int sseg = seg == 0 ? 0 : seg == 1 ? 3 : seg == 2 ? 1 : seg == 3 ? 2 : 4;
            transpose_item(a.in[10] + (size_t)l * D * NIN, NIN, sseg * 512 + gi * 32, seg == 0 || seg == 2, kb * 64, (bf16_t*)(ws + WS_WIN) + (size_t)l * NIN * D, (size_t)g * 32, D, scr, F.lane); continue; }
        r -= 2 * I_IN;
        if (r < 2 * I_OUT) { const int l = r / I_OUT; r %= I_OUT; const int kb = r / 32, g = r % 32;
            transpose_item(a.in[11] + (size_t)l * D * D, D, g * 32, false, kb * 64, (bf16_t*)(ws + WS_WOUT) + (size_t)l * D * D, (size_t)g * 32, D, scr, F.lane); continue; }
        r -= 2 * I_OUT;
        if (r < I_F13) { const int kb = r / 176, g = r % 176, tile = g >> 3, gi = g & 7;
            const float* src = gi < 4 ? a.in[21] : a.in[22];
            transpose_item(src, DFF, tile * 128 + (gi & 3) * 32, false, kb * 64, (bf16_t*)(ws + WS_W13), (size_t)g * 32, D, scr, F.lane); continue; }
        r -= I_F13;
        if (r < I_F2) { const int kb = r / 32, g = r % 32;
            transpose_item(a.in[23], D, g * 32, false, kb * 64, (bf16_t*)(ws + WS_W2), (size_t)g * 32, DFF, scr, F.lane); continue; }
        r -= I_F2;
        if (r < 8 * I_M13) { const int e = r / I_M13; r %= I_M13; const int kb = r / 224, g = r % 224, tile = g >> 3, gi = g & 7;
            const float* src = (gi < 4 ? a.in[25] : a.in[26]) + (size_t)e * D * DEXP;
            transpose_item_f8(src, DEXP, tile * 128 + (gi & 3) * 32, kb * 64, ws + WS_MW13 + (size_t)e * 7168 * D, (size_t)g * 32, D, scr, F.lane); continue; }
        r -= 8 * I_M13;
        { const int e = r / I_M2; r %= I_M2; const int kb = r / 32, g = r % 32;
            transpose_item_f8(a.in[27] + (size_t)e * DEXP * D, D, g * 32, kb * 64, ws + WS_MW2 + (size_t)e * D * DEXP, (size_t)g * 32, DEXP, scr, F.lane); }
    }
}

struct Row { f32x4 v[4]; };
__device__ __forceinline__ Row ld_row_f32(const float* p, int lane) { Row r; const f32x4* q = (const f32x4*)p + lane;
#pragma unroll
    for (int j = 0; j < 4; ++j) r.v[j] = q[64 * j]; return r; }
__device__ __forceinline__ void st_row_f32(float* p, int lane, const Row& r) { f32x4* q = (f32x4*)p + lane;
#pragma unroll
    for (int j = 0; j < 4; ++j) q[64 * j] = r.v[j]; }
__device__ __forceinline__ Row ld_row_bf16(const bf16_t* p, int lane) { Row r; const u32x2* q = (const u32x2*)p + lane;
#pragma unroll
    for (int j = 0; j < 4; ++j) { const u32x2 w = q[64 * j]; r.v[j] = (f32x4){bflo(w.x), bfhi(w.x), bflo(w.y), bfhi(w.y)}; } return r; }
__device__ __forceinline__ void st_row_bf16(bf16_t* p, int lane, const Row& r) { u32x2* q = (u32x2*)p + lane;
#pragma unroll
    for (int j = 0; j < 4; ++j) { u32x2 w; w.x = cvt_pk_bf16(r.v[j][0], r.v[j][1]); w.y = cvt_pk_bf16(r.v[j][2], r.v[j][3]); q[64 * j] = w; } }
__device__ __forceinline__ float row_rms_scale(const Row& r) { float s = 0.f;
#pragma unroll
    for (int j = 0; j < 4; ++j) s += (r.v[j][0] * r.v[j][0] + r.v[j][1] * r.v[j][1]) + (r.v[j][2] * r.v[j][2] + r.v[j][3] * r.v[j][3]);
    return __builtin_amdgcn_rsqf(wave_sum(s) * (1.f / D) + EPS); }
__device__ __forceinline__ Row row_modulate(const Row& x, const float* g, const float* shift, const float* scale, int lane) {
    const float rs = row_rms_scale(x); Row h; const f32x4* gq = (const f32x4*)g + lane; const f32x4* sh = (const f32x4*)shift + lane; const f32x4* sc = (const f32x4*)scale + lane;
#pragma unroll
    for (int j = 0; j < 4; ++j) h.v[j] = x.v[j] * rs * gq[64 * j] * (1.f + sc[64 * j]) + sh[64 * j];
    return h; }
__device__ __forceinline__ void row_residual(Row& x, const Row& y, const float* g, const float* gate, int lane) {
    const float rs = row_rms_scale(y); const f32x4* gq = (const f32x4*)g + lane; const f32x4* gt = (const f32x4*)gate + lane;
#pragma unroll
    for (int j = 0; j < 4; ++j) x.v[j] = x.v[j] + gt[64 * j] * (y.v[j] * rs * gq[64 * j]);
}

struct MoeTab { int cnt[8]; int pbase[9]; };
__device__ __forceinline__ void moe_tab(gu32* ctl, MoeTab& T) {
    int p = 0;
#pragma unroll
    for (int e = 0; e < 8; ++e) { const int c = (int)__builtin_amdgcn_readfirstlane(__hip_atomic_load(ctl + CW_CNT + 64 * e, RLX_AGENT)); T.cnt[e] = c; T.pbase[e] = p; p += (c + 255) >> 8; }
    T.pbase[8] = p;
}
__device__ __forceinline__ int moe_expert_of(const MoeTab& T, int panel) { int e = 0;
#pragma unroll
    for (int i = 1; i < 8; ++i) e += (panel >= T.pbase[i]) ? 1 : 0;
    return e; }

struct MoeUpSched {
    const char* A; const char* Bt; const int* slot_token; int G, c, p0, nM; MoeTab T;
    __device__ __forceinline__ bool next(int i, pg8::Unit& u) const {
        const int L = i * G + c; if (L >= nM * 28) return false;
        int pm, pn; pg8::tile_of(L, nM, 28, pm, pn);
        const int panel = p0 + pm, e = moe_expert_of(T, panel);
        u.pm = pm; u.pn = pn; u.aux = e; u.aux2 = panel; u.Ap = A; u.Bp = Bt + ((size_t)e * 7168 + (size_t)pn * 256) * D; return true;
    }
    __device__ __forceinline__ void aoff(const pg8::Unit& u, const int (&R)[2], const int (&C)[2], unsigned (&o0)[2], unsigned (&o1)[2]) const {
        int pb = 0, cn = 0;
#pragma unroll
        for (int e = 0; e < 8; ++e) { pb = (u.aux == e) ? T.pbase[e] : pb; cn = (u.aux == e) ? T.cnt[e] : cn; }
        const int rk0 = (u.aux2 - pb) * 256;
#pragma unroll
        for (int i = 0; i < 2; ++i) {
            const int ra = rk0 + R[i], rb = rk0 + pg8::HALF + R[i];
            const int ta = slot_token[u.aux * 32768 + (ra < cn ? ra : 0)], tb = slot_token[u.aux * 32768 + (rb < cn ? rb : 0)];
            o0[i] = (unsigned)(ta * D + C[i] * 2); o1[i] = (unsigned)(tb * D + C[i] * 2); }
    }
};
struct MoeDownSched {
    const char* A; const char* Bt; int G, c, p0, nM; MoeTab T;
    __device__ __forceinline__ bool next(int i, pg8::Unit& u) const {
        const int L = i * G + c; if (L >= nM * 4) return false;
        int pm, pn; pg8::tile_of(L, nM, 4, pm, pn);
        const int panel = p0 + pm, e = moe_expert_of(T, panel);
        u.pm = panel; u.pn = pn; u.aux = e; u.aux2 = 0; u.Ap = A + (size_t)pm * 256 * DEXP; u.Bp = Bt + ((size_t)e * D + (size_t)pn * 256) * DEXP; return true;
    }
    __device__ __forceinline__ void aoff(const pg8::Unit&, const int (&R)[2], const int (&C)[2], unsigned (&o0)[2], unsigned (&o1)[2]) const {
#pragma unroll
        for (int i = 0; i < 2; ++i) { o0[i] = (unsigned)(R[i] * DEXP + C[i] * 2); o1[i] = (unsigned)((pg8::HALF + R[i]) * DEXP + C[i] * 2); }
    }
};

constexpr int N_PHASES = 24;

__global__ void __launch_bounds__(NWAVES * 64, 2) mk_fwd(Args args) {
    extern __shared__ __attribute__((aligned(16))) unsigned char lds_raw[];
    Frame F;
    F.lds = (LAS unsigned char*)lds_raw;
    F.tid = threadIdx.x; F.lane = F.tid & 63; F.wave = __builtin_amdgcn_readfirstlane(F.tid >> 6);
    F.G = gridDim.x; { const int bx = blockIdx.x; F.vcu = (F.G % 8 == 0) ? (bx % 8) * (F.G / 8) + bx / 8 : bx; }
    unsigned char* ws = args.ws;
    F.ctl = (gu32*)(ws + WS_CTL);
    volatile LAS unsigned* MISC = (volatile LAS unsigned*)(F.lds + MISC_OFF);
    for (int u = F.tid; u < (LDS_BYTES - LDSCTL_OFF) / 4; u += NWAVES * 64) ((LAS unsigned*)(F.lds + LDSCTL_OFF))[u] = 0u;
    __syncthreads();
    XcdBarrier bar; bar.bar = (unsigned*)(F.ctl + CW_BAR); bar.x = 0; bar.st = nullptr;
    if (!MK_PER_PHASE) bar = xcd_barrier_post((unsigned*)(F.ctl + CW_BAR), MISC + 8);
    const int lo = args.ph_lo, hi = args.ph_hi;
#ifndef DUP_MASK
#define DUP_MASK 0u
#endif
#if ((DUP_MASK) >> 0) & 1
#define REP_0 for (int _rep = 0; _rep < 2; ++_rep)
#else
#define REP_0
#endif
#if ((DUP_MASK) >> 1) & 1
#define REP_1 for (int _rep = 0; _rep < 2; ++_rep)
#else
#define REP_1
#endif
#if ((DUP_MASK) >> 2) & 1
#define REP_2 for (int _rep = 0; _rep < 2; ++_rep)
#else
#define REP_2
#endif
#if ((DUP_MASK) >> 4) & 1
#define REP_4 for (int _rep = 0; _rep < 2; ++_rep)
#else
#define REP_4
#endif
#if ((DUP_MASK) >> 5) & 1
#define REP_5 for (int _rep = 0; _rep < 2; ++_rep)
#else
#define REP_5
#endif
#if ((DUP_MASK) >> 6) & 1
#define REP_6 for (int _rep = 0; _rep < 2; ++_rep)
#else
#define REP_6
#endif
#if ((DUP_MASK) >> 7) & 1
#define REP_7 for (int _rep = 0; _rep < 2; ++_rep)
#else
#define REP_7
#endif
#if ((DUP_MASK) >> 9) & 1
#define REP_9 for (int _rep = 0; _rep < 2; ++_rep)
#else
#define REP_9
#endif
#if ((DUP_MASK) >> 11) & 1
#define REP_11 for (int _rep = 0; _rep < 2; ++_rep)
#else
#define REP_11
#endif
#if ((DUP_MASK) >> 13) & 1
#define REP_13 for (int _rep = 0; _rep < 2; ++_rep)
#else
#define REP_13
#endif
#ifndef PH_MASK
#define PH_MASK 0xffffffu
#endif
#define IN(k) ((((PH_MASK) >> (k)) & 1u) && lo <= (k) && (k) < hi)
#define SEAM(k) do { if (IN(k) && IN((k) + 1)) xcd_barrier(bar); } while (0)

    const float* x_in = args.in[0]; const float* ctx_in = args.in[2];
    float* xlat = args.out; float* xctx = (float*)(ws + WS_XCTX);
    bf16_t* HA = (bf16_t*)(ws + WS_HA); bf16_t* P = (bf16_t*)(ws + WS_R1); bf16_t* HFF = (bf16_t*)(ws + WS_R1); bf16_t* OY = (bf16_t*)(ws + WS_OY); bf16_t* YS = (bf16_t*)(ws + WS_YS);
    const float* MS = (const float*)(ws + WS_MS);
    const float* ropec = (const float*)(ws + WS_ROPE); const float* ropes = ropec + 1024;
    int* tok_e = (int*)(ws + WS_ROUTE); float* tok_g = (float*)(ws + WS_ROUTE + 262144); int* tok_rank = (int*)(ws + WS_ROUTE + 524288);
    int* slot_token = (int*)(ws + WS_SLOT);
    const int gw = F.vcu * NWAVES + F.wave, NGW = F.G * NWAVES;
    char* ldsg = (char*)lds_raw;

    REP_0 if (IN(0)) { p0_prologue(F, args); __syncthreads(); }
    SEAM(0);

    REP_1 if (IN(1)) {
        const float* g = args.in[6];
        for (int m = gw; m < MALL; m += NGW) {
            const bool lat = m < MLAT; const int r17 = lat ? (m >> 11) : 16;
            const float* xr = lat ? x_in + (size_t)m * D : ctx_in + (size_t)(m - MLAT) * D;
            const float* msr = MS + (size_t)r17 * 6144;
            const Row x = ld_row_f32(xr, F.lane);
            const Row h = row_modulate(x, g, msr, msr + 1024, F.lane);
            st_row_bf16(HA + (size_t)m * D, F.lane, h);
        }
    }
    SEAM(1);

    REP_2 if (IN(2)) {
        pg8::DenseSched S{(const char*)HA, (const char*)(ws + WS_WIN), D, D, F.G, (int)blockIdx.x, MALL / 256, 10, 0, 0, 0, 0, 0, 0};
        pg8::EpiInProj E{P, ropec, ropes};
        pg8::gemm_phase<pg8::EpiInProj, pg8::DenseSched, true>(F.lds, D, S, E);
    }
    SEAM(2);

#define ATTN_PHASE(LAYER, WITH_CTX) do { \
        float lam; { const float a1 = args.in[12][(LAYER) * 64 + F.lane] * args.in[13][(LAYER) * 64 + F.lane], a2 = args.in[14][(LAYER) * 64 + F.lane] * args.in[15][(LAYER) * 64 + F.lane]; \
            lam = __expf(wave_sum(a1)) - __expf(wave_sum(a2)) + ((LAYER) ? LAMBDA_INIT1 : LAMBDA_INIT0); } \
        const float oscale = 1.f - ((LAYER) ? LAMBDA_INIT1 : LAMBDA_INIT0); \
        const float* subg = args.in[16] + (LAYER) * 128; \
        const int c = (int)blockIdx.x, xcd = c & 7, jj = c >> 3; \
        if (!DBG_NO_LAT) for (int i = 0; i < 4; ++i) { const int bh = i * 16 + xcd * 2 + (jj >> 4), qb = jj & 15, b = bh >> 2, h = bh & 3; \
            bf16_t* Qb = P + ((size_t)b * SEQ + qb * 128) * NIN + COL_Q + h * 128; \
            const bf16_t* Kc = P + ((size_t)MLAT + b * CTX) * NIN + COL_K + h * 128; const bf16_t* Kl = P + ((size_t)b * SEQ) * NIN + COL_K + h * 128; \
            att::attn_unit(Qb, Kc, 4, Kl, 32, Qb, lam, oscale, subg, ldsg); } \
        int c1 = c; asm volatile("" : "+s"(c1)); \
        if (!DBG_NO_CTX && (WITH_CTX) && c1 < 128) { const int bh = c1 >> 1, qb = c1 & 1, b = bh >> 2, h = bh & 3; \
            bf16_t* Qb = P + ((size_t)MLAT + b * CTX + qb * 128) * NIN + COL_Q + h * 128; const bf16_t* Kc = P + ((size_t)MLAT + b * CTX) * NIN + COL_K + h * 128; \
            att::attn_unit(Qb, Kc, 4, Kc, 0, Qb, lam, oscale, subg, ldsg); } \
        int c2 = c1; asm volatile("" : "+s"(c2)); \
        if (!DBG_NO_SG) { const bf16_t* sgw = (const bf16_t*)(ws + WS_SGW) + (size_t)(LAYER) * 4 * 128 * 128; \
          att::sg_unit(P + (size_t)c2 * 128 * NIN, sgw, args.in[17] + (LAYER) * 512, args.in[18] + (LAYER) * 512, args.in[20] + (LAYER) * 512, ldsg); \
          int c3 = c2; asm volatile("" : "+s"(c3)); \
          if ((WITH_CTX) && c3 >= 128 && c3 < 160) att::sg_unit(P + ((size_t)MLAT + (c3 - 128) * 128) * NIN, sgw, args.in[17] + (LAYER) * 512, args.in[18] + (LAYER) * 512, args.in[20] + (LAYER) * 512, ldsg); } \
    } while (0)
    if (IN(3)) { ATTN_PHASE(0, true); }
    SEAM(3);

    REP_4 if (IN(4)) {
        pg8::DenseSched S{(const char*)P, (const char*)(ws + WS_WOUT), NIN, D, F.G, (int)blockIdx.x, MALL / 256, 4, 0, 0, 0, 0, 0, 0};
        pg8::EpiPlain E{OY, D, 1.f};
        pg8::gemm_phase<pg8::EpiPlain, pg8::DenseSched, true>(F.lds, D, S, E);
    }
    SEAM(4);

    REP_5 if (IN(5)) {
        const float* gpost = args.in[7]; const float* gpre = args.in[8];
        for (int m = gw; m < MALL; m += NGW) {
            const bool lat = m < MLAT; const int r17 = lat ? (m >> 11) : 16;
            const float* xr = lat ? x_in + (size_t)m * D : ctx_in + (size_t)(m - MLAT) * D;
            float* xo = lat ? xlat + (size_t)m * D : xctx + (size_t)(m - MLAT) * D;
            const float* msr = MS + (size_t)r17 * 6144;
            Row x = ld_row_f32(xr, F.lane); const Row o = ld_row_bf16(OY + (size_t)m * D, F.lane);
            row_residual(x, o, gpost, msr + 2 * 1024, F.lane);
            st_row_f32(xo, F.lane, x);
            const Row f = row_modulate(x, gpre, msr + 3 * 1024, msr + 4 * 1024, F.lane);
            st_row_bf16(HA + (size_t)m * D, F.lane, f);
        }
    }
    SEAM(5);

    REP_6 if (IN(6)) {
        pg8::DenseSched S{(const char*)HA, (const char*)(ws + WS_W13), D, D, F.G, (int)blockIdx.x, MALL / 256, 22, 0, 0, 0, 0, 0, 0};
        pg8::EpiSwiglu E{HFF, DFF};
        pg8::gemm_phase<pg8::EpiSwiglu, pg8::DenseSched, true>(F.lds, D, S, E);
    }
    SEAM(6);

    REP_7 if (IN(7)) {
        pg8::DenseSched S{(const char*)HFF, (const char*)(ws + WS_W2), DFF, DFF, F.G, (int)blockIdx.x, MALL / 256, 4, 0, 0, 0, 0, 0, 0};
        pg8::EpiPlain E{OY, D, 1.f};
        pg8::gemm_phase<pg8::EpiPlain, pg8::DenseSched, true>(F.lds, DFF, S, E);
    }
    SEAM(7);

    if (IN(8)) {
        const float* gpost = args.in[9]; const float* gpre = args.in[6] + D;
        for (int m = gw; m < MALL; m += NGW) {
            const bool lat = m < MLAT; const int r17 = lat ? (m >> 11) : 16;
            float* xo = lat ? xlat + (size_t)m * D : xctx + (size_t)(m - MLAT) * D;
            const float* msr = MS + (size_t)r17 * 6144; const float* msr1 = MS + (size_t)(17 + r17) * 6144;
            Row x = ld_row_f32(xo, F.lane); const Row y = ld_row_bf16(OY + (size_t)m * D, F.lane);
            row_residual(x, y, gpost, msr + 5 * 1024, F.lane);
            if (lat) st_row_f32(xo, F.lane, x);
            const Row h = row_modulate(x, gpre, msr1, msr1 + 1024, F.lane);
            st_row_bf16(HA + (size_t)m * D, F.lane, h);
        }
    }
    SEAM(8);

    REP_9 if (IN(9)) {
        pg8::DenseSched S{(const char*)HA, (const char*)(ws + WS_WIN + (size_t)NIN * D * 2), D, D, F.G, (int)blockIdx.x, MLAT / 256, 10, 0, 0, MCTX / 256, 4, MLAT, 4};
        pg8::EpiInProj E{P, ropec, ropes};
        pg8::gemm_phase<pg8::EpiInProj, pg8::DenseSched, true>(F.lds, D, S, E);
    }
    SEAM(9);

    if (IN(10)) { ATTN_PHASE(1, false); }
    SEAM(10);

    REP_11 if (IN(11)) {
        pg8::DenseSched S{(const char*)P, (const char*)(ws + WS_WOUT + (size_t)D * D * 2), NIN, D, F.G, (int)blockIdx.x, MLAT / 256, 4, 0, 0, 0, 0, 0, 0};
        pg8::EpiPlain E{OY, D, 1.f};
        pg8::gemm_phase<pg8::EpiPlain, pg8::DenseSched, true>(F.lds, D, S, E);
    }
    SEAM(11);

    if (IN(12)) {
        const float* gpost = args.in[7] + D; const float* gpre = args.in[8] + D;
        LAS float* rw = (LAS float*)F.lds;
        LAS int* lcnt = (LAS int*)(F.lds + 32768);
        LAS int* rec = (LAS int*)(F.lds + 32768 + 256);
        for (int i = F.tid; i < 8192; i += 512) rw[i] = args.in[24][i];
        if (F.tid < 16) lcnt[F.tid] = 0;
        __syncthreads();
        int nrow = 0;
        for (int m = gw; m < MLAT; m += NGW, ++nrow) {
            const int r17 = m >> 11; const float* msr1 = MS + (size_t)(17 + r17) * 6144;
            float* xo = xlat + (size_t)m * D;
            Row x = ld_row_f32(xo, F.lane); const Row o = ld_row_bf16(OY + (size_t)m * D, F.lane);
            row_residual(x, o, gpost, msr1 + 2 * 1024, F.lane);
            st_row_f32(xo, F.lane, x);
            const Row f = row_modulate(x, gpre, msr1 + 3 * 1024, msr1 + 4 * 1024, F.lane);
            { unsigned* fo = (unsigned*)((unsigned char*)HA + (size_t)m * D) + F.lane;
#pragma unroll
              for (int j = 0; j < 4; ++j) fo[64 * j] = pg8::pk_fp8x4(f.v[j][0] * 4.f, f.v[j][1] * 4.f, f.v[j][2] * 4.f, f.v[j][3] * 4.f); }
            float lg[8];
#pragma unroll
            for (int e = 0; e < 8; ++e) lg[e] = 0.f;
#pragma unroll
            for (int j = 0; j < 4; ++j)
#pragma unroll
                for (int q = 0; q < 4; ++q) { const int k = 4 * (F.lane + 64 * j) + q; const f32x4 wa = *(const LAS f32x4*)(rw + k * 8), wb = *(const LAS f32x4*)(rw + k * 8 + 4); const float fv = f.v[j][q];
                    lg[0] += fv * wa[0]; lg[1] += fv * wa[1]; lg[2] += fv * wa[2]; lg[3] += fv * wa[3]; lg[4] += fv * wb[0]; lg[5] += fv * wb[1]; lg[6] += fv * wb[2]; lg[7] += fv * wb[3]; }
#pragma unroll
            for (int e = 0; e < 8; ++e) lg[e] = wave_sum(lg[e]);
            int e1 = 0; float v1 = lg[0];
#pragma unroll
            for (int e = 1; e < 8; ++e) if (lg[e] > v1) { v1 = lg[e]; e1 = e; }
            int e2 = -1; float v2 = -3.0e38f;
#pragma unroll
            for (int e = 0; e < 8; ++e) if (e != e1 && lg[e] > v2) { v2 = lg[e]; e2 = e; }
            if (F.lane == 0) {
                const float w1 = 1.f / (1.f + __expf(v2 - v1));
                tok_e[m * 2] = e1; tok_e[m * 2 + 1] = e2; tok_g[m * 2] = w1; tok_g[m * 2 + 1] = 1.f - w1;
                const int l1 = __hip_atomic_fetch_add(lcnt + e1, 1, __ATOMIC_RELAXED, __HIP_MEMORY_SCOPE_WORKGROUP), l2 = __hip_atomic_fetch_add(lcnt + e2, 1, __ATOMIC_RELAXED, __HIP_MEMORY_SCOPE_WORKGROUP);
                LAS int* rr = rec + (F.wave * 32 + nrow) * 4; rr[0] = e1; rr[1] = e2; rr[2] = l1; rr[3] = l2;
            }
        }
        __syncthreads();
        if (F.tid < 8) lcnt[8 + F.tid] = (int)__hip_atomic_fetch_add(F.ctl + CW_CNT + 64 * F.tid, (unsigned)lcnt[F.tid], RLX_AGENT);
        __syncthreads();
        if (F.lane == 0) { int k = 0;
            for (int m = gw; m < MLAT; m += NGW, ++k) { const LAS int* rr = rec + (F.wave * 32 + k) * 4;
                const int r1 = lcnt[8 + rr[0]] + rr[2], r2 = lcnt[8 + rr[1]] + rr[3];
                tok_rank[m * 2] = r1; tok_rank[m * 2 + 1] = r2; slot_token[rr[0] * 32768 + r1] = m; slot_token[rr[1] * 32768 + r2] = m; } }
    }
    SEAM(12);

    {
        MoeTab T; T.pbase[8] = 0;
        if (hi > 13 && lo < 23) moe_tab(F.ctl, T);
        const int ptot = T.pbase[8];
        REP_13 for (int ch = 0; ch < 5; ++ch) {
            const int p0 = ch * 64; const int nM = (ptot - p0) < 64 ? (ptot - p0) : 64;
            if (IN(13 + 2 * ch) && nM > 0) {
                MoeUpSched S{(const char*)HA, (const char*)(ws + WS_MW13), slot_token, F.G, (int)blockIdx.x, p0, nM, T};
                pg8::EpiSwigluF8 E{(unsigned char*)HFF, DEXP};
                pg8::gemm_phase<pg8::EpiSwigluF8, MoeUpSched, true, true>(F.lds, D, S, E);
            }
            if (IN(13 + 2 * ch) && IN(14 + 2 * ch) && nM > 0) xcd_barrier(bar);
            if (IN(14 + 2 * ch) && nM > 0) {
                MoeDownSched S{(const char*)HFF, (const char*)(ws + WS_MW2), F.G, (int)blockIdx.x, p0, nM, T};
                pg8::EpiPlain E{YS, D, 1.f / 512.f};
                pg8::gemm_phase<pg8::EpiPlain, MoeDownSched, true, true>(F.lds, DEXP, S, E);
            }
            if (IN(14 + 2 * ch) && IN(15 + 2 * ch) && nM > 0) xcd_barrier(bar);
        }
    }

    if (IN(23)) {
        MoeTab T; moe_tab(F.ctl, T);
        const float* gpost = args.in[9] + D;
        for (int m = gw; m < MLAT; m += NGW) {
            const int r17 = m >> 11; const float* msr1 = MS + (size_t)(17 + r17) * 6144;
            const int e1 = tok_e[m * 2], e2 = tok_e[m * 2 + 1]; const float g1 = tok_g[m * 2], g2 = tok_g[m * 2 + 1];
            int pb1 = 0, pb2 = 0;
#pragma unroll
            for (int e = 0; e < 8; ++e) { pb1 = (e1 == e) ? T.pbase[e] : pb1; pb2 = (e2 == e) ? T.pbase[e] : pb2; }
            const size_t s1 = (size_t)pb1 * 256 + tok_rank[m * 2], s2 = (size_t)pb2 * 256 + tok_rank[m * 2 + 1];
            float* xo = xlat + (size_t)m * D;
            Row x = ld_row_f32(xo, F.lane); const Row ya = ld_row_bf16(YS + s1 * D, F.lane), yb = ld_row_bf16(YS + s2 * D, F.lane);
            Row y;
#pragma unroll
            for (int j = 0; j < 4; ++j) y.v[j] = ya.v[j] * g1 + yb.v[j] * g2;
            row_residual(x, y, gpost, msr1 + 5 * 1024, F.lane);
            st_row_f32(xo, F.lane, x);
        }
    }
#undef IN
#undef SEAM
#undef ATTN_PHASE
}

extern "C" void kernel_launch(void* const* d_in, const int* in_sizes, int n_in, void* d_out, int out_size, void* d_ws, size_t ws_size, hipStream_t stream) {
    static int grid = 0;
    if (grid == 0) {
        if (n_in != 28 || out_size != MLAT * D || ws_size < WS_END) { fprintf(stderr, "kernel_launch: unexpected shapes (n_in %d, out %d, ws %zu)\n", n_in, out_size, ws_size); grid = -1; return; }
        int dev = 0, cus = 0, per_cu = 0;
        if (hipGetDevice(&dev) != hipSuccess || hipDeviceGetAttribute(&cus, hipDeviceAttributeMultiprocessorCount, dev) != hipSuccess) { grid = -1; return; }
        if (hipFuncSetAttribute((const void*)mk_fwd, hipFuncAttributeMaxDynamicSharedMemorySize, LDS_BYTES) != hipSuccess) { fprintf(stderr, "kernel_launch: hipFuncSetAttribute failed\n"); grid = -1; return; }
        if (hipOccupancyMaxActiveBlocksPerMultiprocessor(&per_cu, (const void*)mk_fwd, NWAVES * 64, LDS_BYTES) != hipSuccess || per_cu < 1) { fprintf(stderr, "kernel_launch: occupancy query says %d\n", per_cu); (void)hipGetLastError(); }
        grid = cus;
        if (grid != 256) { fprintf(stderr, "kernel_launch: built for 256 CUs, found %d\n", grid); grid = -1; return; }
    }
    if (grid < 0) return;
    (void)hipMemsetAsync((char*)d_ws + WS_CTL, 0, CTL_ZERO_BYTES, stream);
    Args a{};
    for (int i = 0; i < 28; ++i) a.in[i] = (const float*)d_in[i];
    a.out = (float*)d_out; a.ws = (unsigned char*)d_ws;
#if MK_PER_PHASE
    for (int p = 0; p < N_PHASES; ++p) { a.ph_lo = p; a.ph_hi = p + 1; hipLaunchKernelGGL(mk_fwd, dim3(grid), dim3(NWAVES * 64), LDS_BYTES, stream, a); }
#else
    a.ph_lo = 0; a.ph_hi = N_PHASES;
    hipLaunchKernelGGL(mk_fwd, dim3(grid), dim3(NWAVES * 64), LDS_BYTES, stream, a);
#endif
}
```

```cpp
#include <hip/hip_runtime.h>
#include <cstdio>
#include <cstdint>

#ifndef DBG_NO_SG
#define DBG_NO_SG 0
#endif
#ifndef DBG_NO_CTX
#define DBG_NO_CTX 0
#endif
#ifndef DBG_NO_LAT
#define DBG_NO_LAT 0
#endif
#ifndef MK_PER_PHASE
#define MK_PER_PHASE 0
#endif

#define LAS __attribute__((address_space(3)))
#define GAS __attribute__((address_space(1)))
typedef unsigned short bf16_t;
typedef short bf16x8 __attribute__((ext_vector_type(8)));
typedef short s16x4 __attribute__((ext_vector_type(4)));
typedef float f32x2 __attribute__((ext_vector_type(2)));
typedef float f32x4 __attribute__((ext_vector_type(4)));
typedef float f32x16 __attribute__((ext_vector_type(16)));
typedef unsigned u32x2 __attribute__((ext_vector_type(2)));
typedef unsigned u32x4 __attribute__((ext_vector_type(4)));
typedef GAS unsigned gu32;
typedef int v8i __attribute__((ext_vector_type(8)));
typedef int v4i __attribute__((ext_vector_type(4)));

constexpr int D = 1024, BATCH = 16, SEQ = 2048, CTX = 256;
constexpr int MLAT = BATCH * SEQ;
constexpr int MCTX = BATCH * CTX;
constexpr int MALL = MLAT + MCTX;
constexpr int NIN = 2560;
constexpr int COL_Q = 0, COL_U = 512, COL_K = 1024, COL_V = 1536, COL_G = 2048;
constexpr int DFF = 2816, DEXP = 3584, NEXP = 8;
constexpr float EPS = 1e-6f;
constexpr float LAMBDA_INIT0 = 0.2f, LAMBDA_INIT1 = 0.35550907f;

constexpr size_t MiB = 1u << 20;
constexpr size_t WS_CTL = 0, CTL_ZERO_BYTES = 1 * MiB;
constexpr size_t WS_MS = 1 * MiB;
constexpr size_t WS_ROPE = 2 * MiB;
constexpr size_t WS_ROUTE = 3 * MiB;
constexpr size_t WS_SLOT = 4 * MiB;
constexpr size_t WS_WIN = 5 * MiB;
constexpr size_t WS_WOUT = 15 * MiB;
constexpr size_t WS_SGW = 19 * MiB;
constexpr size_t WS_W13 = 20 * MiB;
constexpr size_t WS_W2 = 31 * MiB;
constexpr size_t WS_MW13 = 37 * MiB;
constexpr size_t WS_MW2 = 93 * MiB;
constexpr size_t WS_XB = 121 * MiB;
constexpr size_t WS_HA = 221 * MiB;
constexpr size_t WS_R1 = 293 * MiB;
constexpr size_t WS_OY = 491 * MiB;
constexpr size_t WS_YS = 405 * MiB;
constexpr size_t WS_END = 563 * MiB;

constexpr int CW_BAR = 4096;
constexpr int CW_CNT = 64;

constexpr int RING_BYTES = 131072;
constexpr int LDSCTL_OFF = RING_BYTES, MISC_OFF = LDSCTL_OFF + 320;
constexpr int LDS_BYTES = 147456;
constexpr int NWAVES = 8;

#define RLX_AGENT __ATOMIC_RELAXED, __HIP_MEMORY_SCOPE_AGENT
#define LDS_WAIT() asm volatile("s_waitcnt lgkmcnt(0)" ::: "memory")
#define VM_WAIT() asm volatile("s_waitcnt vmcnt(0)" ::: "memory")
#define SBAR() __builtin_amdgcn_sched_barrier(0)

__device__ __forceinline__ unsigned cvt_pk_bf16(float lo, float hi) { unsigned r; asm volatile("v_cvt_pk_bf16_f32 %0, %1, %2" : "=v"(r) : "v"(lo), "v"(hi)); return r; }
__device__ __forceinline__ float bf2f(unsigned short b) { return __builtin_bit_cast(float, (unsigned)b << 16); }
__device__ __forceinline__ float bflo(unsigned w) { return __builtin_bit_cast(float, w << 16); }
__device__ __forceinline__ float bfhi(unsigned w) { return __builtin_bit_cast(float, w & 0xffff0000u); }
__device__ __forceinline__ float wave_sum(float v) {
#pragma unroll
    for (int o = 1; o < 64; o <<= 1) v += __shfl_xor(v, o);
    return v;
}
__device__ __forceinline__ float silu_f(float v) { return v / (1.f + __expf(-v)); }

namespace pg8 {
constexpr int BM = 256, BK = 64, HALF = 128, HTB = HALF * BK * 2, STAGE_BYTES = 8 * HTB, NXCD = 8, WGM = 8;
__host__ __device__ __forceinline__ int lds_byte(int r, int c) { const int st = (r >> 4) * 2 + (c >> 5), rr = r & 15, cc = c & 31, ob = rr * 64 + cc * 2; return st * 1024 + (ob ^ (((ob >> 9) & 1) << 5)); }
__host__ __device__ __forceinline__ void stage_rc(int b, int& R, int& C) { const int st = b / 1024, sb = b % 1024, swz = sb ^ (((sb >> 9) & 1) << 5); R = (st >> 1) * 16 + swz / 64; C = (st & 1) * 32 + (swz % 64) / 2; }
__host__ __device__ __forceinline__ int perm32(int rho) { const int n = rho >> 4, i = rho & 15; return 8 * (i >> 2) + 4 * n + (i & 3); }

struct Unit { const char* Ap; const char* Bp; int pm, pn, aux, aux2; };

__device__ __forceinline__ void tile_of(int L, int nM, int nN, int& pm, int& pn) {
    const int nwg = nM * nN; int wgid = L;
    { const int q = nwg / NXCD, r = nwg % NXCD, xcd = wgid % NXCD, off = wgid / NXCD; wgid = (xcd < r ? xcd * (q + 1) : r * (q + 1) + (xcd - r) * q) + off; }
    const int nig = WGM * nN, gid = wgid / nig, fm = gid * WGM, gsz = (nM - fm) < WGM ? (nM - fm) : WGM;
    pm = fm + ((wgid % nig) % gsz); pn = (wgid % nig) / gsz;
}

template <class Epi, class Sched, bool ALIGN_EPI, bool FP8 = false>
__device__ __forceinline__ void gemm_phase(LAS unsigned char* lds, const int K, const Sched& S, const Epi& E) {
    int tid = threadIdx.x; asm volatile("" : "+v"(tid));
    const int wid = __builtin_amdgcn_readfirstlane(tid >> 6), lane = tid & 63, wr = wid >> 2, wc = wid & 3, fr = lane & 15, fq = lane >> 4;
    const int kbytes = FP8 ? K : 2 * K;
    const int nt = kbytes / 128;
    int R[2], C[2]; unsigned voffB[2];
#pragma unroll
    for (int i = 0; i < 2; ++i) { stage_rc(tid * 16 + i * 8192, R[i], C[i]); const int Rb = Epi::PERM ? ((R[i] & ~31) + perm32(R[i] & 31)) : R[i]; voffB[i] = (unsigned)(Rb * kbytes + C[i] * 2); }
    const size_t kstep = (size_t)(BK * 2);
    const size_t hstepB = (size_t)HALF * kbytes;
    const unsigned ldsw = (unsigned)wid * 1024u;
    const int aoff = lds_byte(wr * 64 + fr, fq * 8), boff = lds_byte(wc * 32 + fr, fq * 8);
#define PG8_SA(b, h) (((b) * 2 + (h)) * HTB)
#define PG8_SB(b, h) ((4 + (b) * 2 + (h)) * HTB)
#define PG8_STAGE(bufoff, gbase, voff) do { _Pragma("unroll") for (int _i = 0; _i < 2; ++_i) \
        __builtin_amdgcn_global_load_lds((const unsigned*)((const char*)(gbase) + (voff)[_i]), (LAS unsigned*)(lds + (bufoff) + ldsw + _i * 8192), 16, 0, 0); } while (0)
#define PG8_LDA(dst, b, h) do { _Pragma("unroll") for (int m = 0; m < 4; ++m) { const v4i _lo = *(const LAS v4i*)(lds + PG8_SA(b, h) + aoff + m * 2048), _hi = *(const LAS v4i*)(lds + PG8_SA(b, h) + aoff + m * 2048 + 1024); \
        dst[m] = __builtin_shufflevector(_lo, _hi, 0, 1, 2, 3, 4, 5, 6, 7); } } while (0)
#define PG8_LDB(dst, b, h) do { _Pragma("unroll") for (int n = 0; n < 2; ++n) { const v4i _lo = *(const LAS v4i*)(lds + PG8_SB(b, h) + boff + n * 2048), _hi = *(const LAS v4i*)(lds + PG8_SB(b, h) + boff + n * 2048 + 1024); \
        dst[n] = __builtin_shufflevector(_lo, _hi, 0, 1, 2, 3, 4, 5, 6, 7); } } while (0)
#define PG8_LO(x) __builtin_bit_cast(bf16x8, __builtin_shufflevector(x, x, 0, 1, 2, 3))
#define PG8_HI(x) __builtin_bit_cast(bf16x8, __builtin_shufflevector(x, x, 4, 5, 6, 7))
#define PG8_MMA(ai, bj, At, Bt) do { __builtin_amdgcn_s_setprio(1); \
        if constexpr (FP8) { _Pragma("unroll") for (int m = 0; m < 4; ++m) _Pragma("unroll") for (int n = 0; n < 2; ++n) \
            asm volatile("v_mfma_f32_16x16x128_f8f6f4 %0, %1, %2, %0" : "+v"(acc[ai][bj][m][n]) : "v"(Bt[n]), "v"(At[m])); } \
        else { _Pragma("unroll") for (int m = 0; m < 4; ++m) _Pragma("unroll") for (int n = 0; n < 2; ++n) { \
            acc[ai][bj][m][n] = __builtin_amdgcn_mfma_f32_16x16x32_bf16(PG8_LO(Bt[n]), PG8_LO(At[m]), acc[ai][bj][m][n], 0, 0, 0); \
            acc[ai][bj][m][n] = __builtin_amdgcn_mfma_f32_16x16x32_bf16(PG8_HI(Bt[n]), PG8_HI(At[m]), acc[ai][bj][m][n], 0, 0, 0); } } \
        __builtin_amdgcn_s_setprio(0); } while (0)
#define PG8_WAIT_V(n) asm volatile("s_waitcnt vmcnt(" #n ")" ::: "memory")
#define PG8_WAIT_L(n) asm volatile("s_waitcnt lgkmcnt(" #n ")" ::: "memory")
#define PG8_BAR __builtin_amdgcn_s_barrier()
#define PG8_SCHED __builtin_amdgcn_sched_barrier(0)
    Unit cur, nxt; int ui = 0;
    if (!S.next(0, cur)) return;
    f32x4 acc[2][2][4][2];
#pragma unroll
    for (int a = 0; a < 2; ++a)
#pragma unroll
        for (int b = 0; b < 2; ++b)
#pragma unroll
            for (int m = 0; m < 4; ++m)
#pragma unroll
                for (int n = 0; n < 2; ++n) acc[a][b][m][n] = (f32x4){0.f, 0.f, 0.f, 0.f};
    v8i At[4], B0[2], B1[2];
    unsigned cO0[2], cO1[2], nO0[2], nO1[2];
    S.aoff(cur, R, C, cO0, cO1);
    const char* cA = cur.Ap; const char* cB = cur.Bp;
    PG8_STAGE(PG8_SB(0, 0), cB, voffB); PG8_STAGE(PG8_SB(0, 1), cB + hstepB, voffB); PG8_STAGE(PG8_SA(0, 0), cA, cO0); PG8_STAGE(PG8_SA(0, 1), cA, cO1);
    if (wr == 1) PG8_BAR;
    PG8_WAIT_V(2); PG8_BAR;
    PG8_STAGE(PG8_SB(1, 0), cB + kstep, voffB); PG8_STAGE(PG8_SA(1, 0), cA + kstep, cO0); PG8_STAGE(PG8_SB(1, 1), cB + hstepB + kstep, voffB);
    PG8_WAIT_V(6); PG8_BAR;
    for (;;) {
        const bool has_next = S.next(ui + 1, nxt);
        if constexpr (Sched::GATHER) { if (has_next) S.aoff(nxt, R, C, nO0, nO1); else { nO0[0] = cO0[0]; nO0[1] = cO0[1]; nO1[0] = cO1[0]; nO1[1] = cO1[1]; } }
        const char* nA = has_next ? nxt.Ap : cA; const char* nB = has_next ? nxt.Bp : cB;
        for (int t = 0; t < nt; t += 2) {
            const bool last = (t == nt - 2);
            const char* a1 = cA + (size_t)(t + 1) * kstep;
            const char* a2 = last ? nA : cA + (size_t)(t + 2) * kstep; const char* b2 = last ? nB : cB + (size_t)(t + 2) * kstep;
            const char* a3 = a2 + kstep; const char* b3 = b2 + kstep;
            unsigned xO0[2], xO1[2];
            if constexpr (Sched::GATHER) { xO0[0] = last ? nO0[0] : cO0[0]; xO0[1] = last ? nO0[1] : cO0[1]; xO1[0] = last ? nO1[0] : cO1[0]; xO1[1] = last ? nO1[1] : cO1[1]; }
            else { xO0[0] = cO0[0]; xO0[1] = cO0[1]; xO1[0] = cO1[0]; xO1[1] = cO1[1]; }
            PG8_LDB(B0, 0, 0); PG8_LDB(B1, 0, 1); PG8_SCHED; PG8_LDA(At, 0, 0); PG8_STAGE(PG8_SA(1, 1), a1, cO1);
            PG8_WAIT_V(8); PG8_WAIT_L(0); PG8_BAR; PG8_MMA(0, 0, At, B0); PG8_MMA(0, 1, At, B1); PG8_BAR; PG8_SCHED;
            PG8_LDA(At, 0, 1); PG8_STAGE(PG8_SB(0, 0), b2, voffB); PG8_STAGE(PG8_SB(0, 1), b2 + hstepB, voffB); PG8_STAGE(PG8_SA(0, 0), a2, xO0);
            PG8_WAIT_V(8); PG8_WAIT_L(0); PG8_BAR; PG8_MMA(1, 0, At, B0); PG8_MMA(1, 1, At, B1); PG8_BAR; PG8_SCHED;
            PG8_LDB(B0, 1, 0); PG8_LDB(B1, 1, 1); PG8_SCHED; PG8_LDA(At, 1, 0); PG8_STAGE(PG8_SA(0, 1), a2, xO1);
            PG8_WAIT_V(8); PG8_WAIT_L(0); PG8_BAR; PG8_MMA(0, 0, At, B0); PG8_MMA(0, 1, At, B1); PG8_BAR; PG8_SCHED;
            PG8_LDA(At, 1, 1); PG8_STAGE(PG8_SB(1, 0), b3, voffB); PG8_STAGE(PG8_SB(1, 1), b3 + hstepB, voffB); PG8_STAGE(PG8_SA(1, 0), a3, xO0);
            PG8_WAIT_V(8); PG8_WAIT_L(0); PG8_BAR; PG8_MMA(1, 0, At, B0); PG8_MMA(1, 1, At, B1); PG8_BAR; PG8_SCHED;
        }
        if constexpr (ALIGN_EPI) { if (wr == 0) PG8_BAR; }
        if constexpr (FP8) asm volatile("s_nop 15\n\ts_nop 15\n\ts_nop 15\n\ts_nop 15\n\ts_nop 15\n\ts_nop 15" ::: "memory");
        E(acc, cur, wr, wc, fr, fq);
        if (!has_next) break;
#pragma unroll
        for (int a = 0; a < 2; ++a)
#pragma unroll
            for (int b = 0; b < 2; ++b)
#pragma unroll
                for (int m = 0; m < 4; ++m)
#pragma unroll
                    for (int n = 0; n < 2; ++n) acc[a][b][m][n] = (f32x4){0.f, 0.f, 0.f, 0.f};
        cur = nxt; cA = nA; cB = nB; ++ui;
        if constexpr (Sched::GATHER) { cO0[0] = nO0[0]; cO0[1] = nO0[1]; cO1[0] = nO1[0]; cO1[1] = nO1[1]; }
        if constexpr (ALIGN_EPI) { if (wr == 1) PG8_BAR; }
    }
    PG8_WAIT_V(0);
    if constexpr (!ALIGN_EPI) { if (wr == 0) PG8_BAR; }
    PG8_BAR;
#undef PG8_SA
#undef PG8_SB
#undef PG8_STAGE
#undef PG8_LDA
#undef PG8_LDB
#undef PG8_MMA
#undef PG8_LO
#undef PG8_HI
#undef PG8_WAIT_V
#undef PG8_WAIT_L
#undef PG8_BAR
#undef PG8_SCHED
}

struct DenseSched {
    static constexpr bool GATHER = false;
    const char* A; const char* Bt; int lda, K, G, c;
    int nM0, nN0, arow0_0, pn0_0, nM1, nN1, arow0_1, pn0_1;
    __device__ __forceinline__ bool next(int i, Unit& u) const {
        int L = i * G + c; const int n0 = nM0 * nN0;
        int pm, pn;
        if (L < n0) { tile_of(L, nM0, nN0, pm, pn); u.pm = arow0_0 / 256 + pm; u.pn = pn0_0 + pn; }
        else { L -= n0; if (L >= nM1 * nN1) return false; tile_of(L, nM1, nN1, pm, pn); u.pm = arow0_1 / 256 + pm; u.pn = pn0_1 + pn; }
        u.Ap = A + (size_t)u.pm * 256 * lda * 2; u.Bp = Bt + (size_t)u.pn * 256 * K * 2; u.aux = 0; u.aux2 = 0; return true;
    }
    __device__ __forceinline__ void aoff(const Unit&, const int (&R)[2], const int (&C)[2], unsigned (&o0)[2], unsigned (&o1)[2]) const {
#pragma unroll
        for (int i = 0; i < 2; ++i) { o0[i] = (unsigned)(R[i] * lda + C[i]) * 2u; o1[i] = (unsigned)((HALF + R[i]) * lda + C[i]) * 2u; }
    }
};

struct EpiPlain {
    static constexpr bool PERM = true;
    bf16_t* O; int ldc; float sc;
    __device__ __forceinline__ void operator()(const f32x4 (&acc)[2][2][4][2], const Unit& u, int wr, int wc, int fr, int fq) const {
        const int row0 = u.pm * BM + wr * 64 + fr, col0 = u.pn * BM + wc * 32 + 8 * fq;
#pragma unroll
        for (int ai = 0; ai < 2; ++ai)
#pragma unroll
            for (int m = 0; m < 4; ++m) { bf16_t* rowp = O + (size_t)(row0 + ai * HALF + m * 16) * ldc + col0;
#pragma unroll
                for (int bj = 0; bj < 2; ++bj) { const f32x4 v0 = acc[ai][bj][m][0] * sc, v1 = acc[ai][bj][m][1] * sc;
                    u32x4 w; w.x = cvt_pk_bf16(v0[0], v0[1]); w.y = cvt_pk_bf16(v0[2], v0[3]); w.z = cvt_pk_bf16(v1[0], v1[1]); w.w = cvt_pk_bf16(v1[2], v1[3]);
                    *(u32x4*)(rowp + bj * HALF) = w; } }
    }
};
struct EpiInProj {
    static constexpr bool PERM = true;
    bf16_t* O; const float* ropec; const float* ropes;
    __device__ __forceinline__ void operator()(const f32x4 (&acc)[2][2][4][2], const Unit& u, int wr, int wc, int fr, int fq) const {
        const int row0 = u.pm * BM + wr * 64 + fr, col0 = u.pn * BM + wc * 32 + 8 * fq;
        const bool rope = (u.pm < MLAT / 256) && (u.pn < 2 || (u.pn >= 4 && u.pn < 6));
        const bool colpos = (wc & 1) != 0;
#pragma unroll
        for (int ai = 0; ai < 2; ++ai)
#pragma unroll
            for (int m = 0; m < 4; ++m) { const int row = row0 + ai * HALF + m * 16; bf16_t* rowp = O + (size_t)row * NIN + col0;
                f32x4 cs = {1.f, 1.f, 1.f, 1.f}, sn = {0.f, 0.f, 0.f, 0.f};
                if (rope) { const int t = row & (SEQ - 1), pos = colpos ? (t & 63) : (t >> 6); cs = *(const f32x4*)(ropec + pos * 16 + 4 * fq); sn = *(const f32x4*)(ropes + pos * 16 + 4 * fq); }
#pragma unroll
                for (int bj = 0; bj < 2; ++bj) { const f32x4 a = acc[ai][bj][m][0], b = acc[ai][bj][m][1];
                    const f32x4 v0 = a * cs - b * sn, v1 = b * cs + a * sn;
                    u32x4 w; w.x = cvt_pk_bf16(v0[0], v0[1]); w.y = cvt_pk_bf16(v0[2], v0[3]); w.z = cvt_pk_bf16(v1[0], v1[1]); w.w = cvt_pk_bf16(v1[2], v1[3]);
                    *(u32x4*)(rowp + bj * HALF) = w; } }
    }
};
struct EpiSwiglu {
    static constexpr bool PERM = true;
    bf16_t* O; int ldc;
    __device__ __forceinline__ void operator()(const f32x4 (&acc)[2][2][4][2], const Unit& u, int wr, int wc, int fr, int fq) const {
        const int row0 = u.pm * BM + wr * 64 + fr, col0 = u.pn * HALF + wc * 32 + 8 * fq;
#pragma unroll
        for (int ai = 0; ai < 2; ++ai)
#pragma unroll
            for (int m = 0; m < 4; ++m) { bf16_t* rowp = O + (size_t)(row0 + ai * HALF + m * 16) * ldc + col0;
                f32x4 v[2];
#pragma unroll
                for (int n = 0; n < 2; ++n) { const f32x4 a = acc[ai][0][m][n], b = acc[ai][1][m][n];
#pragma unroll
                    for (int j = 0; j < 4; ++j) v[n][j] = a[j] * __builtin_amdgcn_rcpf(1.f + __builtin_amdgcn_exp2f(-1.4426950408889634f * a[j])) * b[j]; }
                u32x4 w; w.x = cvt_pk_bf16(v[0][0], v[0][1]); w.y = cvt_pk_bf16(v[0][2], v[0][3]); w.z = cvt_pk_bf16(v[1][0], v[1][1]); w.w = cvt_pk_bf16(v[1][2], v[1][3]);
                *(u32x4*)rowp = w; }
    }
};
__device__ __forceinline__ unsigned pk_fp8x4(float a, float b, float c, float d) {
    a = __builtin_amdgcn_fmed3f(a, -448.f, 448.f); b = __builtin_amdgcn_fmed3f(b, -448.f, 448.f); c = __builtin_amdgcn_fmed3f(c, -448.f, 448.f); d = __builtin_amdgcn_fmed3f(d, -448.f, 448.f);
    int p = __builtin_amdgcn_cvt_pk_fp8_f32(a, b, 0, false); p = __builtin_amdgcn_cvt_pk_fp8_f32(c, d, p, true); return (unsigned)p; }
struct EpiSwigluF8 {
    static constexpr bool PERM = true;
    unsigned char* O; int ldc;
    __device__ __forceinline__ void operator()(const f32x4 (&acc)[2][2][4][2], const Unit& u, int wr, int wc, int fr, int fq) const {
        const int row0 = u.pm * BM + wr * 64 + fr, col0 = u.pn * HALF + wc * 32 + 8 * fq;
#pragma unroll
        for (int ai = 0; ai < 2; ++ai)
#pragma unroll
            for (int m = 0; m < 4; ++m) { unsigned char* rowp = O + (size_t)(row0 + ai * HALF + m * 16) * ldc + col0;
                f32x4 v[2];
#pragma unroll
                for (int n = 0; n < 2; ++n) { const f32x4 a = acc[ai][0][m][n] * (1.f / 512.f), b = acc[ai][1][m][n] * (4.f / 512.f);
#pragma unroll
                    for (int j = 0; j < 4; ++j) v[n][j] = a[j] * __builtin_amdgcn_rcpf(1.f + __builtin_amdgcn_exp2f(-1.4426950408889634f * a[j])) * b[j]; }
                u32x2 w; w.x = pk_fp8x4(v[0][0], v[0][1], v[0][2], v[0][3]); w.y = pk_fp8x4(v[1][0], v[1][1], v[1][2], v[1][3]);
                *(u32x2*)rowp = w; }
    }
};
}

namespace att {
constexpr int LDP = NIN;
constexpr int SHM_V = 64 * 128 * 2, SHM_K = 64 * 128 * 2;
constexpr int OFF_V = 0, OFF_K = 2 * SHM_V, OFF_WS = OFF_K + 2 * SHM_K, OFF_OST = OFF_WS + NWAVES * 64 * 4, ATT_LDS = OFF_OST + 4 * 8192;
static_assert(ATT_LDS <= RING_BYTES, "attention LDS");
constexpr float SCALE = 0.125f;
constexpr float THR = 8.f;
#define KSWZ(row, colB) ((row) * 256 + ((colB) ^ (((row) & 7) << 4)))
__device__ __forceinline__ int crow(int r, int hi) { return (r & 3) + 8 * (r >> 2) + 4 * hi; }

__device__ __forceinline__ void partialSM(f32x16& p0, f32x16& p1, float& m_reg, float& mn, float& alpha) {
    constexpr float C = SCALE * 1.4426950408889634f;
    float pmax = p0[0];
#pragma unroll
    for (int r = 1; r < 16; ++r) pmax = fmaxf(pmax, p0[r]);
#pragma unroll
    for (int r = 0; r < 16; ++r) pmax = fmaxf(pmax, p1[r]);
    { auto rr = __builtin_amdgcn_permlane32_swap(__float_as_uint(pmax), __float_as_uint(pmax), false, false);
      pmax = fmaxf(__uint_as_float(rr[0]), __uint_as_float(rr[1])); }
    if (__builtin_expect(__all(pmax - m_reg <= THR / SCALE), 1)) { mn = m_reg; alpha = 1.f; }
    else { mn = fmaxf(m_reg, pmax); alpha = __builtin_amdgcn_exp2f((m_reg - mn) * C); m_reg = mn; }
    const float mnC = -mn * C;
#pragma unroll
    for (int r = 0; r < 16; ++r) p0[r] = fmaf(p0[r], C, mnC);
#pragma unroll
    for (int r = 0; r < 16; ++r) p1[r] = fmaf(p1[r], C, mnC);
#pragma unroll
    for (int r = 0; r < 16; ++r) p0[r] = __builtin_amdgcn_exp2f(p0[r]);
}
__device__ __forceinline__ void finishSM(f32x16& p0, f32x16& p1, float alpha, float& l_reg, bf16x8& pa0, bf16x8& pa1, bf16x8& pa2, bf16x8& pa3) {
#pragma unroll
    for (int r = 0; r < 16; ++r) p1[r] = __builtin_amdgcn_exp2f(p1[r]);
    float ps = 0;
#pragma unroll
    for (int r = 0; r < 16; ++r) ps += p0[r];
#pragma unroll
    for (int r = 0; r < 16; ++r) ps += p1[r];
    { auto rr = __builtin_amdgcn_permlane32_swap(__float_as_uint(ps), __float_as_uint(ps), false, false);
      ps = __uint_as_float(rr[0]) + __uint_as_float(rr[1]); }
    l_reg = l_reg * alpha + ps;
#define PK4(P, BASE, OUT) do { unsigned a0 = cvt_pk_bf16(P[BASE + 0], P[BASE + 1]), a1 = cvt_pk_bf16(P[BASE + 2], P[BASE + 3]);   \
    unsigned b0 = cvt_pk_bf16(P[BASE + 4], P[BASE + 5]), b1 = cvt_pk_bf16(P[BASE + 6], P[BASE + 7]);                              \
    auto r0 = __builtin_amdgcn_permlane32_swap(a0, b0, false, false); auto r1 = __builtin_amdgcn_permlane32_swap(a1, b1, false, false); \
    u32x4 w = {r0[0], r1[0], r0[1], r1[1]}; OUT = __builtin_bit_cast(bf16x8, w); } while (0)
    PK4(p0, 0, pa0); PK4(p0, 8, pa1); PK4(p1, 0, pa2); PK4(p1, 8, pa3);
#undef PK4
}
__device__ __forceinline__ void qkt(f32x16& p0, f32x16& p1, const char* Ks, const bf16x8 (&qr)[4], int r32, int hi, int cb0) {
    p0 = f32x16{}; p1 = f32x16{};
#pragma unroll
    for (int d0 = 0; d0 < 4; ++d0) { const int cb = cb0 + (d0 * 16 + hi * 8) * 2;
        const bf16x8 b0 = *reinterpret_cast<const bf16x8*>(Ks + KSWZ(r32, cb));
        const bf16x8 b1 = *reinterpret_cast<const bf16x8*>(Ks + KSWZ(32 + r32, cb));
        p0 = __builtin_amdgcn_mfma_f32_32x32x16_bf16(b0, qr[d0], p0, 0, 0, 0);
        p1 = __builtin_amdgcn_mfma_f32_32x32x16_bf16(b1, qr[d0], p1, 0, 0, 0); }
}
__device__ __forceinline__ int v_st(int k, int c) { const int kk = (k & ~0xC) | ((k & 4) << 1) | ((k & 8) >> 1); return ((kk >> 3) * 4 + (c >> 5)) * 512 + ((kk & 7) * 32 + (c & 31)) * 2; }
__device__ __forceinline__ int v_rd_base(int lane) { return ((lane & 3) << 3) | (((lane >> 2) & 3) << 6) | (((lane >> 4) & 1) << 5) | (((lane >> 5) & 1) << 8); }
constexpr int v_rd_off(int d0, int ks, int half) { return d0 * 512 + ks * 4096 + half * 2048; }
template <int OFF> __device__ __forceinline__ s16x4 tr_read(int vb) {
    s16x4 r; asm volatile("ds_read_b64_tr_b16 %0, %1 offset:%2" : "=&v"(r) : "v"(vb), "i"(OFF) : "memory"); return r;
}
template <int D0> __device__ __forceinline__ void pv_one(f32x16& od, int vb, bf16x8 pa0, bf16x8 pa1, bf16x8 pa2, bf16x8 pa3) {
    const s16x4 l0 = tr_read<v_rd_off(D0, 0, 0)>(vb), h0 = tr_read<v_rd_off(D0, 0, 1)>(vb), l1 = tr_read<v_rd_off(D0, 1, 0)>(vb), h1 = tr_read<v_rd_off(D0, 1, 1)>(vb);
    const s16x4 l2 = tr_read<v_rd_off(D0, 2, 0)>(vb), h2 = tr_read<v_rd_off(D0, 2, 1)>(vb), l3 = tr_read<v_rd_off(D0, 3, 0)>(vb), h3 = tr_read<v_rd_off(D0, 3, 1)>(vb);
    asm volatile("s_waitcnt lgkmcnt(0)" ::: "memory"); SBAR();
#define PKV(L, H) (bf16x8){L[0], L[1], L[2], L[3], H[0], H[1], H[2], H[3]}
    od = __builtin_amdgcn_mfma_f32_32x32x16_bf16(pa0, PKV(l0, h0), od, 0, 0, 0);
    od = __builtin_amdgcn_mfma_f32_32x32x16_bf16(pa1, PKV(l1, h1), od, 0, 0, 0);
    od = __builtin_amdgcn_mfma_f32_32x32x16_bf16(pa2, PKV(l2, h2), od, 0, 0, 0);
    od = __builtin_amdgcn_mfma_f32_32x32x16_bf16(pa3, PKV(l3, h3), od, 0, 0, 0);
#undef PKV
}
__device__ __forceinline__ void pv_d0(f32x16* o, int vb, bf16x8 pa0, bf16x8 pa1, bf16x8 pa2, bf16x8 pa3) {
    pv_one<0>(o[0], vb, pa0, pa1, pa2, pa3); pv_one<1>(o[1], vb, pa0, pa1, pa2, pa3); pv_one<2>(o[2], vb, pa0, pa1, pa2, pa3); pv_one<3>(o[3], vb, pa0, pa1, pa2, pa3);
}

__device__ __forceinline__ void attn_unit(const bf16_t* __restrict__ Qb, const bf16_t* __restrict__ Ks0, int nt0, const bf16_t* __restrict__ Ks1, int nt1,
                                          bf16_t* Ob, float lam, float oscale, const float* __restrict__ subg, char* lds) {
    int tid = threadIdx.x; asm volatile("" : "+v"(tid));
    const int wid = __builtin_amdgcn_readfirstlane(tid >> 6), lane = tid & 63, r32 = lane & 31, hi = lane >> 5, map = wid >> 2, w4 = wid & 3;
    char* V_lds = lds + OFF_V; char* K_lds = lds + OFF_K;
    float* ws = (float*)(lds + OFF_WS) + wid * 64; float* li_l = ws; float* al_l = ws + 32;
    float m_reg = -1e30f, l_reg = 0; f32x16 o[4] = {}; bf16x8 qr[4];
    const bf16_t* Qw = Qb + (long)(w4 * 32 + r32) * LDP + map * 64 + hi * 8;
#pragma unroll
    for (int d0 = 0; d0 < 4; ++d0) qr[d0] = *reinterpret_cast<const bf16x8*>(Qw + d0 * 16);
    const int cb0 = map * 128;
    const int sr = tid >> 4, sc = (tid & 15) * 8, vst0 = v_st(sr, sc), vst1 = v_st(32 + sr, sc);
    const int vb0 = (int)(uintptr_t)V_lds + v_rd_base(lane);
    struct { bf16x8 vs0, vs1, ks0, ks1; } sr_[1];
    const int NT = nt0 + nt1;
#define TILEP(j) ((j) < nt0 ? Ks0 + (long)(j) * 64 * LDP : Ks1 + (long)((j) - nt0) * 64 * LDP)
#define SLOAD(i, j) do { const bf16_t* _kb = TILEP(j); sr_[i].vs0 = *reinterpret_cast<const bf16x8*>(_kb + 512 + (long)sr * LDP + sc); sr_[i].vs1 = *reinterpret_cast<const bf16x8*>(_kb + 512 + (long)(32 + sr) * LDP + sc); \
    sr_[i].ks0 = *reinterpret_cast<const bf16x8*>(_kb + (long)sr * LDP + sc); sr_[i].ks1 = *reinterpret_cast<const bf16x8*>(_kb + (long)(32 + sr) * LDP + sc); } while (0)
#define SWRITE(b, i) do { *(bf16x8*)(V_lds + (b) * SHM_V + vst0) = sr_[i].vs0; *(bf16x8*)(V_lds + (b) * SHM_V + vst1) = sr_[i].vs1; const int kc = sc * 2;               \
    *(bf16x8*)(K_lds + (b) * SHM_K + KSWZ(sr, kc)) = sr_[i].ks0; *(bf16x8*)(K_lds + (b) * SHM_K + KSWZ(32 + sr, kc)) = sr_[i].ks1; } while (0)
#define SWAIT() asm volatile("s_waitcnt vmcnt(0)" ::: "memory")
#define RESC(a) do { if (__any((a) < 1.f)) { if (hi == 0) al_l[r32] = (a); asm volatile("s_waitcnt lgkmcnt(0)" ::: "memory"); \
    _Pragma("unroll") for (int d = 0; d < 4; ++d) _Pragma("unroll") for (int r = 0; r < 16; ++r) o[d][r] *= al_l[crow(r, hi)]; } } while (0)
    f32x16 pA0, pA1, pB0, pB1; float mnA, mnB, alA, alB; bf16x8 pa0, pa1, pa2, pa3;
    SLOAD(0, 0); asm volatile("s_waitcnt vmcnt(0)" ::: "memory"); SWRITE(0, 0); __syncthreads();
    qkt(pA0, pA1, K_lds, qr, r32, hi, cb0); partialSM(pA0, pA1, m_reg, mnA, alA);
    SLOAD(0, 1);
    SWAIT(); SWRITE(1, 0); __syncthreads();
    for (int j = 1; j + 1 < NT; j += 2) {
        SBAR(); qkt(pB0, pB1, K_lds + SHM_K, qr, r32, hi, cb0);
        finishSM(pA0, pA1, alA, l_reg, pa0, pa1, pa2, pa3); SBAR();
        SLOAD(0, j + 1); SBAR();
        pv_d0(o, vb0, pa0, pa1, pa2, pa3); partialSM(pB0, pB1, m_reg, mnB, alB);
        __syncthreads(); SWAIT(); SWRITE(0, 0);
        RESC(alB); __syncthreads();
        SBAR(); qkt(pA0, pA1, K_lds, qr, r32, hi, cb0);
        finishSM(pB0, pB1, alB, l_reg, pa0, pa1, pa2, pa3); SBAR();
        SLOAD(0, j + 2); SBAR();
        pv_d0(o, vb0 + SHM_V, pa0, pa1, pa2, pa3); partialSM(pA0, pA1, m_reg, mnA, alA);
        __syncthreads(); SWAIT(); SWRITE(1, 0);
        RESC(alA); __syncthreads();
    }
    SBAR(); qkt(pB0, pB1, K_lds + SHM_K, qr, r32, hi, cb0);
    finishSM(pA0, pA1, alA, l_reg, pa0, pa1, pa2, pa3); SBAR();
    pv_d0(o, vb0, pa0, pa1, pa2, pa3); partialSM(pB0, pB1, m_reg, mnB, alB);
    __syncthreads(); RESC(alB);
    finishSM(pB0, pB1, alB, l_reg, pa0, pa1, pa2, pa3); SBAR();
    pv_d0(o, vb0 + SHM_V, pa0, pa1, pa2, pa3);
    if (hi == 0) li_l[r32] = l_reg; asm volatile("s_waitcnt lgkmcnt(0)" ::: "memory");
    float rli[16];
#pragma unroll
    for (int r = 0; r < 16; ++r) rli[r] = __builtin_amdgcn_rcpf(li_l[crow(r, hi)]) * (map ? lam : 1.f);
    __syncthreads();
    float* X = (float*)lds + w4 * (32 * 128);
    if (map == 1) {
#pragma unroll
        for (int r = 0; r < 16; ++r)
#pragma unroll
            for (int d0 = 0; d0 < 4; ++d0) X[crow(r, hi) * 128 + d0 * 32 + r32] = o[d0][r] * rli[r];
    }
    __syncthreads();
    if (map == 0) {
        float ss[16];
#pragma unroll
        for (int r = 0; r < 16; ++r) { float s = 0.f;
#pragma unroll
            for (int d0 = 0; d0 < 4; ++d0) { const float v = o[d0][r] * rli[r] - X[crow(r, hi) * 128 + d0 * 32 + r32]; o[d0][r] = v; s += v * v; }
            ss[r] = s; }
#pragma unroll
        for (int r = 0; r < 16; ++r) { float s = ss[r]; s += __shfl_xor(s, 1); s += __shfl_xor(s, 2); s += __shfl_xor(s, 4); s += __shfl_xor(s, 8); s += __shfl_xor(s, 16);
            ss[r] = __builtin_amdgcn_rsqf(s * (1.f / 128.f) + EPS) * oscale; }
        bf16_t* Ost = (bf16_t*)(lds + OFF_OST) + w4 * 4096;
#pragma unroll
        for (int d0 = 0; d0 < 4; ++d0) { const float g = subg[d0 * 32 + r32];
#pragma unroll
            for (int r = 0; r < 16; ++r) Ost[crow(r, hi) * 128 + d0 * 32 + r32] = (bf16_t)(cvt_pk_bf16(o[d0][r] * ss[r] * g, 0.f) & 0xffffu); }
        asm volatile("s_waitcnt lgkmcnt(0)" ::: "memory");
#pragma unroll
        for (int it = 0; it < 8; ++it) { const int row = it * 4 + (lane >> 4), ch = lane & 15;
            const u32x4 w = *(const u32x4*)(Ost + row * 128 + ch * 8);
            *(u32x4*)(Ob + (long)(w4 * 32 + row) * LDP + ch * 8) = w; }
    }
    __syncthreads();
#undef TILEP
#undef SLOAD
#undef SWRITE
#undef SWAIT
#undef RESC
}

__device__ __forceinline__ void sg_unit(bf16_t* P0, const bf16_t* __restrict__ sgw, const float* __restrict__ lng, const float* __restrict__ lnb, const float* __restrict__ sgb, char* lds) {
    int tid = threadIdx.x; asm volatile("" : "+v"(tid));
    const int wid = __builtin_amdgcn_readfirstlane(tid >> 6), lane = tid & 63, r32 = lane & 31, hi = lane >> 5;
    float* stat = (float*)(lds + 65536);
    for (int i = 0; i < 16; ++i) { const int tkn = wid * 16 + i;
        const u32x4 w = *(const u32x4*)(P0 + (long)tkn * LDP + COL_G + lane * 8);
        float x[8] = {bflo(w.x), bfhi(w.x), bflo(w.y), bfhi(w.y), bflo(w.z), bfhi(w.z), bflo(w.w), bfhi(w.w)};
        float s = 0.f;
#pragma unroll
        for (int j = 0; j < 8; ++j) s += x[j];
        const float mean = wave_sum(s) * (1.f / 512.f); float q = 0.f;
#pragma unroll
        for (int j = 0; j < 8; ++j) { const float d = x[j] - mean; q += d * d; }
        const float rstd = __builtin_amdgcn_rsqf(wave_sum(q) * (1.f / 512.f) + EPS);
        if (lane == 0) { stat[tkn * 2] = mean; stat[tkn * 2 + 1] = rstd; } }
    __syncthreads();
    const int sr = tid >> 4, sc = (tid & 15) * 8;
    const int vb0 = (int)(uintptr_t)lds + v_rd_base(lane);
    const int mt = wid & 3, eh = wid >> 2;
    for (int g = 0; g < 4; ++g) {
        f32x4 ga = *(const f32x4*)(lng + g * 128 + sc), gb = *(const f32x4*)(lng + g * 128 + sc + 4), ba = *(const f32x4*)(lnb + g * 128 + sc), bb = *(const f32x4*)(lnb + g * 128 + sc + 4);
#pragma unroll
        for (int q4 = 0; q4 < 4; ++q4) { const int tkn = q4 * 32 + sr;
            const u32x4 w = *(const u32x4*)(P0 + (long)tkn * LDP + COL_G + g * 128 + sc);
            const float mean = stat[tkn * 2], rstd = stat[tkn * 2 + 1];
            float x[8] = {bflo(w.x), bfhi(w.x), bflo(w.y), bfhi(w.y), bflo(w.z), bfhi(w.z), bflo(w.w), bfhi(w.w)};
            u32x4 ov;
            ov.x = cvt_pk_bf16((x[0] - mean) * rstd * ga[0] + ba[0], (x[1] - mean) * rstd * ga[1] + ba[1]);
            ov.y = cvt_pk_bf16((x[2] - mean) * rstd * ga[2] + ba[2], (x[3] - mean) * rstd * ga[3] + ba[3]);
            ov.z = cvt_pk_bf16((x[4] - mean) * rstd * gb[0] + bb[0], (x[5] - mean) * rstd * gb[1] + bb[1]);
            ov.w = cvt_pk_bf16((x[6] - mean) * rstd * gb[2] + bb[2], (x[7] - mean) * rstd * gb[3] + bb[3]);
            *(u32x4*)(lds + (tkn >> 6) * SHM_V + v_st(tkn & 63, sc)) = ov; }
        __syncthreads();
        f32x16 oa = {}, ob = {};
        const bf16_t* Wp = sgw + (size_t)g * 128 * 128 + (size_t)(mt * 32 + r32) * 128 + hi * 8;
#pragma unroll
        for (int tq = 0; tq < 2; ++tq) {
            const bf16x8 a0 = *(const bf16x8*)(Wp + tq * 64), a1 = *(const bf16x8*)(Wp + tq * 64 + 16), a2 = *(const bf16x8*)(Wp + tq * 64 + 32), a3 = *(const bf16x8*)(Wp + tq * 64 + 48);
            if (eh == 0) { pv_one<0>(oa, vb0 + tq * SHM_V, a0, a1, a2, a3); pv_one<1>(ob, vb0 + tq * SHM_V, a0, a1, a2, a3); }
            else         { pv_one<2>(oa, vb0 + tq * SHM_V, a0, a1, a2, a3); pv_one<3>(ob, vb0 + tq * SHM_V, a0, a1, a2, a3); }
        }
#pragma unroll
        for (int r = 0; r < 16; ++r) { const int p = mt * 32 + crow(r, hi); const float bs = sgb[g * 128 + p];
            bf16_t* up = P0 + (long)p * LDP + COL_U + g * 128 + eh * 64 + r32;
            const float u0 = bf2f(up[0]), u1 = bf2f(up[32]);
            up[0] = (bf16_t)(cvt_pk_bf16(u0 * (oa[r] + bs), 0.f) & 0xffffu); up[32] = (bf16_t)(cvt_pk_bf16(u1 * (ob[r] + bs), 0.f) & 0xffffu); }
        __syncthreads();
    }
}
}

#define XB_TMO      128
#define XB_XCNT(j)  (256  + 64 * (j))
#define XB_XSUB(j)  (1280 + 64 * (j))
#define XB_XGEN(j)  (2304 + 64 * (j))
#define XB_TOP      3328
#define XB_TOPGEN   3392
#define XCD_BAR_WORDS 3456
#define XB_SPIN_CAP (1u << 18)
__device__ __forceinline__ unsigned xb_ld(unsigned* p)              { return __hip_atomic_load(p, __ATOMIC_RELAXED, __HIP_MEMORY_SCOPE_AGENT); }
__device__ __forceinline__ unsigned xb_add(unsigned* p, unsigned v) { return __hip_atomic_fetch_add(p, v, __ATOMIC_RELAXED, __HIP_MEMORY_SCOPE_AGENT); }
__device__ __forceinline__ unsigned xb_xcc_id() { return (unsigned)__builtin_amdgcn_s_getreg((3 << 11) | 20) & 0xFu; }
#define XB_SPIN(cond, bar) do { unsigned _sp = 0; while (cond) { __builtin_amdgcn_s_sleep(1); \
    if ((++_sp & 255u) == 0u) { if (xb_ld(&(bar)[XB_TMO])) break; if (_sp > XB_SPIN_CAP) { atomicAdd(&(bar)[XB_TMO], 1u); break; } } } } while (0)
struct XcdBarrier { unsigned* bar; unsigned x; volatile LAS unsigned* st; };
__device__ __forceinline__ XcdBarrier xcd_barrier_post(unsigned* bar, volatile LAS unsigned* st) {
    XcdBarrier b; b.bar = bar; b.x = xb_xcc_id(); b.st = st;
    if (threadIdx.x == 0) (void)xb_add(&bar[XB_XCNT(b.x)], 1u);
    return b;
}
__device__ __forceinline__ void xcd_barrier_complete(unsigned* bar, unsigned x, unsigned& nloc, unsigned& nx) {
    const unsigned G = gridDim.x * gridDim.y * gridDim.z;
    unsigned sum, cnt, mine, sp = 0u;
    for (;;) {
        sum = 0u; cnt = 0u; mine = 0u;
#pragma unroll
        for (unsigned j = 0; j < 16; ++j) { const unsigned c = xb_ld(&bar[XB_XCNT(j)]); sum += c; cnt += (c > 0u) ? 1u : 0u; mine = (j == x) ? c : mine; }
        if (sum == G) break;
        __builtin_amdgcn_s_sleep(1);
        if ((++sp & 255u) == 0u) { if (xb_ld(&bar[XB_TMO])) break; if (sp > XB_SPIN_CAP) { atomicAdd(&bar[XB_TMO], 1u); break; } }
    }
    nloc = mine > 0u ? mine : 1u; nx = cnt > 0u ? cnt : 1u;
}
__device__ __forceinline__ void xcd_barrier(const XcdBarrier& b) {
    asm volatile("s_waitcnt vmcnt(0)" ::: "memory");
    __syncthreads();
    if (threadIdx.x == 0) {
        unsigned* bar = b.bar;
        __builtin_amdgcn_s_waitcnt(0);
        unsigned nloc = b.st[0], nx = b.st[1];
        if (nloc == 0u) { xcd_barrier_complete(bar, b.x, nloc, nx); b.st[0] = nloc; b.st[1] = nx; }
        const unsigned old = xb_add(&bar[XB_XSUB(b.x)], 1u);
        const unsigned gen = old / nloc;
        if (old + 1u == (gen + 1u) * nloc) {
            __builtin_amdgcn_fence(__ATOMIC_RELEASE, "agent");
            asm volatile("s_waitcnt vmcnt(0)" ::: "memory");
            const unsigned og = xb_add(&bar[XB_TOP], 1u);
            const unsigned tg = og / nx;
            if (og + 1u == (tg + 1u) * nx) xb_add(&bar[XB_TOPGEN], 1u);
            else XB_SPIN(xb_ld(&bar[XB_TOPGEN]) == tg, bar);
            __builtin_amdgcn_fence(__ATOMIC_ACQUIRE, "agent");
            xb_add(&bar[XB_XGEN(b.x)], 1u);
            asm volatile("s_waitcnt vmcnt(0)" ::: "memory");
        } else {
            XB_SPIN(xb_ld(&bar[XB_XGEN(b.x)]) == gen, bar);
            __builtin_amdgcn_fence(__ATOMIC_ACQUIRE, "agent");
            asm volatile("s_waitcnt vmcnt(0)" ::: "memory");
        }
    }
    __syncthreads();
}

struct Args {
    const float* in[28]; float* out; unsigned char* ws; int ph_lo, ph_hi;
};
typedef const __attribute__((address_space(4))) Args* KArgP;
#define KARG() ({ KArgP _p = (KArgP)__builtin_amdgcn_kernarg_segment_ptr(); asm volatile("" : "+s"(_p)); _p; })
struct Frame {
    LAS unsigned char* lds; gu32* ctl; int tid, lane, wave, vcu, G;
};

__device__ __forceinline__ void transpose_item(const float* __restrict__ W, int ldw, int srcg, bool rope, int k0, bf16_t* WT, size_t dst_row0, int K, LAS float* scr, int lane) {
    const int j = lane & 31, sj = rope ? ((j & 3) + 4 * (j >> 3) + 16 * ((j >> 2) & 1)) : j;
    float v[32];
#pragma unroll
    for (int i = 0; i < 32; ++i) { const int kk = 2 * i + (lane >> 5); v[i] = W[(size_t)(k0 + kk) * ldw + srcg + sj]; }
#pragma unroll
    for (int i = 0; i < 32; ++i) { const int kk = 2 * i + (lane >> 5); scr[kk * 33 + j] = v[i]; }
    LDS_WAIT(); asm volatile("" ::: "memory");
    const int c = lane & 7;
#pragma unroll
    for (int jj = 0; jj < 4; ++jj) { const int n = (lane >> 3) + 8 * jj; const LAS float* s = scr + (8 * c) * 33 + n;
        u32x4 o; o.x = cvt_pk_bf16(s[0 * 33], s[1 * 33]); o.y = cvt_pk_bf16(s[2 * 33], s[3 * 33]); o.z = cvt_pk_bf16(s[4 * 33], s[5 * 33]); o.w = cvt_pk_bf16(s[6 * 33], s[7 * 33]);
        *(u32x4*)(WT + (dst_row0 + n) * K + k0 + 8 * c) = o; }
    LDS_WAIT(); asm volatile("" ::: "memory");
}

__device__ __forceinline__ void transpose_item_f8(const float* __restrict__ W, int ldw, int srcg, int k0, unsigned char* WT, size_t dst_row0, int K, LAS float* scr, int lane) {
    const int j = lane & 31;
    float v[32];
#pragma unroll
    for (int i = 0; i < 32; ++i) { const int kk = 2 * i + (lane >> 5); v[i] = W[(size_t)(k0 + kk) * ldw + srcg + j]; }
#pragma unroll
    for (int i = 0; i < 32; ++i) { const int kk = 2 * i + (lane >> 5); scr[kk * 33 + j] = v[i] * 128.f; }
    LDS_WAIT(); asm volatile("" ::: "memory");
    const int n = lane >> 1, hf = lane & 1; const LAS float* s = scr + (32 * hf) * 33 + n;
    u32x4 o0, o1;
    o0.x = pg8::pk_fp8x4(s[0 * 33], s[1 * 33], s[2 * 33], s[3 * 33]);     o0.y = pg8::pk_fp8x4(s[4 * 33], s[5 * 33], s[6 * 33], s[7 * 33]);
    o0.z = pg8::pk_fp8x4(s[8 * 33], s[9 * 33], s[10 * 33], s[11 * 33]);   o0.w = pg8::pk_fp8x4(s[12 * 33], s[13 * 33], s[14 * 33], s[15 * 33]);
    o1.x = pg8::pk_fp8x4(s[16 * 33], s[17 * 33], s[18 * 33], s[19 * 33]); o1.y = pg8::pk_fp8x4(s[20 * 33], s[21 * 33], s[22 * 33], s[23 * 33]);
    o1.z = pg8::pk_fp8x4(s[24 * 33], s[25 * 33], s[26 * 33], s[27 * 33]); o1.w = pg8::pk_fp8x4(s[28 * 33], s[29 * 33], s[30 * 33], s[31 * 33]);
    unsigned char* d = WT + (dst_row0 + n) * K + k0 + 32 * hf;
    *(u32x4*)d = o0; *(u32x4*)(d + 16) = o1;
    LDS_WAIT(); asm volatile("" ::: "memory");
}

__device__ __forceinline__ void p0_prologue(Frame& F, KArgP ap) {
    const __attribute__((address_space(4))) Args& a = *ap;
    unsigned char* ws = a.ws;
    if (blockIdx.x < 192) {
        const int l = blockIdx.x / 96, n0 = (blockIdx.x % 96) * 64;
        LAS float* s = (LAS float*)F.lds;
        LAS float* red = (LAS float*)(F.lds + 73728);
        const float* c = a.in[1]; const float* cc = a.in[3];
        for (int i = F.tid; i < 17 * 1024; i += 512) { const float v = i < 16 * 1024 ? c[i] : cc[i - 16 * 1024]; s[i] = silu_f(v); }
        __syncthreads();
        const float* W = a.in[4] + (size_t)l * D * 6144 + n0 + F.lane;
        float acc[17];
#pragma unroll
        for (int r = 0; r < 17; ++r) acc[r] = 0.f;
        const int kb = F.wave * 128;
        for (int k = 0; k < 128; k += 4) {
            const float w0 = W[(size_t)(kb + k) * 6144], w1 = W[(size_t)(kb + k + 1) * 6144], w2 = W[(size_t)(kb + k + 2) * 6144], w3 = W[(size_t)(kb + k + 3) * 6144];
#pragma unroll
            for (int r = 0; r < 17; ++r) { const f32x4 sv = *(const LAS f32x4*)(s + r * 1024 + kb + k); acc[r] += sv[0] * w0 + sv[1] * w1 + sv[2] * w2 + sv[3] * w3; }
        }
#pragma unroll
        for (int r = 0; r < 17; ++r) red[(F.wave * 17 + r) * 64 + F.lane] = acc[r];
        __syncthreads();
        float* ms = (float*)(ws + WS_MS) + (size_t)l * 17 * 6144;
        const float* bias = a.in[5] + (size_t)l * 6144;
        for (int i = F.tid; i < 17 * 64; i += 512) { const int r = i >> 6, col = i & 63; float v = bias[n0 + col];
#pragma unroll
            for (int w = 0; w < 8; ++w) v += red[(w * 17 + r) * 64 + col];
            ms[(size_t)r * 6144 + n0 + col] = v; }
        __syncthreads();
    }
    if (blockIdx.x == 255) {
        float* rc = (float*)(ws + WS_ROPE); float* rs = rc + 1024;
        for (int i = F.tid; i < 1024; i += 512) { const int pos = i >> 4, j = i & 15; const float inv = powf(10000.0f, -(float)(2 * j) / 32.0f); const float ang = (float)pos * inv; rc[i] = cosf(ang); rs[i] = sinf(ang); }
    }
    { const float* src = a.in[19]; bf16_t* dst = (bf16_t*)(ws + WS_SGW); const int n4 = 2 * 4 * 128 * 128 / 4;
      for (int i = blockIdx.x * 512 + F.tid; i < n4; i += F.G * 512) { const f32x4 v = *(const f32x4*)(src + (size_t)i * 4); u32x2 o; o.x = cvt_pk_bf16(v[0], v[1]); o.y = cvt_pk_bf16(v[2], v[3]); *(u32x2*)(dst + (size_t)i * 4) = o; } }
    LAS float* scr = (LAS float*)(F.lds + F.wave * 16384);
    const int gw = F.vcu * NWAVES + F.wave, NGW = F.G * NWAVES;
    constexpr int I_IN = 16 * 80, I_OUT = 16 * 32, I_F13 = 16 * 176, I_F2 = 44 * 32, I_M13 = 16 * 224, I_M2 = 56 * 32;
    constexpr int NITEMS = 2 * I_IN + 2 * I_OUT + I_F13 + I_F2 + 8 * I_M13 + 8 * I_M2;
    for (int it = gw; it < NITEMS; it += NGW) {
        int r = it;
        if (r < 2 * I_IN) { const int l = r / I_IN; r %= I_IN; const int kb = r / 80, g = r % 80, seg = g >> 4, gi = g & 15;
            const int sseg = seg == 0 ? 0 : seg == 1 ? 3 : seg == 2 ? 1 : seg == 3 ? 2 : 4;
            transpose_item(a.in[10] + (size_t)l * D * NIN, NIN, sseg * 512 + gi * 32, seg == 0 || seg == 2, kb * 64, (bf16_t*)(ws + WS_WIN) + (size_t)l * NIN * D, (size_t)g * 32, D, scr, F.lane); continue; }
        r -= 2 * I_IN;
        if (r < 2 * I_OUT) { const int l = r / I_OUT; r %= I_OUT; const int kb = r / 32, g = r % 32;
            transpose_item(a.in[11] + (size_t)l * D * D, D, g * 32, false, kb * 64, (bf16_t*)(ws + WS_WOUT) + (size_t)l * D * D, (size_t)g * 32, D, scr, F.lane); continue; }
        r -= 2 * I_OUT;
        if (r < I_F13) { const int kb = r / 176, g = r % 176, tile = g >> 3, gi = g & 7;
            const float* src = gi < 4 ? a.in[21] : a.in[22];
            transpose_item(src, DFF, tile * 128 + (gi & 3) * 32, false, kb * 64, (bf16_t*)(ws + WS_W13), (size_t)g * 32, D, scr, F.lane); continue; }
        r -= I_F13;
        if (r < I_F2) { const int kb = r / 32, g = r % 32;
            transpose_item(a.in[23], D, g * 32, false, kb * 64, (bf16_t*)(ws + WS_W2), (size_t)g * 32, DFF, scr, F.lane); continue; }
        r -= I_F2;
        if (r < 8 * I_M13) { const int e = r / I_M13; r %= I_M13; const int kb = r / 224, g = r % 224, tile = g >> 3, gi = g & 7;
            const float* src = (gi < 4 ? a.in[25] : a.in[26]) + (size_t)e * D * DEXP;
            transpose_item_f8(src, DEXP, tile * 128 + (gi & 3) * 32, kb * 64, ws + WS_MW13 + (size_t)e * 7168 * D, (size_t)g * 32, D, scr, F.lane); continue; }
        r -= 8 * I_M13;
        { const int e = r / I_M2; r %= I_M2; const int kb = r / 32, g = r % 32;
            transpose_item_f8(a.in[27] + (size_t)e * DEXP * D, D, g * 32, kb * 64, ws + WS_MW2 + (size_t)e * D * DEXP, (size_t)g * 32, DEXP, scr, F.lane); }
    }
}

struct Row { f32x4 v[4]; };
__device__ __forceinline__ Row ld_row_f32(const float* p, int lane) { Row r; const f32x4* q = (const f32x4*)p + lane;
#pragma unroll
    for (int j = 0; j < 4; ++j) r.v[j] = q[64 * j]; return r; }
__device__ __forceinline__ void st_row_f32(float* p, int lane, const Row& r) { f32x4* q = (f32x4*)p + lane;
#pragma unroll
    for (int j = 0; j < 4; ++j) q[64 * j] = r.v[j]; }
__device__ __forceinline__ Row ld_row_bf16(const bf16_t* p, int lane) { Row r; const u32x2* q = (const u32x2*)p + lane;
#pragma unroll
    for (int j = 0; j < 4; ++j) { const u32x2 w = q[64 * j]; r.v[j] = (f32x4){bflo(w.x), bfhi(w.x), bflo(w.y), bfhi(w.y)}; } return r; }
__device__ __forceinline__ void st_row_bf16(bf16_t* p, int lane, const Row& r) { u32x2* q = (u32x2*)p + lane;
#pragma unroll
    for (int j = 0; j < 4; ++j) { u32x2 w; w.x = cvt_pk_bf16(r.v[j][0], r.v[j][1]); w.y = cvt_pk_bf16(r.v[j][2], r.v[j][3]); q[64 * j] = w; } }
__device__ __forceinline__ float row_rms_scale(const Row& r) { float s = 0.f;
#pragma unroll
    for (int j = 0; j < 4; ++j) s += (r.v[j][0] * r.v[j][0] + r.v[j][1] * r.v[j][1]) + (r.v[j][2] * r.v[j][2] + r.v[j][3] * r.v[j][3]);
    return __builtin_amdgcn_rsqf(wave_sum(s) * (1.f / D) + EPS); }
__device__ __forceinline__ Row row_modulate(const Row& x, const float* g, const float* shift, const float* scale, int lane) {
    const float rs = row_rms_scale(x); Row h; const f32x4* gq = (const f32x4*)g + lane; const f32x4* sh = (const f32x4*)shift + lane; const f32x4* sc = (const f32x4*)scale + lane;
#pragma unroll
    for (int j = 0; j < 4; ++j) h.v[j] = x.v[j] * rs * gq[64 * j] * (1.f + sc[64 * j]) + sh[64 * j];
    return h; }
__device__ __forceinline__ void row_residual(Row& x, const Row& y, const float* g, const float* gate, int lane) {
    const float rs = row_rms_scale(y); const f32x4* gq = (const f32x4*)g + lane; const f32x4* gt = (const f32x4*)gate + lane;
#pragma unroll
    for (int j = 0; j < 4; ++j) x.v[j] = x.v[j] + gt[64 * j] * (y.v[j] * rs * gq[64 * j]);
}

struct ResP { f32x4 a[4]; };
struct ModP { f32x4 b[4], sh[4]; };
__device__ __forceinline__ ResP ld_resp(const float* g, const float* gate, int lane) { ResP r; const f32x4* gq = (const f32x4*)g + lane; const f32x4* gt = (const f32x4*)gate + lane;
#pragma unroll
    for (int j = 0; j < 4; ++j) r.a[j] = gq[64 * j] * gt[64 * j]; return r; }
__device__ __forceinline__ ModP ld_modp(const float* g, const float* shift, const float* scale, int lane) { ModP r; const f32x4* gq = (const f32x4*)g + lane; const f32x4* sh = (const f32x4*)shift + lane; const f32x4* sc = (const f32x4*)scale + lane;
#pragma unroll
    for (int j = 0; j < 4; ++j) { r.b[j] = gq[64 * j] * (1.f + sc[64 * j]); r.sh[j] = sh[64 * j]; } return r; }
__device__ __forceinline__ void row_residual2(Row& x, const Row& y, const ResP& P) { const float rs = row_rms_scale(y);
#pragma unroll
    for (int j = 0; j < 4; ++j) x.v[j] = x.v[j] + P.a[j] * (y.v[j] * rs); }
__device__ __forceinline__ Row row_modulate2(const Row& x, const ModP& P) { const float rs = row_rms_scale(x); Row h;
#pragma unroll
    for (int j = 0; j < 4; ++j) h.v[j] = x.v[j] * rs * P.b[j] + P.sh[j]; return h; }

struct MoeTab { int cnt[8]; int pbase[9]; };
__device__ __forceinline__ void moe_tab(gu32* ctl, MoeTab& T) {
    int p = 0;
#pragma unroll
    for (int e = 0; e < 8; ++e) { const int c = (int)__builtin_amdgcn_readfirstlane(__hip_atomic_load(ctl + CW_CNT + 64 * e, RLX_AGENT)); T.cnt[e] = c; T.pbase[e] = p; p += (c + 255) >> 8; }
    T.pbase[8] = p;
}
__device__ __forceinline__ int moe_expert_of(const MoeTab& T, int panel) { int e = 0;
#pragma unroll
    for (int i = 1; i < 8; ++i) e += (panel >= T.pbase[i]) ? 1 : 0;
    return e; }

struct MoeUpSched {
    static constexpr bool GATHER = true;
    const char* A; const char* Bt; const int* slot_token; int G, c, p0, nM; MoeTab T;
    __device__ __forceinline__ bool next(int i, pg8::Unit& u) const {
        const int L = i * G + c; if (L >= nM * 28) return false;
        int pm, pn; pg8::tile_of(L, nM, 28, pm, pn);
        const int panel = p0 + pm, e = moe_expert_of(T, panel);
        u.pm = pm; u.pn = pn; u.aux = e; u.aux2 = panel; u.Ap = A; u.Bp = Bt + ((size_t)e * 7168 + (size_t)pn * 256) * D; return true;
    }
    __device__ __forceinline__ void aoff(const pg8::Unit& u, const int (&R)[2], const int (&C)[2], unsigned (&o0)[2], unsigned (&o1)[2]) const {
        int pb = 0, cn = 0;
#pragma unroll
        for (int e = 0; e < 8; ++e) { pb = (u.aux == e) ? T.pbase[e] : pb; cn = (u.aux == e) ? T.cnt[e] : cn; }
        const int rk0 = (u.aux2 - pb) * 256;
#pragma unroll
        for (int i = 0; i < 2; ++i) {
            const int ra = rk0 + R[i], rb = rk0 + pg8::HALF + R[i];
            const int ta = slot_token[u.aux * 32768 + (ra < cn ? ra : 0)], tb = slot_token[u.aux * 32768 + (rb < cn ? rb : 0)];
            o0[i] = (unsigned)(ta * D + C[i] * 2); o1[i] = (unsigned)(tb * D + C[i] * 2); }
    }
};
struct MoeDownSched {
    static constexpr bool GATHER = false;
    const char* A; const char* Bt; int G, c, p0, nM; MoeTab T;
    __device__ __forceinline__ bool next(int i, pg8::Unit& u) const {
        const int L = i * G + c; if (L >= nM * 4) return false;
        int pm, pn; pg8::tile_of(L, nM, 4, pm, pn);
        const int panel = p0 + pm, e = moe_expert_of(T, panel);
        u.pm = panel; u.pn = pn; u.aux = e; u.aux2 = 0; u.Ap = A + (size_t)pm * 256 * DEXP; u.Bp = Bt + ((size_t)e * D + (size_t)pn * 256) * DEXP; return true;
    }
    __device__ __forceinline__ void aoff(const pg8::Unit&, const int (&R)[2], const int (&C)[2], unsigned (&o0)[2], unsigned (&o1)[2]) const {
#pragma unroll
        for (int i = 0; i < 2; ++i) { o0[i] = (unsigned)(R[i] * DEXP + C[i] * 2); o1[i] = (unsigned)((pg8::HALF + R[i]) * DEXP + C[i] * 2); }
    }
};

constexpr int N_PHASES = 24;


__global__ void __launch_bounds__(NWAVES * 64, 2) mk_fwd(Args args) {
    extern __shared__ __attribute__((aligned(16))) unsigned char lds_raw[];
    Frame F;
    F.lds = (LAS unsigned char*)lds_raw;
    F.tid = threadIdx.x; F.lane = F.tid & 63; F.wave = __builtin_amdgcn_readfirstlane(F.tid >> 6);
    F.G = gridDim.x; { const int bx = blockIdx.x; F.vcu = (F.G % 8 == 0) ? (bx % 8) * (F.G / 8) + bx / 8 : bx; }
    unsigned char* ws = KARG()->ws;
    F.ctl = (gu32*)(ws + WS_CTL);
    volatile LAS unsigned* MISC = (volatile LAS unsigned*)(F.lds + MISC_OFF);
    for (int u = F.tid; u < (LDS_BYTES - LDSCTL_OFF) / 4; u += NWAVES * 64) ((LAS unsigned*)(F.lds + LDSCTL_OFF))[u] = 0u;
    __syncthreads();
    XcdBarrier bar; bar.bar = (unsigned*)(F.ctl + CW_BAR); bar.x = 0; bar.st = nullptr;
    if (!MK_PER_PHASE) bar = xcd_barrier_post((unsigned*)(F.ctl + CW_BAR), MISC + 8);
    const int lo = KARG()->ph_lo, hi = KARG()->ph_hi;
#ifndef DUP_MASK
#define DUP_MASK 0u
#endif
#if ((DUP_MASK) >> 0) & 1
#define REP_0 for (int _rep = 0; _rep < 2; ++_rep)
#else
#define REP_0
#endif
#if ((DUP_MASK) >> 1) & 1
#define REP_1 for (int _rep = 0; _rep < 2; ++_rep)
#else
#define REP_1
#endif
#if ((DUP_MASK) >> 2) & 1
#define REP_2 for (int _rep = 0; _rep < 2; ++_rep)
#else
#define REP_2
#endif
#if ((DUP_MASK) >> 4) & 1
#define REP_4 for (int _rep = 0; _rep < 2; ++_rep)
#else
#define REP_4
#endif
#if ((DUP_MASK) >> 5) & 1
#define REP_5 for (int _rep = 0; _rep < 2; ++_rep)
#else
#define REP_5
#endif
#if ((DUP_MASK) >> 6) & 1
#define REP_6 for (int _rep = 0; _rep < 2; ++_rep)
#else
#define REP_6
#endif
#if ((DUP_MASK) >> 7) & 1
#define REP_7 for (int _rep = 0; _rep < 2; ++_rep)
#else
#define REP_7
#endif
#if ((DUP_MASK) >> 9) & 1
#define REP_9 for (int _rep = 0; _rep < 2; ++_rep)
#else
#define REP_9
#endif
#if ((DUP_MASK) >> 11) & 1
#define REP_11 for (int _rep = 0; _rep < 2; ++_rep)
#else
#define REP_11
#endif
#if ((DUP_MASK) >> 13) & 1
#define REP_13 for (int _rep = 0; _rep < 2; ++_rep)
#else
#define REP_13
#endif
#if ((DUP_MASK) >> 14) & 1
#define REP_14 for (int _rep2 = 0; _rep2 < 2; ++_rep2)
#else
#define REP_14
#endif
#if ((DUP_MASK) >> 15) & 1
#define REP_15 for (int _rep2 = 0; _rep2 < 2; ++_rep2)
#else
#define REP_15
#endif
#ifndef PH_MASK
#define PH_MASK 0xffffffu
#endif
#define IN(k) ((((PH_MASK) >> (k)) & 1u) && lo <= (k) && (k) < hi)
#define SEAM(k) do { if (IN(k) && IN((k) + 1)) xcd_barrier(bar); } while (0)

    bf16_t* XB = (bf16_t*)(ws + WS_XB);
    bf16_t* HA = (bf16_t*)(ws + WS_HA); bf16_t* P = (bf16_t*)(ws + WS_R1); bf16_t* HFF = (bf16_t*)(ws + WS_R1); bf16_t* OY = (bf16_t*)(ws + WS_OY); bf16_t* YS = (bf16_t*)(ws + WS_YS);
    const float* MS = (const float*)(ws + WS_MS);
    const float* ropec = (const float*)(ws + WS_ROPE); const float* ropes = ropec + 1024;
    int* tok_e = (int*)(ws + WS_ROUTE); float* tok_g = (float*)(ws + WS_ROUTE + 262144); int* tok_rank = (int*)(ws + WS_ROUTE + 524288);
    int* slot_token = (int*)(ws + WS_SLOT);
    const int gw = F.vcu * NWAVES + F.wave, NGW = F.G * NWAVES;
    char* ldsg = (char*)lds_raw;

    REP_0 if (IN(0)) { p0_prologue(F, KARG()); __syncthreads(); }
    SEAM(0);

    REP_1 if (IN(1)) {
        KArgP AP = KARG(); const float* x_in = AP->in[0]; const float* ctx_in = AP->in[2];
        const float* g = AP->in[6];
#pragma unroll 1
        for (int seg = 0; seg < 2; ++seg) {
            const int nr = seg ? 2 : 16; const int m0 = seg ? MLAT + gw * 2 : gw * 16; const int r17 = seg ? 16 : (m0 >> 11);
            const float* xbase = seg ? ctx_in + (size_t)(m0 - MLAT) * D : x_in + (size_t)m0 * D;
            const float* msr = MS + (size_t)r17 * 6144;
            const ModP MP = ld_modp(g, msr, msr + 1024, F.lane);
            Row xn = ld_row_f32(xbase, F.lane);
            for (int i = 0; i < nr; ++i) {
                const Row x = xn; if (i + 1 < nr) xn = ld_row_f32(xbase + (size_t)(i + 1) * D, F.lane);
                st_row_bf16(HA + (size_t)(m0 + i) * D, F.lane, row_modulate2(x, MP));
            }
        }
    }
    SEAM(1);

    REP_2 if (IN(2)) {
        pg8::DenseSched S{(const char*)HA, (const char*)(ws + WS_WIN), D, D, F.G, (int)blockIdx.x, MALL / 256, 10, 0, 0, 0, 0, 0, 0};
        pg8::EpiInProj E{P, ropec, ropes};
        pg8::gemm_phase<pg8::EpiInProj, pg8::DenseSched, true>(F.lds, D, S, E);
    }
    SEAM(2);

#define ATTN_PHASE(LAYER, WITH_CTX) do { \
        KArgP AP = KARG(); \
        float lam; { const float a1 = AP->in[12][(LAYER) * 64 + F.lane] * AP->in[13][(LAYER) * 64 + F.lane], a2 = AP->in[14][(LAYER) * 64 + F.lane] * AP->in[15][(LAYER) * 64 + F.lane]; \
            lam = __expf(wave_sum(a1)) - __expf(wave_sum(a2)) + ((LAYER) ? LAMBDA_INIT1 : LAMBDA_INIT0); } \
        const float oscale = 1.f - ((LAYER) ? LAMBDA_INIT1 : LAMBDA_INIT0); \
        const float* subg = AP->in[16] + (LAYER) * 128; \
        const int c = (int)blockIdx.x, xcd = c & 7, jj = c >> 3; \
        if (!DBG_NO_LAT) for (int i = 0; i < 4; ++i) { const int bh = i * 16 + xcd * 2 + (jj >> 4), qb = jj & 15, b = bh >> 2, h = bh & 3; \
            bf16_t* Qb = P + ((size_t)b * SEQ + qb * 128) * NIN + COL_Q + h * 128; \
            const bf16_t* Kc = P + ((size_t)MLAT + b * CTX) * NIN + COL_K + h * 128; const bf16_t* Kl = P + ((size_t)b * SEQ) * NIN + COL_K + h * 128; \
            att::attn_unit(Qb, Kc, 4, Kl, 32, Qb, lam, oscale, subg, ldsg); } \
        int c1 = c; asm volatile("" : "+s"(c1)); \
        if (!DBG_NO_CTX && (WITH_CTX) && c1 < 128) { const int bh = c1 >> 1, qb = c1 & 1, b = bh >> 2, h = bh & 3; \
            bf16_t* Qb = P + ((size_t)MLAT + b * CTX + qb * 128) * NIN + COL_Q + h * 128; const bf16_t* Kc = P + ((size_t)MLAT + b * CTX) * NIN + COL_K + h * 128; \
            att::attn_unit(Qb, Kc, 4, Kc, 0, Qb, lam, oscale, subg, ldsg); } \
        int c2 = c1; asm volatile("" : "+s"(c2)); \
        if (!DBG_NO_SG) { const bf16_t* sgw = (const bf16_t*)(ws + WS_SGW) + (size_t)(LAYER) * 4 * 128 * 128; \
          att::sg_unit(P + (size_t)c2 * 128 * NIN, sgw, AP->in[17] + (LAYER) * 512, AP->in[18] + (LAYER) * 512, AP->in[20] + (LAYER) * 512, ldsg); \
          int c3 = c2; asm volatile("" : "+s"(c3)); \
          if ((WITH_CTX) && c3 >= 128 && c3 < 160) att::sg_unit(P + ((size_t)MLAT + (c3 - 128) * 128) * NIN, sgw, AP->in[17] + (LAYER) * 512, AP->in[18] + (LAYER) * 512, AP->in[20] + (LAYER) * 512, ldsg); } \
    } while (0)
    if (IN(3)) { ATTN_PHASE(0, true); }
    SEAM(3);

    REP_4 if (IN(4)) {
        pg8::DenseSched S{(const char*)P, (const char*)(ws + WS_WOUT), NIN, D, F.G, (int)blockIdx.x, MALL / 256, 4, 0, 0, 0, 0, 0, 0};
        pg8::EpiPlain E{OY, D, 1.f};
        pg8::gemm_phase<pg8::EpiPlain, pg8::DenseSched, true>(F.lds, D, S, E);
    }
    SEAM(4);

    REP_5 if (IN(5)) {
        KArgP AP = KARG(); const float* x_in = AP->in[0]; const float* ctx_in = AP->in[2];
        const float* gpost = AP->in[7]; const float* gpre = AP->in[8];
#pragma unroll 1
        for (int seg = 0; seg < 2; ++seg) {
            const int nr = seg ? 2 : 16; const int m0 = seg ? MLAT + gw * 2 : gw * 16; const int r17 = seg ? 16 : (m0 >> 11);
            const float* xbase = seg ? ctx_in + (size_t)(m0 - MLAT) * D : x_in + (size_t)m0 * D;
            const float* msr = MS + (size_t)r17 * 6144;
            const ResP RP = ld_resp(gpost, msr + 2 * 1024, F.lane); const ModP MP = ld_modp(gpre, msr + 3 * 1024, msr + 4 * 1024, F.lane);
            Row xn = ld_row_f32(xbase, F.lane), on = ld_row_bf16(OY + (size_t)m0 * D, F.lane);
            for (int i = 0; i < nr; ++i) {
                Row x = xn; const Row o = on; if (i + 1 < nr) { xn = ld_row_f32(xbase + (size_t)(i + 1) * D, F.lane); on = ld_row_bf16(OY + (size_t)(m0 + i + 1) * D, F.lane); }
                row_residual2(x, o, RP);
                st_row_bf16(XB + (size_t)(m0 + i) * D, F.lane, x);
                st_row_bf16(HA + (size_t)(m0 + i) * D, F.lane, row_modulate2(x, MP));
            }
        }
    }
    SEAM(5);

    REP_6 if (IN(6)) {
        pg8::DenseSched S{(const char*)HA, (const char*)(ws + WS_W13), D, D, F.G, (int)blockIdx.x, MALL / 256, 22, 0, 0, 0, 0, 0, 0};
        pg8::EpiSwiglu E{HFF, DFF};
        pg8::gemm_phase<pg8::EpiSwiglu, pg8::DenseSched, true>(F.lds, D, S, E);
    }
    SEAM(6);

    REP_7 if (IN(7)) {
        pg8::DenseSched S{(const char*)HFF, (const char*)(ws + WS_W2), DFF, DFF, F.G, (int)blockIdx.x, MALL / 256, 4, 0, 0, 0, 0, 0, 0};
        pg8::EpiPlain E{OY, D, 1.f};
        pg8::gemm_phase<pg8::EpiPlain, pg8::DenseSched, true>(F.lds, DFF, S, E);
    }
    SEAM(7);

    if (IN(8)) {
        KArgP AP = KARG();
        const float* gpost = AP->in[9]; const float* gpre = AP->in[6] + D;
#pragma unroll 1
        for (int seg = 0; seg < 2; ++seg) {
            const int nr = seg ? 2 : 16; const int m0 = seg ? MLAT + gw * 2 : gw * 16; const int r17 = seg ? 16 : (m0 >> 11);
            const float* msr = MS + (size_t)r17 * 6144; const float* msr1 = MS + (size_t)(17 + r17) * 6144;
            const ResP RP = ld_resp(gpost, msr + 5 * 1024, F.lane); const ModP MP = ld_modp(gpre, msr1, msr1 + 1024, F.lane);
            Row xn = ld_row_bf16(XB + (size_t)m0 * D, F.lane), yn = ld_row_bf16(OY + (size_t)m0 * D, F.lane);
            for (int i = 0; i < nr; ++i) {
                Row x = xn; const Row y = yn; if (i + 1 < nr) { xn = ld_row_bf16(XB + (size_t)(m0 + i + 1) * D, F.lane); yn = ld_row_bf16(OY + (size_t)(m0 + i + 1) * D, F.lane); }
                row_residual2(x, y, RP);
                if (!seg) st_row_bf16(XB + (size_t)(m0 + i) * D, F.lane, x);
                st_row_bf16(HA + (size_t)(m0 + i) * D, F.lane, row_modulate2(x, MP));
            }
        }
    }
    SEAM(8);

    REP_9 if (IN(9)) {
        pg8::DenseSched S{(const char*)HA, (const char*)(ws + WS_WIN + (size_t)NIN * D * 2), D, D, F.G, (int)blockIdx.x, MLAT / 256, 10, 0, 0, MCTX / 256, 4, MLAT, 4};
        pg8::EpiInProj E{P, ropec, ropes};
        pg8::gemm_phase<pg8::EpiInProj, pg8::DenseSched, true>(F.lds, D, S, E);
    }
    SEAM(9);

    if (IN(10)) { ATTN_PHASE(1, false); }
    SEAM(10);

    REP_11 if (IN(11)) {
        pg8::DenseSched S{(const char*)P, (const char*)(ws + WS_WOUT + (size_t)D * D * 2), NIN, D, F.G, (int)blockIdx.x, MLAT / 256, 4, 0, 0, 0, 0, 0, 0};
        pg8::EpiPlain E{OY, D, 1.f};
        pg8::gemm_phase<pg8::EpiPlain, pg8::DenseSched, true>(F.lds, D, S, E);
    }
    SEAM(11);

    if (IN(12)) {
        KArgP AP = KARG();
        const float* gpost = AP->in[7] + D; const float* gpre = AP->in[8] + D;
        LAS float* rw = (LAS float*)F.lds;
        LAS int* lcnt = (LAS int*)(F.lds + 32768);
        LAS int* rec = (LAS int*)(F.lds + 32768 + 256);
        for (int i = F.tid; i < 8192; i += 512) rw[(i & 7) * 1024 + (i >> 3)] = AP->in[24][i];
        if (F.tid < 16) lcnt[F.tid] = 0;
        __syncthreads();
        const int m0 = gw * 16; const int r17 = m0 >> 11; const float* msr1 = MS + (size_t)(17 + r17) * 6144;
        const ResP RP = ld_resp(gpost, msr1 + 2 * 1024, F.lane); const ModP MP = ld_modp(gpre, msr1 + 3 * 1024, msr1 + 4 * 1024, F.lane);
        Row xn = ld_row_bf16(XB + (size_t)m0 * D, F.lane), on = ld_row_bf16(OY + (size_t)m0 * D, F.lane);
        for (int i = 0; i < 16; ++i) {
            const int m = m0 + i;
            Row x = xn; const Row o = on; if (i + 1 < 16) { xn = ld_row_bf16(XB + (size_t)(m + 1) * D, F.lane); on = ld_row_bf16(OY + (size_t)(m + 1) * D, F.lane); }
            row_residual2(x, o, RP);
            st_row_bf16(XB + (size_t)m * D, F.lane, x);
            const Row f = row_modulate2(x, MP);
            { unsigned* fo = (unsigned*)((unsigned char*)HA + (size_t)m * D) + F.lane;
#pragma unroll
              for (int j = 0; j < 4; ++j) fo[64 * j] = pg8::pk_fp8x4(f.v[j][0] * 4.f, f.v[j][1] * 4.f, f.v[j][2] * 4.f, f.v[j][3] * 4.f); }
            float lg[8];
#pragma unroll
            for (int e = 0; e < 8; ++e) { float a = 0.f;
#pragma unroll
                for (int j = 0; j < 4; ++j) { const f32x4 w = *(const LAS f32x4*)(rw + e * 1024 + 4 * (F.lane + 64 * j)); a += (f.v[j][0] * w[0] + f.v[j][1] * w[1]) + (f.v[j][2] * w[2] + f.v[j][3] * w[3]); }
                lg[e] = wave_sum(a); }
            int e1 = 0; float v1 = lg[0];
#pragma unroll
            for (int e = 1; e < 8; ++e) if (lg[e] > v1) { v1 = lg[e]; e1 = e; }
            int e2 = -1; float v2 = -3.0e38f;
#pragma unroll
            for (int e = 0; e < 8; ++e) if (e != e1 && lg[e] > v2) { v2 = lg[e]; e2 = e; }
            if (F.lane == 0) {
                const float w1 = 1.f / (1.f + __expf(v2 - v1));
                tok_e[m * 2] = e1; tok_e[m * 2 + 1] = e2; tok_g[m * 2] = w1; tok_g[m * 2 + 1] = 1.f - w1;
                const int l1 = __hip_atomic_fetch_add(lcnt + e1, 1, __ATOMIC_RELAXED, __HIP_MEMORY_SCOPE_WORKGROUP), l2 = __hip_atomic_fetch_add(lcnt + e2, 1, __ATOMIC_RELAXED, __HIP_MEMORY_SCOPE_WORKGROUP);
                LAS int* rr = rec + (F.wave * 16 + i) * 4; rr[0] = e1; rr[1] = e2; rr[2] = l1; rr[3] = l2;
            }
        }
        __syncthreads();
        if (F.tid < 8) lcnt[8 + F.tid] = (int)__hip_atomic_fetch_add(F.ctl + CW_CNT + 64 * F.tid, (unsigned)lcnt[F.tid], RLX_AGENT);
        __syncthreads();
        if (F.lane < 16) { const int m = m0 + F.lane; const LAS int* rr = rec + (F.wave * 16 + F.lane) * 4;
            const int r1 = lcnt[8 + rr[0]] + rr[2], r2 = lcnt[8 + rr[1]] + rr[3];
            tok_rank[m * 2] = r1; tok_rank[m * 2 + 1] = r2; slot_token[rr[0] * 32768 + r1] = m; slot_token[rr[1] * 32768 + r2] = m; }
    }
    SEAM(12);

    {
        MoeTab T; T.pbase[8] = 0;
        if (hi > 13 && lo < 23) moe_tab(F.ctl, T);
        const int ptot = T.pbase[8];
        REP_13 for (int ch = 0; ch < 5; ++ch) {
            const int p0 = ch * 64; const int nM = (ptot - p0) < 64 ? (ptot - p0) : 64;
            REP_14 if (IN(13 + 2 * ch) && nM > 0) {
                MoeUpSched S{(const char*)HA, (const char*)(ws + WS_MW13), slot_token, F.G, (int)blockIdx.x, p0, nM, T};
                pg8::EpiSwigluF8 E{(unsigned char*)HFF, DEXP};
                pg8::gemm_phase<pg8::EpiSwigluF8, MoeUpSched, true, true>(F.lds, D, S, E);
            }
            if (IN(13 + 2 * ch) && IN(14 + 2 * ch) && nM > 0) xcd_barrier(bar);
            REP_15 if (IN(14 + 2 * ch) && nM > 0) {
                MoeDownSched S{(const char*)HFF, (const char*)(ws + WS_MW2), F.G, (int)blockIdx.x, p0, nM, T};
                pg8::EpiPlain E{YS, D, 1.f / 512.f};
                pg8::gemm_phase<pg8::EpiPlain, MoeDownSched, true, true>(F.lds, DEXP, S, E);
            }
            if (IN(14 + 2 * ch) && IN(15 + 2 * ch) && nM > 0) xcd_barrier(bar);
        }
    }

    if (IN(23)) {
        MoeTab T; moe_tab(F.ctl, T);
        const float* gpost = KARG()->in[9] + D;
#define YS_ROWS(mm, S1, S2) do { const int e1_ = tok_e[(mm) * 2], e2_ = tok_e[(mm) * 2 + 1]; int pb1_ = 0, pb2_ = 0; \
            _Pragma("unroll") for (int e = 0; e < 8; ++e) { pb1_ = (e1_ == e) ? T.pbase[e] : pb1_; pb2_ = (e2_ == e) ? T.pbase[e] : pb2_; } \
            S1 = (size_t)pb1_ * 256 + tok_rank[(mm) * 2]; S2 = (size_t)pb2_ * 256 + tok_rank[(mm) * 2 + 1]; } while (0)
        const int m0 = gw * 16; const int r17 = m0 >> 11; const float* msr1 = MS + (size_t)(17 + r17) * 6144;
        const ResP RP = ld_resp(gpost, msr1 + 5 * 1024, F.lane);
        size_t s1, s2; YS_ROWS(m0, s1, s2);
        Row xn = ld_row_bf16(XB + (size_t)m0 * D, F.lane), yan = ld_row_bf16(YS + s1 * D, F.lane), ybn = ld_row_bf16(YS + s2 * D, F.lane);
        float* outp = KARG()->out;
        for (int i = 0; i < 16; ++i) {
            const int m = m0 + i;
            Row x = xn; const Row ya = yan, yb = ybn; const float g1 = tok_g[m * 2], g2 = tok_g[m * 2 + 1];
            if (i + 1 < 16) { YS_ROWS(m + 1, s1, s2); xn = ld_row_bf16(XB + (size_t)(m + 1) * D, F.lane); yan = ld_row_bf16(YS + s1 * D, F.lane); ybn = ld_row_bf16(YS + s2 * D, F.lane); }
            Row y;
#pragma unroll
            for (int j = 0; j < 4; ++j) y.v[j] = ya.v[j] * g1 + yb.v[j] * g2;
            row_residual2(x, y, RP);
            st_row_f32(outp + (size_t)m * D, F.lane, x);
        }
    }
#undef IN
#undef SEAM
#undef ATTN_PHASE
}

extern "C" void kernel_launch(void* const* d_in, const int* in_sizes, int n_in, void* d_out, int out_size, void* d_ws, size_t ws_size, hipStream_t stream) {
    static int grid = 0;
    if (grid == 0) {
        if (n_in != 28 || out_size != MLAT * D || ws_size < WS_END) { fprintf(stderr, "kernel_launch: unexpected shapes (n_in %d, out %d, ws %zu)\n", n_in, out_size, ws_size); grid = -1; return; }
        int dev = 0, cus = 0, per_cu = 0;
        if (hipGetDevice(&dev) != hipSuccess || hipDeviceGetAttribute(&cus, hipDeviceAttributeMultiprocessorCount, dev) != hipSuccess) { grid = -1; return; }
        if (hipFuncSetAttribute((const void*)mk_fwd, hipFuncAttributeMaxDynamicSharedMemorySize, LDS_BYTES) != hipSuccess) { fprintf(stderr, "kernel_launch: hipFuncSetAttribute failed\n"); grid = -1; return; }
        if (hipOccupancyMaxActiveBlocksPerMultiprocessor(&per_cu, (const void*)mk_fwd, NWAVES * 64, LDS_BYTES) != hipSuccess || per_cu < 1) { fprintf(stderr, "kernel_launch: occupancy query says %d\n", per_cu); (void)hipGetLastError(); }
        grid = cus;
        if (grid != 256) { fprintf(stderr, "kernel_launch: built for 256 CUs, found %d\n", grid); grid = -1; return; }
    }
    if (grid < 0) return;
    (void)hipMemsetAsync((char*)d_ws + WS_CTL, 0, CTL_ZERO_BYTES, stream);
    Args a{};
    for (int i = 0; i < 28; ++i) a.in[i] = (const float*)d_in[i];
    a.out = (float*)d_out; a.ws = (unsigned char*)d_ws;
#if MK_PER_PHASE
    for (int p = 0; p < N_PHASES; ++p) { a.ph_lo = p; a.ph_hi = p + 1; hipLaunchKernelGGL(mk_fwd, dim3(grid), dim3(NWAVES * 64), LDS_BYTES, stream, a); }
#else
    a.ph_lo = 0; a.ph_hi = N_PHASES;
    hipLaunchKernelGGL(mk_fwd, dim3(grid), dim3(NWAVES * 64), LDS_BYTES, stream, a);
#endif
}
```

```cpp
#include <hip/hip_runtime.h>
#include <cstdio>
#include <cstdint>

#ifndef DBG_NO_SG
#define DBG_NO_SG 0
#endif
#ifndef DBG_NO_CTX
#define DBG_NO_CTX 0
#endif
#ifndef DBG_NO_LAT
#define DBG_NO_LAT 0
#endif
#ifndef MK_PER_PHASE
#define MK_PER_PHASE 0
#endif

#define LAS __attribute__((address_space(3)))
#define GAS __attribute__((address_space(1)))
typedef unsigned short bf16_t;
typedef short bf16x8 __attribute__((ext_vector_type(8)));
typedef short s16x4 __attribute__((ext_vector_type(4)));
typedef float f32x2 __attribute__((ext_vector_type(2)));
typedef float f32x4 __attribute__((ext_vector_type(4)));
typedef float f32x16 __attribute__((ext_vector_type(16)));
typedef unsigned u32x2 __attribute__((ext_vector_type(2)));
typedef unsigned u32x4 __attribute__((ext_vector_type(4)));
typedef GAS unsigned gu32;
typedef int v8i __attribute__((ext_vector_type(8)));
typedef int v4i __attribute__((ext_vector_type(4)));

constexpr int D = 1024, BATCH = 16, SEQ = 2048, CTX = 256;
constexpr int MLAT = BATCH * SEQ;
constexpr int MCTX = BATCH * CTX;
constexpr int MALL = MLAT + MCTX;
constexpr int NIN = 2560;
constexpr int COL_Q = 0, COL_U = 512, COL_K = 1024, COL_V = 1536, COL_G = 2048;
constexpr int DFF = 2816, DEXP = 3584, NEXP = 8;
constexpr float EPS = 1e-6f;
constexpr float LAMBDA_INIT0 = 0.2f, LAMBDA_INIT1 = 0.35550907f;

constexpr size_t MiB = 1u << 20;
constexpr size_t WS_CTL = 0, CTL_ZERO_BYTES = 1 * MiB;
constexpr size_t WS_MS = 1 * MiB;
constexpr size_t WS_ROPE = 2 * MiB;
constexpr size_t WS_ROUTE = 3 * MiB;
constexpr size_t WS_SLOT = 4 * MiB;
constexpr size_t WS_WIN = 5 * MiB;
constexpr size_t WS_WOUT = 15 * MiB;
constexpr size_t WS_SGW = 19 * MiB;
constexpr size_t WS_W13 = 20 * MiB;
constexpr size_t WS_W2 = 31 * MiB;
constexpr size_t WS_MW13 = 37 * MiB;
constexpr size_t WS_MW2 = 93 * MiB;
constexpr size_t WS_XB = 121 * MiB;
constexpr size_t WS_HA = 221 * MiB;
constexpr size_t WS_R1 = 293 * MiB;
constexpr size_t WS_OY = 491 * MiB;
constexpr size_t WS_YS = 405 * MiB;
constexpr size_t WS_END = 563 * MiB;

constexpr int CW_BAR = 4096;
constexpr int CW_CNT = 64;

constexpr int RING_BYTES = 131072;
constexpr int LDSCTL_OFF = RING_BYTES, MISC_OFF = LDSCTL_OFF + 320;
constexpr int LDS_BYTES = 147456;
constexpr int NWAVES = 8;

#define RLX_AGENT __ATOMIC_RELAXED, __HIP_MEMORY_SCOPE_AGENT
#define LDS_WAIT() asm volatile("s_waitcnt lgkmcnt(0)" ::: "memory")
#define VM_WAIT() asm volatile("s_waitcnt vmcnt(0)" ::: "memory")
#define SBAR() __builtin_amdgcn_sched_barrier(0)

__device__ __forceinline__ unsigned cvt_pk_bf16(float lo, float hi) { unsigned r; asm volatile("v_cvt_pk_bf16_f32 %0, %1, %2" : "=v"(r) : "v"(lo), "v"(hi)); return r; }
__device__ __forceinline__ float bf2f(unsigned short b) { return __builtin_bit_cast(float, (unsigned)b << 16); }
__device__ __forceinline__ float bflo(unsigned w) { return __builtin_bit_cast(float, w << 16); }
__device__ __forceinline__ float bfhi(unsigned w) { return __builtin_bit_cast(float, w & 0xffff0000u); }
__device__ __forceinline__ float wave_sum(float v) {
#pragma unroll
    for (int o = 1; o < 64; o <<= 1) v += __shfl_xor(v, o);
    return v;
}
__device__ __forceinline__ int lane_id_v() { int l; asm volatile("v_mbcnt_lo_u32_b32 %0, -1, 0\n\tv_mbcnt_hi_u32_b32 %0, -1, %0" : "=v"(l)); return l; }
__device__ __forceinline__ float silu_f(float v) { return v / (1.f + __expf(-v)); }

namespace pg8 {
constexpr int BM = 256, BK = 64, HALF = 128, HTB = HALF * BK * 2, STAGE_BYTES = 8 * HTB, NXCD = 8, WGM = 8;
__host__ __device__ __forceinline__ int lds_byte(int r, int c) { const int st = (r >> 4) * 2 + (c >> 5), rr = r & 15, cc = c & 31, ob = rr * 64 + cc * 2; return st * 1024 + (ob ^ (((ob >> 9) & 1) << 5)); }
__host__ __device__ __forceinline__ void stage_rc(int b, int& R, int& C) { const int st = b / 1024, sb = b % 1024, swz = sb ^ (((sb >> 9) & 1) << 5); R = (st >> 1) * 16 + swz / 64; C = (st & 1) * 32 + (swz % 64) / 2; }
__host__ __device__ __forceinline__ int perm32(int rho) { const int n = rho >> 4, i = rho & 15; return 8 * (i >> 2) + 4 * n + (i & 3); }

struct Unit { const char* Ap; const char* Bp; int pm, pn, aux, aux2; };

__device__ __forceinline__ void tile_of(int L, int nM, int nN, int& pm, int& pn) {
    const int nwg = nM * nN; int wgid = L;
    { const int q = nwg / NXCD, r = nwg % NXCD, xcd = wgid % NXCD, off = wgid / NXCD; wgid = (xcd < r ? xcd * (q + 1) : r * (q + 1) + (xcd - r) * q) + off; }
    const int nig = WGM * nN, gid = wgid / nig, fm = gid * WGM, gsz = (nM - fm) < WGM ? (nM - fm) : WGM;
    pm = fm + ((wgid % nig) % gsz); pn = (wgid % nig) / gsz;
}

template <class Epi, class Sched, bool ALIGN_EPI, bool FP8 = false>
__device__ __forceinline__ void gemm_phase(LAS unsigned char* lds, const int wid, const int K, const Sched& S, const Epi& E) {
    const int lane = lane_id_v(), tid = wid * 64 + lane;
    const int wr = wid >> 2, wc = wid & 3, fr = lane & 15, fq = lane >> 4;
    const int kbytes = FP8 ? K : 2 * K;
    const int nt = kbytes / 128;
    int R[2], C[2]; unsigned voffB[2];
#pragma unroll
    for (int i = 0; i < 2; ++i) { stage_rc(tid * 16 + i * 8192, R[i], C[i]); const int Rb = Epi::PERM ? ((R[i] & ~31) + perm32(R[i] & 31)) : R[i]; voffB[i] = (unsigned)(Rb * kbytes + C[i] * 2); }
    const size_t kstep = (size_t)(BK * 2);
    const size_t hstepB = (size_t)HALF * kbytes;
    const unsigned ldsw = (unsigned)wid * 1024u;
    const int aoff = lds_byte(wr * 64 + fr, fq * 8), boff = lds_byte(wc * 32 + fr, fq * 8);
#define PG8_SA(b, h) (((b) * 2 + (h)) * HTB)
#define PG8_SB(b, h) ((4 + (b) * 2 + (h)) * HTB)
#define PG8_STAGE(bufoff, gbase, voff) do { _Pragma("unroll") for (int _i = 0; _i < 2; ++_i) \
        __builtin_amdgcn_global_load_lds((const unsigned*)((const char*)(gbase) + (voff)[_i]), (LAS unsigned*)(lds + (bufoff) + ldsw + _i * 8192), 16, 0, 0); } while (0)
#define PG8_LDA(dst, b, h) do { _Pragma("unroll") for (int m = 0; m < 4; ++m) { const v4i _lo = *(const LAS v4i*)(lds + PG8_SA(b, h) + aoff + m * 2048), _hi = *(const LAS v4i*)(lds + PG8_SA(b, h) + aoff + m * 2048 + 1024); \
        dst[m] = __builtin_shufflevector(_lo, _hi, 0, 1, 2, 3, 4, 5, 6, 7); } } while (0)
#define PG8_LDB(dst, b, h) do { _Pragma("unroll") for (int n = 0; n < 2; ++n) { const v4i _lo = *(const LAS v4i*)(lds + PG8_SB(b, h) + boff + n * 2048), _hi = *(const LAS v4i*)(lds + PG8_SB(b, h) + boff + n * 2048 + 1024); \
        dst[n] = __builtin_shufflevector(_lo, _hi, 0, 1, 2, 3, 4, 5, 6, 7); } } while (0)
#define PG8_LO(x) __builtin_bit_cast(bf16x8, __builtin_shufflevector(x, x, 0, 1, 2, 3))
#define PG8_HI(x) __builtin_bit_cast(bf16x8, __builtin_shufflevector(x, x, 4, 5, 6, 7))
#define PG8_MMA(ai, bj, At, Bt) do { __builtin_amdgcn_s_setprio(1); \
        if constexpr (FP8) { _Pragma("unroll") for (int m = 0; m < 4; ++m) _Pragma("unroll") for (int n = 0; n < 2; ++n) \
            asm volatile("v_mfma_f32_16x16x128_f8f6f4 %0, %1, %2, %0" : "+v"(acc[ai][bj][m][n]) : "v"(Bt[n]), "v"(At[m])); } \
        else { _Pragma("unroll") for (int m = 0; m < 4; ++m) _Pragma("unroll") for (int n = 0; n < 2; ++n) { \
            acc[ai][bj][m][n] = __builtin_amdgcn_mfma_f32_16x16x32_bf16(PG8_LO(Bt[n]), PG8_LO(At[m]), acc[ai][bj][m][n], 0, 0, 0); \
            acc[ai][bj][m][n] = __builtin_amdgcn_mfma_f32_16x16x32_bf16(PG8_HI(Bt[n]), PG8_HI(At[m]), acc[ai][bj][m][n], 0, 0, 0); } } \
        __builtin_amdgcn_s_setprio(0); } while (0)
#define PG8_WAIT_V(n) asm volatile("s_waitcnt vmcnt(" #n ")" ::: "memory")
#define PG8_WAIT_L(n) asm volatile("s_waitcnt lgkmcnt(" #n ")" ::: "memory")
#define PG8_BAR __builtin_amdgcn_s_barrier()
#define PG8_SCHED __builtin_amdgcn_sched_barrier(0)
    Unit cur, nxt; int ui = 0;
    if (!S.next(0, cur)) return;
    f32x4 acc[2][2][4][2];
#pragma unroll
    for (int a = 0; a < 2; ++a)
#pragma unroll
        for (int b = 0; b < 2; ++b)
#pragma unroll
            for (int m = 0; m < 4; ++m)
#pragma unroll
                for (int n = 0; n < 2; ++n) acc[a][b][m][n] = (f32x4){0.f, 0.f, 0.f, 0.f};
    v8i At[4], B0[2], B1[2];
    unsigned cO0[2], cO1[2], nO0[2], nO1[2];
    S.aoff(cur, R, C, cO0, cO1);
    const char* cA = cur.Ap; const char* cB = cur.Bp;
    PG8_STAGE(PG8_SB(0, 0), cB, voffB); PG8_STAGE(PG8_SB(0, 1), cB + hstepB, voffB); PG8_STAGE(PG8_SA(0, 0), cA, cO0); PG8_STAGE(PG8_SA(0, 1), cA, cO1);
    if (wr == 1) PG8_BAR;
    PG8_WAIT_V(2); PG8_BAR;
    PG8_STAGE(PG8_SB(1, 0), cB + kstep, voffB); PG8_STAGE(PG8_SA(1, 0), cA + kstep, cO0); PG8_STAGE(PG8_SB(1, 1), cB + hstepB + kstep, voffB);
    PG8_WAIT_V(6); PG8_BAR;
    for (;;) {
        const bool has_next = S.next(ui + 1, nxt);
        if constexpr (Sched::GATHER) { if (has_next) S.aoff(nxt, R, C, nO0, nO1); else { nO0[0] = cO0[0]; nO0[1] = cO0[1]; nO1[0] = cO1[0]; nO1[1] = cO1[1]; } }
        const char* nA = has_next ? nxt.Ap : cA; const char* nB = has_next ? nxt.Bp : cB;
        for (int t = 0; t < nt; t += 2) {
            const bool last = (t == nt - 2);
            const char* a1 = cA + (size_t)(t + 1) * kstep;
            const char* a2 = last ? nA : cA + (size_t)(t + 2) * kstep; const char* b2 = last ? nB : cB + (size_t)(t + 2) * kstep;
            const char* a3 = a2 + kstep; const char* b3 = b2 + kstep;
            unsigned xO0[2], xO1[2];
            if constexpr (Sched::GATHER) { xO0[0] = last ? nO0[0] : cO0[0]; xO0[1] = last ? nO0[1] : cO0[1]; xO1[0] = last ? nO1[0] : cO1[0]; xO1[1] = last ? nO1[1] : cO1[1]; }
            else { xO0[0] = cO0[0]; xO0[1] = cO0[1]; xO1[0] = cO1[0]; xO1[1] = cO1[1]; }
            PG8_LDB(B0, 0, 0); PG8_LDB(B1, 0, 1); PG8_SCHED; PG8_LDA(At, 0, 0); PG8_STAGE(PG8_SA(1, 1), a1, cO1);
            PG8_WAIT_V(8); PG8_WAIT_L(0); PG8_BAR; PG8_MMA(0, 0, At, B0); PG8_MMA(0, 1, At, B1); PG8_BAR; PG8_SCHED;
            PG8_LDA(At, 0, 1); PG8_STAGE(PG8_SB(0, 0), b2, voffB); PG8_STAGE(PG8_SB(0, 1), b2 + hstepB, voffB); PG8_STAGE(PG8_SA(0, 0), a2, xO0);
            PG8_WAIT_V(8); PG8_WAIT_L(0); PG8_BAR; PG8_MMA(1, 0, At, B0); PG8_MMA(1, 1, At, B1); PG8_BAR; PG8_SCHED;
            PG8_LDB(B0, 1, 0); PG8_LDB(B1, 1, 1); PG8_SCHED; PG8_LDA(At, 1, 0); PG8_STAGE(PG8_SA(0, 1), a2, xO1);
            PG8_WAIT_V(8); PG8_WAIT_L(0); PG8_BAR; PG8_MMA(0, 0, At, B0); PG8_MMA(0, 1, At, B1); PG8_BAR; PG8_SCHED;
            PG8_LDA(At, 1, 1); PG8_STAGE(PG8_SB(1, 0), b3, voffB); PG8_STAGE(PG8_SB(1, 1), b3 + hstepB, voffB); PG8_STAGE(PG8_SA(1, 0), a3, xO0);
            PG8_WAIT_V(8); PG8_WAIT_L(0); PG8_BAR; PG8_MMA(1, 0, At, B0); PG8_MMA(1, 1, At, B1); PG8_BAR; PG8_SCHED;
        }
        if constexpr (ALIGN_EPI) { if (wr == 0) PG8_BAR; }
        if constexpr (FP8) asm volatile("s_nop 15\n\ts_nop 15\n\ts_nop 15\n\ts_nop 15\n\ts_nop 15\n\ts_nop 15" ::: "memory");
        E(acc, cur, wr, wc, fr, fq);
        if (!has_next) break;
#pragma unroll
        for (int a = 0; a < 2; ++a)
#pragma unroll
            for (int b = 0; b < 2; ++b)
#pragma unroll
                for (int m = 0; m < 4; ++m)
#pragma unroll
                    for (int n = 0; n < 2; ++n) acc[a][b][m][n] = (f32x4){0.f, 0.f, 0.f, 0.f};
        cur = nxt; cA = nA; cB = nB; ++ui;
        if constexpr (Sched::GATHER) { cO0[0] = nO0[0]; cO0[1] = nO0[1]; cO1[0] = nO1[0]; cO1[1] = nO1[1]; }
        if constexpr (ALIGN_EPI) { if (wr == 1) PG8_BAR; }
    }
    PG8_WAIT_V(0);
    if constexpr (!ALIGN_EPI) { if (wr == 0) PG8_BAR; }
    PG8_BAR;
#undef PG8_SA
#undef PG8_SB
#undef PG8_STAGE
#undef PG8_LDA
#undef PG8_LDB
#undef PG8_MMA
#undef PG8_LO
#undef PG8_HI
#undef PG8_WAIT_V
#undef PG8_WAIT_L
#undef PG8_BAR
#undef PG8_SCHED
}

struct DenseSched {
    static constexpr bool GATHER = false;
    const char* A; const char* Bt; int lda, K, G, c;
    int nM0, nN0, arow0_0, pn0_0, nM1, nN1, arow0_1, pn0_1;
    __device__ __forceinline__ bool next(int i, Unit& u) const {
        int L = i * G + c; const int n0 = nM0 * nN0;
        int pm, pn;
        if (L < n0) { tile_of(L, nM0, nN0, pm, pn); u.pm = arow0_0 / 256 + pm; u.pn = pn0_0 + pn; }
        else { L -= n0; if (L >= nM1 * nN1) return false; tile_of(L, nM1, nN1, pm, pn); u.pm = arow0_1 / 256 + pm; u.pn = pn0_1 + pn; }
        u.Ap = A + (size_t)u.pm * 256 * lda * 2; u.Bp = Bt + (size_t)u.pn * 256 * K * 2; u.aux = 0; u.aux2 = 0; return true;
    }
    __device__ __forceinline__ void aoff(const Unit&, const int (&R)[2], const int (&C)[2], unsigned (&o0)[2], unsigned (&o1)[2]) const {
#pragma unroll
        for (int i = 0; i < 2; ++i) { o0[i] = (unsigned)(R[i] * lda + C[i]) * 2u; o1[i] = (unsigned)((HALF + R[i]) * lda + C[i]) * 2u; }
    }
};

struct EpiPlain {
    static constexpr bool PERM = true;
    bf16_t* O; int ldc; float sc;
    __device__ __forceinline__ void operator()(const f32x4 (&acc)[2][2][4][2], const Unit& u, int wr, int wc, int fr, int fq) const {
        const int row0 = u.pm * BM + wr * 64 + fr, col0 = u.pn * BM + wc * 32 + 8 * fq;
#pragma unroll
        for (int ai = 0; ai < 2; ++ai)
#pragma unroll
            for (int m = 0; m < 4; ++m) { bf16_t* rowp = O + (size_t)(row0 + ai * HALF + m * 16) * ldc + col0;
#pragma unroll
                for (int bj = 0; bj < 2; ++bj) { const f32x4 v0 = acc[ai][bj][m][0] * sc, v1 = acc[ai][bj][m][1] * sc;
                    u32x4 w; w.x = cvt_pk_bf16(v0[0], v0[1]); w.y = cvt_pk_bf16(v0[2], v0[3]); w.z = cvt_pk_bf16(v1[0], v1[1]); w.w = cvt_pk_bf16(v1[2], v1[3]);
                    *(u32x4*)(rowp + bj * HALF) = w; } }
    }
};
struct EpiInProj {
    static constexpr bool PERM = true;
    bf16_t* O; const float* ropec; const float* ropes;
    __device__ __forceinline__ void operator()(const f32x4 (&acc)[2][2][4][2], const Unit& u, int wr, int wc, int fr, int fq) const {
        const int row0 = u.pm * BM + wr * 64 + fr, col0 = u.pn * BM + wc * 32 + 8 * fq;
        const bool rope = (u.pm < MLAT / 256) && (u.pn < 2 || (u.pn >= 4 && u.pn < 6));
        const bool colpos = (wc & 1) != 0;
        const float qs = u.pn < 2 ? 0.18033688011112042f : 1.f;
#pragma unroll
        for (int ai = 0; ai < 2; ++ai)
#pragma unroll
            for (int m = 0; m < 4; ++m) { const int row = row0 + ai * HALF + m * 16; bf16_t* rowp = O + (size_t)row * NIN + col0;
                f32x4 cs = {1.f, 1.f, 1.f, 1.f}, sn = {0.f, 0.f, 0.f, 0.f};
                if (rope) { const int t = row & (SEQ - 1), pos = colpos ? (t & 63) : (t >> 6); cs = *(const f32x4*)(ropec + pos * 16 + 4 * fq); sn = *(const f32x4*)(ropes + pos * 16 + 4 * fq); }
#pragma unroll
                for (int bj = 0; bj < 2; ++bj) { const f32x4 a = acc[ai][bj][m][0] * qs, b = acc[ai][bj][m][1] * qs;
                    const f32x4 v0 = a * cs - b * sn, v1 = b * cs + a * sn;
                    u32x4 w; w.x = cvt_pk_bf16(v0[0], v0[1]); w.y = cvt_pk_bf16(v0[2], v0[3]); w.z = cvt_pk_bf16(v1[0], v1[1]); w.w = cvt_pk_bf16(v1[2], v1[3]);
                    *(u32x4*)(rowp + bj * HALF) = w; } }
    }
};
struct EpiSwiglu {
    static constexpr bool PERM = true;
    bf16_t* O; int ldc;
    __device__ __forceinline__ void operator()(const f32x4 (&acc)[2][2][4][2], const Unit& u, int wr, int wc, int fr, int fq) const {
        const int row0 = u.pm * BM + wr * 64 + fr, col0 = u.pn * HALF + wc * 32 + 8 * fq;
#pragma unroll
        for (int ai = 0; ai < 2; ++ai)
#pragma unroll
            for (int m = 0; m < 4; ++m) { bf16_t* rowp = O + (size_t)(row0 + ai * HALF + m * 16) * ldc + col0;
                f32x4 v[2];
#pragma unroll
                for (int n = 0; n < 2; ++n) { const f32x4 a = acc[ai][0][m][n], b = acc[ai][1][m][n];
#pragma unroll
                    for (int j = 0; j < 4; ++j) v[n][j] = a[j] * __builtin_amdgcn_rcpf(1.f + __builtin_amdgcn_exp2f(-1.4426950408889634f * a[j])) * b[j]; }
                u32x4 w; w.x = cvt_pk_bf16(v[0][0], v[0][1]); w.y = cvt_pk_bf16(v[0][2], v[0][3]); w.z = cvt_pk_bf16(v[1][0], v[1][1]); w.w = cvt_pk_bf16(v[1][2], v[1][3]);
                *(u32x4*)rowp = w; }
    }
};
__device__ __forceinline__ unsigned pk_fp8x4(float a, float b, float c, float d) {
    a = __builtin_amdgcn_fmed3f(a, -448.f, 448.f); b = __builtin_amdgcn_fmed3f(b, -448.f, 448.f); c = __builtin_amdgcn_fmed3f(c, -448.f, 448.f); d = __builtin_amdgcn_fmed3f(d, -448.f, 448.f);
    int p = __builtin_amdgcn_cvt_pk_fp8_f32(a, b, 0, false); p = __builtin_amdgcn_cvt_pk_fp8_f32(c, d, p, true); return (unsigned)p; }
struct EpiSwigluF8 {
    static constexpr bool PERM = true;
    unsigned char* O; int ldc;
    __device__ __forceinline__ void operator()(const f32x4 (&acc)[2][2][4][2], const Unit& u, int wr, int wc, int fr, int fq) const {
        const int row0 = u.pm * BM + wr * 64 + fr, col0 = u.pn * HALF + wc * 32 + 8 * fq;
#pragma unroll
        for (int ai = 0; ai < 2; ++ai)
#pragma unroll
            for (int m = 0; m < 4; ++m) { unsigned char* rowp = O + (size_t)(row0 + ai * HALF + m * 16) * ldc + col0;
                f32x4 v[2];
#pragma unroll
                for (int n = 0; n < 2; ++n) { const f32x4 a = acc[ai][0][m][n] * (1.f / 512.f), b = acc[ai][1][m][n] * (4.f / 512.f);
#pragma unroll
                    for (int j = 0; j < 4; ++j) v[n][j] = a[j] * __builtin_amdgcn_rcpf(1.f + __builtin_amdgcn_exp2f(-1.4426950408889634f * a[j])) * b[j]; }
                u32x2 w; w.x = pk_fp8x4(v[0][0], v[0][1], v[0][2], v[0][3]); w.y = pk_fp8x4(v[1][0], v[1][1], v[1][2], v[1][3]);
                *(u32x2*)rowp = w; }
    }
};
}

namespace att {
constexpr int LDP = NIN;
constexpr int SHM_V = 64 * 128 * 2, SHM_K = 64 * 128 * 2;
constexpr int OFF_K = 0, OFF_V = 3 * SHM_K, OFF_WS = OFF_V + 3 * SHM_V, ATT_LDS = OFF_WS + NWAVES * 64 * 4;
constexpr int OFF_X = 0, OFF_OST = 65536;
static_assert(ATT_LDS <= RING_BYTES, "attention LDS");
constexpr float SCALE = 0.125f;
constexpr float THR = 8.f;
#define KSWZ(row, colB) ((row) * 256 + ((colB) ^ (((row) & 7) << 4)))
__device__ __forceinline__ int crow(int r, int hi) { return (r & 3) + 8 * (r >> 2) + 4 * hi; }

constexpr float THRL = 8.f;
template <bool FIRST>
__device__ __forceinline__ void partialSM(f32x16& p0, f32x16& p1, float& mhat, f32x16& negm, float& alpha) {
    float a = fmaxf(fmaxf(p0[0], p0[1]), p1[0]), b = fmaxf(fmaxf(p0[2], p0[3]), p1[1]); a = fmaxf(fmaxf(a, p1[2]), p1[3]);
#pragma unroll
    for (int r = 4; r < 16; r += 4) { a = fmaxf(fmaxf(a, p0[r]), p0[r + 1]); b = fmaxf(fmaxf(b, p0[r + 2]), p0[r + 3]); a = fmaxf(fmaxf(a, p1[r]), p1[r + 1]); b = fmaxf(fmaxf(b, p1[r + 2]), p1[r + 3]); }
    float rm = fmaxf(a, b);
    { auto rr = __builtin_amdgcn_permlane32_swap(__float_as_uint(rm), __float_as_uint(rm), false, false); rm = fmaxf(__uint_as_float(rr[0]), __uint_as_float(rr[1])); }
    alpha = 1.f;
    if (FIRST || __builtin_expect(__any(rm > THRL), 0)) {
        const float dl = FIRST ? rm : fmaxf(rm, 0.f); mhat += dl;
#pragma unroll
        for (int r = 0; r < 16; ++r) { p0[r] -= dl; p1[r] -= dl; }
#pragma unroll
        for (int r = 0; r < 16; ++r) negm[r] = -mhat;
        asm volatile("" : "+v"(negm));
        if (!FIRST) alpha = __builtin_amdgcn_exp2f(-dl);
    }
#pragma unroll
    for (int r = 0; r < 16; ++r) p0[r] = __builtin_amdgcn_exp2f(p0[r]);
}
__device__ __forceinline__ void finishSM(f32x16& p0, f32x16& p1, float alpha, float& l_reg, bf16x8& pa0, bf16x8& pa1, bf16x8& pa2, bf16x8& pa3) {
#pragma unroll
    for (int r = 0; r < 16; ++r) p1[r] = __builtin_amdgcn_exp2f(p1[r]);
    float ps = 0;
#pragma unroll
    for (int r = 0; r < 16; ++r) ps += p0[r];
#pragma unroll
    for (int r = 0; r < 16; ++r) ps += p1[r];
    { auto rr = __builtin_amdgcn_permlane32_swap(__float_as_uint(ps), __float_as_uint(ps), false, false);
      ps = __uint_as_float(rr[0]) + __uint_as_float(rr[1]); }
    l_reg = l_reg * alpha + ps;
#define PK4(P, BASE, OUT) do { u32x4 w = {cvt_pk_bf16(P[BASE + 0], P[BASE + 1]), cvt_pk_bf16(P[BASE + 2], P[BASE + 3]), cvt_pk_bf16(P[BASE + 4], P[BASE + 5]), cvt_pk_bf16(P[BASE + 6], P[BASE + 7])}; OUT = __builtin_bit_cast(bf16x8, w); } while (0)
    PK4(p0, 0, pa0); PK4(p0, 8, pa1); PK4(p1, 0, pa2); PK4(p1, 8, pa3);
#undef PK4
}
__device__ __forceinline__ void qkt(f32x16& p0, f32x16& p1, const char* Ks, const bf16x8 (&qr)[4], const f32x16& negm, int r32, int hi, int cb0) {
#pragma unroll
    for (int d0 = 0; d0 < 4; ++d0) { const int cb = cb0 + (d0 * 16 + hi * 8) * 2;
        const bf16x8 b0 = *reinterpret_cast<const bf16x8*>(Ks + KSWZ(r32, cb));
        const bf16x8 b1 = *reinterpret_cast<const bf16x8*>(Ks + KSWZ(32 + r32, cb));
        if (d0 == 0) { p0 = __builtin_amdgcn_mfma_f32_32x32x16_bf16(b0, qr[0], negm, 0, 0, 0); p1 = __builtin_amdgcn_mfma_f32_32x32x16_bf16(b1, qr[0], negm, 0, 0, 0); }
        else { p0 = __builtin_amdgcn_mfma_f32_32x32x16_bf16(b0, qr[d0], p0, 0, 0, 0); p1 = __builtin_amdgcn_mfma_f32_32x32x16_bf16(b1, qr[d0], p1, 0, 0, 0); } }
}
__device__ __forceinline__ int v_st(int k, int c) { const int kk = (k & ~0xC) | ((k & 4) << 1) | ((k & 8) >> 1); return ((kk >> 3) * 4 + (c >> 5)) * 512 + ((kk & 7) * 32 + (c & 31)) * 2; }
__device__ __forceinline__ int v_rd_base(int lane) { return ((lane & 3) << 3) | (((lane >> 2) & 3) << 6) | (((lane >> 4) & 1) << 5) | (((lane >> 5) & 1) << 11); }
constexpr int v_rd_off(int d0, int ks, int half) { return d0 * 512 + ks * 4096 + half * 256; }
template <int OFF> __device__ __forceinline__ s16x4 tr_read(int vb) {
    s16x4 r; asm volatile("ds_read_b64_tr_b16 %0, %1 offset:%2" : "=&v"(r) : "v"(vb), "i"(OFF) : "memory"); return r;
}
template <int D0> __device__ __forceinline__ void pv_one(f32x16& od, int vb, bf16x8 pa0, bf16x8 pa1, bf16x8 pa2, bf16x8 pa3) {
    const s16x4 l0 = tr_read<v_rd_off(D0, 0, 0)>(vb), h0 = tr_read<v_rd_off(D0, 0, 1)>(vb), l1 = tr_read<v_rd_off(D0, 1, 0)>(vb), h1 = tr_read<v_rd_off(D0, 1, 1)>(vb);
    const s16x4 l2 = tr_read<v_rd_off(D0, 2, 0)>(vb), h2 = tr_read<v_rd_off(D0, 2, 1)>(vb), l3 = tr_read<v_rd_off(D0, 3, 0)>(vb), h3 = tr_read<v_rd_off(D0, 3, 1)>(vb);
    asm volatile("s_waitcnt lgkmcnt(0)" ::: "memory"); SBAR();
#define PKV(L, H) (bf16x8){L[0], L[1], L[2], L[3], H[0], H[1], H[2], H[3]}
    od = __builtin_amdgcn_mfma_f32_32x32x16_bf16(pa0, PKV(l0, h0), od, 0, 0, 0);
    od = __builtin_amdgcn_mfma_f32_32x32x16_bf16(pa1, PKV(l1, h1), od, 0, 0, 0);
    od = __builtin_amdgcn_mfma_f32_32x32x16_bf16(pa2, PKV(l2, h2), od, 0, 0, 0);
    od = __builtin_amdgcn_mfma_f32_32x32x16_bf16(pa3, PKV(l3, h3), od, 0, 0, 0);
#undef PKV
}
__device__ __forceinline__ void pv_d0(f32x16* o, int vb, bf16x8 pa0, bf16x8 pa1, bf16x8 pa2, bf16x8 pa3) {
    pv_one<0>(o[0], vb, pa0, pa1, pa2, pa3); pv_one<1>(o[1], vb, pa0, pa1, pa2, pa3); pv_one<2>(o[2], vb, pa0, pa1, pa2, pa3); pv_one<3>(o[3], vb, pa0, pa1, pa2, pa3);
}

__device__ __forceinline__ void attn_unit(const bf16_t* __restrict__ Qb, const bf16_t* __restrict__ Ks0, int nt0, const bf16_t* __restrict__ Ks1, int nt1,
                                          bf16_t* Ob, float lam, float oscale, const float* __restrict__ subg, char* lds, const int wid) {
    const int lane = lane_id_v(), tid = wid * 64 + lane;
    const int r32 = lane & 31, hi = lane >> 5, map = wid >> 2, w4 = wid & 3; (void)tid;
    char* V_lds = lds + OFF_V; char* K_lds = lds + OFF_K;
    float* ws = (float*)(lds + OFF_WS) + wid * 64; float* li_l = ws; float* al_l = ws + 32;
    float zero_v; asm volatile("v_mov_b32 %0, 0" : "=v"(zero_v));
    float mhat = 0.f, l_reg = 0; f32x16 o[4] = {}; bf16x8 qr[4]; f32x16 negm;
#pragma unroll
    for (int r = 0; r < 16; ++r) negm[r] = zero_v;
    const bf16_t* Qw = Qb + (long)(w4 * 32 + r32) * LDP + map * 64 + hi * 8;
#pragma unroll
    for (int d0 = 0; d0 < 4; ++d0) qr[d0] = *reinterpret_cast<const bf16x8*>(Qw + d0 * 16);
    const int cb0 = map * 128;
    unsigned koff[2], voff[2];
#pragma unroll
    for (int i = 0; i < 2; ++i) { const int row = 4 * wid + 32 * i + (lane >> 4), ch = (lane & 15) ^ (row & 7); koff[i] = (unsigned)(row * LDP + ch * 8) * 2u;
        const int sub = 2 * wid + 16 * i + (lane >> 5), kk = (sub >> 2) * 8 + ((lane & 31) >> 2), k = (kk & ~0xC) | ((kk & 4) << 1) | ((kk & 8) >> 1), c = (sub & 3) * 32 + (lane & 3) * 8;
        voff[i] = (unsigned)(k * LDP + 512 + c) * 2u; }
    const unsigned ldsw = (unsigned)wid * 1024u;
    const int vb0 = (int)(uintptr_t)V_lds + v_rd_base(lane);
    const int NT = nt0 + nt1;
#define TILEP(j) ((const char*)((j) < nt0 ? Ks0 + (long)(j) * 64 * LDP : Ks1 + (long)((j) - nt0) * 64 * LDP))
#define DMA_K(j, slot) do { const char* _tb = TILEP(j); _Pragma("unroll") for (int _i = 0; _i < 2; ++_i) \
        __builtin_amdgcn_global_load_lds((const unsigned*)(_tb + koff[_i]), (LAS unsigned*)((LAS char*)(uintptr_t)(unsigned)(uintptr_t)K_lds + (slot) + ldsw + _i * 8192), 16, 0, 0); } while (0)
#define DMA_V(j, slot) do { const char* _tb = TILEP(j); _Pragma("unroll") for (int _i = 0; _i < 2; ++_i) \
        __builtin_amdgcn_global_load_lds((const unsigned*)(_tb + voff[_i]), (LAS unsigned*)((LAS char*)(uintptr_t)(unsigned)(uintptr_t)V_lds + (slot) + ldsw + _i * 8192), 16, 0, 0); } while (0)
#define WAIT_BAR(N) asm volatile("s_waitcnt vmcnt(" #N ") lgkmcnt(0)\n\ts_barrier" ::: "memory")
#define RESC(a) do { if (__any((a) < 1.f)) { if (hi == 0) al_l[r32] = (a); asm volatile("s_waitcnt lgkmcnt(0)" ::: "memory"); \
    _Pragma("unroll") for (int d = 0; d < 4; ++d) _Pragma("unroll") for (int r = 0; r < 16; ++r) o[d][r] *= al_l[crow(r, hi)]; } } while (0)
    f32x16 pA0, pA1, pB0, pB1; float alA, alB; bf16x8 pa0, pa1, pa2, pa3;
    DMA_K(0, 0); DMA_V(0, 0); DMA_K(1, SHM_K);
    WAIT_BAR(4);
    DMA_K(2, 2 * SHM_K); DMA_V(1, SHM_V);
    qkt(pA0, pA1, K_lds, qr, negm, r32, hi, cb0); partialSM<true>(pA0, pA1, mhat, negm, alA);
    WAIT_BAR(4);
    int sl_prev = 0, sl_cur = SHM_K, sl_next = 2 * SHM_K;
#define ROT() do { const int _t = sl_prev; sl_prev = sl_cur; sl_cur = sl_next; sl_next = _t; } while (0)
#define STEP(C0, C1, P0, P1, alC, alP, t) do { \
        if ((t) + 2 < NT) DMA_K((t) + 2, sl_prev); if ((t) + 1 < NT) DMA_V((t) + 1, sl_next); \
        SBAR(); qkt(C0, C1, K_lds + sl_cur, qr, negm, r32, hi, cb0); \
        finishSM(P0, P1, alP, l_reg, pa0, pa1, pa2, pa3); SBAR(); \
        pv_d0(o, vb0 + sl_prev, pa0, pa1, pa2, pa3); partialSM<false>(C0, C1, mhat, negm, alC); \
        RESC(alC); \
        if ((t) + 2 < NT) WAIT_BAR(4); else WAIT_BAR(0); \
        ROT(); } while (0)
    for (int t = 1; t + 1 < NT; t += 2) {
        STEP(pB0, pB1, pA0, pA1, alB, alA, t);
        STEP(pA0, pA1, pB0, pB1, alA, alB, t + 1);
    }
    STEP(pB0, pB1, pA0, pA1, alB, alA, NT - 1);
    finishSM(pB0, pB1, alB, l_reg, pa0, pa1, pa2, pa3); SBAR();
    pv_d0(o, vb0 + sl_prev, pa0, pa1, pa2, pa3);
#undef STEP
#undef ROT
    if (hi == 0) li_l[r32] = l_reg; asm volatile("s_waitcnt lgkmcnt(0)" ::: "memory");
    float rli[16];
#pragma unroll
    for (int r = 0; r < 16; ++r) rli[r] = __builtin_amdgcn_rcpf(li_l[crow(r, hi)]) * (map ? lam : 1.f);
    __syncthreads();
    float* X = (float*)(lds + OFF_X) + w4 * (32 * 128);
    if (map == 1) {
#pragma unroll
        for (int r = 0; r < 16; ++r)
#pragma unroll
            for (int d0 = 0; d0 < 4; ++d0) X[crow(r, hi) * 128 + d0 * 32 + r32] = o[d0][r] * rli[r];
    }
    __syncthreads();
    if (map == 0) {
        float ss[16];
#pragma unroll
        for (int r = 0; r < 16; ++r) { float s = 0.f;
#pragma unroll
            for (int d0 = 0; d0 < 4; ++d0) { const float v = o[d0][r] * rli[r] - X[crow(r, hi) * 128 + d0 * 32 + r32]; o[d0][r] = v; s += v * v; }
            ss[r] = s; }
#pragma unroll
        for (int r = 0; r < 16; ++r) { float s = ss[r]; s += __shfl_xor(s, 1); s += __shfl_xor(s, 2); s += __shfl_xor(s, 4); s += __shfl_xor(s, 8); s += __shfl_xor(s, 16);
            ss[r] = __builtin_amdgcn_rsqf(s * (1.f / 128.f) + EPS) * oscale; }
        bf16_t* Ost = (bf16_t*)(lds + OFF_OST) + w4 * 4096;
#pragma unroll
        for (int d0 = 0; d0 < 4; ++d0) { const float g = subg[d0 * 32 + r32];
#pragma unroll
            for (int r = 0; r < 16; ++r) Ost[crow(r, hi) * 128 + d0 * 32 + r32] = (bf16_t)(cvt_pk_bf16(o[d0][r] * ss[r] * g, 0.f) & 0xffffu); }
        asm volatile("s_waitcnt lgkmcnt(0)" ::: "memory");
#pragma unroll
        for (int it = 0; it < 8; ++it) { const int row = it * 4 + (lane >> 4), ch = lane & 15;
            const u32x4 w = *(const u32x4*)(Ost + row * 128 + ch * 8);
            *(u32x4*)(Ob + (long)(w4 * 32 + row) * LDP + ch * 8) = w; }
    }
    __syncthreads();
#undef TILEP
#undef DMA_K
#undef DMA_V
#undef WAIT_BAR
#undef RESC
}

__device__ __forceinline__ void sg_unit(bf16_t* P0, const bf16_t* __restrict__ sgw, const float* __restrict__ lng, const float* __restrict__ lnb, const float* __restrict__ sgb, char* lds, const int wid) {
    const int lane = lane_id_v(), tid = wid * 64 + lane;
    const int r32 = lane & 31, hi = lane >> 5;
    float* stat = (float*)(lds + 65536);
    for (int i = 0; i < 16; ++i) { const int tkn = wid * 16 + i;
        const u32x4 w = *(const u32x4*)(P0 + (long)tkn * LDP + COL_G + lane * 8);
        float x[8] = {bflo(w.x), bfhi(w.x), bflo(w.y), bfhi(w.y), bflo(w.z), bfhi(w.z), bflo(w.w), bfhi(w.w)};
        float s = 0.f;
#pragma unroll
        for (int j = 0; j < 8; ++j) s += x[j];
        const float mean = wave_sum(s) * (1.f / 512.f); float q = 0.f;
#pragma unroll
        for (int j = 0; j < 8; ++j) { const float d = x[j] - mean; q += d * d; }
        const float rstd = __builtin_amdgcn_rsqf(wave_sum(q) * (1.f / 512.f) + EPS);
        if (lane == 0) { stat[tkn * 2] = mean; stat[tkn * 2 + 1] = rstd; } }
    __syncthreads();
    const int sr = tid >> 4, sc = (tid & 15) * 8;
    const int vb0 = (int)(uintptr_t)lds + v_rd_base(lane);
    const int mt = wid & 3, eh = wid >> 2;
    for (int g = 0; g < 4; ++g) {
        f32x4 ga = *(const f32x4*)(lng + g * 128 + sc), gb = *(const f32x4*)(lng + g * 128 + sc + 4), ba = *(const f32x4*)(lnb + g * 128 + sc), bb = *(const f32x4*)(lnb + g * 128 + sc + 4);
#pragma unroll
        for (int q4 = 0; q4 < 4; ++q4) { const int tkn = q4 * 32 + sr;
            const u32x4 w = *(const u32x4*)(P0 + (long)tkn * LDP + COL_G + g * 128 + sc);
            const float mean = stat[tkn * 2], rstd = stat[tkn * 2 + 1];
            float x[8] = {bflo(w.x), bfhi(w.x), bflo(w.y), bfhi(w.y), bflo(w.z), bfhi(w.z), bflo(w.w), bfhi(w.w)};
            u32x4 ov;
            ov.x = cvt_pk_bf16((x[0] - mean) * rstd * ga[0] + ba[0], (x[1] - mean) * rstd * ga[1] + ba[1]);
            ov.y = cvt_pk_bf16((x[2] - mean) * rstd * ga[2] + ba[2], (x[3] - mean) * rstd * ga[3] + ba[3]);
            ov.z = cvt_pk_bf16((x[4] - mean) * rstd * gb[0] + bb[0], (x[5] - mean) * rstd * gb[1] + bb[1]);
            ov.w = cvt_pk_bf16((x[6] - mean) * rstd * gb[2] + bb[2], (x[7] - mean) * rstd * gb[3] + bb[3]);
            *(u32x4*)(lds + (tkn >> 6) * SHM_V + v_st(tkn & 63, sc)) = ov; }
        __syncthreads();
        f32x16 oa = {}, ob = {};
        const bf16_t* Wp = sgw + (size_t)g * 128 * 128 + (size_t)(mt * 32 + r32) * 128 + hi * 4;
#pragma unroll
        for (int tq = 0; tq < 2; ++tq) {
#define WFRAG(s_) ({ const u32x2 lo_ = *(const u32x2*)(Wp + tq * 64 + (s_) * 16), hi_ = *(const u32x2*)(Wp + tq * 64 + (s_) * 16 + 8); u32x4 w_ = {lo_.x, lo_.y, hi_.x, hi_.y}; __builtin_bit_cast(bf16x8, w_); })
            const bf16x8 a0 = WFRAG(0), a1 = WFRAG(1), a2 = WFRAG(2), a3 = WFRAG(3);
#undef WFRAG
            if (eh == 0) { pv_one<0>(oa, vb0 + tq * SHM_V, a0, a1, a2, a3); pv_one<1>(ob, vb0 + tq * SHM_V, a0, a1, a2, a3); }
            else         { pv_one<2>(oa, vb0 + tq * SHM_V, a0, a1, a2, a3); pv_one<3>(ob, vb0 + tq * SHM_V, a0, a1, a2, a3); }
        }
#pragma unroll
        for (int r = 0; r < 16; ++r) { const int p = mt * 32 + crow(r, hi); const float bs = sgb[g * 128 + p];
            bf16_t* up = P0 + (long)p * LDP + COL_U + g * 128 + eh * 64 + r32;
            const float u0 = bf2f(up[0]), u1 = bf2f(up[32]);
            up[0] = (bf16_t)(cvt_pk_bf16(u0 * (oa[r] + bs), 0.f) & 0xffffu); up[32] = (bf16_t)(cvt_pk_bf16(u1 * (ob[r] + bs), 0.f) & 0xffffu); }
        __syncthreads();
    }
}
}

#define XB_TMO      128
#define XB_XCNT(j)  (256  + 64 * (j))
#define XB_XSUB(j)  (1280 + 64 * (j))
#define XB_XGEN(j)  (2304 + 64 * (j))
#define XB_TOP      3328
#define XB_TOPGEN   3392
#define XCD_BAR_WORDS 3456
#define XB_SPIN_CAP (1u << 18)
__device__ __forceinline__ unsigned xb_ld(unsigned* p)              { return __hip_atomic_load(p, __ATOMIC_RELAXED, __HIP_MEMORY_SCOPE_AGENT); }
__device__ __forceinline__ unsigned xb_add(unsigned* p, unsigned v) { return __hip_atomic_fetch_add(p, v, __ATOMIC_RELAXED, __HIP_MEMORY_SCOPE_AGENT); }
__device__ __forceinline__ unsigned xb_xcc_id() { return (unsigned)__builtin_amdgcn_s_getreg((3 << 11) | 20) & 0xFu; }
#define XB_SPIN(cond, bar) do { unsigned _sp = 0; while (cond) { __builtin_amdgcn_s_sleep(1); \
    if ((++_sp & 255u) == 0u) { if (xb_ld(&(bar)[XB_TMO])) break; if (_sp > XB_SPIN_CAP) { atomicAdd(&(bar)[XB_TMO], 1u); break; } } } } while (0)
struct XcdBarrier { unsigned* bar; unsigned x; volatile LAS unsigned* st; };
__device__ __forceinline__ XcdBarrier xcd_barrier_post(unsigned* bar, volatile LAS unsigned* st, int tid) {
    XcdBarrier b; b.bar = bar; b.x = xb_xcc_id(); b.st = st;
    if (tid == 0) (void)xb_add(&bar[XB_XCNT(b.x)], 1u);
    return b;
}
__device__ __forceinline__ void xcd_barrier_complete(unsigned* bar, unsigned x, unsigned& nloc, unsigned& nx) {
    const unsigned G = gridDim.x * gridDim.y * gridDim.z;
    unsigned sum, cnt, mine, sp = 0u;
    for (;;) {
        sum = 0u; cnt = 0u; mine = 0u;
#pragma unroll
        for (unsigned j = 0; j < 16; ++j) { const unsigned c = xb_ld(&bar[XB_XCNT(j)]); sum += c; cnt += (c > 0u) ? 1u : 0u; mine = (j == x) ? c : mine; }
        if (sum == G) break;
        __builtin_amdgcn_s_sleep(1);
        if ((++sp & 255u) == 0u) { if (xb_ld(&bar[XB_TMO])) break; if (sp > XB_SPIN_CAP) { atomicAdd(&bar[XB_TMO], 1u); break; } }
    }
    nloc = mine > 0u ? mine : 1u; nx = cnt > 0u ? cnt : 1u;
}
__device__ __forceinline__ void xcd_barrier(const XcdBarrier& b, int wave) {
    asm volatile("s_waitcnt vmcnt(0)" ::: "memory");
    __syncthreads();
    if (wave == 0 && lane_id_v() == 0) {
        unsigned* bar = b.bar;
        __builtin_amdgcn_s_waitcnt(0);
        unsigned nloc = b.st[0], nx = b.st[1];
        if (nloc == 0u) { xcd_barrier_complete(bar, b.x, nloc, nx); b.st[0] = nloc; b.st[1] = nx; }
        const unsigned old = xb_add(&bar[XB_XSUB(b.x)], 1u);
        const unsigned gen = old / nloc;
        if (old + 1u == (gen + 1u) * nloc) {
            __builtin_amdgcn_fence(__ATOMIC_RELEASE, "agent");
            asm volatile("s_waitcnt vmcnt(0)" ::: "memory");
            const unsigned og = xb_add(&bar[XB_TOP], 1u);
            const unsigned tg = og / nx;
            if (og + 1u == (tg + 1u) * nx) xb_add(&bar[XB_TOPGEN], 1u);
            else XB_SPIN(xb_ld(&bar[XB_TOPGEN]) == tg, bar);
            __builtin_amdgcn_fence(__ATOMIC_ACQUIRE, "agent");
            xb_add(&bar[XB_XGEN(b.x)], 1u);
            asm volatile("s_waitcnt vmcnt(0)" ::: "memory");
        } else {
            XB_SPIN(xb_ld(&bar[XB_XGEN(b.x)]) == gen, bar);
            __builtin_amdgcn_fence(__ATOMIC_ACQUIRE, "agent");
            asm volatile("s_waitcnt vmcnt(0)" ::: "memory");
        }
    }
    __syncthreads();
}

struct Args {
    const float* in[28]; float* out; unsigned char* ws; int ph_lo, ph_hi;
};
typedef const __attribute__((address_space(4))) Args* KArgP;
#define KARG() ({ KArgP _p = (KArgP)__builtin_amdgcn_kernarg_segment_ptr(); asm volatile("" : "+s"(_p)); _p; })
struct Frame {
    LAS unsigned char* lds; gu32* ctl; int tid, lane, wave, vcu, G;
};

__device__ __forceinline__ void transpose_item(const float* __restrict__ W, int ldw, int srcg, bool rope, int k0, bf16_t* WT, size_t dst_row0, int K, LAS float* scr, int lane) {
    const int j = lane & 31, sj = rope ? ((j & 3) + 4 * (j >> 3) + 16 * ((j >> 2) & 1)) : j;
    float v[32];
#pragma unroll
    for (int i = 0; i < 32; ++i) { const int kk = 2 * i + (lane >> 5); v[i] = W[(size_t)(k0 + kk) * ldw + srcg + sj]; }
#pragma unroll
    for (int i = 0; i < 32; ++i) { const int kk = 2 * i + (lane >> 5); scr[kk * 33 + j] = v[i]; }
    LDS_WAIT(); asm volatile("" ::: "memory");
    const int c = lane & 7;
#pragma unroll
    for (int jj = 0; jj < 4; ++jj) { const int n = (lane >> 3) + 8 * jj; const LAS float* s = scr + (8 * c) * 33 + n;
        u32x4 o; o.x = cvt_pk_bf16(s[0 * 33], s[1 * 33]); o.y = cvt_pk_bf16(s[2 * 33], s[3 * 33]); o.z = cvt_pk_bf16(s[4 * 33], s[5 * 33]); o.w = cvt_pk_bf16(s[6 * 33], s[7 * 33]);
        *(u32x4*)(WT + (dst_row0 + n) * K + k0 + 8 * c) = o; }
    LDS_WAIT(); asm volatile("" ::: "memory");
}

__device__ __forceinline__ void transpose_item_f8(const float* __restrict__ W, int ldw, int srcg, int k0, unsigned char* WT, size_t dst_row0, int K, LAS float* scr, int lane) {
    const int j = lane & 31;
    float v[32];
#pragma unroll
    for (int i = 0; i < 32; ++i) { const int kk = 2 * i + (lane >> 5); v[i] = W[(size_t)(k0 + kk) * ldw + srcg + j]; }
#pragma unroll
    for (int i = 0; i < 32; ++i) { const int kk = 2 * i + (lane >> 5); scr[kk * 33 + j] = v[i] * 128.f; }
    LDS_WAIT(); asm volatile("" ::: "memory");
    const int n = lane >> 1, hf = lane & 1; const LAS float* s = scr + (32 * hf) * 33 + n;
    u32x4 o0, o1;
    o0.x = pg8::pk_fp8x4(s[0 * 33], s[1 * 33], s[2 * 33], s[3 * 33]);     o0.y = pg8::pk_fp8x4(s[4 * 33], s[5 * 33], s[6 * 33], s[7 * 33]);
    o0.z = pg8::pk_fp8x4(s[8 * 33], s[9 * 33], s[10 * 33], s[11 * 33]);   o0.w = pg8::pk_fp8x4(s[12 * 33], s[13 * 33], s[14 * 33], s[15 * 33]);
    o1.x = pg8::pk_fp8x4(s[16 * 33], s[17 * 33], s[18 * 33], s[19 * 33]); o1.y = pg8::pk_fp8x4(s[20 * 33], s[21 * 33], s[22 * 33], s[23 * 33]);
    o1.z = pg8::pk_fp8x4(s[24 * 33], s[25 * 33], s[26 * 33], s[27 * 33]); o1.w = pg8::pk_fp8x4(s[28 * 33], s[29 * 33], s[30 * 33], s[31 * 33]);
    unsigned char* d = WT + (dst_row0 + n) * K + k0 + 32 * hf;
    *(u32x4*)d = o0; *(u32x4*)(d + 16) = o1;
    LDS_WAIT(); asm volatile("" ::: "memory");
}

__device__ __forceinline__ void p0_prologue(Frame& F, KArgP ap) {
    const __attribute__((address_space(4))) Args& a = *ap;
    unsigned char* ws = a.ws;
    if (blockIdx.x < 192) {
        const int l = blockIdx.x / 96, n0 = (blockIdx.x % 96) * 64;
        LAS float* s = (LAS float*)F.lds;
        LAS float* red = (LAS float*)(F.lds + 73728);
        const float* c = a.in[1]; const float* cc = a.in[3];
        for (int i = F.tid; i < 17 * 1024; i += 512) { const float v = i < 16 * 1024 ? c[i] : cc[i - 16 * 1024]; s[i] = silu_f(v); }
        __syncthreads();
        const float* W = a.in[4] + (size_t)l * D * 6144 + n0 + F.lane;
        float acc[17];
#pragma unroll
        for (int r = 0; r < 17; ++r) acc[r] = 0.f;
        const int kb = F.wave * 128;
        for (int k = 0; k < 128; k += 4) {
            const float w0 = W[(size_t)(kb + k) * 6144], w1 = W[(size_t)(kb + k + 1) * 6144], w2 = W[(size_t)(kb + k + 2) * 6144], w3 = W[(size_t)(kb + k + 3) * 6144];
#pragma unroll
            for (int r = 0; r < 17; ++r) { const f32x4 sv = *(const LAS f32x4*)(s + r * 1024 + kb + k); acc[r] += sv[0] * w0 + sv[1] * w1 + sv[2] * w2 + sv[3] * w3; }
        }
#pragma unroll
        for (int r = 0; r < 17; ++r) red[(F.wave * 17 + r) * 64 + F.lane] = acc[r];
        __syncthreads();
        float* ms = (float*)(ws + WS_MS) + (size_t)l * 17 * 6144;
        const float* bias = a.in[5] + (size_t)l * 6144;
        for (int i = F.tid; i < 17 * 64; i += 512) { const int r = i >> 6, col = i & 63; float v = bias[n0 + col];
#pragma unroll
            for (int w = 0; w < 8; ++w) v += red[(w * 17 + r) * 64 + col];
            ms[(size_t)r * 6144 + n0 + col] = v; }
        __syncthreads();
    }
    if (blockIdx.x == 255) {
        float* rc = (float*)(ws + WS_ROPE); float* rs = rc + 1024;
        for (int i = F.tid; i < 1024; i += 512) { const int pos = i >> 4, j = i & 15; const float inv = powf(10000.0f, -(float)(2 * j) / 32.0f); const float ang = (float)pos * inv; rc[i] = cosf(ang); rs[i] = sinf(ang); }
    }
    { const float* src = a.in[19]; bf16_t* dst = (bf16_t*)(ws + WS_SGW); const int n4 = 2 * 4 * 128 * 128 / 4;
      for (int i = blockIdx.x * 512 + F.tid; i < n4; i += F.G * 512) { const f32x4 v = *(const f32x4*)(src + (size_t)i * 4); u32x2 o; o.x = cvt_pk_bf16(v[0], v[1]); o.y = cvt_pk_bf16(v[2], v[3]); *(u32x2*)(dst + (size_t)i * 4) = o; } }
    LAS float* scr = (LAS float*)(F.lds + F.wave * 16384);
    const int gw = F.vcu * NWAVES + F.wave, NGW = F.G * NWAVES;
    constexpr int I_IN = 16 * 80, I_OUT = 16 * 32, I_F13 = 16 * 176, I_F2 = 44 * 32, I_M13 = 16 * 224, I_M2 = 56 * 32;
    constexpr int NITEMS = 2 * I_IN + 2 * I_OUT + I_F13 + I_F2 + 8 * I_M13 + 8 * I_M2;
    for (int it = gw; it < NITEMS; it += NGW) {
        int r = it;
        if (r < 2 * I_IN) { const int l = r / I_IN; r %= I_IN; const int kb = r / 80, g = r % 80, seg = g >> 4, gi = g & 15;
            const int sseg = seg == 0 ? 0 : seg == 1 ? 3 : seg == 2 ? 1 : seg == 3 ? 2 : 4;
            transpose_item(a.in[10] + (size_t)l * D * NIN, NIN, sseg * 512 + gi * 32, seg == 0 || seg == 2, kb * 64, (bf16_t*)(ws + WS_WIN) + (size_t)l * NIN * D, (size_t)g * 32, D, scr, F.lane); continue; }
        r -= 2 * I_IN;
        if (r < 2 * I_OUT) { const int l = r / I_OUT; r %= I_OUT; const int kb = r / 32, g = r % 32;
            transpose_item(a.in[11] + (size_t)l * D * D, D, g * 32, false, kb * 64, (bf16_t*)(ws + WS_WOUT) + (size_t)l * D * D, (size_t)g * 32, D, scr, F.lane); continue; }
        r -= 2 * I_OUT;
        if (r < I_F13) { const int kb = r / 176, g = r % 176, tile = g >> 3, gi = g & 7;
            const float* src = gi < 4 ? a.in[21] : a.in[22];
            transpose_item(src, DFF, tile * 128 + (gi & 3) * 32, false, kb * 64, (bf16_t*)(ws + WS_W13), (size_t)g * 32, D, scr, F.lane); continue; }
        r -= I_F13;
        if (r < I_F2) { const int kb = r / 32, g = r % 32;
            transpose_item(a.in[23], D, g * 32, false, kb * 64, (bf16_t*)(ws + WS_W2), (size_t)g * 32, DFF, scr, F.lane); continue; }
        r -= I_F2;
        if (r < 8 * I_M13) { const int e = r / I_M13; r %= I_M13; const int kb = r / 224, g = r % 224, tile = g >> 3, gi = g & 7;
            const float* src = (gi < 4 ? a.in[25] : a.in[26]) + (size_t)e * D * DEXP;
            transpose_item_f8(src, DEXP, tile * 128 + (gi & 3) * 32, kb * 64, ws + WS_MW13 + (size_t)e * 7168 * D, (size_t)g * 32, D, scr, F.lane); continue; }
        r -= 8 * I_M13;
        { const int e = r / I_M2; r %= I_M2; const int kb = r / 32, g = r % 32;
            transpose_item_f8(a.in[27] + (size_t)e * DEXP * D, D, g * 32, kb * 64, ws + WS_MW2 + (size_t)e * D * DEXP, (size_t)g * 32, DEXP, scr, F.lane); }
    }
}

struct Row { f32x4 v[4]; };
__device__ __forceinline__ Row ld_row_f32(const float* p, int lane) { Row r; const f32x4* q = (const f32x4*)p + lane;
#pragma unroll
    for (int j = 0; j < 4; ++j) r.v[j] = q[64 * j]; return r; }
__device__ __forceinline__ void st_row_f32(float* p, int lane, const Row& r) { f32x4* q = (f32x4*)p + lane;
#pragma unroll
    for (int j = 0; j < 4; ++j) q[64 * j] = r.v[j]; }
__device__ __forceinline__ Row ld_row_bf16(const bf16_t* p, int lane) { Row r; const u32x2* q = (const u32x2*)p + lane;
#pragma unroll
    for (int j = 0; j < 4; ++j) { const u32x2 w = q[64 * j]; r.v[j] = (f32x4){bflo(w.x), bfhi(w.x), bflo(w.y), bfhi(w.y)}; } return r; }
__device__ __forceinline__ void st_row_bf16(bf16_t* p, int lane, const Row& r) { u32x2* q = (u32x2*)p + lane;
#pragma unroll
    for (int j = 0; j < 4; ++j) { u32x2 w; w.x = cvt_pk_bf16(r.v[j][0], r.v[j][1]); w.y = cvt_pk_bf16(r.v[j][2], r.v[j][3]); q[64 * j] = w; } }
__device__ __forceinline__ float row_rms_scale(const Row& r) { float s = 0.f;
#pragma unroll
    for (int j = 0; j < 4; ++j) s += (r.v[j][0] * r.v[j][0] + r.v[j][1] * r.v[j][1]) + (r.v[j][2] * r.v[j][2] + r.v[j][3] * r.v[j][3]);
    return __builtin_amdgcn_rsqf(wave_sum(s) * (1.f / D) + EPS); }
__device__ __forceinline__ Row row_modulate(const Row& x, const float* g, const float* shift, const float* scale, int lane) {
    const float rs = row_rms_scale(x); Row h; const f32x4* gq = (const f32x4*)g + lane; const f32x4* sh = (const f32x4*)shift + lane; const f32x4* sc = (const f32x4*)scale + lane;
#pragma unroll
    for (int j = 0; j < 4; ++j) h.v[j] = x.v[j] * rs * gq[64 * j] * (1.f + sc[64 * j]) + sh[64 * j];
    return h; }
__device__ __forceinline__ void row_residual(Row& x, const Row& y, const float* g, const float* gate, int lane) {
    const float rs = row_rms_scale(y); const f32x4* gq = (const f32x4*)g + lane; const f32x4* gt = (const f32x4*)gate + lane;
#pragma unroll
    for (int j = 0; j < 4; ++j) x.v[j] = x.v[j] + gt[64 * j] * (y.v[j] * rs * gq[64 * j]);
}

struct ResP { f32x4 a[4]; };
struct ModP { f32x4 b[4], sh[4]; };
__device__ __forceinline__ ResP ld_resp(const float* g, const float* gate, int lane) { ResP r; const f32x4* gq = (const f32x4*)g + lane; const f32x4* gt = (const f32x4*)gate + lane;
#pragma unroll
    for (int j = 0; j < 4; ++j) r.a[j] = gq[64 * j] * gt[64 * j]; return r; }
__device__ __forceinline__ ModP ld_modp(const float* g, const float* shift, const float* scale, int lane) { ModP r; const f32x4* gq = (const f32x4*)g + lane; const f32x4* sh = (const f32x4*)shift + lane; const f32x4* sc = (const f32x4*)scale + lane;
#pragma unroll
    for (int j = 0; j < 4; ++j) { r.b[j] = gq[64 * j] * (1.f + sc[64 * j]); r.sh[j] = sh[64 * j]; } return r; }
__device__ __forceinline__ void row_residual2(Row& x, const Row& y, const ResP& P) { const float rs = row_rms_scale(y);
#pragma unroll
    for (int j = 0; j < 4; ++j) x.v[j] = x.v[j] + P.a[j] * (y.v[j] * rs); }
__device__ __forceinline__ Row row_modulate2(const Row& x, const ModP& P) { const float rs = row_rms_scale(x); Row h;
#pragma unroll
    for (int j = 0; j < 4; ++j) h.v[j] = x.v[j] * rs * P.b[j] + P.sh[j]; return h; }

struct MoeTab { int cnt[8]; int pbase[9]; };
__device__ __forceinline__ void moe_tab(gu32* ctl, MoeTab& T) {
    int p = 0;
#pragma unroll
    for (int e = 0; e < 8; ++e) { const int c = (int)__builtin_amdgcn_readfirstlane(__hip_atomic_load(ctl + CW_CNT + 64 * e, RLX_AGENT)); T.cnt[e] = c; T.pbase[e] = p; p += (c + 255) >> 8; }
    T.pbase[8] = p;
}
__device__ __forceinline__ int moe_expert_of(const MoeTab& T, int panel) { int e = 0;
#pragma unroll
    for (int i = 1; i < 8; ++i) e += (panel >= T.pbase[i]) ? 1 : 0;
    return e; }

struct MoeUpSched {
    static constexpr bool GATHER = true;
    const char* A; const char* Bt; const int* slot_token; int G, c, p0, nM; MoeTab T;
    __device__ __forceinline__ bool next(int i, pg8::Unit& u) const {
        const int L = i * G + c; if (L >= nM * 28) return false;
        int pm, pn; pg8::tile_of(L, nM, 28, pm, pn);
        const int panel = p0 + pm, e = moe_expert_of(T, panel);
        u.pm = pm; u.pn = pn; u.aux = e; u.aux2 = panel; u.Ap = A; u.Bp = Bt + ((size_t)e * 7168 + (size_t)pn * 256) * D; return true;
    }
    __device__ __forceinline__ void aoff(const pg8::Unit& u, const int (&R)[2], const int (&C)[2], unsigned (&o0)[2], unsigned (&o1)[2]) const {
        int pb = 0, cn = 0;
#pragma unroll
        for (int e = 0; e < 8; ++e) { pb = (u.aux == e) ? T.pbase[e] : pb; cn = (u.aux == e) ? T.cnt[e] : cn; }
        const int rk0 = (u.aux2 - pb) * 256;
#pragma unroll
        for (int i = 0; i < 2; ++i) {
            const int ra = rk0 + R[i], rb = rk0 + pg8::HALF + R[i];
            const int ta = slot_token[u.aux * 32768 + (ra < cn ? ra : 0)], tb = slot_token[u.aux * 32768 + (rb < cn ? rb : 0)];
            o0[i] = (unsigned)(ta * D + C[i] * 2); o1[i] = (unsigned)(tb * D + C[i] * 2); }
    }
};
struct MoeDownSched {
    static constexpr bool GATHER = false;
    const char* A; const char* Bt; int G, c, p0, nM; MoeTab T;
    __device__ __forceinline__ bool next(int i, pg8::Unit& u) const {
        const int L = i * G + c; if (L >= nM * 4) return false;
        int pm, pn; pg8::tile_of(L, nM, 4, pm, pn);
        const int panel = p0 + pm, e = moe_expert_of(T, panel);
        u.pm = panel; u.pn = pn; u.aux = e; u.aux2 = 0; u.Ap = A + (size_t)pm * 256 * DEXP; u.Bp = Bt + ((size_t)e * D + (size_t)pn * 256) * DEXP; return true;
    }
    __device__ __forceinline__ void aoff(const pg8::Unit&, const int (&R)[2], const int (&C)[2], unsigned (&o0)[2], unsigned (&o1)[2]) const {
#pragma unroll
        for (int i = 0; i < 2; ++i) { o0[i] = (unsigned)(R[i] * DEXP + C[i] * 2); o1[i] = (unsigned)((pg8::HALF + R[i]) * DEXP + C[i] * 2); }
    }
};

constexpr int N_PHASES = 24;


__global__ void __launch_bounds__(NWAVES * 64, 2) mk_fwd(Args args) {
    extern __shared__ __attribute__((aligned(16))) unsigned char lds_raw[];
    Frame F;
    F.lds = (LAS unsigned char*)lds_raw;
    F.tid = threadIdx.x; F.lane = F.tid & 63; F.wave = __builtin_amdgcn_readfirstlane(F.tid >> 6);
    F.G = gridDim.x; { const int bx = blockIdx.x; F.vcu = (F.G % 8 == 0) ? (bx % 8) * (F.G / 8) + bx / 8 : bx; }
    unsigned char* ws = KARG()->ws;
    F.ctl = (gu32*)(ws + WS_CTL);
    volatile LAS unsigned* MISC = (volatile LAS unsigned*)(F.lds + MISC_OFF);
    for (int u = F.tid; u < (LDS_BYTES - LDSCTL_OFF) / 4; u += NWAVES * 64) ((LAS unsigned*)(F.lds + LDSCTL_OFF))[u] = 0u;
    __syncthreads();
    XcdBarrier bar; bar.bar = (unsigned*)(F.ctl + CW_BAR); bar.x = 0; bar.st = nullptr;
    if (!MK_PER_PHASE) bar = xcd_barrier_post((unsigned*)(F.ctl + CW_BAR), MISC + 8, F.tid);
    const int lo = KARG()->ph_lo, hi = KARG()->ph_hi;
#ifndef DUP_MASK
#define DUP_MASK 0u
#endif
#if ((DUP_MASK) >> 0) & 1
#define REP_0 for (int _rep = 0; _rep < 2; ++_rep)
#else
#define REP_0
#endif
#if ((DUP_MASK) >> 1) & 1
#define REP_1 for (int _rep = 0; _rep < 2; ++_rep)
#else
#define REP_1
#endif
#if ((DUP_MASK) >> 2) & 1
#define REP_2 for (int _rep = 0; _rep < 2; ++_rep)
#else
#define REP_2
#endif
#if ((DUP_MASK) >> 4) & 1
#define REP_4 for (int _rep = 0; _rep < 2; ++_rep)
#else
#define REP_4
#endif
#if ((DUP_MASK) >> 5) & 1
#define REP_5 for (int _rep = 0; _rep < 2; ++_rep)
#else
#define REP_5
#endif
#if ((DUP_MASK) >> 6) & 1
#define REP_6 for (int _rep = 0; _rep < 2; ++_rep)
#else
#define REP_6
#endif
#if ((DUP_MASK) >> 7) & 1
#define REP_7 for (int _rep = 0; _rep < 2; ++_rep)
#else
#define REP_7
#endif
#if ((DUP_MASK) >> 9) & 1
#define REP_9 for (int _rep = 0; _rep < 2; ++_rep)
#else
#define REP_9
#endif
#if ((DUP_MASK) >> 11) & 1
#define REP_11 for (int _rep = 0; _rep < 2; ++_rep)
#else
#define REP_11
#endif
#if ((DUP_MASK) >> 13) & 1
#define REP_13 for (int _rep = 0; _rep < 2; ++_rep)
#else
#define REP_13
#endif
#if ((DUP_MASK) >> 14) & 1
#define REP_14 for (int _rep2 = 0; _rep2 < 2; ++_rep2)
#else
#define REP_14
#endif
#if ((DUP_MASK) >> 15) & 1
#define REP_15 for (int _rep2 = 0; _rep2 < 2; ++_rep2)
#else
#define REP_15
#endif
#ifndef PH_MASK
#define PH_MASK 0xffffffu
#endif
#define IN(k) ((((PH_MASK) >> (k)) & 1u) && lo <= (k) && (k) < hi)
#define SEAM(k) do { if (IN(k) && IN((k) + 1)) xcd_barrier(bar, F.wave); F.lane = lane_id_v(); F.tid = F.wave * 64 + F.lane; } while (0)

    bf16_t* XB = (bf16_t*)(ws + WS_XB);
    bf16_t* HA = (bf16_t*)(ws + WS_HA); bf16_t* P = (bf16_t*)(ws + WS_R1); bf16_t* HFF = (bf16_t*)(ws + WS_R1); bf16_t* OY = (bf16_t*)(ws + WS_OY); bf16_t* YS = (bf16_t*)(ws + WS_YS);
    const float* MS = (const float*)(ws + WS_MS);
    const float* ropec = (const float*)(ws + WS_ROPE); const float* ropes = ropec + 1024;
    int* tok_e = (int*)(ws + WS_ROUTE); float* tok_g = (float*)(ws + WS_ROUTE + 262144); int* tok_rank = (int*)(ws + WS_ROUTE + 524288);
    int* slot_token = (int*)(ws + WS_SLOT);
    const int gw = F.vcu * NWAVES + F.wave, NGW = F.G * NWAVES;
    char* ldsg = (char*)lds_raw;

    REP_0 if (IN(0)) { p0_prologue(F, KARG()); __syncthreads(); }
    SEAM(0);

    REP_1 if (IN(1)) {
        KArgP AP = KARG(); const float* x_in = AP->in[0]; const float* ctx_in = AP->in[2];
        const float* g = AP->in[6];
#pragma unroll 1
        for (int seg = 0; seg < 2; ++seg) {
            const int nr = seg ? 2 : 16; const int m0 = seg ? MLAT + gw * 2 : gw * 16; const int r17 = seg ? 16 : (m0 >> 11);
            const float* xbase = seg ? ctx_in + (size_t)(m0 - MLAT) * D : x_in + (size_t)m0 * D;
            const float* msr = MS + (size_t)r17 * 6144;
            const ModP MP = ld_modp(g, msr, msr + 1024, F.lane);
            Row xn = ld_row_f32(xbase, F.lane);
            for (int i = 0; i < nr; ++i) {
                const Row x = xn; if (i + 1 < nr) xn = ld_row_f32(xbase + (size_t)(i + 1) * D, F.lane);
                st_row_bf16(HA + (size_t)(m0 + i) * D, F.lane, row_modulate2(x, MP));
            }
        }
    }
    SEAM(1);

    REP_2 if (IN(2)) {
        pg8::DenseSched S{(const char*)HA, (const char*)(ws + WS_WIN), D, D, F.G, (int)blockIdx.x, MALL / 256, 10, 0, 0, 0, 0, 0, 0};
        pg8::EpiInProj E{P, ropec, ropes};
        pg8::gemm_phase<pg8::EpiInProj, pg8::DenseSched, true>(F.lds, F.wave, D, S, E);
    }
    SEAM(2);

#define ATTN_PHASE(LAYER, WITH_CTX) do { \
        KArgP AP = KARG(); \
        float lam; { const float a1 = AP->in[12][(LAYER) * 64 + F.lane] * AP->in[13][(LAYER) * 64 + F.lane], a2 = AP->in[14][(LAYER) * 64 + F.lane] * AP->in[15][(LAYER) * 64 + F.lane]; \
            lam = __expf(wave_sum(a1)) - __expf(wave_sum(a2)) + ((LAYER) ? LAMBDA_INIT1 : LAMBDA_INIT0); } \
        const float oscale = 1.f - ((LAYER) ? LAMBDA_INIT1 : LAMBDA_INIT0); \
        const float* subg = AP->in[16] + (LAYER) * 128; \
        const int c = (int)blockIdx.x, xcd = c & 7, jj = c >> 3; \
        for (int i = 0; i < 5; ++i) { \
            bf16_t* Qb; const bf16_t* K0; const bf16_t* K1; int n1; \
            if (i < 4) { const int bh = i * 16 + xcd * 2 + (jj >> 4), qb = jj & 15, b = bh >> 2, h = bh & 3; \
                Qb = P + ((size_t)b * SEQ + qb * 128) * NIN + COL_Q + h * 128; K0 = P + ((size_t)MLAT + b * CTX) * NIN + COL_K + h * 128; K1 = P + ((size_t)b * SEQ) * NIN + COL_K + h * 128; n1 = 32; } \
            else { if (!((WITH_CTX) && c < 128)) break; const int bh = c >> 1, qb = c & 1, b = bh >> 2, h = bh & 3;        \
                Qb = P + ((size_t)MLAT + b * CTX + qb * 128) * NIN + COL_Q + h * 128; K0 = P + ((size_t)MLAT + b * CTX) * NIN + COL_K + h * 128; K1 = K0; n1 = 0; } \
            att::attn_unit(Qb, K0, 4, K1, n1, Qb, lam, oscale, subg, ldsg, F.wave); } \
        int c1 = c; asm volatile("" : "+s"(c1)); \
        int c2 = c1; asm volatile("" : "+s"(c2)); \
        if (!DBG_NO_SG) { const bf16_t* sgw = (const bf16_t*)(ws + WS_SGW) + (size_t)(LAYER) * 4 * 128 * 128; \
          att::sg_unit(P + (size_t)c2 * 128 * NIN, sgw, AP->in[17] + (LAYER) * 512, AP->in[18] + (LAYER) * 512, AP->in[20] + (LAYER) * 512, ldsg, F.wave); \
          int c3 = c2; asm volatile("" : "+s"(c3)); \
          if ((WITH_CTX) && c3 >= 128 && c3 < 160) att::sg_unit(P + ((size_t)MLAT + (c3 - 128) * 128) * NIN, sgw, AP->in[17] + (LAYER) * 512, AP->in[18] + (LAYER) * 512, AP->in[20] + (LAYER) * 512, ldsg, F.wave); } \
    } while (0)
    if (IN(3)) { ATTN_PHASE(0, true); }
    SEAM(3);

    REP_4 if (IN(4)) {
        pg8::DenseSched S{(const char*)P, (const char*)(ws + WS_WOUT), NIN, D, F.G, (int)blockIdx.x, MALL / 256, 4, 0, 0, 0, 0, 0, 0};
        pg8::EpiPlain E{OY, D, 1.f};
        pg8::gemm_phase<pg8::EpiPlain, pg8::DenseSched, true>(F.lds, F.wave, D, S, E);
    }
    SEAM(4);

    REP_5 if (IN(5)) {
        KArgP AP = KARG(); const float* x_in = AP->in[0]; const float* ctx_in = AP->in[2];
        const float* gpost = AP->in[7]; const float* gpre = AP->in[8];
#pragma unroll 1
        for (int seg = 0; seg < 2; ++seg) {
            const int nr = seg ? 2 : 16; const int m0 = seg ? MLAT + gw * 2 : gw * 16; const int r17 = seg ? 16 : (m0 >> 11);
            const float* xbase = seg ? ctx_in + (size_t)(m0 - MLAT) * D : x_in + (size_t)m0 * D;
            const float* msr = MS + (size_t)r17 * 6144;
            const ResP RP = ld_resp(gpost, msr + 2 * 1024, F.lane); const ModP MP = ld_modp(gpre, msr + 3 * 1024, msr + 4 * 1024, F.lane);
            Row xn = ld_row_f32(xbase, F.lane), on = ld_row_bf16(OY + (size_t)m0 * D, F.lane);
            for (int i = 0; i < nr; ++i) {
                Row x = xn; const Row o = on; if (i + 1 < nr) { xn = ld_row_f32(xbase + (size_t)(i + 1) * D, F.lane); on = ld_row_bf16(OY + (size_t)(m0 + i + 1) * D, F.lane); }
                row_residual2(x, o, RP);
                st_row_bf16(XB + (size_t)(m0 + i) * D, F.lane, x);
                st_row_bf16(HA + (size_t)(m0 + i) * D, F.lane, row_modulate2(x, MP));
            }
        }
    }
    SEAM(5);

    REP_6 if (IN(6)) {
        pg8::DenseSched S{(const char*)HA, (const char*)(ws + WS_W13), D, D, F.G, (int)blockIdx.x, MALL / 256, 22, 0, 0, 0, 0, 0, 0};
        pg8::EpiSwiglu E{HFF, DFF};
        pg8::gemm_phase<pg8::EpiSwiglu, pg8::DenseSched, true>(F.lds, F.wave, D, S, E);
    }
    SEAM(6);

    REP_7 if (IN(7)) {
        pg8::DenseSched S{(const char*)HFF, (const char*)(ws + WS_W2), DFF, DFF, F.G, (int)blockIdx.x, MALL / 256, 4, 0, 0, 0, 0, 0, 0};
        pg8::EpiPlain E{OY, D, 1.f};
        pg8::gemm_phase<pg8::EpiPlain, pg8::DenseSched, true>(F.lds, F.wave, DFF, S, E);
    }
    SEAM(7);

    if (IN(8)) {
        KArgP AP = KARG();
        const float* gpost = AP->in[9]; const float* gpre = AP->in[6] + D;
#pragma unroll 1
        for (int seg = 0; seg < 2; ++seg) {
            const int nr = seg ? 2 : 16; const int m0 = seg ? MLAT + gw * 2 : gw * 16; const int r17 = seg ? 16 : (m0 >> 11);
            const float* msr = MS + (size_t)r17 * 6144; const float* msr1 = MS + (size_t)(17 + r17) * 6144;
            const ResP RP = ld_resp(gpost, msr + 5 * 1024, F.lane); const ModP MP = ld_modp(gpre, msr1, msr1 + 1024, F.lane);
            Row xn = ld_row_bf16(XB + (size_t)m0 * D, F.lane), yn = ld_row_bf16(OY + (size_t)m0 * D, F.lane);
            for (int i = 0; i < nr; ++i) {
                Row x = xn; const Row y = yn; if (i + 1 < nr) { xn = ld_row_bf16(XB + (size_t)(m0 + i + 1) * D, F.lane); yn = ld_row_bf16(OY + (size_t)(m0 + i + 1) * D, F.lane); }
                row_residual2(x, y, RP);
                if (!seg) st_row_bf16(XB + (size_t)(m0 + i) * D, F.lane, x);
                st_row_bf16(HA + (size_t)(m0 + i) * D, F.lane, row_modulate2(x, MP));
            }
        }
    }
    SEAM(8);

    REP_9 if (IN(9)) {
        pg8::DenseSched S{(const char*)HA, (const char*)(ws + WS_WIN + (size_t)NIN * D * 2), D, D, F.G, (int)blockIdx.x, MLAT / 256, 10, 0, 0, MCTX / 256, 4, MLAT, 4};
        pg8::EpiInProj E{P, ropec, ropes};
        pg8::gemm_phase<pg8::EpiInProj, pg8::DenseSched, true>(F.lds, F.wave, D, S, E);
    }
    SEAM(9);

    if (IN(10)) { ATTN_PHASE(1, false); }
    SEAM(10);

    REP_11 if (IN(11)) {
        pg8::DenseSched S{(const char*)P, (const char*)(ws + WS_WOUT + (size_t)D * D * 2), NIN, D, F.G, (int)blockIdx.x, MLAT / 256, 4, 0, 0, 0, 0, 0, 0};
        pg8::EpiPlain E{OY, D, 1.f};
        pg8::gemm_phase<pg8::EpiPlain, pg8::DenseSched, true>(F.lds, F.wave, D, S, E);
    }
    SEAM(11);

    if (IN(12)) {
        KArgP AP = KARG();
        const float* gpost = AP->in[7] + D; const float* gpre = AP->in[8] + D;
        LAS float* rw = (LAS float*)F.lds;
        LAS int* lcnt = (LAS int*)(F.lds + 32768);
        LAS int* rec = (LAS int*)(F.lds + 32768 + 256);
        for (int i = F.tid; i < 8192; i += 512) rw[(i & 7) * 1024 + (i >> 3)] = AP->in[24][i];
        if (F.tid < 16) lcnt[F.tid] = 0;
        __syncthreads();
        const int m0 = gw * 16; const int r17 = m0 >> 11; const float* msr1 = MS + (size_t)(17 + r17) * 6144;
        const ResP RP = ld_resp(gpost, msr1 + 2 * 1024, F.lane); const ModP MP = ld_modp(gpre, msr1 + 3 * 1024, msr1 + 4 * 1024, F.lane);
        Row xn = ld_row_bf16(XB + (size_t)m0 * D, F.lane), on = ld_row_bf16(OY + (size_t)m0 * D, F.lane);
        for (int i = 0; i < 16; ++i) {
            const int m = m0 + i;
            Row x = xn; const Row o = on; if (i + 1 < 16) { xn = ld_row_bf16(XB + (size_t)(m + 1) * D, F.lane); on = ld_row_bf16(OY + (size_t)(m + 1) * D, F.lane); }
            row_residual2(x, o, RP);
            st_row_bf16(XB + (size_t)m * D, F.lane, x);
            const Row f = row_modulate2(x, MP);
            { unsigned* fo = (unsigned*)((unsigned char*)HA + (size_t)m * D) + F.lane;
#pragma unroll
              for (int j = 0; j < 4; ++j) fo[64 * j] = pg8::pk_fp8x4(f.v[j][0] * 4.f, f.v[j][1] * 4.f, f.v[j][2] * 4.f, f.v[j][3] * 4.f); }
            float lg[8];
#pragma unroll
            for (int e = 0; e < 8; ++e) { float a = 0.f;
#pragma unroll
                for (int j = 0; j < 4; ++j) { const f32x4 w = *(const LAS f32x4*)(rw + e * 1024 + 4 * (F.lane + 64 * j)); a += (f.v[j][0] * w[0] + f.v[j][1] * w[1]) + (f.v[j][2] * w[2] + f.v[j][3] * w[3]); }
                lg[e] = wave_sum(a); }
            int e1 = 0; float v1 = lg[0];
#pragma unroll
            for (int e = 1; e < 8; ++e) if (lg[e] > v1) { v1 = lg[e]; e1 = e; }
            int e2 = -1; float v2 = -3.0e38f;
#pragma unroll
            for (int e = 0; e < 8; ++e) if (e != e1 && lg[e] > v2) { v2 = lg[e]; e2 = e; }
            if (F.lane == 0) {
                const float w1 = 1.f / (1.f + __expf(v2 - v1));
                tok_e[m * 2] = e1; tok_e[m * 2 + 1] = e2; tok_g[m * 2] = w1; tok_g[m * 2 + 1] = 1.f - w1;
                const int l1 = __hip_atomic_fetch_add(lcnt + e1, 1, __ATOMIC_RELAXED, __HIP_MEMORY_SCOPE_WORKGROUP), l2 = __hip_atomic_fetch_add(lcnt + e2, 1, __ATOMIC_RELAXED, __HIP_MEMORY_SCOPE_WORKGROUP);
                LAS int* rr = rec + (F.wave * 16 + i) * 4; rr[0] = e1; rr[1] = e2; rr[2] = l1; rr[3] = l2;
            }
        }
        __syncthreads();
        if (F.tid < 8) lcnt[8 + F.tid] = (int)__hip_atomic_fetch_add(F.ctl + CW_CNT + 64 * F.tid, (unsigned)lcnt[F.tid], RLX_AGENT);
        __syncthreads();
        if (F.lane < 16) { const int m = m0 + F.lane; const LAS int* rr = rec + (F.wave * 16 + F.lane) * 4;
            const int r1 = lcnt[8 + rr[0]] + rr[2], r2 = lcnt[8 + rr[1]] + rr[3];
            tok_rank[m * 2] = r1; tok_rank[m * 2 + 1] = r2; slot_token[rr[0] * 32768 + r1] = m; slot_token[rr[1] * 32768 + r2] = m; }
    }
    SEAM(12);

    {
        MoeTab T; T.pbase[8] = 0;
        if (hi > 13 && lo < 23) moe_tab(F.ctl, T);
        const int ptot = T.pbase[8];
        REP_13 for (int ch = 0; ch < 5; ++ch) {
            const int p0 = ch * 64; const int nM = (ptot - p0) < 64 ? (ptot - p0) : 64;
            REP_14 if (IN(13 + 2 * ch) && nM > 0) {
                MoeUpSched S{(const char*)HA, (const char*)(ws + WS_MW13), slot_token, F.G, (int)blockIdx.x, p0, nM, T};
                pg8::EpiSwigluF8 E{(unsigned char*)HFF, DEXP};
                pg8::gemm_phase<pg8::EpiSwigluF8, MoeUpSched, true, true>(F.lds, F.wave, D, S, E);
            }
            if (IN(13 + 2 * ch) && IN(14 + 2 * ch) && nM > 0) xcd_barrier(bar, F.wave);
            REP_15 if (IN(14 + 2 * ch) && nM > 0) {
                MoeDownSched S{(const char*)HFF, (const char*)(ws + WS_MW2), F.G, (int)blockIdx.x, p0, nM, T};
                pg8::EpiPlain E{YS, D, 1.f / 512.f};
                pg8::gemm_phase<pg8::EpiPlain, MoeDownSched, true, true>(F.lds, F.wave, DEXP, S, E);
            }
            if (IN(14 + 2 * ch) && IN(15 + 2 * ch) && nM > 0) xcd_barrier(bar, F.wave);
        }
    }

    if (IN(23)) {
        MoeTab T; moe_tab(F.ctl, T);
        const float* gpost = KARG()->in[9] + D;
#define YS_ROWS(mm, S1, S2) do { const int e1_ = tok_e[(mm) * 2], e2_ = tok_e[(mm) * 2 + 1]; int pb1_ = 0, pb2_ = 0; \
            _Pragma("unroll") for (int e = 0; e < 8; ++e) { pb1_ = (e1_ == e) ? T.pbase[e] : pb1_; pb2_ = (e2_ == e) ? T.pbase[e] : pb2_; } \
            S1 = (size_t)pb1_ * 256 + tok_rank[(mm) * 2]; S2 = (size_t)pb2_ * 256 + tok_rank[(mm) * 2 + 1]; } while (0)
        const int m0 = gw * 16; const int r17 = m0 >> 11; const float* msr1 = MS + (size_t)(17 + r17) * 6144;
        const ResP RP = ld_resp(gpost, msr1 + 5 * 1024, F.lane);
        size_t s1, s2; YS_ROWS(m0, s1, s2);
        Row xn = ld_row_bf16(XB + (size_t)m0 * D, F.lane), yan = ld_row_bf16(YS + s1 * D, F.lane), ybn = ld_row_bf16(YS + s2 * D, F.lane);
        float* outp = KARG()->out;
        for (int i = 0; i < 16; ++i) {
            const int m = m0 + i;
            Row x = xn; const Row ya = yan, yb = ybn; const float g1 = tok_g[m * 2], g2 = tok_g[m * 2 + 1];
            if (i + 1 < 16) { YS_ROWS(m + 1, s1, s2); xn = ld_row_bf16(XB + (size_t)(m + 1) * D, F.lane); yan = ld_row_bf16(YS + s1 * D, F.lane); ybn = ld_row_bf16(YS + s2 * D, F.lane); }
            Row y;
#pragma unroll
            for (int j = 0; j < 4; ++j) y.v[j] = ya.v[j] * g1 + yb.v[j] * g2;
            row_residual2(x, y, RP);
            st_row_f32(outp + (size_t)m * D, F.lane, x);
        }
    }
#undef IN
#undef SEAM
#undef ATTN_PHASE
}

extern "C" void kernel_launch(void* const* d_in, const int* in_sizes, int n_in, void* d_out, int out_size, void* d_ws, size_t ws_size, hipStream_t stream) {
    static int grid = 0;
    if (grid == 0) {
        if (n_in != 28 || out_size != MLAT * D || ws_size < WS_END) { fprintf(stderr, "kernel_launch: unexpected shapes (n_in %d, out %d, ws %zu)\n", n_in, out_size, ws_size); grid = -1; return; }
        int dev = 0, cus = 0, per_cu = 0;
        if (hipGetDevice(&dev) != hipSuccess || hipDeviceGetAttribute(&cus, hipDeviceAttributeMultiprocessorCount, dev) != hipSuccess) { grid = -1; return; }
        if (hipFuncSetAttribute((const void*)mk_fwd, hipFuncAttributeMaxDynamicSharedMemorySize, LDS_BYTES) != hipSuccess) { fprintf(stderr, "kernel_launch: hipFuncSetAttribute failed\n"); grid = -1; return; }
        if (hipOccupancyMaxActiveBlocksPerMultiprocessor(&per_cu, (const void*)mk_fwd, NWAVES * 64, LDS_BYTES) != hipSuccess || per_cu < 1) { fprintf(stderr, "kernel_launch: occupancy query says %d\n", per_cu); (void)hipGetLastError(); }
        grid = cus;
        if (grid != 256) { fprintf(stderr, "kernel_launch: built for 256 CUs, found %d\n", grid); grid = -1; return; }
    }
    if (grid < 0) return;
    (void)hipMemsetAsync((char*)d_ws + WS_CTL, 0, CTL_ZERO_BYTES, stream);
    Args a{};
    for (int i = 0; i < 28; ++i) a.in[i] = (const float*)d_in[i];
    a.out = (float*)d_out; a.ws = (unsigned char*)d_ws;
#if MK_PER_PHASE
    for (int p = 0; p < N_PHASES; ++p) { a.ph_lo = p; a.ph_hi = p + 1; hipLaunchKernelGGL(mk_fwd, dim3(grid), dim3(NWAVES * 64), LDS_BYTES, stream, a); }
#else
    a.ph_lo = 0; a.ph_hi = N_PHASES;
    hipLaunchKernelGGL(mk_fwd, dim3(grid), dim3(NWAVES * 64), LDS_BYTES, stream, a);
#endif
}
```

```cpp
#include <hip/hip_runtime.h>
#include <cstdio>
#include <cstdint>

#ifndef DBG_NO_SG
#define DBG_NO_SG 0
#endif
#ifndef DBG_NO_CTX
#define DBG_NO_CTX 0
#endif
#ifndef DBG_NO_LAT
#define DBG_NO_LAT 0
#endif
#ifndef PROBE_T
#define PROBE_T 0
#endif
#ifndef PROBE_T_PHASE
#define PROBE_T_PHASE 6
#endif
#ifndef FFN_DOWN_FP8
#define FFN_DOWN_FP8 1
#endif
#ifndef MK_PER_PHASE
#define MK_PER_PHASE 0
#endif

#define LAS __attribute__((address_space(3)))
#define GAS __attribute__((address_space(1)))
typedef unsigned short bf16_t;
typedef short bf16x8 __attribute__((ext_vector_type(8)));
typedef short s16x4 __attribute__((ext_vector_type(4)));
typedef float f32x2 __attribute__((ext_vector_type(2)));
typedef float f32x4 __attribute__((ext_vector_type(4)));
typedef float f32x16 __attribute__((ext_vector_type(16)));
typedef unsigned u32x2 __attribute__((ext_vector_type(2)));
typedef unsigned u32x4 __attribute__((ext_vector_type(4)));
typedef GAS unsigned gu32;
typedef int v8i __attribute__((ext_vector_type(8)));
typedef int v4i __attribute__((ext_vector_type(4)));

constexpr int D = 1024, BATCH = 16, SEQ = 2048, CTX = 256;
constexpr int MLAT = BATCH * SEQ;
constexpr int MCTX = BATCH * CTX;
constexpr int MALL = MLAT + MCTX;
constexpr int NIN = 2560;
constexpr int COL_Q = 0, COL_U = 512, COL_K = 1024, COL_V = 1536, COL_G = 2048;
constexpr int DFF = 2816, DEXP = 3584, NEXP = 8;
constexpr float EPS = 1e-6f;
constexpr float LAMBDA_INIT0 = 0.2f, LAMBDA_INIT1 = 0.35550907f;

constexpr size_t MiB = 1u << 20;
constexpr size_t WS_CTL = 0, CTL_ZERO_BYTES = 1 * MiB;
constexpr size_t WS_MS = 1 * MiB;
constexpr size_t WS_ROPE = 2 * MiB;
constexpr size_t WS_ROUTE = 3 * MiB;
constexpr size_t WS_SLOT = 4 * MiB;
constexpr size_t WS_WIN = 5 * MiB;
constexpr size_t WS_WOUT = 15 * MiB;
constexpr size_t WS_SGW = 19 * MiB;
constexpr size_t WS_W13 = 20 * MiB;
constexpr size_t WS_W2 = 31 * MiB;
constexpr size_t WS_MW13 = 37 * MiB;
constexpr size_t WS_MW2 = 93 * MiB;
constexpr size_t WS_XB = 121 * MiB;
constexpr size_t WS_HA = 221 * MiB;
constexpr size_t WS_R1 = 293 * MiB;
constexpr size_t WS_OY = 491 * MiB;
constexpr size_t WS_YS = 413 * MiB;
constexpr size_t WS_END = 563 * MiB;

constexpr int CW_BAR = 4096;
constexpr int CW_CNT = 64;

constexpr int RING_BYTES = 131072;
constexpr int LDSCTL_OFF = RING_BYTES, MISC_OFF = LDSCTL_OFF + 320;
constexpr int LDS_BYTES = 147456;
constexpr int ROPE_LDS = RING_BYTES + 6144;
static_assert(ROPE_LDS + 8192 <= LDS_BYTES, "LDS map");
constexpr int NWAVES = 8;

#define RLX_AGENT __ATOMIC_RELAXED, __HIP_MEMORY_SCOPE_AGENT
#define LDS_WAIT() asm volatile("s_waitcnt lgkmcnt(0)" ::: "memory")
#define VM_WAIT() asm volatile("s_waitcnt vmcnt(0)" ::: "memory")
#define SBAR() __builtin_amdgcn_sched_barrier(0)

__device__ __forceinline__ unsigned cvt_pk_bf16(float lo, float hi) { unsigned r; asm volatile("v_cvt_pk_bf16_f32 %0, %1, %2" : "=v"(r) : "v"(lo), "v"(hi)); return r; }
__device__ __forceinline__ float bf2f(unsigned short b) { return __builtin_bit_cast(float, (unsigned)b << 16); }
__device__ __forceinline__ float bflo(unsigned w) { return __builtin_bit_cast(float, w << 16); }
__device__ __forceinline__ float bfhi(unsigned w) { return __builtin_bit_cast(float, w & 0xffff0000u); }
__device__ __forceinline__ float wave_sum(float v) {
#pragma unroll
    for (int o = 1; o < 64; o <<= 1) v += __shfl_xor(v, o);
    return v;
}
__device__ __forceinline__ int lane_id_v() { int l; asm volatile("v_mbcnt_lo_u32_b32 %0, -1, 0\n\tv_mbcnt_hi_u32_b32 %0, -1, %0" : "=v"(l)); return l; }
__device__ __forceinline__ float silu_f(float v) { return v / (1.f + __expf(-v)); }

namespace pg8 {
constexpr int BM = 256, BK = 64, HALF = 128, HTB = HALF * BK * 2, STAGE_BYTES = 8 * HTB, NXCD = 8, WGM = 4;
constexpr int IDX_OFF = STAGE_BYTES + 4096;
__host__ __device__ __forceinline__ int lds_byte(int r, int c) { const int st = (r >> 4) * 2 + (c >> 5), rr = r & 15, cc = c & 31, ob = rr * 64 + cc * 2; return st * 1024 + (ob ^ (((ob >> 9) & 1) << 5)); }
__host__ __device__ __forceinline__ void stage_rc(int b, int& R, int& C) { const int st = b / 1024, sb = b % 1024, swz = sb ^ (((sb >> 9) & 1) << 5); R = (st >> 1) * 16 + swz / 64; C = (st & 1) * 32 + (swz % 64) / 2; }
__host__ __device__ __forceinline__ int perm32(int rho) { const int n = rho >> 4, i = rho & 15; return 8 * (i >> 2) + 4 * n + (i & 3); }

struct Unit { const char* Ap; const char* Bp; int pm, pn, aux, aux2; };

__device__ __forceinline__ void tile_of(int L, int nM, int nN, int& pm, int& pn) {
    const int nwg = nM * nN; int wgid = L;
    { const int q = nwg / NXCD, r = nwg % NXCD, xcd = wgid % NXCD, off = wgid / NXCD; wgid = (xcd < r ? xcd * (q + 1) : r * (q + 1) + (xcd - r) * q) + off; }
    const int nig = WGM * nN, gid = wgid / nig, fm = gid * WGM, gsz = (nM - fm) < WGM ? (nM - fm) : WGM;
    pm = fm + ((wgid % nig) % gsz); pn = (wgid % nig) / gsz;
}

template <class Epi, class Sched, bool ALIGN_EPI, bool FP8 = false>
__device__ __forceinline__ void gemm_phase(LAS unsigned char* lds, const int wid, const int K, const Sched& S, const Epi& E) {
    const int lane = lane_id_v(), tid = wid * 64 + lane;
    const int wr = wid >> 2, wc = wid & 3, fr = lane & 15, fq = lane >> 4;
    const int kbytes = FP8 ? K : 2 * K;
    const int nt = kbytes / 128;
    int R[2], C[2]; unsigned voffB[2];
#pragma unroll
    for (int i = 0; i < 2; ++i) { stage_rc(tid * 16 + i * 8192, R[i], C[i]); const int Rb = Epi::PERM ? ((R[i] & ~31) + perm32(R[i] & 31)) : R[i]; voffB[i] = (unsigned)(Rb * kbytes + C[i] * 2); }
    const size_t kstep = (size_t)(BK * 2);
    const size_t hstepB = (size_t)HALF * kbytes;
    const unsigned ldsw = (unsigned)wid * 1024u;
    const int aoff = lds_byte(wr * 64 + fr, fq * 8), boff = lds_byte(wc * 32 + fr, fq * 8);
#define PG8_SA(b, h) (((b) * 2 + (h)) * HTB)
#define PG8_SB(b, h) ((4 + (b) * 2 + (h)) * HTB)
#define PG8_STAGE(bufoff, gbase, voff) do { _Pragma("unroll") for (int _i = 0; _i < 2; ++_i) \
        __builtin_amdgcn_global_load_lds((const unsigned*)((const char*)(gbase) + (voff)[_i]), (LAS unsigned*)(lds + (bufoff) + ldsw + _i * 8192), 16, 0, 0); } while (0)
#define PG8_LDA(dst, b, h) do { _Pragma("unroll") for (int m = 0; m < 4; ++m) { const v4i _lo = *(const LAS v4i*)(lds + PG8_SA(b, h) + aoff + m * 2048), _hi = *(const LAS v4i*)(lds + PG8_SA(b, h) + aoff + m * 2048 + 1024); \
        dst[m] = __builtin_shufflevector(_lo, _hi, 0, 1, 2, 3, 4, 5, 6, 7); } } while (0)
#define PG8_LDB(dst, b, h) do { _Pragma("unroll") for (int n = 0; n < 2; ++n) { const v4i _lo = *(const LAS v4i*)(lds + PG8_SB(b, h) + boff + n * 2048), _hi = *(const LAS v4i*)(lds + PG8_SB(b, h) + boff + n * 2048 + 1024); \
        dst[n] = __builtin_shufflevector(_lo, _hi, 0, 1, 2, 3, 4, 5, 6, 7); } } while (0)
#define PG8_LO(x) __builtin_bit_cast(bf16x8, __builtin_shufflevector(x, x, 0, 1, 2, 3))
#define PG8_HI(x) __builtin_bit_cast(bf16x8, __builtin_shufflevector(x, x, 4, 5, 6, 7))
#define PG8_MMA(ai, bj, At, Bt) do { __builtin_amdgcn_s_setprio(1); \
        if constexpr (FP8) { _Pragma("unroll") for (int m = 0; m < 4; ++m) _Pragma("unroll") for (int n = 0; n < 2; ++n) \
            asm volatile("v_mfma_f32_16x16x128_f8f6f4 %0, %1, %2, %0" : "+v"(acc[ai][bj][m][n]) : "v"(Bt[n]), "v"(At[m])); } \
        else { _Pragma("unroll") for (int m = 0; m < 4; ++m) _Pragma("unroll") for (int n = 0; n < 2; ++n) { \
            acc[ai][bj][m][n] = __builtin_amdgcn_mfma_f32_16x16x32_bf16(PG8_LO(Bt[n]), PG8_LO(At[m]), acc[ai][bj][m][n], 0, 0, 0); \
            acc[ai][bj][m][n] = __builtin_amdgcn_mfma_f32_16x16x32_bf16(PG8_HI(Bt[n]), PG8_HI(At[m]), acc[ai][bj][m][n], 0, 0, 0); } } \
        __builtin_amdgcn_s_setprio(0); } while (0)
#define PG8_WAIT_V(n) asm volatile("s_waitcnt vmcnt(" #n ")" ::: "memory")
#define PG8_WAIT_L(n) asm volatile("s_waitcnt lgkmcnt(" #n ")" ::: "memory")
#define PG8_BAR __builtin_amdgcn_s_barrier()
#define PG8_SCHED __builtin_amdgcn_sched_barrier(0)
#if PROBE_T
    volatile LAS unsigned* tacc = (volatile LAS unsigned*)(lds + MISC_OFF) + 16;
#define PG8_T(n) do { if (S.tprobe && wid == 0 && blockIdx.x == 0 && lane == 0) { const unsigned _now = (unsigned)__builtin_amdgcn_s_memrealtime(); tacc[n] += _now - tacc[0]; tacc[0] = _now; } } while (0)
#else
#define PG8_T(n) do {} while (0)
#endif
    Unit cur, nxt; int ui = 0;
    if (!S.next(0, cur)) return;
    f32x4 acc[2][2][4][2];
#pragma unroll
    for (int a = 0; a < 2; ++a)
#pragma unroll
        for (int b = 0; b < 2; ++b)
#pragma unroll
            for (int m = 0; m < 4; ++m)
#pragma unroll
                for (int n = 0; n < 2; ++n) acc[a][b][m][n] = (f32x4){0.f, 0.f, 0.f, 0.f};
    v8i At[4], B0[2], B1[2];
    unsigned cO0[2], cO1[2], nO0[2], nO1[2];
    S.aoff(cur, R, C, cO0, cO1);
    const char* cA = cur.Ap; const char* cB = cur.Bp;
    PG8_STAGE(PG8_SB(0, 0), cB, voffB); PG8_STAGE(PG8_SB(0, 1), cB + hstepB, voffB); PG8_STAGE(PG8_SA(0, 0), cA, cO0); PG8_STAGE(PG8_SA(0, 1), cA, cO1);
    if (wr == 1) PG8_BAR;
    PG8_WAIT_V(2); PG8_BAR;
    PG8_STAGE(PG8_SB(1, 0), cB + kstep, voffB); PG8_STAGE(PG8_SA(1, 0), cA + kstep, cO0); PG8_STAGE(PG8_SB(1, 1), cB + hstepB + kstep, voffB);
    PG8_WAIT_V(6); PG8_BAR;
    PG8_T(7);
    for (;;) {
        const bool has_next = S.next(ui + 1, nxt);
        if constexpr (Sched::GATHER) { if (has_next) S.prefetch_idx(nxt, lds + IDX_OFF, wid, lane); nO0[0] = cO0[0]; nO0[1] = cO0[1]; nO1[0] = cO1[0]; nO1[1] = cO1[1]; }
        const char* nA = has_next ? nxt.Ap : cA; const char* nB = has_next ? nxt.Bp : cB;
        PG8_T(4);
        for (int t = 0; t < nt; t += 2) {
            const bool last = (t == nt - 2);
            const char* a1 = cA + (size_t)(t + 1) * kstep;
            const char* a2 = last ? nA : cA + (size_t)(t + 2) * kstep; const char* b2 = last ? nB : cB + (size_t)(t + 2) * kstep;
            const char* a3 = a2 + kstep; const char* b3 = b2 + kstep;
            unsigned xO0[2], xO1[2];
            if constexpr (Sched::GATHER) { if (last && has_next) S.aoff_lds(R, C, lds + IDX_OFF, nO0, nO1); }
            if constexpr (Sched::GATHER) { xO0[0] = last ? nO0[0] : cO0[0]; xO0[1] = last ? nO0[1] : cO0[1]; xO1[0] = last ? nO1[0] : cO1[0]; xO1[1] = last ? nO1[1] : cO1[1]; }
            else { xO0[0] = cO0[0]; xO0[1] = cO0[1]; xO1[0] = cO1[0]; xO1[1] = cO1[1]; }
            const int relax = __builtin_amdgcn_readfirstlane((t == 0 && ui > 0) ? 1 : 0);
#define PG8_WAIT_VR() do { if constexpr (Epi::NSTORES == 16) asm volatile("s_cmp_eq_u32 %0, 0\n\ts_cbranch_scc1 .Lwv%=\n\ts_waitcnt vmcnt(24)\n\ts_branch .Lwe%=\n.Lwv%=:\n\ts_waitcnt vmcnt(8)\n.Lwe%=:" :: "s"(relax) : "memory", "scc"); \
        else asm volatile("s_cmp_eq_u32 %0, 0\n\ts_cbranch_scc1 .Lwv%=\n\ts_waitcnt vmcnt(16)\n\ts_branch .Lwe%=\n.Lwv%=:\n\ts_waitcnt vmcnt(8)\n.Lwe%=:" :: "s"(relax) : "memory", "scc"); } while (0)
            PG8_LDB(B0, 0, 0); PG8_LDB(B1, 0, 1); PG8_SCHED; PG8_LDA(At, 0, 0); PG8_STAGE(PG8_SA(1, 1), a1, cO1);
            PG8_WAIT_VR(); PG8_WAIT_L(0); PG8_BAR; PG8_MMA(0, 0, At, B0); PG8_MMA(0, 1, At, B1); PG8_BAR; PG8_SCHED;
            PG8_LDA(At, 0, 1); PG8_STAGE(PG8_SB(0, 0), b2, voffB); PG8_STAGE(PG8_SB(0, 1), b2 + hstepB, voffB); PG8_STAGE(PG8_SA(0, 0), a2, xO0);
            PG8_WAIT_VR(); PG8_WAIT_L(0); PG8_BAR; PG8_MMA(1, 0, At, B0); PG8_MMA(1, 1, At, B1); PG8_BAR; PG8_SCHED;
            PG8_LDB(B0, 1, 0); PG8_LDB(B1, 1, 1); PG8_SCHED; PG8_LDA(At, 1, 0); PG8_STAGE(PG8_SA(0, 1), a2, xO1);
            PG8_WAIT_V(8); PG8_WAIT_L(0); PG8_BAR; PG8_MMA(0, 0, At, B0); PG8_MMA(0, 1, At, B1); PG8_BAR; PG8_SCHED;
#undef PG8_WAIT_VR
            PG8_LDA(At, 1, 1); PG8_STAGE(PG8_SB(1, 0), b3, voffB); PG8_STAGE(PG8_SB(1, 1), b3 + hstepB, voffB); PG8_STAGE(PG8_SA(1, 0), a3, xO0);
            PG8_WAIT_V(8); PG8_WAIT_L(0); PG8_BAR; PG8_MMA(1, 0, At, B0); PG8_MMA(1, 1, At, B1); PG8_BAR; PG8_SCHED;
        }
        PG8_T(1);
        if constexpr (ALIGN_EPI) { if (wr == 0) PG8_BAR; }
        PG8_T(2);
        if constexpr (FP8) asm volatile("s_nop 15\n\ts_nop 15\n\ts_nop 15\n\ts_nop 15\n\ts_nop 15\n\ts_nop 15" ::: "memory");
        E(acc, cur, wr, wc, fr, fq);
        PG8_T(3);
        if (!has_next) break;
#pragma unroll
        for (int a = 0; a < 2; ++a)
#pragma unroll
            for (int b = 0; b < 2; ++b)
#pragma unroll
                for (int m = 0; m < 4; ++m)
#pragma unroll
                    for (int n = 0; n < 2; ++n) acc[a][b][m][n] = (f32x4){0.f, 0.f, 0.f, 0.f};
        cur = nxt; cA = nA; cB = nB; ++ui;
        if constexpr (Sched::GATHER) { cO0[0] = nO0[0]; cO0[1] = nO0[1]; cO1[0] = nO1[0]; cO1[1] = nO1[1]; }
        if constexpr (ALIGN_EPI) { if (wr == 1) PG8_BAR; }
    }
    PG8_WAIT_V(0);
    if constexpr (!ALIGN_EPI) { if (wr == 0) PG8_BAR; }
    PG8_BAR;
#undef PG8_SA
#undef PG8_SB
#undef PG8_STAGE
#undef PG8_LDA
#undef PG8_LDB
#undef PG8_MMA
#undef PG8_LO
#undef PG8_HI
#undef PG8_WAIT_V
#undef PG8_WAIT_L
#undef PG8_BAR
#undef PG8_SCHED
#undef PG8_T
}

struct DenseSched {
    static constexpr bool GATHER = false;
    const char* A; const char* Bt; int lda, K, G, c;
    int nM0, nN0, arow0_0, pn0_0, nM1, nN1, arow0_1, pn0_1; int tprobe;
    __device__ __forceinline__ bool next(int i, Unit& u) const {
        int L = i * G + c; const int n0 = nM0 * nN0;
        int pm, pn;
        if (L < n0) { tile_of(L, nM0, nN0, pm, pn); u.pm = arow0_0 / 256 + pm; u.pn = pn0_0 + pn; }
        else { L -= n0; if (L >= nM1 * nN1) return false; tile_of(L, nM1, nN1, pm, pn); u.pm = arow0_1 / 256 + pm; u.pn = pn0_1 + pn; }
        u.Ap = A + (size_t)u.pm * 256 * lda * 2; u.Bp = Bt + (size_t)u.pn * 256 * K * 2; u.aux = 0; u.aux2 = 0; return true;
    }
    __device__ __forceinline__ void aoff(const Unit&, const int (&R)[2], const int (&C)[2], unsigned (&o0)[2], unsigned (&o1)[2]) const {
#pragma unroll
        for (int i = 0; i < 2; ++i) { o0[i] = (unsigned)(R[i] * lda + C[i]) * 2u; o1[i] = (unsigned)((HALF + R[i]) * lda + C[i]) * 2u; }
    }
};

struct DenseSchedF8 {
    static constexpr bool GATHER = false;
    const char* A; const char* Bt; int lda, K, G, c, nM, nN; int tprobe;
    __device__ __forceinline__ bool next(int i, Unit& u) const {
        const int L = i * G + c; if (L >= nM * nN) return false;
        int pm, pn; tile_of(L, nM, nN, pm, pn); u.pm = pm; u.pn = pn;
        u.Ap = A + (size_t)pm * 256 * lda; u.Bp = Bt + (size_t)pn * 256 * K; u.aux = 0; u.aux2 = 0; return true;
    }
    __device__ __forceinline__ void aoff(const Unit&, const int (&R)[2], const int (&C)[2], unsigned (&o0)[2], unsigned (&o1)[2]) const {
#pragma unroll
        for (int i = 0; i < 2; ++i) { o0[i] = (unsigned)(R[i] * lda + C[i] * 2); o1[i] = (unsigned)((HALF + R[i]) * lda + C[i] * 2); }
    }
};

struct EpiPlain {
    static constexpr bool PERM = true; static constexpr int NSTORES = 16;
    bf16_t* O; int ldc; float sc;
    __device__ __forceinline__ void operator()(const f32x4 (&acc)[2][2][4][2], const Unit& u, int wr, int wc, int fr, int fq) const {
        const int row0 = u.pm * BM + wr * 64 + fr, col0 = u.pn * BM + wc * 32 + 8 * fq;
#pragma unroll
        for (int ai = 0; ai < 2; ++ai)
#pragma unroll
            for (int m = 0; m < 4; ++m) { bf16_t* rowp = O + (size_t)(row0 + ai * HALF + m * 16) * ldc + col0;
#pragma unroll
                for (int bj = 0; bj < 2; ++bj) { const f32x4 v0 = acc[ai][bj][m][0] * sc, v1 = acc[ai][bj][m][1] * sc;
                    u32x4 w; w.x = cvt_pk_bf16(v0[0], v0[1]); w.y = cvt_pk_bf16(v0[2], v0[3]); w.z = cvt_pk_bf16(v1[0], v1[1]); w.w = cvt_pk_bf16(v1[2], v1[3]);
                    *(u32x4*)(rowp + bj * HALF) = w; } }
    }
};
struct EpiPlainMask {
    static constexpr bool PERM = true; static constexpr int NSTORES = 16;
    bf16_t* O; int ldc;
    __device__ __forceinline__ void operator()(const f32x4 (&acc)[2][2][4][2], const Unit& u, int wr, int wc, int fr, int fq) const {
        const int row0 = wr * 64 + fr, col0 = u.pn * BM + wc * 32 + 8 * fq;
#pragma unroll
        for (int ai = 0; ai < 2; ++ai)
#pragma unroll
            for (int m = 0; m < 4; ++m) { bf16_t* rowp = O + (size_t)(row0 + ai * HALF + m * 16) * ldc + col0;
#pragma unroll
                for (int bj = 0; bj < 2; ++bj) { const f32x4 v0 = acc[ai][bj][m][0], v1 = acc[ai][bj][m][1];
                    u32x4 w; w.x = cvt_pk_bf16(v0[0], v0[1]); w.y = cvt_pk_bf16(v0[2], v0[3]); w.z = cvt_pk_bf16(v1[0], v1[1]); w.w = cvt_pk_bf16(v1[2], v1[3]);
                    *(u32x4*)(rowp + bj * HALF) = w; } }
    }
};
struct EpiNull {
    static constexpr bool PERM = true; static constexpr int NSTORES = 8;
    __device__ __forceinline__ void operator()(const f32x4 (&acc)[2][2][4][2], const Unit&, int, int, int, int) const {
#pragma unroll
        for (int ai = 0; ai < 2; ++ai)
#pragma unroll
            for (int bj = 0; bj < 2; ++bj)
#pragma unroll
                for (int m = 0; m < 4; ++m) asm volatile("" :: "v"(acc[ai][bj][m][0]), "v"(acc[ai][bj][m][1]));
    }
};
struct EpiInProj {
    static constexpr bool PERM = true; static constexpr int NSTORES = 16;
    bf16_t* O; const LAS float* ropec; const LAS float* ropes;
    __device__ __forceinline__ void operator()(const f32x4 (&acc)[2][2][4][2], const Unit& u, int wr, int wc, int fr, int fq) const {
        const int row0 = u.pm * BM + wr * 64 + fr, col0 = u.pn * BM + wc * 32 + 8 * fq;
        const bool rope = (u.pm < MLAT / 256) && (u.pn < 2 || (u.pn >= 4 && u.pn < 6));
        const bool colpos = (wc & 1) != 0;
        const float qs = u.pn < 2 ? 0.18033688011112042f : 1.f;
#pragma unroll
        for (int ai = 0; ai < 2; ++ai)
#pragma unroll
            for (int m = 0; m < 4; ++m) { const int row = row0 + ai * HALF + m * 16; bf16_t* rowp = O + (size_t)row * NIN + col0;
                f32x4 cs = {1.f, 1.f, 1.f, 1.f}, sn = {0.f, 0.f, 0.f, 0.f};
                if (rope) { const int t = row & (SEQ - 1), pos = colpos ? (t & 63) : (t >> 6); cs = *(const LAS f32x4*)(ropec + pos * 16 + 4 * fq); sn = *(const LAS f32x4*)(ropes + pos * 16 + 4 * fq); }
#pragma unroll
                for (int bj = 0; bj < 2; ++bj) { const f32x4 a = acc[ai][bj][m][0] * qs, b = acc[ai][bj][m][1] * qs;
                    const f32x4 v0 = a * cs - b * sn, v1 = b * cs + a * sn;
                    u32x4 w; w.x = cvt_pk_bf16(v0[0], v0[1]); w.y = cvt_pk_bf16(v0[2], v0[3]); w.z = cvt_pk_bf16(v1[0], v1[1]); w.w = cvt_pk_bf16(v1[2], v1[3]);
                    *(u32x4*)(rowp + bj * HALF) = w; } }
    }
};
struct EpiSwiglu {
    static constexpr bool PERM = true; static constexpr int NSTORES = 8;
    bf16_t* O; int ldc;
    __device__ __forceinline__ void operator()(const f32x4 (&acc)[2][2][4][2], const Unit& u, int wr, int wc, int fr, int fq) const {
        const int row0 = u.pm * BM + wr * 64 + fr, col0 = u.pn * HALF + wc * 32 + 8 * fq;
#pragma unroll
        for (int ai = 0; ai < 2; ++ai)
#pragma unroll
            for (int m = 0; m < 4; ++m) { bf16_t* rowp = O + (size_t)(row0 + ai * HALF + m * 16) * ldc + col0;
                f32x2 v[2][2];
#pragma unroll
                for (int n = 0; n < 2; ++n)
#pragma unroll
                    for (int h2 = 0; h2 < 2; ++h2) { const f32x2 a2 = {acc[ai][0][m][n][2 * h2], acc[ai][0][m][n][2 * h2 + 1]}, b2 = {acc[ai][1][m][n][2 * h2], acc[ai][1][m][n][2 * h2 + 1]};
                        const f32x2 mm = a2 * (-1.4426950408889634f); f32x2 e; e.x = __builtin_amdgcn_exp2f(mm.x); e.y = __builtin_amdgcn_exp2f(mm.y);
                        const f32x2 d = e + 1.0f; f32x2 r; r.x = __builtin_amdgcn_rcpf(d.x); r.y = __builtin_amdgcn_rcpf(d.y);
                        v[n][h2] = (a2 * r) * b2; }
                u32x4 w; w.x = cvt_pk_bf16(v[0][0].x, v[0][0].y); w.y = cvt_pk_bf16(v[0][1].x, v[0][1].y); w.z = cvt_pk_bf16(v[1][0].x, v[1][0].y); w.w = cvt_pk_bf16(v[1][1].x, v[1][1].y);
                *(u32x4*)rowp = w; }
    }
};
__device__ __forceinline__ unsigned pk_fp8x4(float a, float b, float c, float d) {
    a = __builtin_amdgcn_fmed3f(a, -448.f, 448.f); b = __builtin_amdgcn_fmed3f(b, -448.f, 448.f); c = __builtin_amdgcn_fmed3f(c, -448.f, 448.f); d = __builtin_amdgcn_fmed3f(d, -448.f, 448.f);
    int p = __builtin_amdgcn_cvt_pk_fp8_f32(a, b, 0, false); p = __builtin_amdgcn_cvt_pk_fp8_f32(c, d, p, true); return (unsigned)p; }
struct EpiSwigluF8 {
    static constexpr bool PERM = true; static constexpr int NSTORES = 8;
    unsigned char* O; int ldc; float k1, k2;
    __device__ __forceinline__ void operator()(const f32x4 (&acc)[2][2][4][2], const Unit& u, int wr, int wc, int fr, int fq) const {
        const int row0 = u.pm * BM + wr * 64 + fr, col0 = u.pn * HALF + wc * 32 + 8 * fq;
#pragma unroll
        for (int ai = 0; ai < 2; ++ai)
#pragma unroll
            for (int m = 0; m < 4; ++m) { unsigned char* rowp = O + (size_t)(row0 + ai * HALF + m * 16) * ldc + col0;
                f32x2 v[2][2];
#pragma unroll
                for (int n = 0; n < 2; ++n)
#pragma unroll
                    for (int h2 = 0; h2 < 2; ++h2) { const f32x2 a2 = {acc[ai][0][m][n][2 * h2], acc[ai][0][m][n][2 * h2 + 1]}, b2 = {acc[ai][1][m][n][2 * h2], acc[ai][1][m][n][2 * h2 + 1]};
                        const f32x2 mm = a2 * k1; f32x2 e; e.x = __builtin_amdgcn_exp2f(mm.x); e.y = __builtin_amdgcn_exp2f(mm.y);
                        const f32x2 d = e + 1.0f; f32x2 r; r.x = __builtin_amdgcn_rcpf(d.x); r.y = __builtin_amdgcn_rcpf(d.y);
                        v[n][h2] = (a2 * r) * (b2 * k2); }
                u32x2 w; w.x = pk_fp8x4(v[0][0].x, v[0][0].y, v[0][1].x, v[0][1].y); w.y = pk_fp8x4(v[1][0].x, v[1][0].y, v[1][1].x, v[1][1].y);
                *(u32x2*)rowp = w; }
    }
};
}

namespace att {
constexpr int LDP = NIN;
constexpr int SHM_V = 64 * 128 * 2, SHM_K = 64 * 128 * 2;
constexpr int OFF_K = 0, OFF_V = 4 * SHM_K, OFF_WS = RING_BYTES + 14336, ATT_LDS = OFF_WS + NWAVES * 64 * 4;
constexpr int OFF_X = 0, OFF_OST = 65536;
static_assert(OFF_V + 4 * SHM_V <= RING_BYTES && ATT_LDS <= LDS_BYTES, "attention LDS");
constexpr float SCALE = 0.125f;
constexpr float THR = 8.f;
#define KSWZ(row, colB) ((row) * 256 + ((colB) ^ (((row) & 7) << 4)))
__device__ __forceinline__ int crow(int r, int hi) { return (r & 3) + 8 * (r >> 2) + 4 * hi; }

constexpr float THRL = 8.f;
template <bool FIRST>
__device__ __forceinline__ void partialSM(f32x16& p0, f32x16& p1, float& mhat, f32x16& negm, float& alpha) {
    float a = fmaxf(fmaxf(p0[0], p0[1]), p1[0]), b = fmaxf(fmaxf(p0[2], p0[3]), p1[1]); a = fmaxf(fmaxf(a, p1[2]), p1[3]);
#pragma unroll
    for (int r = 4; r < 16; r += 4) { a = fmaxf(fmaxf(a, p0[r]), p0[r + 1]); b = fmaxf(fmaxf(b, p0[r + 2]), p0[r + 3]); a = fmaxf(fmaxf(a, p1[r]), p1[r + 1]); b = fmaxf(fmaxf(b, p1[r + 2]), p1[r + 3]); }
    float rm = fmaxf(a, b);
    { auto rr = __builtin_amdgcn_permlane32_swap(__float_as_uint(rm), __float_as_uint(rm), false, false); rm = fmaxf(__uint_as_float(rr[0]), __uint_as_float(rr[1])); }
    alpha = 1.f;
    if (FIRST || __builtin_expect(__any(rm > THRL), 0)) {
        const float dl = FIRST ? rm : fmaxf(rm, 0.f); mhat += dl;
#pragma unroll
        for (int r = 0; r < 16; ++r) { p0[r] -= dl; p1[r] -= dl; }
#pragma unroll
        for (int r = 0; r < 16; ++r) negm[r] = -mhat;
        asm volatile("" : "+v"(negm));
        if (!FIRST) alpha = __builtin_amdgcn_exp2f(-dl);
    }
#pragma unroll
    for (int r = 0; r < 16; ++r) p0[r] = __builtin_amdgcn_exp2f(p0[r]);
}
__device__ __forceinline__ void finishSM(f32x16& p0, f32x16& p1, float alpha, float& l_reg, bf16x8& pa0, bf16x8& pa1, bf16x8& pa2, bf16x8& pa3) {
#pragma unroll
    for (int r = 0; r < 16; ++r) p1[r] = __builtin_amdgcn_exp2f(p1[r]);
    float ps = 0;
#pragma unroll
    for (int r = 0; r < 16; ++r) ps += p0[r];
#pragma unroll
    for (int r = 0; r < 16; ++r) ps += p1[r];
    { auto rr = __builtin_amdgcn_permlane32_swap(__float_as_uint(ps), __float_as_uint(ps), false, false);
      ps = __uint_as_float(rr[0]) + __uint_as_float(rr[1]); }
    l_reg = l_reg * alpha + ps;
#define PK4(P, BASE, OUT) do { u32x4 w = {cvt_pk_bf16(P[BASE + 0], P[BASE + 1]), cvt_pk_bf16(P[BASE + 2], P[BASE + 3]), cvt_pk_bf16(P[BASE + 4], P[BASE + 5]), cvt_pk_bf16(P[BASE + 6], P[BASE + 7])}; OUT = __builtin_bit_cast(bf16x8, w); } while (0)
    PK4(p0, 0, pa0); PK4(p0, 8, pa1); PK4(p1, 0, pa2); PK4(p1, 8, pa3);
#undef PK4
}
__device__ __forceinline__ void qkt(f32x16& p0, f32x16& p1, const char* Ks, const bf16x8 (&qr)[4], const f32x16& negm, int r32, int hi, int cb0) {
#pragma unroll
    for (int d0 = 0; d0 < 4; ++d0) { const int cb = cb0 + (d0 * 16 + hi * 8) * 2;
        const bf16x8 b0 = *reinterpret_cast<const bf16x8*>(Ks + KSWZ(r32, cb));
        const bf16x8 b1 = *reinterpret_cast<const bf16x8*>(Ks + KSWZ(32 + r32, cb));
        if (d0 == 0) { p0 = __builtin_amdgcn_mfma_f32_32x32x16_bf16(b0, qr[0], negm, 0, 0, 0); p1 = __builtin_amdgcn_mfma_f32_32x32x16_bf16(b1, qr[0], negm, 0, 0, 0); }
        else { p0 = __builtin_amdgcn_mfma_f32_32x32x16_bf16(b0, qr[d0], p0, 0, 0, 0); p1 = __builtin_amdgcn_mfma_f32_32x32x16_bf16(b1, qr[d0], p1, 0, 0, 0); } }
}
__device__ __forceinline__ int v_st(int k, int c) { const int kk = (k & ~0xC) | ((k & 4) << 1) | ((k & 8) >> 1); return ((kk >> 3) * 4 + (c >> 5)) * 512 + ((kk & 7) * 32 + (c & 31)) * 2; }
__device__ __forceinline__ int v_rd_base(int lane) { return ((lane & 3) << 3) | (((lane >> 2) & 3) << 6) | (((lane >> 4) & 1) << 5) | (((lane >> 5) & 1) << 11); }
constexpr int v_rd_off(int d0, int ks, int half) { return d0 * 512 + ks * 4096 + half * 256; }
template <int OFF> __device__ __forceinline__ s16x4 tr_read(int vb) {
    s16x4 r; asm volatile("ds_read_b64_tr_b16 %0, %1 offset:%2" : "=&v"(r) : "v"(vb), "i"(OFF) : "memory"); return r;
}
template <int D0> __device__ __forceinline__ void pv_one(f32x16& od, int vb, bf16x8 pa0, bf16x8 pa1, bf16x8 pa2, bf16x8 pa3) {
    const s16x4 l0 = tr_read<v_rd_off(D0, 0, 0)>(vb), h0 = tr_read<v_rd_off(D0, 0, 1)>(vb), l1 = tr_read<v_rd_off(D0, 1, 0)>(vb), h1 = tr_read<v_rd_off(D0, 1, 1)>(vb);
    const s16x4 l2 = tr_read<v_rd_off(D0, 2, 0)>(vb), h2 = tr_read<v_rd_off(D0, 2, 1)>(vb), l3 = tr_read<v_rd_off(D0, 3, 0)>(vb), h3 = tr_read<v_rd_off(D0, 3, 1)>(vb);
    asm volatile("s_waitcnt lgkmcnt(0)" ::: "memory"); SBAR();
#define PKV(L, H) (bf16x8){L[0], L[1], L[2], L[3], H[0], H[1], H[2], H[3]}
    od = __builtin_amdgcn_mfma_f32_32x32x16_bf16(pa0, PKV(l0, h0), od, 0, 0, 0);
    od = __builtin_amdgcn_mfma_f32_32x32x16_bf16(pa1, PKV(l1, h1), od, 0, 0, 0);
    od = __builtin_amdgcn_mfma_f32_32x32x16_bf16(pa2, PKV(l2, h2), od, 0, 0, 0);
    od = __builtin_amdgcn_mfma_f32_32x32x16_bf16(pa3, PKV(l3, h3), od, 0, 0, 0);
#undef PKV
}
struct VFrag { s16x4 l0, h0, l1, h1, l2, h2, l3, h3; };
template <int D0> __device__ __forceinline__ void v_reads(VFrag& f, int vb) {
    f.l0 = tr_read<v_rd_off(D0, 0, 0)>(vb); f.h0 = tr_read<v_rd_off(D0, 0, 1)>(vb); f.l1 = tr_read<v_rd_off(D0, 1, 0)>(vb); f.h1 = tr_read<v_rd_off(D0, 1, 1)>(vb);
    f.l2 = tr_read<v_rd_off(D0, 2, 0)>(vb); f.h2 = tr_read<v_rd_off(D0, 2, 1)>(vb); f.l3 = tr_read<v_rd_off(D0, 3, 0)>(vb); f.h3 = tr_read<v_rd_off(D0, 3, 1)>(vb);
}
__device__ __forceinline__ void v_mfmas(f32x16& od, const VFrag& f, bf16x8 pa0, bf16x8 pa1, bf16x8 pa2, bf16x8 pa3) {
#define PKV(L, H) (bf16x8){L[0], L[1], L[2], L[3], H[0], H[1], H[2], H[3]}
    od = __builtin_amdgcn_mfma_f32_32x32x16_bf16(pa0, PKV(f.l0, f.h0), od, 0, 0, 0);
    od = __builtin_amdgcn_mfma_f32_32x32x16_bf16(pa1, PKV(f.l1, f.h1), od, 0, 0, 0);
    od = __builtin_amdgcn_mfma_f32_32x32x16_bf16(pa2, PKV(f.l2, f.h2), od, 0, 0, 0);
    od = __builtin_amdgcn_mfma_f32_32x32x16_bf16(pa3, PKV(f.l3, f.h3), od, 0, 0, 0);
#undef PKV
}
__device__ __forceinline__ void pv_d0(f32x16* o, int vb, bf16x8 pa0, bf16x8 pa1, bf16x8 pa2, bf16x8 pa3) {
    VFrag fa, fb;
    v_reads<0>(fa, vb);
    v_reads<1>(fb, vb); asm volatile("s_waitcnt lgkmcnt(8)" ::: "memory"); SBAR(); v_mfmas(o[0], fa, pa0, pa1, pa2, pa3);
    v_reads<2>(fa, vb); asm volatile("s_waitcnt lgkmcnt(8)" ::: "memory"); SBAR(); v_mfmas(o[1], fb, pa0, pa1, pa2, pa3);
    v_reads<3>(fb, vb); asm volatile("s_waitcnt lgkmcnt(8)" ::: "memory"); SBAR(); v_mfmas(o[2], fa, pa0, pa1, pa2, pa3);
    asm volatile("s_waitcnt lgkmcnt(0)" ::: "memory"); SBAR(); v_mfmas(o[3], fb, pa0, pa1, pa2, pa3);
}

__device__ __forceinline__ void attn_unit(const bf16_t* __restrict__ Qb, const bf16_t* __restrict__ Ks0, int nt0, const bf16_t* __restrict__ Ks1, int nt1,
                                          bf16_t* Ob, float lam, float oscale, const float* __restrict__ subg, char* lds, const int wid) {
    const int lane = lane_id_v(), tid = wid * 64 + lane;
    const int r32 = lane & 31, hi = lane >> 5, map = wid >> 2, w4 = wid & 3; (void)tid;
    char* V_lds = lds + OFF_V; char* K_lds = lds + OFF_K;
    float* ws = (float*)(lds + OFF_WS) + wid * 64; float* li_l = ws; float* al_l = ws + 32;
    float zero_v; asm volatile("v_mov_b32 %0, 0" : "=v"(zero_v));
    float mhat = 0.f, l_reg = 0; f32x16 o[4] = {}; bf16x8 qr[4]; f32x16 negm;
#pragma unroll
    for (int r = 0; r < 16; ++r) negm[r] = zero_v;
    const bf16_t* Qw = Qb + (long)(w4 * 32 + r32) * LDP + map * 64 + hi * 8;
#pragma unroll
    for (int d0 = 0; d0 < 4; ++d0) qr[d0] = *reinterpret_cast<const bf16x8*>(Qw + d0 * 16);
    const int cb0 = map * 128;
    unsigned koff[2], voff[2];
#pragma unroll
    for (int i = 0; i < 2; ++i) { const int row = 4 * wid + 32 * i + (lane >> 4), ch = (lane & 15) ^ (row & 7); koff[i] = (unsigned)(row * LDP + ch * 8) * 2u;
        const int sub = 2 * wid + 16 * i + (lane >> 5), kk = (sub >> 2) * 8 + ((lane & 31) >> 2), k = (kk & ~0xC) | ((kk & 4) << 1) | ((kk & 8) >> 1), c = (sub & 3) * 32 + (lane & 3) * 8;
        voff[i] = (unsigned)(k * LDP + 512 + c) * 2u; }
    const unsigned ldsw = (unsigned)wid * 1024u;
    const int vb0 = (int)(uintptr_t)V_lds + v_rd_base(lane);
    const int NT = nt0 + nt1;
#define TILEP(j) ((const char*)((j) < nt0 ? Ks0 + (long)(j) * 64 * LDP : Ks1 + (long)((j) - nt0) * 64 * LDP))
#define DMA_K(j, slot) do { const char* _tb = TILEP(j); _Pragma("unroll") for (int _i = 0; _i < 2; ++_i) \
        __builtin_amdgcn_global_load_lds((const unsigned*)(_tb + koff[_i]), (LAS unsigned*)((LAS char*)(uintptr_t)(unsigned)(uintptr_t)K_lds + (slot) + ldsw + _i * 8192), 16, 0, 0); } while (0)
#define DMA_V(j, slot) do { const char* _tb = TILEP(j); _Pragma("unroll") for (int _i = 0; _i < 2; ++_i) \
        __builtin_amdgcn_global_load_lds((const unsigned*)(_tb + voff[_i]), (LAS unsigned*)((LAS char*)(uintptr_t)(unsigned)(uintptr_t)V_lds + (slot) + ldsw + _i * 8192), 16, 0, 0); } while (0)
#define WAIT_BAR(N) asm volatile("s_waitcnt vmcnt(" #N ") lgkmcnt(0)\n\ts_barrier" ::: "memory")
#define RESC(a) do { if (__any((a) < 1.f)) { if (hi == 0) al_l[r32] = (a); asm volatile("s_waitcnt lgkmcnt(0)" ::: "memory"); \
    _Pragma("unroll") for (int d = 0; d < 4; ++d) _Pragma("unroll") for (int r = 0; r < 16; ++r) o[d][r] *= al_l[crow(r, hi)]; } } while (0)
    f32x16 pA0, pA1, pB0, pB1; float alA, alB; bf16x8 pa0, pa1, pa2, pa3;
    DMA_K(0, 0); DMA_K(1, SHM_K); DMA_V(0, 0);
    WAIT_BAR(0);
#define HALF_STEP(C0, C1, P0, P1, alC, alP, t) do { \
        SBAR(); qkt(C0, C1, K_lds + (((t) >> 1) & 1) * 2 * SHM_K + ((t) & 1) * SHM_K, qr, negm, r32, hi, cb0); \
        finishSM(P0, P1, alP, l_reg, pa0, pa1, pa2, pa3); SBAR(); \
        pv_d0(o, vb0 + (((t) - 1) & 3) * SHM_V, pa0, pa1, pa2, pa3); partialSM<false>(C0, C1, mhat, negm, alC); \
        RESC(alC); } while (0)
    if (2 < NT) { DMA_K(2, 2 * SHM_K); DMA_K(3, 3 * SHM_K); } DMA_V(1, SHM_V); if (2 < NT) DMA_V(2, 2 * SHM_V);
    qkt(pA0, pA1, K_lds, qr, negm, r32, hi, cb0); partialSM<true>(pA0, pA1, mhat, negm, alA);
    HALF_STEP(pB0, pB1, pA0, pA1, alB, alA, 1);
    WAIT_BAR(0);
    for (int t = 2; t < NT; t += 2) {
        if (t + 2 < NT) { DMA_K(t + 2, (((t + 2) >> 1) & 1) * 2 * SHM_K); DMA_K(t + 3, (((t + 2) >> 1) & 1) * 2 * SHM_K + SHM_K); }
        DMA_V(t + 1, ((t + 1) & 3) * SHM_V); if (t + 2 < NT) DMA_V(t + 2, ((t + 2) & 3) * SHM_V);
        HALF_STEP(pA0, pA1, pB0, pB1, alA, alB, t);
        HALF_STEP(pB0, pB1, pA0, pA1, alB, alA, t + 1);
        WAIT_BAR(0);
    }
    finishSM(pB0, pB1, alB, l_reg, pa0, pa1, pa2, pa3); SBAR();
    pv_d0(o, vb0 + ((NT - 1) & 3) * SHM_V, pa0, pa1, pa2, pa3);
#undef HALF_STEP
    if (hi == 0) li_l[r32] = l_reg; asm volatile("s_waitcnt lgkmcnt(0)" ::: "memory");
    float rli[16];
#pragma unroll
    for (int r = 0; r < 16; ++r) rli[r] = __builtin_amdgcn_rcpf(li_l[crow(r, hi)]) * (map ? lam : 1.f);
    __syncthreads();
    float* X = (float*)(lds + OFF_X) + w4 * (32 * 128);
    if (map == 1) {
#pragma unroll
        for (int r = 0; r < 16; ++r)
#pragma unroll
            for (int d0 = 0; d0 < 4; ++d0) X[crow(r, hi) * 128 + d0 * 32 + r32] = o[d0][r] * rli[r];
    }
    __syncthreads();
    if (map == 0) {
        float ss[16];
#pragma unroll
        for (int r = 0; r < 16; ++r) { float s = 0.f;
#pragma unroll
            for (int d0 = 0; d0 < 4; ++d0) { const float v = o[d0][r] * rli[r] - X[crow(r, hi) * 128 + d0 * 32 + r32]; o[d0][r] = v; s += v * v; }
            ss[r] = s; }
#pragma unroll
        for (int r = 0; r < 16; ++r) { float s = ss[r]; s += __shfl_xor(s, 1); s += __shfl_xor(s, 2); s += __shfl_xor(s, 4); s += __shfl_xor(s, 8); s += __shfl_xor(s, 16);
            ss[r] = __builtin_amdgcn_rsqf(s * (1.f / 128.f) + EPS) * oscale; }
        bf16_t* Ost = (bf16_t*)(lds + OFF_OST) + w4 * 4096;
#pragma unroll
        for (int d0 = 0; d0 < 4; ++d0) { const float g = subg[d0 * 32 + r32];
#pragma unroll
            for (int r = 0; r < 16; ++r) Ost[crow(r, hi) * 128 + d0 * 32 + r32] = (bf16_t)(cvt_pk_bf16(o[d0][r] * ss[r] * g, 0.f) & 0xffffu); }
        asm volatile("s_waitcnt lgkmcnt(0)" ::: "memory");
#pragma unroll
        for (int it = 0; it < 8; ++it) { const int row = it * 4 + (lane >> 4), ch = lane & 15;
            const u32x4 w = *(const u32x4*)(Ost + row * 128 + ch * 8);
            *(u32x4*)(Ob + (long)(w4 * 32 + row) * LDP + ch * 8) = w; }
    }
    __syncthreads();
#undef TILEP
#undef DMA_K
#undef DMA_V
#undef WAIT_BAR
#undef RESC
}

__device__ __forceinline__ void sg_unit(bf16_t* P0, const bf16_t* __restrict__ sgw, const float* __restrict__ lng, const float* __restrict__ lnb, const float* __restrict__ sgb, char* lds, const int wid, const int g_lo, const int g_hi) {
    const int lane = lane_id_v(), tid = wid * 64 + lane;
    const int r32 = lane & 31, hi = lane >> 5;
    const int sr = tid >> 4, sc = (tid & 15) * 8;
    float* Mt = (float*)(lds + 65536);
    u32x4 gb[4][4];
#pragma unroll
    for (int q4 = 0; q4 < 4; ++q4)
#pragma unroll
        for (int g = 0; g < 4; ++g) gb[q4][g] = *(const u32x4*)(P0 + (long)(q4 * 32 + sr) * LDP + COL_G + g * 128 + sc);
    float mean[4], rstd[4];
#pragma unroll
    for (int q4 = 0; q4 < 4; ++q4) { float sm = 0.f;
#pragma unroll
        for (int g = 0; g < 4; ++g) { const u32x4 w = gb[q4][g]; sm += (bflo(w.x) + bfhi(w.x)) + (bflo(w.y) + bfhi(w.y)) + (bflo(w.z) + bfhi(w.z)) + (bflo(w.w) + bfhi(w.w)); }
        sm += __shfl_xor(sm, 1); sm += __shfl_xor(sm, 2); sm += __shfl_xor(sm, 4); sm += __shfl_xor(sm, 8);
        const float mu = sm * (1.f / 512.f); float q = 0.f;
#pragma unroll
        for (int g = 0; g < 4; ++g) { const u32x4 w = gb[q4][g]; const float x[8] = {bflo(w.x), bfhi(w.x), bflo(w.y), bfhi(w.y), bflo(w.z), bfhi(w.z), bflo(w.w), bfhi(w.w)};
#pragma unroll
            for (int k = 0; k < 8; ++k) { const float d = x[k] - mu; q += d * d; } }
        q += __shfl_xor(q, 1); q += __shfl_xor(q, 2); q += __shfl_xor(q, 4); q += __shfl_xor(q, 8);
        mean[q4] = mu; rstd[q4] = __builtin_amdgcn_rsqf(q * (1.f / 512.f) + EPS); }
    const int vb0 = (int)(uintptr_t)lds + v_rd_base(lane);
    const int mt = wid & 3, eh = wid >> 2;
#pragma unroll
    for (int g = 0; g < 4; ++g) {
        if (g < g_lo || g >= g_hi) continue;
        u32x4 ub[4];
#pragma unroll
        for (int q4 = 0; q4 < 4; ++q4) ub[q4] = *(const u32x4*)(P0 + (long)(q4 * 32 + sr) * LDP + COL_U + g * 128 + sc);
        const bf16_t* Wp = sgw + (size_t)g * 128 * 128 + (size_t)(mt * 32 + r32) * 128 + hi * 4;
        bf16x8 af[2][4];
#pragma unroll
        for (int tq = 0; tq < 2; ++tq)
#pragma unroll
            for (int ks = 0; ks < 4; ++ks) { const u32x2 lo_ = *(const u32x2*)(Wp + tq * 64 + ks * 16), hi_ = *(const u32x2*)(Wp + tq * 64 + ks * 16 + 8); u32x4 w_ = {lo_.x, lo_.y, hi_.x, hi_.y}; af[tq][ks] = __builtin_bit_cast(bf16x8, w_); }
        const f32x4 ga = *(const f32x4*)(lng + g * 128 + sc), gbv = *(const f32x4*)(lng + g * 128 + sc + 4), ba = *(const f32x4*)(lnb + g * 128 + sc), bb = *(const f32x4*)(lnb + g * 128 + sc + 4);
#pragma unroll
        for (int q4 = 0; q4 < 4; ++q4) { const int tkn = q4 * 32 + sr; const u32x4 w = gb[q4][g]; const float mu = mean[q4], rs = rstd[q4];
            const float x[8] = {bflo(w.x), bfhi(w.x), bflo(w.y), bfhi(w.y), bflo(w.z), bfhi(w.z), bflo(w.w), bfhi(w.w)};
            u32x4 ov;
            ov.x = cvt_pk_bf16((x[0] - mu) * rs * ga[0] + ba[0], (x[1] - mu) * rs * ga[1] + ba[1]);
            ov.y = cvt_pk_bf16((x[2] - mu) * rs * ga[2] + ba[2], (x[3] - mu) * rs * ga[3] + ba[3]);
            ov.z = cvt_pk_bf16((x[4] - mu) * rs * gbv[0] + bb[0], (x[5] - mu) * rs * gbv[1] + bb[1]);
            ov.w = cvt_pk_bf16((x[6] - mu) * rs * gbv[2] + bb[2], (x[7] - mu) * rs * gbv[3] + bb[3]);
            *(u32x4*)(lds + (tkn >> 6) * SHM_V + v_st(tkn & 63, sc)) = ov; }
        __syncthreads();
        f32x16 oa = {}, ob = {};
#pragma unroll
        for (int tq = 0; tq < 2; ++tq) {
            if (eh == 0) { pv_one<0>(oa, vb0 + tq * SHM_V, af[tq][0], af[tq][1], af[tq][2], af[tq][3]); pv_one<1>(ob, vb0 + tq * SHM_V, af[tq][0], af[tq][1], af[tq][2], af[tq][3]); }
            else         { pv_one<2>(oa, vb0 + tq * SHM_V, af[tq][0], af[tq][1], af[tq][2], af[tq][3]); pv_one<3>(ob, vb0 + tq * SHM_V, af[tq][0], af[tq][1], af[tq][2], af[tq][3]); }
        }
#pragma unroll
        for (int r = 0; r < 16; ++r) { const int pr = mt * 32 + crow(r, hi); const float bs = sgb[g * 128 + pr];
            Mt[pr * 128 + eh * 64 + r32] = oa[r] + bs; Mt[pr * 128 + eh * 64 + 32 + r32] = ob[r] + bs; }
        __syncthreads();
#pragma unroll
        for (int q4 = 0; q4 < 4; ++q4) { const int tkn = q4 * 32 + sr; const f32x4 m0 = *(const f32x4*)(Mt + tkn * 128 + sc), m1 = *(const f32x4*)(Mt + tkn * 128 + sc + 4); const u32x4 w = ub[q4];
            u32x4 ov;
            ov.x = cvt_pk_bf16(bflo(w.x) * m0[0], bfhi(w.x) * m0[1]); ov.y = cvt_pk_bf16(bflo(w.y) * m0[2], bfhi(w.y) * m0[3]);
            ov.z = cvt_pk_bf16(bflo(w.z) * m1[0], bfhi(w.z) * m1[1]); ov.w = cvt_pk_bf16(bflo(w.w) * m1[2], bfhi(w.w) * m1[3]);
            *(u32x4*)(P0 + (long)tkn * LDP + COL_U + g * 128 + sc) = ov; }
    }
    __syncthreads();
}
}

#define XB_TMO      128
#define XB_XCNT(j)  (256  + 64 * (j))
#define XB_XSUB(j)  (1280 + 64 * (j))
#define XB_XGEN(j)  (2304 + 64 * (j))
#define XB_TOP      3328
#define XB_TOPGEN   3392
#define XCD_BAR_WORDS 3456
#define XB_SPIN_CAP (1u << 18)
__device__ __forceinline__ unsigned xb_ld(unsigned* p)              { return __hip_atomic_load(p, __ATOMIC_RELAXED, __HIP_MEMORY_SCOPE_AGENT); }
__device__ __forceinline__ unsigned xb_add(unsigned* p, unsigned v) { return __hip_atomic_fetch_add(p, v, __ATOMIC_RELAXED, __HIP_MEMORY_SCOPE_AGENT); }
__device__ __forceinline__ unsigned xb_xcc_id() { return (unsigned)__builtin_amdgcn_s_getreg((3 << 11) | 20) & 0xFu; }
#define XB_SPIN(cond, bar) do { unsigned _sp = 0; while (cond) { __builtin_amdgcn_s_sleep(1); \
    if ((++_sp & 255u) == 0u) { if (xb_ld(&(bar)[XB_TMO])) break; if (_sp > XB_SPIN_CAP) { atomicAdd(&(bar)[XB_TMO], 1u); break; } } } } while (0)
struct XcdBarrier { unsigned* bar; unsigned x; volatile LAS unsigned* st; };
__device__ __forceinline__ XcdBarrier xcd_barrier_post(unsigned* bar, volatile LAS unsigned* st, int tid) {
    XcdBarrier b; b.bar = bar; b.x = xb_xcc_id(); b.st = st;
    if (tid == 0) (void)xb_add(&bar[XB_XCNT(b.x)], 1u);
    return b;
}
__device__ __forceinline__ void xcd_barrier_complete(unsigned* bar, unsigned x, unsigned& nloc, unsigned& nx) {
    const unsigned G = gridDim.x * gridDim.y * gridDim.z;
    unsigned sum, cnt, mine, sp = 0u;
    for (;;) {
        sum = 0u; cnt = 0u; mine = 0u;
#pragma unroll
        for (unsigned j = 0; j < 16; ++j) { const unsigned c = xb_ld(&bar[XB_XCNT(j)]); sum += c; cnt += (c > 0u) ? 1u : 0u; mine = (j == x) ? c : mine; }
        if (sum == G) break;
        __builtin_amdgcn_s_sleep(1);
        if ((++sp & 255u) == 0u) { if (xb_ld(&bar[XB_TMO])) break; if (sp > XB_SPIN_CAP) { atomicAdd(&bar[XB_TMO], 1u); break; } }
    }
    nloc = mine > 0u ? mine : 1u; nx = cnt > 0u ? cnt : 1u;
}
__device__ __forceinline__ void xcd_barrier(const XcdBarrier& b, int wave) {
    asm volatile("s_waitcnt vmcnt(0)" ::: "memory");
    __syncthreads();
    if (wave == 0 && lane_id_v() == 0) {
        unsigned* bar = b.bar;
        __builtin_amdgcn_s_waitcnt(0);
        unsigned nloc = b.st[0], nx = b.st[1];
        if (nloc == 0u) { xcd_barrier_complete(bar, b.x, nloc, nx); b.st[0] = nloc; b.st[1] = nx; }
        const unsigned old = xb_add(&bar[XB_XSUB(b.x)], 1u);
        const unsigned gen = old / nloc;
        if (old + 1u == (gen + 1u) * nloc) {
            __builtin_amdgcn_fence(__ATOMIC_RELEASE, "agent");
            asm volatile("s_waitcnt vmcnt(0)" ::: "memory");
            const unsigned og = xb_add(&bar[XB_TOP], 1u);
            const unsigned tg = og / nx;
            if (og + 1u == (tg + 1u) * nx) xb_add(&bar[XB_TOPGEN], 1u);
            else XB_SPIN(xb_ld(&bar[XB_TOPGEN]) == tg, bar);
            __builtin_amdgcn_fence(__ATOMIC_ACQUIRE, "agent");
            xb_add(&bar[XB_XGEN(b.x)], 1u);
            asm volatile("s_waitcnt vmcnt(0)" ::: "memory");
        } else {
            XB_SPIN(xb_ld(&bar[XB_XGEN(b.x)]) == gen, bar);
            __builtin_amdgcn_fence(__ATOMIC_ACQUIRE, "agent");
            asm volatile("s_waitcnt vmcnt(0)" ::: "memory");
        }
    }
    __syncthreads();
}

struct Args {
    const float* in[28]; float* out; unsigned char* ws; int ph_lo, ph_hi;
};
typedef const __attribute__((address_space(4))) Args* KArgP;
#define KARG() ({ KArgP _p = (KArgP)__builtin_amdgcn_kernarg_segment_ptr(); asm volatile("" : "+s"(_p)); _p; })
struct Frame {
    LAS unsigned char* lds; gu32* ctl; int tid, lane, wave, vcu, G;
};

constexpr int I_IN = 16 * 80, I_OUT = 16 * 32, I_F13 = 16 * 176, I_F2 = 44 * 32, I_M13 = 16 * 224, I_M2 = 56 * 32;
constexpr int CV_L0 = 2 * I_IN + 2 * I_OUT + I_F13 + I_F2, CV_N = CV_L0 + 8 * I_M13 + 8 * I_M2;
__device__ __forceinline__ void convert_range(LAS unsigned char* lds, int wave, int lane, KArgP ap, int first, int stride, int end) {
    const __attribute__((address_space(4))) Args& a = *ap; unsigned char* ws = a.ws;
    LAS float* scr = (LAS float*)(lds + wave * 16384);
    struct Item { const float* src; unsigned char* dst; int ldw, K, k0; bool rope, f8; };
#define DECODE(it_, I) do { int r = (it_); \
        if (r < 2 * I_IN) { const int l = r / I_IN; r %= I_IN; const int kb = r / 80, g = r % 80, seg = g >> 4, gi = g & 15; \
            const int sseg = seg == 0 ? 0 : seg == 1 ? 3 : seg == 2 ? 1 : seg == 3 ? 2 : 4;        \
            I.src = a.in[10] + (size_t)l * D * NIN + (size_t)kb * 64 * NIN + sseg * 512 + gi * 32; I.ldw = NIN; I.K = D; I.k0 = kb * 64; I.rope = (seg == 0 || seg == 2); I.f8 = false; \
            I.dst = ws + WS_WIN + ((size_t)l * NIN * D + (size_t)g * 32 * D + kb * 64) * 2; break; } \
        r -= 2 * I_IN; \
        if (r < 2 * I_OUT) { const int l = r / I_OUT; r %= I_OUT; const int kb = r / 32, g = r % 32; \
            I.src = a.in[11] + (size_t)l * D * D + (size_t)kb * 64 * D + g * 32; I.ldw = D; I.K = D; I.k0 = kb * 64; I.rope = false; I.f8 = false; \
            I.dst = ws + WS_WOUT + ((size_t)l * D * D + (size_t)g * 32 * D + kb * 64) * 2; break; } \
        r -= 2 * I_OUT; \
        if (r < I_F13) { const int kb = r / 176, g = r % 176, tile = g >> 3, gi = g & 7;            \
            I.src = (gi < 4 ? a.in[21] : a.in[22]) + (size_t)kb * 64 * DFF + tile * 128 + (gi & 3) * 32; I.ldw = DFF; I.K = D; I.k0 = kb * 64; I.rope = false; I.f8 = false; \
            I.dst = ws + WS_W13 + ((size_t)g * 32 * D + kb * 64) * 2; break; } \
        r -= I_F13; \
        if (r < I_F2) { const int kb = r / 32, g = r % 32; \
            I.src = a.in[23] + (size_t)kb * 64 * D + g * 32; I.ldw = D; I.K = DFF; I.k0 = kb * 64; I.rope = false; I.f8 = FFN_DOWN_FP8 != 0; \
            I.dst = ws + WS_W2 + ((size_t)g * 32 * DFF + kb * 64) * (FFN_DOWN_FP8 ? 1 : 2); break; } \
        r -= I_F2; \
        if (r < 8 * I_M13) { const int e = r / I_M13; r %= I_M13; const int kb = r / 224, g = r % 224, tile = g >> 3, gi = g & 7; \
            I.src = (gi < 4 ? a.in[25] : a.in[26]) + (size_t)e * D * DEXP + (size_t)kb * 64 * DEXP + tile * 128 + (gi & 3) * 32; I.ldw = DEXP; I.K = D; I.k0 = kb * 64; I.rope = false; I.f8 = true; \
            I.dst = ws + WS_MW13 + (size_t)e * 7168 * D + (size_t)g * 32 * D + kb * 64; break; } \
        r -= 8 * I_M13; \
        { const int e = r / I_M2; r %= I_M2; const int kb = r / 32, g = r % 32; \
            I.src = a.in[27] + (size_t)e * DEXP * D + (size_t)kb * 64 * D + g * 32; I.ldw = D; I.K = DEXP; I.k0 = kb * 64; I.rope = false; I.f8 = true; \
            I.dst = ws + WS_MW2 + (size_t)e * D * DEXP + (size_t)g * 32 * DEXP + kb * 64; } \
    } while (0)
#define LOADITEM(I, v) do { const int j_ = lane & 31, sj_ = I.rope ? ((j_ & 3) + 4 * (j_ >> 3) + 16 * ((j_ >> 2) & 1)) : j_; const float* sp_ = I.src + (size_t)(lane >> 5) * I.ldw + sj_; \
        _Pragma("unroll") for (int i = 0; i < 32; ++i) v[i] = sp_[(size_t)(2 * i) * I.ldw]; } while (0)
    if (first < end) {
        Item cur, nxt; float v[32], vn[32];
        DECODE(first, cur); LOADITEM(cur, v);
        for (int it = first; it < end; it += stride) {
            const int itn = it + stride; const bool has_next = itn < end;
            if (has_next) { DECODE(itn, nxt); LOADITEM(nxt, vn); }
            const int j = lane & 31; const float sc = cur.f8 ? 128.f : 1.f;
#pragma unroll
            for (int i = 0; i < 32; ++i) { const int kk = 2 * i + (lane >> 5); scr[kk * 33 + j] = v[i] * sc; }
            LDS_WAIT(); asm volatile("" ::: "memory");
            if (cur.f8) {
                const int n = lane >> 1, hf = lane & 1; const LAS float* s = scr + (32 * hf) * 33 + n;
                u32x4 o0, o1;
                o0.x = pg8::pk_fp8x4(s[0 * 33], s[1 * 33], s[2 * 33], s[3 * 33]);     o0.y = pg8::pk_fp8x4(s[4 * 33], s[5 * 33], s[6 * 33], s[7 * 33]);
                o0.z = pg8::pk_fp8x4(s[8 * 33], s[9 * 33], s[10 * 33], s[11 * 33]);   o0.w = pg8::pk_fp8x4(s[12 * 33], s[13 * 33], s[14 * 33], s[15 * 33]);
                o1.x = pg8::pk_fp8x4(s[16 * 33], s[17 * 33], s[18 * 33], s[19 * 33]); o1.y = pg8::pk_fp8x4(s[20 * 33], s[21 * 33], s[22 * 33], s[23 * 33]);
                o1.z = pg8::pk_fp8x4(s[24 * 33], s[25 * 33], s[26 * 33], s[27 * 33]); o1.w = pg8::pk_fp8x4(s[28 * 33], s[29 * 33], s[30 * 33], s[31 * 33]);
                unsigned char* d = cur.dst + (size_t)n * cur.K + 32 * hf;
                *(u32x4*)d = o0; *(u32x4*)(d + 16) = o1;
            } else {
                const int c = lane & 7;
#pragma unroll
                for (int jj = 0; jj < 4; ++jj) { const int n = (lane >> 3) + 8 * jj; const LAS float* s = scr + (8 * c) * 33 + n;
                    u32x4 o; o.x = cvt_pk_bf16(s[0 * 33], s[1 * 33]); o.y = cvt_pk_bf16(s[2 * 33], s[3 * 33]); o.z = cvt_pk_bf16(s[4 * 33], s[5 * 33]); o.w = cvt_pk_bf16(s[6 * 33], s[7 * 33]);
                    *(u32x4*)(cur.dst + ((size_t)n * cur.K + 8 * c) * 2) = o; }
            }
            LDS_WAIT(); asm volatile("" ::: "memory");
            if (has_next) { cur = nxt;
#pragma unroll
                for (int i = 0; i < 32; ++i) v[i] = vn[i]; }
        }
    }
#undef DECODE
#undef LOADITEM
}

__device__ __forceinline__ void p0_prologue(Frame& F, KArgP ap) {
    const __attribute__((address_space(4))) Args& a = *ap;
    unsigned char* ws = a.ws;
    if (blockIdx.x < 192) {
        const int l = blockIdx.x / 96, n0 = (blockIdx.x % 96) * 64;
        LAS float* s = (LAS float*)F.lds;
        LAS float* red = (LAS float*)(F.lds + 73728);
        const float* c = a.in[1]; const float* cc = a.in[3];
        for (int i = F.tid; i < 17 * 1024; i += 512) { const float v = i < 16 * 1024 ? c[i] : cc[i - 16 * 1024]; s[i] = silu_f(v); }
        __syncthreads();
        const float* W = a.in[4] + (size_t)l * D * 6144 + n0 + F.lane;
        float acc[17];
#pragma unroll
        for (int r = 0; r < 17; ++r) acc[r] = 0.f;
        const int kb = F.wave * 128;
#pragma unroll
        for (int k0 = 0; k0 < 128; k0 += 32) {
            float wv[32];
#pragma unroll
            for (int k = 0; k < 32; ++k) wv[k] = W[(size_t)(kb + k0 + k) * 6144];
#pragma unroll
            for (int k = 0; k < 32; k += 4)
#pragma unroll
                for (int r = 0; r < 17; ++r) { const f32x4 sv = *(const LAS f32x4*)(s + r * 1024 + kb + k0 + k); acc[r] += sv[0] * wv[k] + sv[1] * wv[k + 1] + sv[2] * wv[k + 2] + sv[3] * wv[k + 3]; }
        }
#pragma unroll
        for (int r = 0; r < 17; ++r) red[(F.wave * 17 + r) * 64 + F.lane] = acc[r];
        __syncthreads();
        float* ms = (float*)(ws + WS_MS) + (size_t)l * 17 * 6144;
        const float* bias = a.in[5] + (size_t)l * 6144;
        for (int i = F.tid; i < 17 * 64; i += 512) { const int r = i >> 6, col = i & 63; float v = bias[n0 + col];
#pragma unroll
            for (int w = 0; w < 8; ++w) v += red[(w * 17 + r) * 64 + col];
            ms[(size_t)r * 6144 + n0 + col] = v; }
        __syncthreads();
    }
    if (blockIdx.x == 255) {
        float* rc = (float*)(ws + WS_ROPE); float* rs = rc + 1024;
        for (int i = F.tid; i < 1024; i += 512) { const int pos = i >> 4, j = i & 15; const float inv = powf(10000.0f, -(float)(2 * j) / 32.0f); const float ang = (float)pos * inv; rc[i] = cosf(ang); rs[i] = sinf(ang); }
    }
    { const float* src = a.in[19]; bf16_t* dst = (bf16_t*)(ws + WS_SGW); const int n4 = 2 * 4 * 128 * 128 / 4;
      for (int i = blockIdx.x * 512 + F.tid; i < n4; i += F.G * 512) { const f32x4 v = *(const f32x4*)(src + (size_t)i * 4); u32x2 o; o.x = cvt_pk_bf16(v[0], v[1]); o.y = cvt_pk_bf16(v[2], v[3]); *(u32x2*)(dst + (size_t)i * 4) = o; } }
    convert_range(F.lds, F.wave, F.lane, ap, F.vcu * NWAVES + F.wave, F.G * NWAVES, CV_L0);
}

struct Row { f32x4 v[4]; };
__device__ __forceinline__ Row ld_row_f32(const float* p, int lane) { Row r; const f32x4* q = (const f32x4*)p + lane;
#pragma unroll
    for (int j = 0; j < 4; ++j) r.v[j] = __builtin_nontemporal_load(q + 64 * j); return r; }
__device__ __forceinline__ void st_row_f32(float* p, int lane, const Row& r) { f32x4* q = (f32x4*)p + lane;
#pragma unroll
    for (int j = 0; j < 4; ++j) q[64 * j] = r.v[j]; }
__device__ __forceinline__ Row ld_row_bf16(const bf16_t* p, int lane) { Row r; const u32x2* q = (const u32x2*)p + lane;
#pragma unroll
    for (int j = 0; j < 4; ++j) { const u32x2 w = __builtin_nontemporal_load(q + 64 * j); r.v[j] = (f32x4){bflo(w.x), bfhi(w.x), bflo(w.y), bfhi(w.y)}; } return r; }
__device__ __forceinline__ void st_row_bf16(bf16_t* p, int lane, const Row& r) { u32x2* q = (u32x2*)p + lane;
#pragma unroll
    for (int j = 0; j < 4; ++j) { u32x2 w; w.x = cvt_pk_bf16(r.v[j][0], r.v[j][1]); w.y = cvt_pk_bf16(r.v[j][2], r.v[j][3]); q[64 * j] = w; } }
__device__ __forceinline__ float row_rms_scale(const Row& r) { float s = 0.f;
#pragma unroll
    for (int j = 0; j < 4; ++j) s += (r.v[j][0] * r.v[j][0] + r.v[j][1] * r.v[j][1]) + (r.v[j][2] * r.v[j][2] + r.v[j][3] * r.v[j][3]);
    return __builtin_amdgcn_rsqf(wave_sum(s) * (1.f / D) + EPS); }
__device__ __forceinline__ Row row_modulate(const Row& x, const float* g, const float* shift, const float* scale, int lane) {
    const float rs = row_rms_scale(x); Row h; const f32x4* gq = (const f32x4*)g + lane; const f32x4* sh = (const f32x4*)shift + lane; const f32x4* sc = (const f32x4*)scale + lane;
#pragma unroll
    for (int j = 0; j < 4; ++j) h.v[j] = x.v[j] * rs * gq[64 * j] * (1.f + sc[64 * j]) + sh[64 * j];
    return h; }
__device__ __forceinline__ void row_residual(Row& x, const Row& y, const float* g, const float* gate, int lane) {
    const float rs = row_rms_scale(y); const f32x4* gq = (const f32x4*)g + lane; const f32x4* gt = (const f32x4*)gate + lane;
#pragma unroll
    for (int j = 0; j < 4; ++j) x.v[j] = x.v[j] + gt[64 * j] * (y.v[j] * rs * gq[64 * j]);
}

struct ResP { f32x4 a[4]; };
struct ModP { f32x4 b[4], sh[4]; };
__device__ __forceinline__ ResP ld_resp(const float* g, const float* gate, int lane) { ResP r; const f32x4* gq = (const f32x4*)g + lane; const f32x4* gt = (const f32x4*)gate + lane;
#pragma unroll
    for (int j = 0; j < 4; ++j) r.a[j] = gq[64 * j] * gt[64 * j]; return r; }
__device__ __forceinline__ ModP ld_modp(const float* g, const float* shift, const float* scale, int lane) { ModP r; const f32x4* gq = (const f32x4*)g + lane; const f32x4* sh = (const f32x4*)shift + lane; const f32x4* sc = (const f32x4*)scale + lane;
#pragma unroll
    for (int j = 0; j < 4; ++j) { r.b[j] = gq[64 * j] * (1.f + sc[64 * j]); r.sh[j] = sh[64 * j]; } return r; }
__device__ __forceinline__ void row_residual2(Row& x, const Row& y, const ResP& P) { const float rs = row_rms_scale(y);
#pragma unroll
    for (int j = 0; j < 4; ++j) x.v[j] = x.v[j] + P.a[j] * (y.v[j] * rs); }
__device__ __forceinline__ Row row_modulate2(const Row& x, const ModP& P) { const float rs = row_rms_scale(x); Row h;
#pragma unroll
    for (int j = 0; j < 4; ++j) h.v[j] = x.v[j] * rs * P.b[j] + P.sh[j]; return h; }

struct MoeTab { int cnt[8]; int pbase[9]; };
__device__ __forceinline__ void moe_tab(gu32* ctl, MoeTab& T) {
    int p = 0;
#pragma unroll
    for (int e = 0; e < 8; ++e) { const int c = (int)__builtin_amdgcn_readfirstlane(__hip_atomic_load(ctl + CW_CNT + 64 * e, RLX_AGENT)); T.cnt[e] = c; T.pbase[e] = p; p += (c + 255) >> 8; }
    T.pbase[8] = p;
}
__device__ __forceinline__ int moe_expert_of(const MoeTab& T, int panel) { int e = 0;
#pragma unroll
    for (int i = 1; i < 8; ++i) e += (panel >= T.pbase[i]) ? 1 : 0;
    return e; }

struct MoeUpSched {
    static constexpr bool GATHER = true;
    const char* A; const char* Bt; const int* slot_token; int G, c, p0, nM; MoeTab T; int tprobe;
    __device__ __forceinline__ bool next(int i, pg8::Unit& u) const {
        const int L = i * G + c; if (L >= nM * 28) return false;
        int pm, pn; pg8::tile_of(L, nM, 28, pm, pn);
        const int panel = p0 + pm, e = moe_expert_of(T, panel);
        u.pm = pm; u.pn = pn; u.aux = e; u.aux2 = panel; u.Ap = A; u.Bp = Bt + ((size_t)e * 7168 + (size_t)pn * 256) * D; return true;
    }
    __device__ __forceinline__ void aoff(const pg8::Unit& u, const int (&R)[2], const int (&C)[2], unsigned (&o0)[2], unsigned (&o1)[2]) const {
        int pb = 0, cn = 0;
#pragma unroll
        for (int e = 0; e < 8; ++e) { pb = (u.aux == e) ? T.pbase[e] : pb; cn = (u.aux == e) ? T.cnt[e] : cn; }
        const int rk0 = (u.aux2 - pb) * 256;
#pragma unroll
        for (int i = 0; i < 2; ++i) {
            const int ra = rk0 + R[i], rb = rk0 + pg8::HALF + R[i];
            const int ta = slot_token[u.aux * 32768 + (ra < cn ? ra : 0)], tb = slot_token[u.aux * 32768 + (rb < cn ? rb : 0)];
            o0[i] = (unsigned)(ta * D + C[i] * 2); o1[i] = (unsigned)(tb * D + C[i] * 2); }
    }
    __device__ __forceinline__ void prefetch_idx(const pg8::Unit& u, LAS unsigned char* idx, int wid, int lane) const {
        int pb = 0, cn = 0;
#pragma unroll
        for (int e = 0; e < 8; ++e) { pb = (u.aux == e) ? T.pbase[e] : pb; cn = (u.aux == e) ? T.cnt[e] : cn; }
        const int r = (u.aux2 - pb) * 256 + (wid & 3) * 64 + lane;
        __builtin_amdgcn_global_load_lds((const unsigned*)(slot_token + u.aux * 32768 + (r < cn ? r : 0)), (LAS unsigned*)(idx + (wid & 3) * 256), 4, 0, 0);
    }
    __device__ __forceinline__ void aoff_lds(const int (&R)[2], const int (&C)[2], const LAS unsigned char* idx, unsigned (&o0)[2], unsigned (&o1)[2]) const {
#pragma unroll
        for (int i = 0; i < 2; ++i) { const int ta = ((const LAS int*)idx)[R[i]], tb = ((const LAS int*)idx)[pg8::HALF + R[i]];
            o0[i] = (unsigned)(ta * D + C[i] * 2); o1[i] = (unsigned)(tb * D + C[i] * 2); }
    }
};
struct MoeDownSched {
    static constexpr bool GATHER = false;
    const char* A; const char* Bt; int G, c, p0, nM; MoeTab T; int tprobe;
    __device__ __forceinline__ bool next(int i, pg8::Unit& u) const {
        const int L = i * G + c; if (L >= nM * 4) return false;
        int pm, pn; pg8::tile_of(L, nM, 4, pm, pn);
        const int panel = p0 + pm, e = moe_expert_of(T, panel);
        u.pm = panel; u.pn = pn; u.aux = e; u.aux2 = 0; u.Ap = A + (size_t)pm * 256 * DEXP; u.Bp = Bt + ((size_t)e * D + (size_t)pn * 256) * DEXP; return true;
    }
    __device__ __forceinline__ void aoff(const pg8::Unit&, const int (&R)[2], const int (&C)[2], unsigned (&o0)[2], unsigned (&o1)[2]) const {
#pragma unroll
        for (int i = 0; i < 2; ++i) { o0[i] = (unsigned)(R[i] * DEXP + C[i] * 2); o1[i] = (unsigned)((pg8::HALF + R[i]) * DEXP + C[i] * 2); }
    }
};

constexpr int N_PHASES = 24;


__global__ void __launch_bounds__(NWAVES * 64, 2) mk_fwd(Args args) {
    extern __shared__ __attribute__((aligned(16))) unsigned char lds_raw[];
    Frame F;
    F.lds = (LAS unsigned char*)lds_raw;
    F.tid = threadIdx.x; F.lane = F.tid & 63; F.wave = __builtin_amdgcn_readfirstlane(F.tid >> 6);
    F.G = gridDim.x; { const int bx = blockIdx.x; F.vcu = (F.G % 8 == 0) ? (bx % 8) * (F.G / 8) + bx / 8 : bx; }
    unsigned char* ws = KARG()->ws;
    F.ctl = (gu32*)(ws + WS_CTL);
    volatile LAS unsigned* MISC = (volatile LAS unsigned*)(F.lds + MISC_OFF);
    for (int u = F.tid; u < (LDS_BYTES - LDSCTL_OFF) / 4; u += NWAVES * 64) ((LAS unsigned*)(F.lds + LDSCTL_OFF))[u] = 0u;
    __syncthreads();
    XcdBarrier bar; bar.bar = (unsigned*)(F.ctl + CW_BAR); bar.x = 0; bar.st = nullptr;
    if (!MK_PER_PHASE) bar = xcd_barrier_post((unsigned*)(F.ctl + CW_BAR), MISC + 8, F.tid);
    const int lo = KARG()->ph_lo, hi = KARG()->ph_hi;
#ifndef PROBE_NULL_G2
#define PROBE_NULL_G2 0
#endif
#ifndef DUP_MASK
#define DUP_MASK 0u
#endif
#if ((DUP_MASK) >> 0) & 1
#define REP_0 for (int _rep = 0; _rep < 2; ++_rep)
#else
#define REP_0
#endif
#if ((DUP_MASK) >> 1) & 1
#define REP_1 for (int _rep = 0; _rep < 2; ++_rep)
#else
#define REP_1
#endif
#if ((DUP_MASK) >> 2) & 1
#define REP_2 for (int _rep = 0; _rep < 2; ++_rep)
#else
#define REP_2
#endif
#if ((DUP_MASK) >> 4) & 1
#define REP_4 for (int _rep = 0; _rep < 2; ++_rep)
#else
#define REP_4
#endif
#if ((DUP_MASK) >> 5) & 1
#define REP_5 for (int _rep = 0; _rep < 2; ++_rep)
#else
#define REP_5
#endif
#if ((DUP_MASK) >> 6) & 1
#define REP_6 for (int _rep = 0; _rep < 2; ++_rep)
#else
#define REP_6
#endif
#if ((DUP_MASK) >> 7) & 1
#define REP_7 for (int _rep = 0; _rep < 2; ++_rep)
#else
#define REP_7
#endif
#if ((DUP_MASK) >> 9) & 1
#define REP_9 for (int _rep = 0; _rep < 2; ++_rep)
#else
#define REP_9
#endif
#if ((DUP_MASK) >> 11) & 1
#define REP_11 for (int _rep = 0; _rep < 2; ++_rep)
#else
#define REP_11
#endif
#if ((DUP_MASK) >> 13) & 1
#define REP_13 for (int _rep = 0; _rep < 2; ++_rep)
#else
#define REP_13
#endif
#if ((DUP_MASK) >> 14) & 1
#define REP_14 for (int _rep2 = 0; _rep2 < 2; ++_rep2)
#else
#define REP_14
#endif
#if ((DUP_MASK) >> 15) & 1
#define REP_15 for (int _rep2 = 0; _rep2 < 2; ++_rep2)
#else
#define REP_15
#endif
#ifndef PH_MASK
#define PH_MASK 0xffffffu
#endif
#define IN(k) ((((PH_MASK) >> (k)) & 1u) && lo <= (k) && (k) < hi)
#define SEAM(k) do { if (IN(k) && IN((k) + 1)) xcd_barrier(bar, F.wave); F.lane = lane_id_v(); F.tid = F.wave * 64 + F.lane; } while (0)

    bf16_t* XB = (bf16_t*)(ws + WS_XB);
    bf16_t* HA = (bf16_t*)(ws + WS_HA); bf16_t* P = (bf16_t*)(ws + WS_R1); bf16_t* HFF = (bf16_t*)(ws + WS_R1); bf16_t* OY = (bf16_t*)(ws + WS_OY); bf16_t* YS = (bf16_t*)(ws + WS_YS);
    const float* MS = (const float*)(ws + WS_MS);
    const float* ropec = (const float*)(ws + WS_ROPE); const float* ropes = ropec + 1024;
    int* tok_e = (int*)(ws + WS_ROUTE); float* tok_g = (float*)(ws + WS_ROUTE + 262144); int* tok_rank = (int*)(ws + WS_ROUTE + 524288);
    int* slot_token = (int*)(ws + WS_SLOT);
    const int gw = F.vcu * NWAVES + F.wave, NGW = F.G * NWAVES;
    char* ldsg = (char*)lds_raw;

#define TAIL_FILL(busy, kper, base) do { const int c_ = (int)blockIdx.x; if (c_ >= (busy)) { const int nfw_ = (256 - (busy)) * NWAVES, r_ = (c_ - (busy)) * NWAVES + F.wave; \
        convert_range(F.lds, F.wave, lane_id_v(), KARG(), CV_L0 + (base) + r_, nfw_, CV_L0 + (base) + (kper) * nfw_); } } while (0)
    constexpr int TF_K = 4, TF_K4 = 14;
    constexpr int TF_B2 = 0, TF_B4 = TF_B2 + 96 * NWAVES * TF_K, TF_B6 = TF_B4 + 192 * NWAVES * TF_K, TF_B7 = TF_B6 + 160 * NWAVES * TF_K, TF_B9 = TF_B7 + 192 * NWAVES * TF_K4, TF_END = TF_B9 + 192 * NWAVES * TF_K;
    static_assert(CV_L0 + TF_END <= CV_N, "tail fillers");
#if PROBE_T && PROBE_T_PHASE == 40
#define RGN(n) do { if (F.wave == 0 && blockIdx.x == 0 && lane_id_v() == 0) { volatile LAS unsigned* tacc_ = (volatile LAS unsigned*)(F.lds + MISC_OFF) + 16; const unsigned _now = (unsigned)__builtin_amdgcn_s_memrealtime(); tacc_[n] += _now - tacc_[0]; tacc_[0] = _now; } } while (0)
#else
#define RGN(n) do {} while (0)
#endif
    RGN(0);
    REP_0 if (IN(0)) { p0_prologue(F, KARG()); __syncthreads(); }
    RGN(1);
    SEAM(0);

    RGN(0);
    REP_1 if (IN(1)) {
        KArgP AP = KARG(); const float* x_in = AP->in[0]; const float* ctx_in = AP->in[2];
        const float* g = AP->in[6];
#pragma unroll 1
        for (int seg = 0; seg < 2; ++seg) {
            const int nr = seg ? 2 : 16; const int m0 = seg ? MLAT + gw * 2 : gw * 16; const int r17 = seg ? 16 : (m0 >> 11);
            const float* xbase = seg ? ctx_in + (size_t)(m0 - MLAT) * D : x_in + (size_t)m0 * D;
            const float* msr = MS + (size_t)r17 * 6144;
            const ModP MP = ld_modp(g, msr, msr + 1024, F.lane);
            Row xn = ld_row_f32(xbase, F.lane);
            for (int i = 0; i < nr; ++i) {
                const Row x = xn; if (i + 1 < nr) xn = ld_row_f32(xbase + (size_t)(i + 1) * D, F.lane);
                st_row_bf16(HA + (size_t)(m0 + i) * D, F.lane, row_modulate2(x, MP));
            }
        }
    }
    RGN(2);
    SEAM(1);

    REP_2 if (IN(2)) {
        pg8::DenseSched S{(const char*)HA, (const char*)(ws + WS_WIN), D, D, F.G, (int)blockIdx.x, MALL / 256, 10, 0, 0, 0, 0, 0, 0};
        LAS float* rl = (LAS float*)(F.lds + ROPE_LDS); for (int i = F.tid; i < 2048; i += NWAVES * 64) rl[i] = ropec[i]; __syncthreads();
        pg8::EpiInProj E{P, rl, rl + 1024};
        pg8::gemm_phase<pg8::EpiInProj, pg8::DenseSched, true>(F.lds, F.wave, D, S, E);
        TAIL_FILL(1440 - 5 * 256, TF_K, TF_B2);
    }
    SEAM(2);

#define ATTN_PHASE(LAYER, WITH_CTX) do { \
        KArgP AP = KARG(); \
        float lam; { const float a1 = AP->in[12][(LAYER) * 64 + F.lane] * AP->in[13][(LAYER) * 64 + F.lane], a2 = AP->in[14][(LAYER) * 64 + F.lane] * AP->in[15][(LAYER) * 64 + F.lane]; \
            lam = __expf(wave_sum(a1)) - __expf(wave_sum(a2)) + ((LAYER) ? LAMBDA_INIT1 : LAMBDA_INIT0); } \
        const float oscale = 1.f - ((LAYER) ? LAMBDA_INIT1 : LAMBDA_INIT0); \
        const float* subg = AP->in[16] + (LAYER) * 128; \
        const int c = (int)blockIdx.x, xcd = c & 7, jj = c >> 3; \
        for (int i = 0; i < 5; ++i) { \
            bf16_t* Qb; const bf16_t* K0; const bf16_t* K1; int n1; \
            if (i < 4) { const int bh = i * 16 + xcd * 2 + (jj >> 4), qb = jj & 15, b = bh >> 2, h = bh & 3; \
                Qb = P + ((size_t)b * SEQ + qb * 128) * NIN + COL_Q + h * 128; K0 = P + ((size_t)MLAT + b * CTX) * NIN + COL_K + h * 128; K1 = P + ((size_t)b * SEQ) * NIN + COL_K + h * 128; n1 = 32; } \
            else { if (!((WITH_CTX) && c < 128)) break; const int bh = c >> 1, qb = c & 1, b = bh >> 2, h = bh & 3;        \
                Qb = P + ((size_t)MLAT + b * CTX + qb * 128) * NIN + COL_Q + h * 128; K0 = P + ((size_t)MLAT + b * CTX) * NIN + COL_K + h * 128; K1 = K0; n1 = 0; } \
            att::attn_unit(Qb, K0, 4, K1, n1, Qb, lam, oscale, subg, ldsg, F.wave); } \
        int c1 = c; asm volatile("" : "+s"(c1)); \
        int c2 = c1; asm volatile("" : "+s"(c2)); \
        SGT(7); \
        if (!DBG_NO_SG) { const bf16_t* sgw = (const bf16_t*)(ws + WS_SGW) + (size_t)(LAYER) * 4 * 128 * 128; \
          att::sg_unit(P + (size_t)c2 * 128 * NIN, sgw, AP->in[17] + (LAYER) * 512, AP->in[18] + (LAYER) * 512, AP->in[20] + (LAYER) * 512, ldsg, F.wave, 0, 4); \
          int c3 = c2; asm volatile("" : "+s"(c3)); \
          if ((WITH_CTX) && c3 >= 128) { const int it_ = c3 - 128;          \
              att::sg_unit(P + ((size_t)MLAT + (it_ >> 2) * 128) * NIN, sgw, AP->in[17] + (LAYER) * 512, AP->in[18] + (LAYER) * 512, AP->in[20] + (LAYER) * 512, ldsg, F.wave, it_ & 3, (it_ & 3) + 1); } } \
        SGT(1); \
    } while (0)
#if PROBE_T && PROBE_T_PHASE == 30
#define SGT(n) do { if (F.wave == 0 && blockIdx.x == 0 && lane_id_v() == 0) { volatile LAS unsigned* tacc_ = (volatile LAS unsigned*)(F.lds + MISC_OFF) + 16; const unsigned _now = (unsigned)__builtin_amdgcn_s_memrealtime(); tacc_[n] += _now - tacc_[0]; tacc_[0] = _now; } } while (0)
#else
#define SGT(n) do {} while (0)
#endif
    RGN(0);
    if (IN(3)) { ATTN_PHASE(0, true); }
    RGN(3);
    SEAM(3);

    REP_4 if (IN(4)) {
        pg8::DenseSched S{(const char*)P, (const char*)(ws + WS_WOUT), NIN, D, F.G, (int)blockIdx.x, MALL / 256, 4, 0, 0, 0, 0, 0, 0};
        pg8::EpiPlain E{OY, D, 1.f};
        pg8::gemm_phase<pg8::EpiPlain, pg8::DenseSched, true>(F.lds, F.wave, D, S, E);
#if PROBE_NULL_G2 == 1
        { pg8::EpiNull E0; pg8::gemm_phase<pg8::EpiNull, pg8::DenseSched, true>(F.lds, F.wave, D, S, E0); }
#elif PROBE_NULL_G2 == 2
        { pg8::EpiPlainMask E0{HA, D}; pg8::gemm_phase<pg8::EpiPlainMask, pg8::DenseSched, true>(F.lds, F.wave, D, S, E0); }
#endif
        TAIL_FILL(576 - 2 * 256, TF_K, TF_B4);
    }
    SEAM(4);

    RGN(0);
    REP_5 if (IN(5)) {
        KArgP AP = KARG(); const float* x_in = AP->in[0]; const float* ctx_in = AP->in[2];
        const float* gpost = AP->in[7]; const float* gpre = AP->in[8];
#pragma unroll 1
        for (int seg = 0; seg < 2; ++seg) {
            const int nr = seg ? 2 : 16; const int m0 = seg ? MLAT + gw * 2 : gw * 16; const int r17 = seg ? 16 : (m0 >> 11);
            const float* xbase = seg ? ctx_in + (size_t)(m0 - MLAT) * D : x_in + (size_t)m0 * D;
            const float* msr = MS + (size_t)r17 * 6144;
            const ResP RP = ld_resp(gpost, msr + 2 * 1024, F.lane); const ModP MP = ld_modp(gpre, msr + 3 * 1024, msr + 4 * 1024, F.lane);
            Row xn = ld_row_f32(xbase, F.lane), on = ld_row_bf16(OY + (size_t)m0 * D, F.lane);
            for (int i = 0; i < nr; ++i) {
                Row x = xn; const Row o = on; if (i + 1 < nr) { xn = ld_row_f32(xbase + (size_t)(i + 1) * D, F.lane); on = ld_row_bf16(OY + (size_t)(m0 + i + 1) * D, F.lane); }
                row_residual2(x, o, RP);
                st_row_bf16(XB + (size_t)(m0 + i) * D, F.lane, x);
                st_row_bf16(HA + (size_t)(m0 + i) * D, F.lane, row_modulate2(x, MP));
            }
        }
    }
    RGN(4);
    SEAM(5);

    REP_6 if (IN(6)) {
        pg8::DenseSched S{(const char*)HA, (const char*)(ws + WS_W13), D, D, F.G, (int)blockIdx.x, MALL / 256, 22, 0, 0, 0, 0, 0, 0, PROBE_T_PHASE == 6};
#if FFN_DOWN_FP8
        pg8::EpiSwigluF8 E{(unsigned char*)HFF, DFF, -1.4426950408889634f, 4.f};
        pg8::gemm_phase<pg8::EpiSwigluF8, pg8::DenseSched, true>(F.lds, F.wave, D, S, E);
#else
        pg8::EpiSwiglu E{HFF, DFF};
        pg8::gemm_phase<pg8::EpiSwiglu, pg8::DenseSched, true>(F.lds, F.wave, D, S, E);
#endif
        TAIL_FILL(3168 - 12 * 256, TF_K, TF_B6);
    }
    SEAM(6);

    REP_7 if (IN(7)) {
#if FFN_DOWN_FP8
        pg8::DenseSchedF8 S{(const char*)HFF, (const char*)(ws + WS_W2), DFF, DFF, F.G, (int)blockIdx.x, MALL / 256, 4, 0};
        pg8::EpiPlain E{OY, D, 1.f / 512.f};
        pg8::gemm_phase<pg8::EpiPlain, pg8::DenseSchedF8, true, true>(F.lds, F.wave, DFF, S, E);
#else
        pg8::DenseSched S{(const char*)HFF, (const char*)(ws + WS_W2), DFF, DFF, F.G, (int)blockIdx.x, MALL / 256, 4, 0, 0, 0, 0, 0, 0};
        pg8::EpiPlain E{OY, D, 1.f};
        pg8::gemm_phase<pg8::EpiPlain, pg8::DenseSched, true>(F.lds, F.wave, DFF, S, E);
#endif
        TAIL_FILL(576 - 2 * 256, TF_K4, TF_B7);
    }
    SEAM(7);

    if (IN(8)) {
        KArgP AP = KARG();
        const float* gpost = AP->in[9]; const float* gpre = AP->in[6] + D;
#pragma unroll 1
        for (int seg = 0; seg < 2; ++seg) {
            const int nr = seg ? 2 : 16; const int m0 = seg ? MLAT + gw * 2 : gw * 16; const int r17 = seg ? 16 : (m0 >> 11);
            const float* msr = MS + (size_t)r17 * 6144; const float* msr1 = MS + (size_t)(17 + r17) * 6144;
            const ResP RP = ld_resp(gpost, msr + 5 * 1024, F.lane); const ModP MP = ld_modp(gpre, msr1, msr1 + 1024, F.lane);
            Row xn = ld_row_bf16(XB + (size_t)m0 * D, F.lane), yn = ld_row_bf16(OY + (size_t)m0 * D, F.lane);
            for (int i = 0; i < nr; ++i) {
                Row x = xn; const Row y = yn; if (i + 1 < nr) { xn = ld_row_bf16(XB + (size_t)(m0 + i + 1) * D, F.lane); yn = ld_row_bf16(OY + (size_t)(m0 + i + 1) * D, F.lane); }
                row_residual2(x, y, RP);
                if (!seg) st_row_bf16(XB + (size_t)(m0 + i) * D, F.lane, x);
                st_row_bf16(HA + (size_t)(m0 + i) * D, F.lane, row_modulate2(x, MP));
            }
        }
    }
    SEAM(8);

    REP_9 if (IN(9)) {
        pg8::DenseSched S{(const char*)HA, (const char*)(ws + WS_WIN + (size_t)NIN * D * 2), D, D, F.G, (int)blockIdx.x, MLAT / 256, 10, 0, 0, MCTX / 256, 4, MLAT, 4};
        LAS float* rl = (LAS float*)(F.lds + ROPE_LDS); for (int i = F.tid; i < 2048; i += NWAVES * 64) rl[i] = ropec[i]; __syncthreads();
        pg8::EpiInProj E{P, rl, rl + 1024};
        pg8::gemm_phase<pg8::EpiInProj, pg8::DenseSched, true>(F.lds, F.wave, D, S, E);
        TAIL_FILL(1344 - 5 * 256, TF_K, TF_B9);
    }
    SEAM(9);

    if (IN(10)) { ATTN_PHASE(1, false); }
    SEAM(10);

    REP_11 if (IN(11)) {
        pg8::DenseSched S{(const char*)P, (const char*)(ws + WS_WOUT + (size_t)D * D * 2), NIN, D, F.G, (int)blockIdx.x, MLAT / 256, 4, 0, 0, 0, 0, 0, 0};
        pg8::EpiPlain E{OY, D, 1.f};
        pg8::gemm_phase<pg8::EpiPlain, pg8::DenseSched, true>(F.lds, F.wave, D, S, E);
    }
    SEAM(11);

    RGN(0);
    if (IN(12)) {
        KArgP AP = KARG();
        const float* gpost = AP->in[7] + D; const float* gpre = AP->in[8] + D;
        LAS float* rw = (LAS float*)F.lds;
        LAS int* lcnt = (LAS int*)(F.lds + 32768);
        LAS int* rec = (LAS int*)(F.lds + 32768 + 256);
        for (int i = F.tid; i < 8192; i += 512) rw[(i & 7) * 1024 + (i >> 3)] = AP->in[24][i];
        if (F.tid < 16) lcnt[F.tid] = 0;
        __syncthreads();
        const int m0 = gw * 16; const int r17 = m0 >> 11; const float* msr1 = MS + (size_t)(17 + r17) * 6144;
        const ResP RP = ld_resp(gpost, msr1 + 2 * 1024, F.lane); const ModP MP = ld_modp(gpre, msr1 + 3 * 1024, msr1 + 4 * 1024, F.lane);
        Row xn = ld_row_bf16(XB + (size_t)m0 * D, F.lane), on = ld_row_bf16(OY + (size_t)m0 * D, F.lane);
        for (int i = 0; i < 16; ++i) {
            const int m = m0 + i;
            Row x = xn; const Row o = on; if (i + 1 < 16) { xn = ld_row_bf16(XB + (size_t)(m + 1) * D, F.lane); on = ld_row_bf16(OY + (size_t)(m + 1) * D, F.lane); }
            row_residual2(x, o, RP);
            st_row_bf16(XB + (size_t)m * D, F.lane, x);
            const Row f = row_modulate2(x, MP);
            { unsigned* fo = (unsigned*)((unsigned char*)HA + (size_t)m * D) + F.lane;
#pragma unroll
              for (int j = 0; j < 4; ++j) fo[64 * j] = pg8::pk_fp8x4(f.v[j][0] * 4.f, f.v[j][1] * 4.f, f.v[j][2] * 4.f, f.v[j][3] * 4.f); }
            float lg[8];
#pragma unroll
            for (int e = 0; e < 8; ++e) { float a = 0.f;
#pragma unroll
                for (int j = 0; j < 4; ++j) { const f32x4 w = *(const LAS f32x4*)(rw + e * 1024 + 4 * (F.lane + 64 * j)); a += (f.v[j][0] * w[0] + f.v[j][1] * w[1]) + (f.v[j][2] * w[2] + f.v[j][3] * w[3]); }
                lg[e] = wave_sum(a); }
            int e1 = 0; float v1 = lg[0];
#pragma unroll
            for (int e = 1; e < 8; ++e) if (lg[e] > v1) { v1 = lg[e]; e1 = e; }
            int e2 = -1; float v2 = -3.0e38f;
#pragma unroll
            for (int e = 0; e < 8; ++e) if (e != e1 && lg[e] > v2) { v2 = lg[e]; e2 = e; }
            if (F.lane == 0) {
                const float w1 = 1.f / (1.f + __expf(v2 - v1));
                tok_e[m * 2] = e1; tok_e[m * 2 + 1] = e2; tok_g[m * 2] = w1; tok_g[m * 2 + 1] = 1.f - w1;
                const int l1 = __hip_atomic_fetch_add(lcnt + e1, 1, __ATOMIC_RELAXED, __HIP_MEMORY_SCOPE_WORKGROUP), l2 = __hip_atomic_fetch_add(lcnt + e2, 1, __ATOMIC_RELAXED, __HIP_MEMORY_SCOPE_WORKGROUP);
                LAS int* rr = rec + (F.wave * 16 + i) * 4; rr[0] = e1; rr[1] = e2; rr[2] = l1; rr[3] = l2;
            }
        }
        __syncthreads();
        if (F.tid < 8) lcnt[8 + F.tid] = (int)__hip_atomic_fetch_add(F.ctl + CW_CNT + 64 * F.tid, (unsigned)lcnt[F.tid], RLX_AGENT);
        __syncthreads();
        if (F.lane < 16) { const int m = m0 + F.lane; const LAS int* rr = rec + (F.wave * 16 + F.lane) * 4;
            const int r1 = lcnt[8 + rr[0]] + rr[2], r2 = lcnt[8 + rr[1]] + rr[3];
            tok_rank[m * 2] = r1; tok_rank[m * 2 + 1] = r2; slot_token[rr[0] * 32768 + r1] = m; slot_token[rr[1] * 32768 + r2] = m; }
        __syncthreads();
        convert_range(F.lds, F.wave, lane_id_v(), KARG(), CV_L0 + TF_END + gw, NGW, CV_N);
    }
    RGN(5);
    SEAM(12);

    {
        MoeTab T; T.pbase[8] = 0;
        if (hi > 13 && lo < 23) moe_tab(F.ctl, T);
        const int ptot = T.pbase[8];
        REP_13 for (int ch = 0; ch < 2; ++ch) {
            const int p0 = ch * 128; const int nM = ch ? ptot - 128 : (ptot < 128 ? ptot : 128);
            REP_14 if (IN(13 + 2 * ch) && nM > 0) {
                MoeUpSched S{(const char*)HA, (const char*)(ws + WS_MW13), slot_token, F.G, (int)blockIdx.x, p0, nM, T, PROBE_T_PHASE == 13};
                pg8::EpiSwigluF8 E{(unsigned char*)HFF, DEXP, -1.4426950408889634f / 512.f, 4.f / (512.f * 512.f)};
                pg8::gemm_phase<pg8::EpiSwigluF8, MoeUpSched, true, true>(F.lds, F.wave, D, S, E);
            }
            if (IN(13 + 2 * ch) && IN(14 + 2 * ch) && nM > 0) xcd_barrier(bar, F.wave);
            REP_15 if (IN(14 + 2 * ch) && nM > 0) {
                MoeDownSched S{(const char*)HFF, (const char*)(ws + WS_MW2), F.G, (int)blockIdx.x, p0, nM, T, PROBE_T_PHASE == 14};
                pg8::EpiPlain E{YS, D, 1.f / 512.f};
                pg8::gemm_phase<pg8::EpiPlain, MoeDownSched, true, true>(F.lds, F.wave, DEXP, S, E);
            }
            if (IN(14 + 2 * ch) && IN(15 + 2 * ch) && nM > 0) xcd_barrier(bar, F.wave);
        }
    }

    RGN(0);
    if (IN(23)) {
        MoeTab T; moe_tab(F.ctl, T);
        const float* gpost = KARG()->in[9] + D;
#define YS_ROWS(mm, S1, S2) do { const int e1_ = tok_e[(mm) * 2], e2_ = tok_e[(mm) * 2 + 1]; int pb1_ = 0, pb2_ = 0; \
            _Pragma("unroll") for (int e = 0; e < 8; ++e) { pb1_ = (e1_ == e) ? T.pbase[e] : pb1_; pb2_ = (e2_ == e) ? T.pbase[e] : pb2_; } \
            S1 = (size_t)pb1_ * 256 + tok_rank[(mm) * 2]; S2 = (size_t)pb2_ * 256 + tok_rank[(mm) * 2 + 1]; } while (0)
        const int m0 = gw * 16; const int r17 = m0 >> 11; const float* msr1 = MS + (size_t)(17 + r17) * 6144;
        const ResP RP = ld_resp(gpost, msr1 + 5 * 1024, F.lane);
        size_t s1, s2; YS_ROWS(m0, s1, s2);
        Row xn = ld_row_bf16(XB + (size_t)m0 * D, F.lane), yan = ld_row_bf16(YS + s1 * D, F.lane), ybn = ld_row_bf16(YS + s2 * D, F.lane);
        float* outp = KARG()->out;
        for (int i = 0; i < 16; ++i) {
            const int m = m0 + i;
            Row x = xn; const Row ya = yan, yb = ybn; const float g1 = tok_g[m * 2], g2 = tok_g[m * 2 + 1];
            if (i + 1 < 16) { YS_ROWS(m + 1, s1, s2); xn = ld_row_bf16(XB + (size_t)(m + 1) * D, F.lane); yan = ld_row_bf16(YS + s1 * D, F.lane); ybn = ld_row_bf16(YS + s2 * D, F.lane); }
            Row y;
#pragma unroll
            for (int j = 0; j < 4; ++j) y.v[j] = ya.v[j] * g1 + yb.v[j] * g2;
            row_residual2(x, y, RP);
            st_row_f32(outp + (size_t)m * D, F.lane, x);
        }
    }
    RGN(6);
#if PROBE_T
    if (blockIdx.x == 0 && F.wave == 0) { const unsigned ticks = ((volatile LAS unsigned*)(F.lds + MISC_OFF))[16 + PROBE_T]; const unsigned long long t0 = __builtin_amdgcn_s_memrealtime();
        while (__builtin_amdgcn_s_memrealtime() - t0 < (unsigned long long)ticks * 8ull) __builtin_amdgcn_s_sleep(8); }
#endif
#undef TAIL_FILL
#undef IN
#undef SEAM
#undef ATTN_PHASE
}

extern "C" void kernel_launch(void* const* d_in, const int* in_sizes, int n_in, void* d_out, int out_size, void* d_ws, size_t ws_size, hipStream_t stream) {
    static int grid = 0;
    if (grid == 0) {
        if (n_in != 28 || out_size != MLAT * D || ws_size < WS_END) { fprintf(stderr, "kernel_launch: unexpected shapes (n_in %d, out %d, ws %zu)\n", n_in, out_size, ws_size); grid = -1; return; }
        int dev = 0, cus = 0, per_cu = 0;
        if (hipGetDevice(&dev) != hipSuccess || hipDeviceGetAttribute(&cus, hipDeviceAttributeMultiprocessorCount, dev) != hipSuccess) { grid = -1; return; }
        if (hipFuncSetAttribute((const void*)mk_fwd, hipFuncAttributeMaxDynamicSharedMemorySize, LDS_BYTES) != hipSuccess) { fprintf(stderr, "kernel_launch: hipFuncSetAttribute failed\n"); grid = -1; return; }
        if (hipOccupancyMaxActiveBlocksPerMultiprocessor(&per_cu, (const void*)mk_fwd, NWAVES * 64, LDS_BYTES) != hipSuccess || per_cu < 1) { fprintf(stderr, "kernel_launch: occupancy query says %d\n", per_cu); (void)hipGetLastError(); }
        grid = cus;
        if (grid != 256) { fprintf(stderr, "kernel_launch: built for 256 CUs, found %d\n", grid); grid = -1; return; }
    }
    if (grid < 0) return;
    (void)hipMemsetAsync((char*)d_ws + WS_CTL, 0, CTL_ZERO_BYTES, stream);
    Args a{};
    for (int i = 0; i < 28; ++i) a.in[i] = (const float*)d_in[i];
    a.out = (float*)d_out; a.ws = (unsigned char*)d_ws;
#if MK_PER_PHASE
    for (int p = 0; p < N_PHASES; ++p) { a.ph_lo = p; a.ph_hi = p + 1; hipLaunchKernelGGL(mk_fwd, dim3(grid), dim3(NWAVES * 64), LDS_BYTES, stream, a); }
#else
    a.ph_lo = 0; a.ph_hi = N_PHASES;
    hipLaunchKernelGGL(mk_fwd, dim3(grid), dim3(NWAVES * 64), LDS_BYTES, stream, a);
#endif
}
```

```cpp
#include <hip/hip_runtime.h>
#include <cstdio>
#include <cstdint>

#ifndef DBG_NO_SG
#define DBG_NO_SG 0
#endif
#ifndef DBG_NO_CTX
#define DBG_NO_CTX 0
#endif
#ifndef DBG_NO_LAT
#define DBG_NO_LAT 0
#endif
#ifndef PROBE_T
#define PROBE_T 0
#endif
#ifndef PROBE_T_PHASE
#define PROBE_T_PHASE 6
#endif
#ifndef FFN_DOWN_FP8
#define FFN_DOWN_FP8 1
#endif
#ifndef MK_PER_PHASE
#define MK_PER_PHASE 0
#endif

#define LAS __attribute__((address_space(3)))
#define GAS __attribute__((address_space(1)))
typedef unsigned short bf16_t;
typedef short bf16x8 __attribute__((ext_vector_type(8)));
typedef short s16x4 __attribute__((ext_vector_type(4)));
typedef float f32x2 __attribute__((ext_vector_type(2)));
typedef float f32x4 __attribute__((ext_vector_type(4)));
typedef float f32x16 __attribute__((ext_vector_type(16)));
typedef unsigned u32x2 __attribute__((ext_vector_type(2)));
typedef unsigned u32x4 __attribute__((ext_vector_type(4)));
typedef GAS unsigned gu32;
typedef int v8i __attribute__((ext_vector_type(8)));
typedef int v4i __attribute__((ext_vector_type(4)));

constexpr int D = 1024, BATCH = 16, SEQ = 2048, CTX = 256;
constexpr int MLAT = BATCH * SEQ;
constexpr int MCTX = BATCH * CTX;
constexpr int MALL = MLAT + MCTX;
constexpr int NIN = 2560;
constexpr int COL_Q = 0, COL_U = 512, COL_K = 1024, COL_V = 1536, COL_G = 2048;
constexpr int DFF = 2816, DEXP = 3584, NEXP = 8;
constexpr float EPS = 1e-6f;
constexpr float LAMBDA_INIT0 = 0.2f, LAMBDA_INIT1 = 0.35550907f;

constexpr size_t MiB = 1u << 20;
constexpr size_t WS_CTL = 0, CTL_ZERO_BYTES = 1 * MiB;
constexpr size_t WS_MS = 1 * MiB;
constexpr size_t WS_ROPE = 2 * MiB;
constexpr size_t WS_ROUTE = 3 * MiB;
constexpr size_t WS_SLOT = 4 * MiB;
constexpr size_t WS_WIN = 5 * MiB;
constexpr size_t WS_WOUT = 15 * MiB;
constexpr size_t WS_SGW = 19 * MiB;
constexpr size_t WS_W13 = 20 * MiB;
constexpr size_t WS_W2 = 31 * MiB;
constexpr size_t WS_MW13 = 37 * MiB;
constexpr size_t WS_MW2 = 93 * MiB;
constexpr size_t WS_XB = 121 * MiB;
constexpr size_t WS_HA = 221 * MiB;
constexpr size_t WS_R1 = 293 * MiB;
constexpr size_t WS_OY = 491 * MiB;
constexpr size_t WS_F8 = 5 * MiB;
constexpr size_t WS_HF8 = 221 * MiB;
constexpr size_t WS_YS = 452 * MiB;
constexpr size_t WS_END = 584 * MiB;

constexpr int CW_BAR = 4096;
constexpr int CW_CNT = 64;

constexpr int RING_BYTES = 131072;
constexpr int LDSCTL_OFF = RING_BYTES, MISC_OFF = LDSCTL_OFF + 320;
constexpr int LDS_BYTES = 147456;
constexpr int ROPE_LDS = RING_BYTES + 6144;
static_assert(ROPE_LDS + 8192 <= LDS_BYTES, "LDS map");
constexpr int NWAVES = 8;

#define RLX_AGENT __ATOMIC_RELAXED, __HIP_MEMORY_SCOPE_AGENT
#define LDS_WAIT() asm volatile("s_waitcnt lgkmcnt(0)" ::: "memory")
#define VM_WAIT() asm volatile("s_waitcnt vmcnt(0)" ::: "memory")
#define SBAR() __builtin_amdgcn_sched_barrier(0)

__device__ __forceinline__ unsigned cvt_pk_bf16(float lo, float hi) { unsigned r; asm volatile("v_cvt_pk_bf16_f32 %0, %1, %2" : "=v"(r) : "v"(lo), "v"(hi)); return r; }
__device__ __forceinline__ float bf2f(unsigned short b) { return __builtin_bit_cast(float, (unsigned)b << 16); }
__device__ __forceinline__ float bflo(unsigned w) { return __builtin_bit_cast(float, w << 16); }
__device__ __forceinline__ float bfhi(unsigned w) { return __builtin_bit_cast(float, w & 0xffff0000u); }
__device__ __forceinline__ float wave_sum(float v) {
#pragma unroll
    for (int o = 1; o < 64; o <<= 1) v += __shfl_xor(v, o);
    return v;
}
__device__ __forceinline__ int lane_id_v() { int l; asm volatile("v_mbcnt_lo_u32_b32 %0, -1, 0\n\tv_mbcnt_hi_u32_b32 %0, -1, %0" : "=v"(l)); return l; }
__device__ __forceinline__ float silu_f(float v) { return v / (1.f + __expf(-v)); }

namespace pg8 {
constexpr int BM = 256, BK = 64, HALF = 128, HTB = HALF * BK * 2, STAGE_BYTES = 8 * HTB, NXCD = 8, WGM = 4;
constexpr int IDX_OFF = STAGE_BYTES + 4096;
__host__ __device__ __forceinline__ int lds_byte(int r, int c) { const int st = (r >> 4) * 2 + (c >> 5), rr = r & 15, cc = c & 31, ob = rr * 64 + cc * 2; return st * 1024 + (ob ^ (((ob >> 9) & 1) << 5)); }
__host__ __device__ __forceinline__ void stage_rc(int b, int& R, int& C) { const int st = b / 1024, sb = b % 1024, swz = sb ^ (((sb >> 9) & 1) << 5); R = (st >> 1) * 16 + swz / 64; C = (st & 1) * 32 + (swz % 64) / 2; }
__host__ __device__ __forceinline__ int perm32(int rho) { const int n = rho >> 4, i = rho & 15; return 8 * (i >> 2) + 4 * n + (i & 3); }

struct Unit { const char* Ap; const char* Bp; int pm, pn, aux, aux2; };

__device__ __forceinline__ void tile_of(int L, int nM, int nN, int& pm, int& pn) {
    const int nwg = nM * nN; int wgid = L;
    { const int q = nwg / NXCD, r = nwg % NXCD, xcd = wgid % NXCD, off = wgid / NXCD; wgid = (xcd < r ? xcd * (q + 1) : r * (q + 1) + (xcd - r) * q) + off; }
    const int nig = WGM * nN, gid = wgid / nig, fm = gid * WGM, gsz = (nM - fm) < WGM ? (nM - fm) : WGM;
    pm = fm + ((wgid % nig) % gsz); pn = (wgid % nig) / gsz;
}

template <class Epi, class Sched, bool ALIGN_EPI, bool FP8 = false>
__device__ __forceinline__ void gemm_phase(LAS unsigned char* lds, const int wid, const int K, const Sched& S, const Epi& E) {
    const int lane = lane_id_v(), tid = wid * 64 + lane;
    const int wr = wid >> 2, wc = wid & 3, fr = lane & 15, fq = lane >> 4;
    const int kbytes = FP8 ? K : 2 * K;
    const int nt = kbytes / 128;
    int R[2], C[2]; unsigned voffB[2];
#pragma unroll
    for (int i = 0; i < 2; ++i) { stage_rc(tid * 16 + i * 8192, R[i], C[i]); const int Rb = Epi::PERM ? ((R[i] & ~31) + perm32(R[i] & 31)) : R[i]; voffB[i] = (unsigned)(Rb * kbytes + C[i] * 2); }
    const size_t kstep = (size_t)(BK * 2);
    const size_t hstepB = (size_t)HALF * kbytes;
    const unsigned ldsw = (unsigned)wid * 1024u;
    const int aoff = lds_byte(wr * 64 + fr, fq * 8), boff = lds_byte(wc * 32 + fr, fq * 8);
#define PG8_SA(b, h) (((b) * 2 + (h)) * HTB)
#define PG8_SB(b, h) ((4 + (b) * 2 + (h)) * HTB)
#define PG8_STAGE(bufoff, gbase, voff) do { _Pragma("unroll") for (int _i = 0; _i < 2; ++_i) \
        __builtin_amdgcn_global_load_lds((const unsigned*)((const char*)(gbase) + (voff)[_i]), (LAS unsigned*)(lds + (bufoff) + ldsw + _i * 8192), 16, 0, 0); } while (0)
#define PG8_LDA(dst, b, h) do { _Pragma("unroll") for (int m = 0; m < 4; ++m) { const v4i _lo = *(const LAS v4i*)(lds + PG8_SA(b, h) + aoff + m * 2048), _hi = *(const LAS v4i*)(lds + PG8_SA(b, h) + aoff + m * 2048 + 1024); \
        dst[m] = __builtin_shufflevector(_lo, _hi, 0, 1, 2, 3, 4, 5, 6, 7); } } while (0)
#define PG8_LDB(dst, b, h) do { _Pragma("unroll") for (int n = 0; n < 2; ++n) { const v4i _lo = *(const LAS v4i*)(lds + PG8_SB(b, h) + boff + n * 2048), _hi = *(const LAS v4i*)(lds + PG8_SB(b, h) + boff + n * 2048 + 1024); \
        dst[n] = __builtin_shufflevector(_lo, _hi, 0, 1, 2, 3, 4, 5, 6, 7); } } while (0)
#define PG8_LO(x) __builtin_bit_cast(bf16x8, __builtin_shufflevector(x, x, 0, 1, 2, 3))
#define PG8_HI(x) __builtin_bit_cast(bf16x8, __builtin_shufflevector(x, x, 4, 5, 6, 7))
#define PG8_MMA(ai, bj, At, Bt) do { __builtin_amdgcn_s_setprio(1); \
        if constexpr (FP8) { _Pragma("unroll") for (int m = 0; m < 4; ++m) _Pragma("unroll") for (int n = 0; n < 2; ++n) \
            asm volatile("v_mfma_f32_16x16x128_f8f6f4 %0, %1, %2, %0" : "+v"(acc[ai][bj][m][n]) : "v"(Bt[n]), "v"(At[m])); } \
        else { _Pragma("unroll") for (int m = 0; m < 4; ++m) _Pragma("unroll") for (int n = 0; n < 2; ++n) { \
            acc[ai][bj][m][n] = __builtin_amdgcn_mfma_f32_16x16x32_bf16(PG8_LO(Bt[n]), PG8_LO(At[m]), acc[ai][bj][m][n], 0, 0, 0); \
            acc[ai][bj][m][n] = __builtin_amdgcn_mfma_f32_16x16x32_bf16(PG8_HI(Bt[n]), PG8_HI(At[m]), acc[ai][bj][m][n], 0, 0, 0); } } \
        __builtin_amdgcn_s_setprio(0); } while (0)
#define PG8_WAIT_V(n) asm volatile("s_waitcnt vmcnt(" #n ")" ::: "memory")
#define PG8_WAIT_L(n) asm volatile("s_waitcnt lgkmcnt(" #n ")" ::: "memory")
#define PG8_BAR __builtin_amdgcn_s_barrier()
#define PG8_SCHED __builtin_amdgcn_sched_barrier(0)
#if PROBE_T
    volatile LAS unsigned* tacc = (volatile LAS unsigned*)(lds + MISC_OFF) + 16;
#define PG8_T(n) do { if (S.tprobe && wid == 0 && blockIdx.x == 0 && lane == 0) { const unsigned _now = (unsigned)__builtin_amdgcn_s_memrealtime(); tacc[n] += _now - tacc[0]; tacc[0] = _now; } } while (0)
#else
#define PG8_T(n) do {} while (0)
#endif
    Unit cur, nxt; int ui = 0;
    if (!S.next(0, cur)) return;
    f32x4 acc[2][2][4][2];
#pragma unroll
    for (int a = 0; a < 2; ++a)
#pragma unroll
        for (int b = 0; b < 2; ++b)
#pragma unroll
            for (int m = 0; m < 4; ++m)
#pragma unroll
                for (int n = 0; n < 2; ++n) acc[a][b][m][n] = (f32x4){0.f, 0.f, 0.f, 0.f};
    v8i At[4], B0[2], B1[2];
    unsigned cO0[2], cO1[2], nO0[2], nO1[2];
    S.aoff(cur, R, C, cO0, cO1);
    const char* cA = cur.Ap; const char* cB = cur.Bp;
    PG8_STAGE(PG8_SB(0, 0), cB, voffB); PG8_STAGE(PG8_SB(0, 1), cB + hstepB, voffB); PG8_STAGE(PG8_SA(0, 0), cA, cO0); PG8_STAGE(PG8_SA(0, 1), cA, cO1);
    if (wr == 1) PG8_BAR;
    PG8_WAIT_V(2); PG8_BAR;
    PG8_STAGE(PG8_SB(1, 0), cB + kstep, voffB); PG8_STAGE(PG8_SA(1, 0), cA + kstep, cO0); PG8_STAGE(PG8_SB(1, 1), cB + hstepB + kstep, voffB);
    PG8_WAIT_V(6); PG8_BAR;
    PG8_T(7);
    for (;;) {
        const bool has_next = S.next(ui + 1, nxt);
        if constexpr (Sched::GATHER) { if (has_next) S.prefetch_idx(nxt, lds + IDX_OFF, wid, lane); nO0[0] = cO0[0]; nO0[1] = cO0[1]; nO1[0] = cO1[0]; nO1[1] = cO1[1]; }
        const char* nA = has_next ? nxt.Ap : cA; const char* nB = has_next ? nxt.Bp : cB;
        PG8_T(4);
        for (int t = 0; t < nt; t += 2) {
            const bool last = (t == nt - 2);
            const char* a1 = cA + (size_t)(t + 1) * kstep;
            const char* a2 = last ? nA : cA + (size_t)(t + 2) * kstep; const char* b2 = last ? nB : cB + (size_t)(t + 2) * kstep;
            const char* a3 = a2 + kstep; const char* b3 = b2 + kstep;
            unsigned xO0[2], xO1[2];
            if constexpr (Sched::GATHER) { if (last && has_next) S.aoff_lds(R, C, lds + IDX_OFF, nO0, nO1); }
            if constexpr (Sched::GATHER) { xO0[0] = last ? nO0[0] : cO0[0]; xO0[1] = last ? nO0[1] : cO0[1]; xO1[0] = last ? nO1[0] : cO1[0]; xO1[1] = last ? nO1[1] : cO1[1]; }
            else { xO0[0] = cO0[0]; xO0[1] = cO0[1]; xO1[0] = cO1[0]; xO1[1] = cO1[1]; }
            const int relax = __builtin_amdgcn_readfirstlane((t == 0 && ui > 0) ? 1 : 0);
#define PG8_WAIT_VR() do { if constexpr (Epi::NSTORES == 16) asm volatile("s_cmp_eq_u32 %0, 0\n\ts_cbranch_scc1 .Lwv%=\n\ts_waitcnt vmcnt(24)\n\ts_branch .Lwe%=\n.Lwv%=:\n\ts_waitcnt vmcnt(8)\n.Lwe%=:" :: "s"(relax) : "memory", "scc"); \
        else asm volatile("s_cmp_eq_u32 %0, 0\n\ts_cbranch_scc1 .Lwv%=\n\ts_waitcnt vmcnt(16)\n\ts_branch .Lwe%=\n.Lwv%=:\n\ts_waitcnt vmcnt(8)\n.Lwe%=:" :: "s"(relax) : "memory", "scc"); } while (0)
            PG8_LDB(B0, 0, 0); PG8_LDB(B1, 0, 1); PG8_SCHED; PG8_LDA(At, 0, 0); PG8_STAGE(PG8_SA(1, 1), a1, cO1);
            PG8_WAIT_VR(); PG8_WAIT_L(0); PG8_BAR; PG8_MMA(0, 0, At, B0); PG8_MMA(0, 1, At, B1); PG8_BAR; PG8_SCHED;
            PG8_LDA(At, 0, 1); PG8_STAGE(PG8_SB(0, 0), b2, voffB); PG8_STAGE(PG8_SB(0, 1), b2 + hstepB, voffB); PG8_STAGE(PG8_SA(0, 0), a2, xO0);
            PG8_WAIT_VR(); PG8_WAIT_L(0); PG8_BAR; PG8_MMA(1, 0, At, B0); PG8_MMA(1, 1, At, B1); PG8_BAR; PG8_SCHED;
            PG8_LDB(B0, 1, 0); PG8_LDB(B1, 1, 1); PG8_SCHED; PG8_LDA(At, 1, 0); PG8_STAGE(PG8_SA(0, 1), a2, xO1);
            PG8_WAIT_V(8); PG8_WAIT_L(0); PG8_BAR; PG8_MMA(0, 0, At, B0); PG8_MMA(0, 1, At, B1); PG8_BAR; PG8_SCHED;
#undef PG8_WAIT_VR
            PG8_LDA(At, 1, 1); PG8_STAGE(PG8_SB(1, 0), b3, voffB); PG8_STAGE(PG8_SB(1, 1), b3 + hstepB, voffB); PG8_STAGE(PG8_SA(1, 0), a3, xO0);
            PG8_WAIT_V(8); PG8_WAIT_L(0); PG8_BAR; PG8_MMA(1, 0, At, B0); PG8_MMA(1, 1, At, B1); PG8_BAR; PG8_SCHED;
        }
        PG8_T(1);
        if constexpr (ALIGN_EPI) { if (wr == 0) PG8_BAR; }
        PG8_T(2);
        if constexpr (FP8) asm volatile("s_nop 15\n\ts_nop 15\n\ts_nop 15\n\ts_nop 15\n\ts_nop 15\n\ts_nop 15" ::: "memory");
        E(acc, cur, wr, wc, fr, fq);
        PG8_T(3);
        if (!has_next) break;
#pragma unroll
        for (int a = 0; a < 2; ++a)
#pragma unroll
            for (int b = 0; b < 2; ++b)
#pragma unroll
                for (int m = 0; m < 4; ++m)
#pragma unroll
                    for (int n = 0; n < 2; ++n) acc[a][b][m][n] = (f32x4){0.f, 0.f, 0.f, 0.f};
        cur = nxt; cA = nA; cB = nB; ++ui;
        if constexpr (Sched::GATHER) { cO0[0] = nO0[0]; cO0[1] = nO0[1]; cO1[0] = nO1[0]; cO1[1] = nO1[1]; }
        if constexpr (ALIGN_EPI) { if (wr == 1) PG8_BAR; }
    }
    PG8_WAIT_V(0);
    if constexpr (!ALIGN_EPI) { if (wr == 0) PG8_BAR; }
    PG8_BAR;
#undef PG8_SA
#undef PG8_SB
#undef PG8_STAGE
#undef PG8_LDA
#undef PG8_LDB
#undef PG8_MMA
#undef PG8_LO
#undef PG8_HI
#undef PG8_WAIT_V
#undef PG8_WAIT_L
#undef PG8_BAR
#undef PG8_SCHED
#undef PG8_T
}

struct DenseSched {
    static constexpr bool GATHER = false;
    const char* A; const char* Bt; int lda, K, G, c;
    int nM0, nN0, arow0_0, pn0_0, nM1, nN1, arow0_1, pn0_1; int tprobe;
    __device__ __forceinline__ bool next(int i, Unit& u) const {
        int L = i * G + c; const int n0 = nM0 * nN0;
        int pm, pn;
        if (L < n0) { tile_of(L, nM0, nN0, pm, pn); u.pm = arow0_0 / 256 + pm; u.pn = pn0_0 + pn; }
        else { L -= n0; if (L >= nM1 * nN1) return false; tile_of(L, nM1, nN1, pm, pn); u.pm = arow0_1 / 256 + pm; u.pn = pn0_1 + pn; }
        u.Ap = A + (size_t)u.pm * 256 * lda * 2; u.Bp = Bt + (size_t)u.pn * 256 * K * 2; u.aux = 0; u.aux2 = 0; return true;
    }
    __device__ __forceinline__ void aoff(const Unit&, const int (&R)[2], const int (&C)[2], unsigned (&o0)[2], unsigned (&o1)[2]) const {
#pragma unroll
        for (int i = 0; i < 2; ++i) { o0[i] = (unsigned)(R[i] * lda + C[i]) * 2u; o1[i] = (unsigned)((HALF + R[i]) * lda + C[i]) * 2u; }
    }
};

struct DenseSchedF8 {
    static constexpr bool GATHER = false;
    const char* A; const char* Bt; int lda, K, G, c, nM, nN; int tprobe;
    __device__ __forceinline__ bool next(int i, Unit& u) const {
        const int L = i * G + c; if (L >= nM * nN) return false;
        int pm, pn; tile_of(L, nM, nN, pm, pn); u.pm = pm; u.pn = pn;
        u.Ap = A + (size_t)pm * 256 * lda; u.Bp = Bt + (size_t)pn * 256 * K; u.aux = 0; u.aux2 = 0; return true;
    }
    __device__ __forceinline__ void aoff(const Unit&, const int (&R)[2], const int (&C)[2], unsigned (&o0)[2], unsigned (&o1)[2]) const {
#pragma unroll
        for (int i = 0; i < 2; ++i) { o0[i] = (unsigned)(R[i] * lda + C[i] * 2); o1[i] = (unsigned)((HALF + R[i]) * lda + C[i] * 2); }
    }
};

struct EpiPlain {
    static constexpr bool PERM = true; static constexpr int NSTORES = 16;
    bf16_t* O; int ldc; float sc;
    __device__ __forceinline__ void operator()(const f32x4 (&acc)[2][2][4][2], const Unit& u, int wr, int wc, int fr, int fq) const {
        const int row0 = u.pm * BM + wr * 64 + fr, col0 = u.pn * BM + wc * 32 + 8 * fq;
#pragma unroll
        for (int ai = 0; ai < 2; ++ai)
#pragma unroll
            for (int m = 0; m < 4; ++m) { bf16_t* rowp = O + (size_t)(row0 + ai * HALF + m * 16) * ldc + col0;
#pragma unroll
                for (int bj = 0; bj < 2; ++bj) { const f32x4 v0 = acc[ai][bj][m][0] * sc, v1 = acc[ai][bj][m][1] * sc;
                    u32x4 w; w.x = cvt_pk_bf16(v0[0], v0[1]); w.y = cvt_pk_bf16(v0[2], v0[3]); w.z = cvt_pk_bf16(v1[0], v1[1]); w.w = cvt_pk_bf16(v1[2], v1[3]);
                    *(u32x4*)(rowp + bj * HALF) = w; } }
    }
};
struct EpiPlainMask {
    static constexpr bool PERM = true; static constexpr int NSTORES = 16;
    bf16_t* O; int ldc;
    __device__ __forceinline__ void operator()(const f32x4 (&acc)[2][2][4][2], const Unit& u, int wr, int wc, int fr, int fq) const {
        const int row0 = wr * 64 + fr, col0 = u.pn * BM + wc * 32 + 8 * fq;
#pragma unroll
        for (int ai = 0; ai < 2; ++ai)
#pragma unroll
            for (int m = 0; m < 4; ++m) { bf16_t* rowp = O + (size_t)(row0 + ai * HALF + m * 16) * ldc + col0;
#pragma unroll
                for (int bj = 0; bj < 2; ++bj) { const f32x4 v0 = acc[ai][bj][m][0], v1 = acc[ai][bj][m][1];
                    u32x4 w; w.x = cvt_pk_bf16(v0[0], v0[1]); w.y = cvt_pk_bf16(v0[2], v0[3]); w.z = cvt_pk_bf16(v1[0], v1[1]); w.w = cvt_pk_bf16(v1[2], v1[3]);
                    *(u32x4*)(rowp + bj * HALF) = w; } }
    }
};
struct EpiNull {
    static constexpr bool PERM = true; static constexpr int NSTORES = 8;
    __device__ __forceinline__ void operator()(const f32x4 (&acc)[2][2][4][2], const Unit&, int, int, int, int) const {
#pragma unroll
        for (int ai = 0; ai < 2; ++ai)
#pragma unroll
            for (int bj = 0; bj < 2; ++bj)
#pragma unroll
                for (int m = 0; m < 4; ++m) asm volatile("" :: "v"(acc[ai][bj][m][0]), "v"(acc[ai][bj][m][1]));
    }
};
struct EpiInProj {
    static constexpr bool PERM = true; static constexpr int NSTORES = 16;
    bf16_t* O; const LAS float* ropec; const LAS float* ropes;
    __device__ __forceinline__ void operator()(const f32x4 (&acc)[2][2][4][2], const Unit& u, int wr, int wc, int fr, int fq) const {
        const int row0 = u.pm * BM + wr * 64 + fr, col0 = u.pn * BM + wc * 32 + 8 * fq;
        const bool rope = (u.pm < MLAT / 256) && (u.pn < 2 || (u.pn >= 4 && u.pn < 6));
        const bool colpos = (wc & 1) != 0;
        const float qs = u.pn < 2 ? 0.18033688011112042f : 1.f;
#pragma unroll
        for (int ai = 0; ai < 2; ++ai)
#pragma unroll
            for (int m = 0; m < 4; ++m) { const int row = row0 + ai * HALF + m * 16; bf16_t* rowp = O + (size_t)row * NIN + col0;
                f32x4 cs = {1.f, 1.f, 1.f, 1.f}, sn = {0.f, 0.f, 0.f, 0.f};
                if (rope) { const int t = row & (SEQ - 1), pos = colpos ? (t & 63) : (t >> 6); cs = *(const LAS f32x4*)(ropec + pos * 16 + 4 * fq); sn = *(const LAS f32x4*)(ropes + pos * 16 + 4 * fq); }
#pragma unroll
                for (int bj = 0; bj < 2; ++bj) { const f32x4 a = acc[ai][bj][m][0] * qs, b = acc[ai][bj][m][1] * qs;
                    const f32x4 v0 = a * cs - b * sn, v1 = b * cs + a * sn;
                    u32x4 w; w.x = cvt_pk_bf16(v0[0], v0[1]); w.y = cvt_pk_bf16(v0[2], v0[3]); w.z = cvt_pk_bf16(v1[0], v1[1]); w.w = cvt_pk_bf16(v1[2], v1[3]);
                    *(u32x4*)(rowp + bj * HALF) = w; } }
    }
};
struct EpiSwiglu {
    static constexpr bool PERM = true; static constexpr int NSTORES = 8;
    bf16_t* O; int ldc;
    __device__ __forceinline__ void operator()(const f32x4 (&acc)[2][2][4][2], const Unit& u, int wr, int wc, int fr, int fq) const {
        const int row0 = u.pm * BM + wr * 64 + fr, col0 = u.pn * HALF + wc * 32 + 8 * fq;
#pragma unroll
        for (int ai = 0; ai < 2; ++ai)
#pragma unroll
            for (int m = 0; m < 4; ++m) { bf16_t* rowp = O + (size_t)(row0 + ai * HALF + m * 16) * ldc + col0;
                f32x2 v[2][2];
#pragma unroll
                for (int n = 0; n < 2; ++n)
#pragma unroll
                    for (int h2 = 0; h2 < 2; ++h2) { const f32x2 a2 = {acc[ai][0][m][n][2 * h2], acc[ai][0][m][n][2 * h2 + 1]}, b2 = {acc[ai][1][m][n][2 * h2], acc[ai][1][m][n][2 * h2 + 1]};
                        const f32x2 mm = a2 * (-1.4426950408889634f); f32x2 e; e.x = __builtin_amdgcn_exp2f(mm.x); e.y = __builtin_amdgcn_exp2f(mm.y);
                        const f32x2 d = e + 1.0f; f32x2 r; r.x = __builtin_amdgcn_rcpf(d.x); r.y = __builtin_amdgcn_rcpf(d.y);
                        v[n][h2] = (a2 * r) * b2; }
                u32x4 w; w.x = cvt_pk_bf16(v[0][0].x, v[0][0].y); w.y = cvt_pk_bf16(v[0][1].x, v[0][1].y); w.z = cvt_pk_bf16(v[1][0].x, v[1][0].y); w.w = cvt_pk_bf16(v[1][1].x, v[1][1].y);
                *(u32x4*)rowp = w; }
    }
};
__device__ __forceinline__ unsigned pk_fp8x4(float a, float b, float c, float d) {
    a = __builtin_amdgcn_fmed3f(a, -448.f, 448.f); b = __builtin_amdgcn_fmed3f(b, -448.f, 448.f); c = __builtin_amdgcn_fmed3f(c, -448.f, 448.f); d = __builtin_amdgcn_fmed3f(d, -448.f, 448.f);
    int p = __builtin_amdgcn_cvt_pk_fp8_f32(a, b, 0, false); p = __builtin_amdgcn_cvt_pk_fp8_f32(c, d, p, true); return (unsigned)p; }
struct EpiSwigluF8 {
    static constexpr bool PERM = true; static constexpr int NSTORES = 8;
    unsigned char* O; int ldc; float k1, k2;
    __device__ __forceinline__ void operator()(const f32x4 (&acc)[2][2][4][2], const Unit& u, int wr, int wc, int fr, int fq) const {
        const int row0 = u.pm * BM + wr * 64 + fr, col0 = u.pn * HALF + wc * 32 + 8 * fq;
#pragma unroll
        for (int ai = 0; ai < 2; ++ai)
#pragma unroll
            for (int m = 0; m < 4; ++m) { unsigned char* rowp = O + (size_t)(row0 + ai * HALF + m * 16) * ldc + col0;
                f32x2 v[2][2];
#pragma unroll
                for (int n = 0; n < 2; ++n)
#pragma unroll
                    for (int h2 = 0; h2 < 2; ++h2) { const f32x2 a2 = {acc[ai][0][m][n][2 * h2], acc[ai][0][m][n][2 * h2 + 1]}, b2 = {acc[ai][1][m][n][2 * h2], acc[ai][1][m][n][2 * h2 + 1]};
                        const f32x2 mm = a2 * k1; f32x2 e; e.x = __builtin_amdgcn_exp2f(mm.x); e.y = __builtin_amdgcn_exp2f(mm.y);
                        const f32x2 d = e + 1.0f; f32x2 r; r.x = __builtin_amdgcn_rcpf(d.x); r.y = __builtin_amdgcn_rcpf(d.y);
                        v[n][h2] = (a2 * r) * (b2 * k2); }
                u32x2 w; w.x = pk_fp8x4(v[0][0].x, v[0][0].y, v[0][1].x, v[0][1].y); w.y = pk_fp8x4(v[1][0].x, v[1][0].y, v[1][1].x, v[1][1].y);
                *(u32x2*)rowp = w; }
    }
};
}

namespace att {
constexpr int LDP = NIN;
constexpr int SHM_V = 64 * 128 * 2, SHM_K = 64 * 128 * 2;
constexpr int OFF_K = 0, OFF_V = 4 * SHM_K, OFF_WS = RING_BYTES + 14336, ATT_LDS = OFF_WS + NWAVES * 64 * 4;
constexpr int OFF_X = 0, OFF_OST = 65536;
static_assert(OFF_V + 4 * SHM_V <= RING_BYTES && ATT_LDS <= LDS_BYTES, "attention LDS");
constexpr float SCALE = 0.125f;
constexpr float THR = 8.f;
#define KSWZ(row, colB) ((row) * 256 + ((colB) ^ (((row) & 7) << 4)))
__device__ __forceinline__ int crow(int r, int hi) { return (r & 3) + 8 * (r >> 2) + 4 * hi; }

constexpr float THRL = 8.f;
template <bool FIRST>
__device__ __forceinline__ void partialSM(f32x16& p0, f32x16& p1, float& mhat, f32x16& negm, float& alpha) {
    float a = fmaxf(fmaxf(p0[0], p0[1]), p1[0]), b = fmaxf(fmaxf(p0[2], p0[3]), p1[1]); a = fmaxf(fmaxf(a, p1[2]), p1[3]);
#pragma unroll
    for (int r = 4; r < 16; r += 4) { a = fmaxf(fmaxf(a, p0[r]), p0[r + 1]); b = fmaxf(fmaxf(b, p0[r + 2]), p0[r + 3]); a = fmaxf(fmaxf(a, p1[r]), p1[r + 1]); b = fmaxf(fmaxf(b, p1[r + 2]), p1[r + 3]); }
    float rm = fmaxf(a, b);
    { auto rr = __builtin_amdgcn_permlane32_swap(__float_as_uint(rm), __float_as_uint(rm), false, false); rm = fmaxf(__uint_as_float(rr[0]), __uint_as_float(rr[1])); }
    alpha = 1.f;
    if (FIRST || __builtin_expect(__any(rm > THRL), 0)) {
        const float dl = FIRST ? rm : fmaxf(rm, 0.f); mhat += dl;
#pragma unroll
        for (int r = 0; r < 16; ++r) { p0[r] -= dl; p1[r] -= dl; }
#pragma unroll
        for (int r = 0; r < 16; ++r) negm[r] = -mhat;
        asm volatile("" : "+v"(negm));
        if (!FIRST) alpha = __builtin_amdgcn_exp2f(-dl);
    }
#pragma unroll
    for (int r = 0; r < 16; ++r) p0[r] = __builtin_amdgcn_exp2f(p0[r]);
}
__device__ __forceinline__ void finishSM(f32x16& p0, f32x16& p1, float alpha, float& l_reg, bf16x8& pa0, bf16x8& pa1, bf16x8& pa2, bf16x8& pa3) {
#pragma unroll
    for (int r = 0; r < 16; ++r) p1[r] = __builtin_amdgcn_exp2f(p1[r]);
    float ps = 0;
#pragma unroll
    for (int r = 0; r < 16; ++r) ps += p0[r];
#pragma unroll
    for (int r = 0; r < 16; ++r) ps += p1[r];
    { auto rr = __builtin_amdgcn_permlane32_swap(__float_as_uint(ps), __float_as_uint(ps), false, false);
      ps = __uint_as_float(rr[0]) + __uint_as_float(rr[1]); }
    l_reg = l_reg * alpha + ps;
#define PK4(P, BASE, OUT) do { u32x4 w = {cvt_pk_bf16(P[BASE + 0], P[BASE + 1]), cvt_pk_bf16(P[BASE + 2], P[BASE + 3]), cvt_pk_bf16(P[BASE + 4], P[BASE + 5]), cvt_pk_bf16(P[BASE + 6], P[BASE + 7])}; OUT = __builtin_bit_cast(bf16x8, w); } while (0)
    PK4(p0, 0, pa0); PK4(p0, 8, pa1); PK4(p1, 0, pa2); PK4(p1, 8, pa3);
#undef PK4
}
__device__ __forceinline__ void qkt(f32x16& p0, f32x16& p1, const char* Ks, const bf16x8 (&qr)[4], const f32x16& negm, int r32, int hi, int cb0) {
#pragma unroll
    for (int d0 = 0; d0 < 4; ++d0) { const int cb = cb0 + (d0 * 16 + hi * 8) * 2;
        const bf16x8 b0 = *reinterpret_cast<const bf16x8*>(Ks + KSWZ(r32, cb));
        const bf16x8 b1 = *reinterpret_cast<const bf16x8*>(Ks + KSWZ(32 + r32, cb));
        if (d0 == 0) { p0 = __builtin_amdgcn_mfma_f32_32x32x16_bf16(b0, qr[0], negm, 0, 0, 0); p1 = __builtin_amdgcn_mfma_f32_32x32x16_bf16(b1, qr[0], negm, 0, 0, 0); }
        else { p0 = __builtin_amdgcn_mfma_f32_32x32x16_bf16(b0, qr[d0], p0, 0, 0, 0); p1 = __builtin_amdgcn_mfma_f32_32x32x16_bf16(b1, qr[d0], p1, 0, 0, 0); } }
}
__device__ __forceinline__ int v_st(int k, int c) { const int kk = (k & ~0xC) | ((k & 4) << 1) | ((k & 8) >> 1); return ((kk >> 3) * 4 + (c >> 5)) * 512 + ((kk & 7) * 32 + (c & 31)) * 2; }
__device__ __forceinline__ int v_rd_base(int lane) { return ((lane & 3) << 3) | (((lane >> 2) & 3) << 6) | (((lane >> 4) & 1) << 5) | (((lane >> 5) & 1) << 11); }
constexpr int v_rd_off(int d0, int ks, int half) { return d0 * 512 + ks * 4096 + half * 256; }
template <int OFF> __device__ __forceinline__ s16x4 tr_read(int vb) {
    s16x4 r; asm volatile("ds_read_b64_tr_b16 %0, %1 offset:%2" : "=&v"(r) : "v"(vb), "i"(OFF) : "memory"); return r;
}
template <int D0> __device__ __forceinline__ void pv_one(f32x16& od, int vb, bf16x8 pa0, bf16x8 pa1, bf16x8 pa2, bf16x8 pa3) {
    const s16x4 l0 = tr_read<v_rd_off(D0, 0, 0)>(vb), h0 = tr_read<v_rd_off(D0, 0, 1)>(vb), l1 = tr_read<v_rd_off(D0, 1, 0)>(vb), h1 = tr_read<v_rd_off(D0, 1, 1)>(vb);
    const s16x4 l2 = tr_read<v_rd_off(D0, 2, 0)>(vb), h2 = tr_read<v_rd_off(D0, 2, 1)>(vb), l3 = tr_read<v_rd_off(D0, 3, 0)>(vb), h3 = tr_read<v_rd_off(D0, 3, 1)>(vb);
    asm volatile("s_waitcnt lgkmcnt(0)" ::: "memory"); SBAR();
#define PKV(L, H) (bf16x8){L[0], L[1], L[2], L[3], H[0], H[1], H[2], H[3]}
    od = __builtin_amdgcn_mfma_f32_32x32x16_bf16(pa0, PKV(l0, h0), od, 0, 0, 0);
    od = __builtin_amdgcn_mfma_f32_32x32x16_bf16(pa1, PKV(l1, h1), od, 0, 0, 0);
    od = __builtin_amdgcn_mfma_f32_32x32x16_bf16(pa2, PKV(l2, h2), od, 0, 0, 0);
    od = __builtin_amdgcn_mfma_f32_32x32x16_bf16(pa3, PKV(l3, h3), od, 0, 0, 0);
#undef PKV
}
struct VFrag { s16x4 l0, h0, l1, h1, l2, h2, l3, h3; };
template <int D0> __device__ __forceinline__ void v_reads(VFrag& f, int vb) {
    f.l0 = tr_read<v_rd_off(D0, 0, 0)>(vb); f.h0 = tr_read<v_rd_off(D0, 0, 1)>(vb); f.l1 = tr_read<v_rd_off(D0, 1, 0)>(vb); f.h1 = tr_read<v_rd_off(D0, 1, 1)>(vb);
    f.l2 = tr_read<v_rd_off(D0, 2, 0)>(vb); f.h2 = tr_read<v_rd_off(D0, 2, 1)>(vb); f.l3 = tr_read<v_rd_off(D0, 3, 0)>(vb); f.h3 = tr_read<v_rd_off(D0, 3, 1)>(vb);
}
__device__ __forceinline__ void v_mfmas(f32x16& od, const VFrag& f, bf16x8 pa0, bf16x8 pa1, bf16x8 pa2, bf16x8 pa3) {
#define PKV(L, H) (bf16x8){L[0], L[1], L[2], L[3], H[0], H[1], H[2], H[3]}
    od = __builtin_amdgcn_mfma_f32_32x32x16_bf16(pa0, PKV(f.l0, f.h0), od, 0, 0, 0);
    od = __builtin_amdgcn_mfma_f32_32x32x16_bf16(pa1, PKV(f.l1, f.h1), od, 0, 0, 0);
    od = __builtin_amdgcn_mfma_f32_32x32x16_bf16(pa2, PKV(f.l2, f.h2), od, 0, 0, 0);
    od = __builtin_amdgcn_mfma_f32_32x32x16_bf16(pa3, PKV(f.l3, f.h3), od, 0, 0, 0);
#undef PKV
}
__device__ __forceinline__ void pv_d0(f32x16* o, int vb, bf16x8 pa0, bf16x8 pa1, bf16x8 pa2, bf16x8 pa3) {
    VFrag fa, fb;
    v_reads<0>(fa, vb);
    v_reads<1>(fb, vb); asm volatile("s_waitcnt lgkmcnt(8)" ::: "memory"); SBAR(); v_mfmas(o[0], fa, pa0, pa1, pa2, pa3);
    v_reads<2>(fa, vb); asm volatile("s_waitcnt lgkmcnt(8)" ::: "memory"); SBAR(); v_mfmas(o[1], fb, pa0, pa1, pa2, pa3);
    v_reads<3>(fb, vb); asm volatile("s_waitcnt lgkmcnt(8)" ::: "memory"); SBAR(); v_mfmas(o[2], fa, pa0, pa1, pa2, pa3);
    asm volatile("s_waitcnt lgkmcnt(0)" ::: "memory"); SBAR(); v_mfmas(o[3], fb, pa0, pa1, pa2, pa3);
}

__device__ __forceinline__ void attn_unit(const bf16_t* __restrict__ Qb, const bf16_t* __restrict__ Ks0, int nt0, const bf16_t* __restrict__ Ks1, int nt1,
                                          bf16_t* Ob, float lam, float oscale, const float* __restrict__ subg, char* lds, const int wid) {
    const int lane = lane_id_v(), tid = wid * 64 + lane;
    const int r32 = lane & 31, hi = lane >> 5, map = wid >> 2, w4 = wid & 3; (void)tid;
    char* V_lds = lds + OFF_V; char* K_lds = lds + OFF_K;
    float* ws = (float*)(lds + OFF_WS) + wid * 64; float* li_l = ws; float* al_l = ws + 32;
    float zero_v; asm volatile("v_mov_b32 %0, 0" : "=v"(zero_v));
    float mhat = 0.f, l_reg = 0; f32x16 o[4] = {}; bf16x8 qr[4]; f32x16 negm;
#pragma unroll
    for (int r = 0; r < 16; ++r) negm[r] = zero_v;
    const bf16_t* Qw = Qb + (long)(w4 * 32 + r32) * LDP + map * 64 + hi * 8;
#pragma unroll
    for (int d0 = 0; d0 < 4; ++d0) qr[d0] = *reinterpret_cast<const bf16x8*>(Qw + d0 * 16);
    const int cb0 = map * 128;
    unsigned koff[2], voff[2];
#pragma unroll
    for (int i = 0; i < 2; ++i) { const int row = 4 * wid + 32 * i + (lane >> 4), ch = (lane & 15) ^ (row & 7); koff[i] = (unsigned)(row * LDP + ch * 8) * 2u;
        const int sub = 2 * wid + 16 * i + (lane >> 5), kk = (sub >> 2) * 8 + ((lane & 31) >> 2), k = (kk & ~0xC) | ((kk & 4) << 1) | ((kk & 8) >> 1), c = (sub & 3) * 32 + (lane & 3) * 8;
        voff[i] = (unsigned)(k * LDP + 512 + c) * 2u; }
    const unsigned ldsw = (unsigned)wid * 1024u;
    const int vb0 = (int)(uintptr_t)V_lds + v_rd_base(lane);
    const int NT = nt0 + nt1;
#define TILEP(j) ((const char*)((j) < nt0 ? Ks0 + (long)(j) * 64 * LDP : Ks1 + (long)((j) - nt0) * 64 * LDP))
#define DMA_K(j, slot) do { const char* _tb = TILEP(j); _Pragma("unroll") for (int _i = 0; _i < 2; ++_i) \
        __builtin_amdgcn_global_load_lds((const unsigned*)(_tb + koff[_i]), (LAS unsigned*)((LAS char*)(uintptr_t)(unsigned)(uintptr_t)K_lds + (slot) + ldsw + _i * 8192), 16, 0, 0); } while (0)
#define DMA_V(j, slot) do { const char* _tb = TILEP(j); _Pragma("unroll") for (int _i = 0; _i < 2; ++_i) \
        __builtin_amdgcn_global_load_lds((const unsigned*)(_tb + voff[_i]), (LAS unsigned*)((LAS char*)(uintptr_t)(unsigned)(uintptr_t)V_lds + (slot) + ldsw + _i * 8192), 16, 0, 0); } while (0)
#define WAIT_BAR(N) asm volatile("s_waitcnt vmcnt(" #N ") lgkmcnt(0)\n\ts_barrier" ::: "memory")
#define RESC(a) do { if (__any((a) < 1.f)) { if (hi == 0) al_l[r32] = (a); asm volatile("s_waitcnt lgkmcnt(0)" ::: "memory"); \
    _Pragma("unroll") for (int d = 0; d < 4; ++d) _Pragma("unroll") for (int r = 0; r < 16; ++r) o[d][r] *= al_l[crow(r, hi)]; } } while (0)
    f32x16 pA0, pA1, pB0, pB1; float alA, alB; bf16x8 pa0, pa1, pa2, pa3;
    DMA_K(0, 0); DMA_K(1, SHM_K); DMA_V(0, 0);
    WAIT_BAR(0);
#define HALF_STEP(C0, C1, P0, P1, alC, alP, t) do { \
        SBAR(); qkt(C0, C1, K_lds + (((t) >> 1) & 1) * 2 * SHM_K + ((t) & 1) * SHM_K, qr, negm, r32, hi, cb0); \
        finishSM(P0, P1, alP, l_reg, pa0, pa1, pa2, pa3); SBAR(); \
        pv_d0(o, vb0 + (((t) - 1) & 3) * SHM_V, pa0, pa1, pa2, pa3); partialSM<false>(C0, C1, mhat, negm, alC); \
        RESC(alC); } while (0)
    if (2 < NT) { DMA_K(2, 2 * SHM_K); DMA_K(3, 3 * SHM_K); } DMA_V(1, SHM_V); if (2 < NT) DMA_V(2, 2 * SHM_V);
    qkt(pA0, pA1, K_lds, qr, negm, r32, hi, cb0); partialSM<true>(pA0, pA1, mhat, negm, alA);
    HALF_STEP(pB0, pB1, pA0, pA1, alB, alA, 1);
    WAIT_BAR(0);
    for (int t = 2; t < NT; t += 2) {
        if (t + 2 < NT) { DMA_K(t + 2, (((t + 2) >> 1) & 1) * 2 * SHM_K); DMA_K(t + 3, (((t + 2) >> 1) & 1) * 2 * SHM_K + SHM_K); }
        DMA_V(t + 1, ((t + 1) & 3) * SHM_V); if (t + 2 < NT) DMA_V(t + 2, ((t + 2) & 3) * SHM_V);
        HALF_STEP(pA0, pA1, pB0, pB1, alA, alB, t);
        HALF_STEP(pB0, pB1, pA0, pA1, alB, alA, t + 1);
        WAIT_BAR(0);
    }
    finishSM(pB0, pB1, alB, l_reg, pa0, pa1, pa2, pa3); SBAR();
    pv_d0(o, vb0 + ((NT - 1) & 3) * SHM_V, pa0, pa1, pa2, pa3);
#undef HALF_STEP
    if (hi == 0) li_l[r32] = l_reg; asm volatile("s_waitcnt lgkmcnt(0)" ::: "memory");
    float rli[16];
#pragma unroll
    for (int r = 0; r < 16; ++r) rli[r] = __builtin_amdgcn_rcpf(li_l[crow(r, hi)]) * (map ? lam : 1.f);
    __syncthreads();
    float* X = (float*)(lds + OFF_X) + w4 * (32 * 128);
    if (map == 1) {
#pragma unroll
        for (int r = 0; r < 16; ++r)
#pragma unroll
            for (int d0 = 0; d0 < 4; ++d0) X[crow(r, hi) * 128 + d0 * 32 + r32] = o[d0][r] * rli[r];
    }
    __syncthreads();
    if (map == 0) {
        float ss[16];
#pragma unroll
        for (int r = 0; r < 16; ++r) { float s = 0.f;
#pragma unroll
            for (int d0 = 0; d0 < 4; ++d0) { const float v = o[d0][r] * rli[r] - X[crow(r, hi) * 128 + d0 * 32 + r32]; o[d0][r] = v; s += v * v; }
            ss[r] = s; }
#pragma unroll
        for (int r = 0; r < 16; ++r) { float s = ss[r]; s += __shfl_xor(s, 1); s += __shfl_xor(s, 2); s += __shfl_xor(s, 4); s += __shfl_xor(s, 8); s += __shfl_xor(s, 16);
            ss[r] = __builtin_amdgcn_rsqf(s * (1.f / 128.f) + EPS) * oscale; }
        bf16_t* Ost = (bf16_t*)(lds + OFF_OST) + w4 * 4096;
#pragma unroll
        for (int d0 = 0; d0 < 4; ++d0) { const float g = subg[d0 * 32 + r32];
#pragma unroll
            for (int r = 0; r < 16; ++r) Ost[crow(r, hi) * 128 + d0 * 32 + r32] = (bf16_t)(cvt_pk_bf16(o[d0][r] * ss[r] * g, 0.f) & 0xffffu); }
        asm volatile("s_waitcnt lgkmcnt(0)" ::: "memory");
#pragma unroll
        for (int it = 0; it < 8; ++it) { const int row = it * 4 + (lane >> 4), ch = lane & 15;
            const u32x4 w = *(const u32x4*)(Ost + row * 128 + ch * 8);
            *(u32x4*)(Ob + (long)(w4 * 32 + row) * LDP + ch * 8) = w; }
    }
    __syncthreads();
#undef TILEP
#undef DMA_K
#undef DMA_V
#undef WAIT_BAR
#undef RESC
}

__device__ __forceinline__ void sg_unit(bf16_t* P0, const bf16_t* __restrict__ sgw, const float* __restrict__ lng, const float* __restrict__ lnb, const float* __restrict__ sgb, char* lds, const int wid, const int g_lo, const int g_hi) {
    const int lane = lane_id_v(), tid = wid * 64 + lane;
    const int r32 = lane & 31, hi = lane >> 5;
    const int sr = tid >> 4, sc = (tid & 15) * 8;
    float* Mt = (float*)(lds + 65536);
    u32x4 gb[4][4];
#pragma unroll
    for (int q4 = 0; q4 < 4; ++q4)
#pragma unroll
        for (int g = 0; g < 4; ++g) gb[q4][g] = *(const u32x4*)(P0 + (long)(q4 * 32 + sr) * LDP + COL_G + g * 128 + sc);
    float mean[4], rstd[4];
#pragma unroll
    for (int q4 = 0; q4 < 4; ++q4) { float sm = 0.f;
#pragma unroll
        for (int g = 0; g < 4; ++g) { const u32x4 w = gb[q4][g]; sm += (bflo(w.x) + bfhi(w.x)) + (bflo(w.y) + bfhi(w.y)) + (bflo(w.z) + bfhi(w.z)) + (bflo(w.w) + bfhi(w.w)); }
        sm += __shfl_xor(sm, 1); sm += __shfl_xor(sm, 2); sm += __shfl_xor(sm, 4); sm += __shfl_xor(sm, 8);
        const float mu = sm * (1.f / 512.f); float q = 0.f;
#pragma unroll
        for (int g = 0; g < 4; ++g) { const u32x4 w = gb[q4][g]; const float x[8] = {bflo(w.x), bfhi(w.x), bflo(w.y), bfhi(w.y), bflo(w.z), bfhi(w.z), bflo(w.w), bfhi(w.w)};
#pragma unroll
            for (int k = 0; k < 8; ++k) { const float d = x[k] - mu; q += d * d; } }
        q += __shfl_xor(q, 1); q += __shfl_xor(q, 2); q += __shfl_xor(q, 4); q += __shfl_xor(q, 8);
        mean[q4] = mu; rstd[q4] = __builtin_amdgcn_rsqf(q * (1.f / 512.f) + EPS); }
    const int vb0 = (int)(uintptr_t)lds + v_rd_base(lane);
    const int mt = wid & 3, eh = wid >> 2;
#pragma unroll
    for (int g = 0; g < 4; ++g) {
        if (g < g_lo || g >= g_hi) continue;
        u32x4 ub[4];
#pragma unroll
        for (int q4 = 0; q4 < 4; ++q4) ub[q4] = *(const u32x4*)(P0 + (long)(q4 * 32 + sr) * LDP + COL_U + g * 128 + sc);
        const bf16_t* Wp = sgw + (size_t)g * 128 * 128 + (size_t)(mt * 32 + r32) * 128 + hi * 4;
        bf16x8 af[2][4];
#pragma unroll
        for (int tq = 0; tq < 2; ++tq)
#pragma unroll
            for (int ks = 0; ks < 4; ++ks) { const u32x2 lo_ = *(const u32x2*)(Wp + tq * 64 + ks * 16), hi_ = *(const u32x2*)(Wp + tq * 64 + ks * 16 + 8); u32x4 w_ = {lo_.x, lo_.y, hi_.x, hi_.y}; af[tq][ks] = __builtin_bit_cast(bf16x8, w_); }
        const f32x4 ga = *(const f32x4*)(lng + g * 128 + sc), gbv = *(const f32x4*)(lng + g * 128 + sc + 4), ba = *(const f32x4*)(lnb + g * 128 + sc), bb = *(const f32x4*)(lnb + g * 128 + sc + 4);
#pragma unroll
        for (int q4 = 0; q4 < 4; ++q4) { const int tkn = q4 * 32 + sr; const u32x4 w = gb[q4][g]; const float mu = mean[q4], rs = rstd[q4];
            const float x[8] = {bflo(w.x), bfhi(w.x), bflo(w.y), bfhi(w.y), bflo(w.z), bfhi(w.z), bflo(w.w), bfhi(w.w)};
            u32x4 ov;
            ov.x = cvt_pk_bf16((x[0] - mu) * rs * ga[0] + ba[0], (x[1] - mu) * rs * ga[1] + ba[1]);
            ov.y = cvt_pk_bf16((x[2] - mu) * rs * ga[2] + ba[2], (x[3] - mu) * rs * ga[3] + ba[3]);
            ov.z = cvt_pk_bf16((x[4] - mu) * rs * gbv[0] + bb[0], (x[5] - mu) * rs * gbv[1] + bb[1]);
            ov.w = cvt_pk_bf16((x[6] - mu) * rs * gbv[2] + bb[2], (x[7] - mu) * rs * gbv[3] + bb[3]);
            *(u32x4*)(lds + (tkn >> 6) * SHM_V + v_st(tkn & 63, sc)) = ov; }
        __syncthreads();
        f32x16 oa = {}, ob = {};
#pragma unroll
        for (int tq = 0; tq < 2; ++tq) {
            if (eh == 0) { pv_one<0>(oa, vb0 + tq * SHM_V, af[tq][0], af[tq][1], af[tq][2], af[tq][3]); pv_one<1>(ob, vb0 + tq * SHM_V, af[tq][0], af[tq][1], af[tq][2], af[tq][3]); }
            else         { pv_one<2>(oa, vb0 + tq * SHM_V, af[tq][0], af[tq][1], af[tq][2], af[tq][3]); pv_one<3>(ob, vb0 + tq * SHM_V, af[tq][0], af[tq][1], af[tq][2], af[tq][3]); }
        }
#pragma unroll
        for (int r = 0; r < 16; ++r) { const int pr = mt * 32 + crow(r, hi); const float bs = sgb[g * 128 + pr];
            Mt[pr * 128 + eh * 64 + r32] = oa[r] + bs; Mt[pr * 128 + eh * 64 + 32 + r32] = ob[r] + bs; }
        __syncthreads();
#pragma unroll
        for (int q4 = 0; q4 < 4; ++q4) { const int tkn = q4 * 32 + sr; const f32x4 m0 = *(const f32x4*)(Mt + tkn * 128 + sc), m1 = *(const f32x4*)(Mt + tkn * 128 + sc + 4); const u32x4 w = ub[q4];
            u32x4 ov;
            ov.x = cvt_pk_bf16(bflo(w.x) * m0[0], bfhi(w.x) * m0[1]); ov.y = cvt_pk_bf16(bflo(w.y) * m0[2], bfhi(w.y) * m0[3]);
            ov.z = cvt_pk_bf16(bflo(w.z) * m1[0], bfhi(w.z) * m1[1]); ov.w = cvt_pk_bf16(bflo(w.w) * m1[2], bfhi(w.w) * m1[3]);
            *(u32x4*)(P0 + (long)tkn * LDP + COL_U + g * 128 + sc) = ov; }
    }
    __syncthreads();
}
}

#define XB_TMO      128
#define XB_XCNT(j)  (256  + 64 * (j))
#define XB_XSUB(j)  (1280 + 64 * (j))
#define XB_XGEN(j)  (2304 + 64 * (j))
#define XB_TOP      3328
#define XB_TOPGEN   3392
#define XCD_BAR_WORDS 3456
#define XB_SPIN_CAP (1u << 18)
__device__ __forceinline__ unsigned xb_ld(unsigned* p)              { return __hip_atomic_load(p, __ATOMIC_RELAXED, __HIP_MEMORY_SCOPE_AGENT); }
__device__ __forceinline__ unsigned xb_add(unsigned* p, unsigned v) { return __hip_atomic_fetch_add(p, v, __ATOMIC_RELAXED, __HIP_MEMORY_SCOPE_AGENT); }
__device__ __forceinline__ unsigned xb_xcc_id() { return (unsigned)__builtin_amdgcn_s_getreg((3 << 11) | 20) & 0xFu; }
#define XB_SPIN(cond, bar) do { unsigned _sp = 0; while (cond) { __builtin_amdgcn_s_sleep(1); \
    if ((++_sp & 255u) == 0u) { if (xb_ld(&(bar)[XB_TMO])) break; if (_sp > XB_SPIN_CAP) { atomicAdd(&(bar)[XB_TMO], 1u); break; } } } } while (0)
struct XcdBarrier { unsigned* bar; unsigned x; volatile LAS unsigned* st; };
__device__ __forceinline__ XcdBarrier xcd_barrier_post(unsigned* bar, volatile LAS unsigned* st, int tid) {
    XcdBarrier b; b.bar = bar; b.x = xb_xcc_id(); b.st = st;
    if (tid == 0) (void)xb_add(&bar[XB_XCNT(b.x)], 1u);
    return b;
}
__device__ __forceinline__ void xcd_barrier_complete(unsigned* bar, unsigned x, unsigned& nloc, unsigned& nx) {
    const unsigned G = gridDim.x * gridDim.y * gridDim.z;
    unsigned sum, cnt, mine, sp = 0u;
    for (;;) {
        sum = 0u; cnt = 0u; mine = 0u;
#pragma unroll
        for (unsigned j = 0; j < 16; ++j) { const unsigned c = xb_ld(&bar[XB_XCNT(j)]); sum += c; cnt += (c > 0u) ? 1u : 0u; mine = (j == x) ? c : mine; }
        if (sum == G) break;
        __builtin_amdgcn_s_sleep(1);
        if ((++sp & 255u) == 0u) { if (xb_ld(&bar[XB_TMO])) break; if (sp > XB_SPIN_CAP) { atomicAdd(&bar[XB_TMO], 1u); break; } }
    }
    nloc = mine > 0u ? mine : 1u; nx = cnt > 0u ? cnt : 1u;
}
__device__ __forceinline__ void xcd_barrier(const XcdBarrier& b, int wave) {
    asm volatile("s_waitcnt vmcnt(0)" ::: "memory");
    __syncthreads();
    if (wave == 0 && lane_id_v() == 0) {
        unsigned* bar = b.bar;
        __builtin_amdgcn_s_waitcnt(0);
        unsigned nloc = b.st[0], nx = b.st[1];
        if (nloc == 0u) { xcd_barrier_complete(bar, b.x, nloc, nx); b.st[0] = nloc; b.st[1] = nx; }
        const unsigned old = xb_add(&bar[XB_XSUB(b.x)], 1u);
        const unsigned gen = old / nloc;
        if (old + 1u == (gen + 1u) * nloc) {
            __builtin_amdgcn_fence(__ATOMIC_RELEASE, "agent");
            asm volatile("s_waitcnt vmcnt(0)" ::: "memory");
            const unsigned og = xb_add(&bar[XB_TOP], 1u);
            const unsigned tg = og / nx;
            if (og + 1u == (tg + 1u) * nx) xb_add(&bar[XB_TOPGEN], 1u);
            else XB_SPIN(xb_ld(&bar[XB_TOPGEN]) == tg, bar);
            __builtin_amdgcn_fence(__ATOMIC_ACQUIRE, "agent");
            xb_add(&bar[XB_XGEN(b.x)], 1u);
            asm volatile("s_waitcnt vmcnt(0)" ::: "memory");
        } else {
            XB_SPIN(xb_ld(&bar[XB_XGEN(b.x)]) == gen, bar);
            __builtin_amdgcn_fence(__ATOMIC_ACQUIRE, "agent");
            asm volatile("s_waitcnt vmcnt(0)" ::: "memory");
        }
    }
    __syncthreads();
}

struct Args {
    const float* in[28]; float* out; unsigned char* ws; int ph_lo, ph_hi;
};
typedef const __attribute__((address_space(4))) Args* KArgP;
#define KARG() ({ KArgP _p = (KArgP)__builtin_amdgcn_kernarg_segment_ptr(); asm volatile("" : "+s"(_p)); _p; })
struct Frame {
    LAS unsigned char* lds; gu32* ctl; int tid, lane, wave, vcu, G;
};

constexpr int I_IN = 16 * 80, I_OUT = 16 * 32, I_F13 = 16 * 176, I_F2 = 44 * 32, I_M13 = 16 * 224, I_M2 = 56 * 32;
constexpr int CV_L0 = 2 * I_IN + 2 * I_OUT + I_F13 + I_F2, CV_N = CV_L0 + 8 * I_M13 + 8 * I_M2;
__device__ __forceinline__ void convert_range(LAS unsigned char* lds, int wave, int lane, KArgP ap, int first, int stride, int end) {
    const __attribute__((address_space(4))) Args& a = *ap; unsigned char* ws = a.ws;
    LAS float* scr = (LAS float*)(lds + wave * 16384);
    struct Item { const float* src; unsigned char* dst; int ldw, K, k0; bool rope, f8; };
#define DECODE(it_, I) do { int r = (it_); \
        if (r < 2 * I_IN) { const int l = r / I_IN; r %= I_IN; const int kb = r / 80, g = r % 80, seg = g >> 4, gi = g & 15; \
            const int sseg = seg == 0 ? 0 : seg == 1 ? 3 : seg == 2 ? 1 : seg == 3 ? 2 : 4;        \
            I.src = a.in[10] + (size_t)l * D * NIN + (size_t)kb * 64 * NIN + sseg * 512 + gi * 32; I.ldw = NIN; I.K = D; I.k0 = kb * 64; I.rope = (seg == 0 || seg == 2); I.f8 = false; \
            I.dst = ws + WS_WIN + ((size_t)l * NIN * D + (size_t)g * 32 * D + kb * 64) * 2; break; } \
        r -= 2 * I_IN; \
        if (r < 2 * I_OUT) { const int l = r / I_OUT; r %= I_OUT; const int kb = r / 32, g = r % 32; \
            I.src = a.in[11] + (size_t)l * D * D + (size_t)kb * 64 * D + g * 32; I.ldw = D; I.K = D; I.k0 = kb * 64; I.rope = false; I.f8 = false; \
            I.dst = ws + WS_WOUT + ((size_t)l * D * D + (size_t)g * 32 * D + kb * 64) * 2; break; } \
        r -= 2 * I_OUT; \
        if (r < I_F13) { const int kb = r / 176, g = r % 176, tile = g >> 3, gi = g & 7;            \
            I.src = (gi < 4 ? a.in[21] : a.in[22]) + (size_t)kb * 64 * DFF + tile * 128 + (gi & 3) * 32; I.ldw = DFF; I.K = D; I.k0 = kb * 64; I.rope = false; I.f8 = false; \
            I.dst = ws + WS_W13 + ((size_t)g * 32 * D + kb * 64) * 2; break; } \
        r -= I_F13; \
        if (r < I_F2) { const int kb = r / 32, g = r % 32; \
            I.src = a.in[23] + (size_t)kb * 64 * D + g * 32; I.ldw = D; I.K = DFF; I.k0 = kb * 64; I.rope = false; I.f8 = FFN_DOWN_FP8 != 0; \
            I.dst = ws + WS_W2 + ((size_t)g * 32 * DFF + kb * 64) * (FFN_DOWN_FP8 ? 1 : 2); break; } \
        r -= I_F2; \
        if (r < 8 * I_M13) { const int e = r / I_M13; r %= I_M13; const int kb = r / 224, g = r % 224, tile = g >> 3, gi = g & 7; \
            I.src = (gi < 4 ? a.in[25] : a.in[26]) + (size_t)e * D * DEXP + (size_t)kb * 64 * DEXP + tile * 128 + (gi & 3) * 32; I.ldw = DEXP; I.K = D; I.k0 = kb * 64; I.rope = false; I.f8 = true; \
            I.dst = ws + WS_MW13 + (size_t)e * 7168 * D + (size_t)g * 32 * D + kb * 64; break; } \
        r -= 8 * I_M13; \
        { const int e = r / I_M2; r %= I_M2; const int kb = r / 32, g = r % 32; \
            I.src = a.in[27] + (size_t)e * DEXP * D + (size_t)kb * 64 * D + g * 32; I.ldw = D; I.K = DEXP; I.k0 = kb * 64; I.rope = false; I.f8 = true; \
            I.dst = ws + WS_MW2 + (size_t)e * D * DEXP + (size_t)g * 32 * DEXP + kb * 64; } \
    } while (0)
#define LOADITEM(I, v) do { const int j_ = lane & 31, sj_ = I.rope ? ((j_ & 3) + 4 * (j_ >> 3) + 16 * ((j_ >> 2) & 1)) : j_; const float* sp_ = I.src + (size_t)(lane >> 5) * I.ldw + sj_; \
        _Pragma("unroll") for (int i = 0; i < 32; ++i) v[i] = sp_[(size_t)(2 * i) * I.ldw]; } while (0)
    if (first < end) {
        Item cur, nxt; float v[32], vn[32];
        DECODE(first, cur); LOADITEM(cur, v);
        for (int it = first; it < end; it += stride) {
            const int itn = it + stride; const bool has_next = itn < end;
            if (has_next) { DECODE(itn, nxt); LOADITEM(nxt, vn); }
            const int j = lane & 31; const float sc = cur.f8 ? 128.f : 1.f;
#pragma unroll
            for (int i = 0; i < 32; ++i) { const int kk = 2 * i + (lane >> 5); scr[kk * 33 + j] = v[i] * sc; }
            LDS_WAIT(); asm volatile("" ::: "memory");
            if (cur.f8) {
                const int n = lane >> 1, hf = lane & 1; const LAS float* s = scr + (32 * hf) * 33 + n;
                u32x4 o0, o1;
                o0.x = pg8::pk_fp8x4(s[0 * 33], s[1 * 33], s[2 * 33], s[3 * 33]);     o0.y = pg8::pk_fp8x4(s[4 * 33], s[5 * 33], s[6 * 33], s[7 * 33]);
                o0.z = pg8::pk_fp8x4(s[8 * 33], s[9 * 33], s[10 * 33], s[11 * 33]);   o0.w = pg8::pk_fp8x4(s[12 * 33], s[13 * 33], s[14 * 33], s[15 * 33]);
                o1.x = pg8::pk_fp8x4(s[16 * 33], s[17 * 33], s[18 * 33], s[19 * 33]); o1.y = pg8::pk_fp8x4(s[20 * 33], s[21 * 33], s[22 * 33], s[23 * 33]);
                o1.z = pg8::pk_fp8x4(s[24 * 33], s[25 * 33], s[26 * 33], s[27 * 33]); o1.w = pg8::pk_fp8x4(s[28 * 33], s[29 * 33], s[30 * 33], s[31 * 33]);
                unsigned char* d = cur.dst + (size_t)n * cur.K + 32 * hf;
                *(u32x4*)d = o0; *(u32x4*)(d + 16) = o1;
            } else {
                const int c = lane & 7;
#pragma unroll
                for (int jj = 0; jj < 4; ++jj) { const int n = (lane >> 3) + 8 * jj; const LAS float* s = scr + (8 * c) * 33 + n;
                    u32x4 o; o.x = cvt_pk_bf16(s[0 * 33], s[1 * 33]); o.y = cvt_pk_bf16(s[2 * 33], s[3 * 33]); o.z = cvt_pk_bf16(s[4 * 33], s[5 * 33]); o.w = cvt_pk_bf16(s[6 * 33], s[7 * 33]);
                    *(u32x4*)(cur.dst + ((size_t)n * cur.K + 8 * c) * 2) = o; }
            }
            LDS_WAIT(); asm volatile("" ::: "memory");
            if (has_next) { cur = nxt;
#pragma unroll
                for (int i = 0; i < 32; ++i) v[i] = vn[i]; }
        }
    }
#undef DECODE
#undef LOADITEM
}

__device__ __forceinline__ void p0_prologue(Frame& F, KArgP ap) {
    const __attribute__((address_space(4))) Args& a = *ap;
    unsigned char* ws = a.ws;
    if (blockIdx.x < 192) {
        const int l = blockIdx.x / 96, n0 = (blockIdx.x % 96) * 64;
        LAS float* s = (LAS float*)F.lds;
        LAS float* red = (LAS float*)(F.lds + 73728);
        const float* c = a.in[1]; const float* cc = a.in[3];
        for (int i = F.tid; i < 17 * 1024; i += 512) { const float v = i < 16 * 1024 ? c[i] : cc[i - 16 * 1024]; s[i] = silu_f(v); }
        __syncthreads();
        const float* W = a.in[4] + (size_t)l * D * 6144 + n0 + F.lane;
        float acc[17];
#pragma unroll
        for (int r = 0; r < 17; ++r) acc[r] = 0.f;
        const int kb = F.wave * 128;
#pragma unroll
        for (int k0 = 0; k0 < 128; k0 += 32) {
            float wv[32];
#pragma unroll
            for (int k = 0; k < 32; ++k) wv[k] = W[(size_t)(kb + k0 + k) * 6144];
#pragma unroll
            for (int k = 0; k < 32; k += 4)
#pragma unroll
                for (int r = 0; r < 17; ++r) { const f32x4 sv = *(const LAS f32x4*)(s + r * 1024 + kb + k0 + k); acc[r] += sv[0] * wv[k] + sv[1] * wv[k + 1] + sv[2] * wv[k + 2] + sv[3] * wv[k + 3]; }
        }
#pragma unroll
        for (int r = 0; r < 17; ++r) red[(F.wave * 17 + r) * 64 + F.lane] = acc[r];
        __syncthreads();
        float* ms = (float*)(ws + WS_MS) + (size_t)l * 17 * 6144;
        const float* bias = a.in[5] + (size_t)l * 6144;
        for (int i = F.tid; i < 17 * 64; i += 512) { const int r = i >> 6, col = i & 63; float v = bias[n0 + col];
#pragma unroll
            for (int w = 0; w < 8; ++w) v += red[(w * 17 + r) * 64 + col];
            ms[(size_t)r * 6144 + n0 + col] = v; }
        __syncthreads();
    }
    if (blockIdx.x == 255) {
        float* rc = (float*)(ws + WS_ROPE); float* rs = rc + 1024;
        for (int i = F.tid; i < 1024; i += 512) { const int pos = i >> 4, j = i & 15; const float inv = powf(10000.0f, -(float)(2 * j) / 32.0f); const float ang = (float)pos * inv; rc[i] = cosf(ang); rs[i] = sinf(ang); }
    }
    { const float* src = a.in[19]; bf16_t* dst = (bf16_t*)(ws + WS_SGW); const int n4 = 2 * 4 * 128 * 128 / 4;
      for (int i = blockIdx.x * 512 + F.tid; i < n4; i += F.G * 512) { const f32x4 v = *(const f32x4*)(src + (size_t)i * 4); u32x2 o; o.x = cvt_pk_bf16(v[0], v[1]); o.y = cvt_pk_bf16(v[2], v[3]); *(u32x2*)(dst + (size_t)i * 4) = o; } }
    convert_range(F.lds, F.wave, F.lane, ap, F.vcu * NWAVES + F.wave, F.G * NWAVES, CV_L0);
}

struct Row { f32x4 v[4]; };
__device__ __forceinline__ Row ld_row_f32(const float* p, int lane) { Row r; const f32x4* q = (const f32x4*)p + lane;
#pragma unroll
    for (int j = 0; j < 4; ++j) r.v[j] = q[64 * j]; return r; }
__device__ __forceinline__ void st_row_f32(float* p, int lane, const Row& r) { f32x4* q = (f32x4*)p + lane;
#pragma unroll
    for (int j = 0; j < 4; ++j) q[64 * j] = r.v[j]; }
__device__ __forceinline__ Row ld_row_bf16(const bf16_t* p, int lane) { Row r; const u32x2* q = (const u32x2*)p + lane;
#pragma unroll
    for (int j = 0; j < 4; ++j) { const u32x2 w = q[64 * j]; r.v[j] = (f32x4){bflo(w.x), bfhi(w.x), bflo(w.y), bfhi(w.y)}; } return r; }
__device__ __forceinline__ void st_row_bf16(bf16_t* p, int lane, const Row& r) { u32x2* q = (u32x2*)p + lane;
#pragma unroll
    for (int j = 0; j < 4; ++j) { u32x2 w; w.x = cvt_pk_bf16(r.v[j][0], r.v[j][1]); w.y = cvt_pk_bf16(r.v[j][2], r.v[j][3]); q[64 * j] = w; } }
__device__ __forceinline__ float row_rms_scale(const Row& r) { float s = 0.f;
#pragma unroll
    for (int j = 0; j < 4; ++j) s += (r.v[j][0] * r.v[j][0] + r.v[j][1] * r.v[j][1]) + (r.v[j][2] * r.v[j][2] + r.v[j][3] * r.v[j][3]);
    return __builtin_amdgcn_rsqf(wave_sum(s) * (1.f / D) + EPS); }
__device__ __forceinline__ Row row_modulate(const Row& x, const float* g, const float* shift, const float* scale, int lane) {
    const float rs = row_rms_scale(x); Row h; const f32x4* gq = (const f32x4*)g + lane; const f32x4* sh = (const f32x4*)shift + lane; const f32x4* sc = (const f32x4*)scale + lane;
#pragma unroll
    for (int j = 0; j < 4; ++j) h.v[j] = x.v[j] * rs * gq[64 * j] * (1.f + sc[64 * j]) + sh[64 * j];
    return h; }
__device__ __forceinline__ void row_residual(Row& x, const Row& y, const float* g, const float* gate, int lane) {
    const float rs = row_rms_scale(y); const f32x4* gq = (const f32x4*)g + lane; const f32x4* gt = (const f32x4*)gate + lane;
#pragma unroll
    for (int j = 0; j < 4; ++j) x.v[j] = x.v[j] + gt[64 * j] * (y.v[j] * rs * gq[64 * j]);
}

struct ResP { f32x4 a[4]; };
struct ModP { f32x4 b[4], sh[4]; };
__device__ __forceinline__ ResP ld_resp(const float* g, const float* gate, int lane) { ResP r; const f32x4* gq = (const f32x4*)g + lane; const f32x4* gt = (const f32x4*)gate + lane;
#pragma unroll
    for (int j = 0; j < 4; ++j) r.a[j] = gq[64 * j] * gt[64 * j]; return r; }
__device__ __forceinline__ ModP ld_modp(const float* g, const float* shift, const float* scale, int lane) { ModP r; const f32x4* gq = (const f32x4*)g + lane; const f32x4* sh = (const f32x4*)shift + lane; const f32x4* sc = (const f32x4*)scale + lane;
#pragma unroll
    for (int j = 0; j < 4; ++j) { r.b[j] = gq[64 * j] * (1.f + sc[64 * j]); r.sh[j] = sh[64 * j]; } return r; }
__device__ __forceinline__ void row_residual2(Row& x, const Row& y, const ResP& P) { const float rs = row_rms_scale(y);
#pragma unroll
    for (int j = 0; j < 4; ++j) x.v[j] = x.v[j] + P.a[j] * (y.v[j] * rs); }
__device__ __forceinline__ Row row_modulate2(const Row& x, const ModP& P) { const float rs = row_rms_scale(x); Row h;
#pragma unroll
    for (int j = 0; j < 4; ++j) h.v[j] = x.v[j] * rs * P.b[j] + P.sh[j]; return h; }

struct MoeTab { int cnt[8]; int pbase[9]; };
__device__ __forceinline__ void moe_tab(gu32* ctl, MoeTab& T) {
    int p = 0;
#pragma unroll
    for (int e = 0; e < 8; ++e) { const int c = (int)__builtin_amdgcn_readfirstlane(__hip_atomic_load(ctl + CW_CNT + 64 * e, RLX_AGENT)); T.cnt[e] = c; T.pbase[e] = p; p += (c + 255) >> 8; }
    T.pbase[8] = p;
}
__device__ __forceinline__ int moe_expert_of(const MoeTab& T, int panel) { int e = 0;
#pragma unroll
    for (int i = 1; i < 8; ++i) e += (panel >= T.pbase[i]) ? 1 : 0;
    return e; }

struct MoeUpSched {
    static constexpr bool GATHER = true;
    const char* A; const char* Bt; const int* slot_token; int G, c, p0, nM; MoeTab T; int tprobe;
    __device__ __forceinline__ bool next(int i, pg8::Unit& u) const {
        const int L = i * G + c; if (L >= nM * 28) return false;
        int pm, pn; pg8::tile_of(L, nM, 28, pm, pn);
        const int panel = p0 + pm, e = moe_expert_of(T, panel);
        u.pm = pm; u.pn = pn; u.aux = e; u.aux2 = panel; u.Ap = A; u.Bp = Bt + ((size_t)e * 7168 + (size_t)pn * 256) * D; return true;
    }
    __device__ __forceinline__ void aoff(const pg8::Unit& u, const int (&R)[2], const int (&C)[2], unsigned (&o0)[2], unsigned (&o1)[2]) const {
        int pb = 0, cn = 0;
#pragma unroll
        for (int e = 0; e < 8; ++e) { pb = (u.aux == e) ? T.pbase[e] : pb; cn = (u.aux == e) ? T.cnt[e] : cn; }
        const int rk0 = (u.aux2 - pb) * 256;
#pragma unroll
        for (int i = 0; i < 2; ++i) {
            const int ra = rk0 + R[i], rb = rk0 + pg8::HALF + R[i];
            const int ta = slot_token[u.aux * 32768 + (ra < cn ? ra : 0)], tb = slot_token[u.aux * 32768 + (rb < cn ? rb : 0)];
            o0[i] = (unsigned)(ta * D + C[i] * 2); o1[i] = (unsigned)(tb * D + C[i] * 2); }
    }
    __device__ __forceinline__ void prefetch_idx(const pg8::Unit& u, LAS unsigned char* idx, int wid, int lane) const {
        int pb = 0, cn = 0;
#pragma unroll
        for (int e = 0; e < 8; ++e) { pb = (u.aux == e) ? T.pbase[e] : pb; cn = (u.aux == e) ? T.cnt[e] : cn; }
        const int r = (u.aux2 - pb) * 256 + (wid & 3) * 64 + lane;
        __builtin_amdgcn_global_load_lds((const unsigned*)(slot_token + u.aux * 32768 + (r < cn ? r : 0)), (LAS unsigned*)(idx + (wid & 3) * 256), 4, 0, 0);
    }
    __device__ __forceinline__ void aoff_lds(const int (&R)[2], const int (&C)[2], const LAS unsigned char* idx, unsigned (&o0)[2], unsigned (&o1)[2]) const {
#pragma unroll
        for (int i = 0; i < 2; ++i) { const int ta = ((const LAS int*)idx)[R[i]], tb = ((const LAS int*)idx)[pg8::HALF + R[i]];
            o0[i] = (unsigned)(ta * D + C[i] * 2); o1[i] = (unsigned)(tb * D + C[i] * 2); }
    }
};
struct MoeDownSched {
    static constexpr bool GATHER = false;
    const char* A; const char* Bt; int G, c, p0, nM; MoeTab T; int tprobe;
    __device__ __forceinline__ bool next(int i, pg8::Unit& u) const {
        const int L = i * G + c; if (L >= nM * 4) return false;
        int pm, pn; pg8::tile_of(L, nM, 4, pm, pn);
        const int panel = p0 + pm, e = moe_expert_of(T, panel);
        u.pm = panel; u.pn = pn; u.aux = e; u.aux2 = 0; u.Ap = A + (size_t)pm * 256 * DEXP; u.Bp = Bt + ((size_t)e * D + (size_t)pn * 256) * DEXP; return true;
    }
    __device__ __forceinline__ void aoff(const pg8::Unit&, const int (&R)[2], const int (&C)[2], unsigned (&o0)[2], unsigned (&o1)[2]) const {
#pragma unroll
        for (int i = 0; i < 2; ++i) { o0[i] = (unsigned)(R[i] * DEXP + C[i] * 2); o1[i] = (unsigned)((pg8::HALF + R[i]) * DEXP + C[i] * 2); }
    }
};

constexpr int N_PHASES = 24;


__global__ void __launch_bounds__(NWAVES * 64, 2) mk_fwd(Args args) {
    extern __shared__ __attribute__((aligned(16))) unsigned char lds_raw[];
    Frame F;
    F.lds = (LAS unsigned char*)lds_raw;
    F.tid = threadIdx.x; F.lane = F.tid & 63; F.wave = __builtin_amdgcn_readfirstlane(F.tid >> 6);
    F.G = gridDim.x; { const int bx = blockIdx.x; F.vcu = (F.G % 8 == 0) ? (bx % 8) * (F.G / 8) + bx / 8 : bx; }
    unsigned char* ws = KARG()->ws;
    F.ctl = (gu32*)(ws + WS_CTL);
    volatile LAS unsigned* MISC = (volatile LAS unsigned*)(F.lds + MISC_OFF);
    for (int u = F.tid; u < (LDS_BYTES - LDSCTL_OFF) / 4; u += NWAVES * 64) ((LAS unsigned*)(F.lds + LDSCTL_OFF))[u] = 0u;
    __syncthreads();
    XcdBarrier bar; bar.bar = (unsigned*)(F.ctl + CW_BAR); bar.x = 0; bar.st = nullptr;
    if (!MK_PER_PHASE) bar = xcd_barrier_post((unsigned*)(F.ctl + CW_BAR), MISC + 8, F.tid);
    const int lo = KARG()->ph_lo, hi = KARG()->ph_hi;
#ifndef PROBE_NULL_G2
#define PROBE_NULL_G2 0
#endif
#ifndef DUP_MASK
#define DUP_MASK 0u
#endif
#if ((DUP_MASK) >> 0) & 1
#define REP_0 for (int _rep = 0; _rep < 2; ++_rep)
#else
#define REP_0
#endif
#if ((DUP_MASK) >> 1) & 1
#define REP_1 for (int _rep = 0; _rep < 2; ++_rep)
#else
#define REP_1
#endif
#if ((DUP_MASK) >> 2) & 1
#define REP_2 for (int _rep = 0; _rep < 2; ++_rep)
#else
#define REP_2
#endif
#if ((DUP_MASK) >> 4) & 1
#define REP_4 for (int _rep = 0; _rep < 2; ++_rep)
#else
#define REP_4
#endif
#if ((DUP_MASK) >> 5) & 1
#define REP_5 for (int _rep = 0; _rep < 2; ++_rep)
#else
#define REP_5
#endif
#if ((DUP_MASK) >> 6) & 1
#define REP_6 for (int _rep = 0; _rep < 2; ++_rep)
#else
#define REP_6
#endif
#if ((DUP_MASK) >> 7) & 1
#define REP_7 for (int _rep = 0; _rep < 2; ++_rep)
#else
#define REP_7
#endif
#if ((DUP_MASK) >> 9) & 1
#define REP_9 for (int _rep = 0; _rep < 2; ++_rep)
#else
#define REP_9
#endif
#if ((DUP_MASK) >> 11) & 1
#define REP_11 for (int _rep = 0; _rep < 2; ++_rep)
#else
#define REP_11
#endif
#if ((DUP_MASK) >> 13) & 1
#define REP_13 for (int _rep = 0; _rep < 2; ++_rep)
#else
#define REP_13
#endif
#if ((DUP_MASK) >> 14) & 1
#define REP_14 for (int _rep2 = 0; _rep2 < 2; ++_rep2)
#else
#define REP_14
#endif
#if ((DUP_MASK) >> 15) & 1
#define REP_15 for (int _rep2 = 0; _rep2 < 2; ++_rep2)
#else
#define REP_15
#endif
#ifndef PH_MASK
#define PH_MASK 0xffffffu
#endif
#define IN(k) ((((PH_MASK) >> (k)) & 1u) && lo <= (k) && (k) < hi)
#define SEAM(k) do { if (IN(k) && IN((k) + 1)) xcd_barrier(bar, F.wave); F.lane = lane_id_v(); F.tid = F.wave * 64 + F.lane; } while (0)

    bf16_t* XB = (bf16_t*)(ws + WS_XB);
    bf16_t* HA = (bf16_t*)(ws + WS_HA); bf16_t* P = (bf16_t*)(ws + WS_R1); bf16_t* HFF = (bf16_t*)(ws + WS_R1); bf16_t* OY = (bf16_t*)(ws + WS_OY); bf16_t* YS = (bf16_t*)(ws + WS_YS);
    const float* MS = (const float*)(ws + WS_MS);
    const float* ropec = (const float*)(ws + WS_ROPE); const float* ropes = ropec + 1024;
    int* tok_e = (int*)(ws + WS_ROUTE); float* tok_g = (float*)(ws + WS_ROUTE + 262144); int* tok_rank = (int*)(ws + WS_ROUTE + 524288);
    int* slot_token = (int*)(ws + WS_SLOT);
    const int gw = F.vcu * NWAVES + F.wave, NGW = F.G * NWAVES;
    char* ldsg = (char*)lds_raw;

#define TAIL_FILL(busy, kper, base) do { const int c_ = (int)blockIdx.x; if (c_ >= (busy)) { const int nfw_ = (256 - (busy)) * NWAVES, r_ = (c_ - (busy)) * NWAVES + F.wave; \
        convert_range(F.lds, F.wave, lane_id_v(), KARG(), CV_L0 + (base) + r_, nfw_, CV_L0 + (base) + (kper) * nfw_); } } while (0)
    constexpr int TF_K = 4, TF_K4 = 14;
    constexpr int TF_B2 = 0, TF_B4 = TF_B2 + 96 * NWAVES * TF_K, TF_B6 = TF_B4 + 192 * NWAVES * TF_K, TF_B7 = TF_B6 + 160 * NWAVES * TF_K, TF_B9 = TF_B7 + 192 * NWAVES * TF_K4, TF_END = TF_B9 + 192 * NWAVES * TF_K;
    static_assert(CV_L0 + TF_END <= CV_N, "tail fillers");
#if PROBE_T && PROBE_T_PHASE == 40
#define RGN(n) do { if (F.wave == 0 && blockIdx.x == 0 && lane_id_v() == 0) { volatile LAS unsigned* tacc_ = (volatile LAS unsigned*)(F.lds + MISC_OFF) + 16; const unsigned _now = (unsigned)__builtin_amdgcn_s_memrealtime(); tacc_[n] += _now - tacc_[0]; tacc_[0] = _now; } } while (0)
#else
#define RGN(n) do {} while (0)
#endif
    RGN(0);
    REP_0 if (IN(0)) { p0_prologue(F, KARG()); __syncthreads(); }
    RGN(1);
    SEAM(0);

    RGN(0);
    REP_1 if (IN(1)) {
        KArgP AP = KARG(); const float* x_in = AP->in[0]; const float* ctx_in = AP->in[2];
        const float* g = AP->in[6];
#pragma unroll 1
        for (int seg = 0; seg < 2; ++seg) {
            const int nr = seg ? 2 : 16; const int m0 = seg ? MLAT + gw * 2 : gw * 16; const int r17 = seg ? 16 : (m0 >> 11);
            const float* xbase = seg ? ctx_in + (size_t)(m0 - MLAT) * D : x_in + (size_t)m0 * D;
            const float* msr = MS + (size_t)r17 * 6144;
            const ModP MP = ld_modp(g, msr, msr + 1024, F.lane);
            Row xn = ld_row_f32(xbase, F.lane);
            for (int i = 0; i < nr; ++i) {
                const Row x = xn; if (i + 1 < nr) xn = ld_row_f32(xbase + (size_t)(i + 1) * D, F.lane);
                st_row_bf16(HA + (size_t)(m0 + i) * D, F.lane, row_modulate2(x, MP));
            }
        }
    }
    RGN(2);
    SEAM(1);

    REP_2 if (IN(2)) {
        pg8::DenseSched S{(const char*)HA, (const char*)(ws + WS_WIN), D, D, F.G, (int)blockIdx.x, MALL / 256, 10, 0, 0, 0, 0, 0, 0};
        LAS float* rl = (LAS float*)(F.lds + ROPE_LDS); for (int i = F.tid; i < 2048; i += NWAVES * 64) rl[i] = ropec[i]; __syncthreads();
        pg8::EpiInProj E{P, rl, rl + 1024};
        pg8::gemm_phase<pg8::EpiInProj, pg8::DenseSched, true>(F.lds, F.wave, D, S, E);
        TAIL_FILL(1440 - 5 * 256, TF_K, TF_B2);
    }
    SEAM(2);

#define ATTN_PHASE(LAYER, WITH_CTX) do { \
        KArgP AP = KARG(); \
        float lam; { const float a1 = AP->in[12][(LAYER) * 64 + F.lane] * AP->in[13][(LAYER) * 64 + F.lane], a2 = AP->in[14][(LAYER) * 64 + F.lane] * AP->in[15][(LAYER) * 64 + F.lane]; \
            lam = __expf(wave_sum(a1)) - __expf(wave_sum(a2)) + ((LAYER) ? LAMBDA_INIT1 : LAMBDA_INIT0); } \
        const float oscale = 1.f - ((LAYER) ? LAMBDA_INIT1 : LAMBDA_INIT0); \
        const float* subg = AP->in[16] + (LAYER) * 128; \
        const int c = (int)blockIdx.x, xcd = c & 7, jj = c >> 3; \
        for (int i = 0; i < 5; ++i) { \
            bf16_t* Qb; const bf16_t* K0; const bf16_t* K1; int n1; \
            if (i < 4) { const int bh = i * 16 + xcd * 2 + (jj >> 4), qb = jj & 15, b = bh >> 2, h = bh & 3; \
                Qb = P + ((size_t)b * SEQ + qb * 128) * NIN + COL_Q + h * 128; K0 = P + ((size_t)MLAT + b * CTX) * NIN + COL_K + h * 128; K1 = P + ((size_t)b * SEQ) * NIN + COL_K + h * 128; n1 = 32; } \
            else { if (!((WITH_CTX) && c < 128)) break; const int bh = c >> 1, qb = c & 1, b = bh >> 2, h = bh & 3;        \
                Qb = P + ((size_t)MLAT + b * CTX + qb * 128) * NIN + COL_Q + h * 128; K0 = P + ((size_t)MLAT + b * CTX) * NIN + COL_K + h * 128; K1 = K0; n1 = 0; } \
            att::attn_unit(Qb, K0, 4, K1, n1, Qb, lam, oscale, subg, ldsg, F.wave); } \
        int c1 = c; asm volatile("" : "+s"(c1)); \
        int c2 = c1; asm volatile("" : "+s"(c2)); \
        SGT(7); \
        if (!DBG_NO_SG) { const bf16_t* sgw = (const bf16_t*)(ws + WS_SGW) + (size_t)(LAYER) * 4 * 128 * 128; \
          att::sg_unit(P + (size_t)c2 * 128 * NIN, sgw, AP->in[17] + (LAYER) * 512, AP->in[18] + (LAYER) * 512, AP->in[20] + (LAYER) * 512, ldsg, F.wave, 0, 4); \
          int c3 = c2; asm volatile("" : "+s"(c3)); \
          if ((WITH_CTX) && c3 >= 128) { const int it_ = c3 - 128;          \
              att::sg_unit(P + ((size_t)MLAT + (it_ >> 2) * 128) * NIN, sgw, AP->in[17] + (LAYER) * 512, AP->in[18] + (LAYER) * 512, AP->in[20] + (LAYER) * 512, ldsg, F.wave, it_ & 3, (it_ & 3) + 1); } } \
        SGT(1); \
    } while (0)
#if PROBE_T && PROBE_T_PHASE == 30
#define SGT(n) do { if (F.wave == 0 && blockIdx.x == 0 && lane_id_v() == 0) { volatile LAS unsigned* tacc_ = (volatile LAS unsigned*)(F.lds + MISC_OFF) + 16; const unsigned _now = (unsigned)__builtin_amdgcn_s_memrealtime(); tacc_[n] += _now - tacc_[0]; tacc_[0] = _now; } } while (0)
#else
#define SGT(n) do {} while (0)
#endif
    RGN(0);
    if (IN(3)) { ATTN_PHASE(0, true); }
    RGN(3);
    SEAM(3);

    REP_4 if (IN(4)) {
        pg8::DenseSched S{(const char*)P, (const char*)(ws + WS_WOUT), NIN, D, F.G, (int)blockIdx.x, MALL / 256, 4, 0, 0, 0, 0, 0, 0};
        pg8::EpiPlain E{OY, D, 1.f};
        pg8::gemm_phase<pg8::EpiPlain, pg8::DenseSched, true>(F.lds, F.wave, D, S, E);
#if PROBE_NULL_G2 == 1
        { pg8::EpiNull E0; pg8::gemm_phase<pg8::EpiNull, pg8::DenseSched, true>(F.lds, F.wave, D, S, E0); }
#elif PROBE_NULL_G2 == 2
        { pg8::EpiPlainMask E0{HA, D}; pg8::gemm_phase<pg8::EpiPlainMask, pg8::DenseSched, true>(F.lds, F.wave, D, S, E0); }
#endif
        TAIL_FILL(576 - 2 * 256, TF_K, TF_B4);
    }
    SEAM(4);

    RGN(0);
    REP_5 if (IN(5)) {
        KArgP AP = KARG(); const float* x_in = AP->in[0]; const float* ctx_in = AP->in[2];
        const float* gpost = AP->in[7]; const float* gpre = AP->in[8];
#pragma unroll 1
        for (int seg = 0; seg < 2; ++seg) {
            const int nr = seg ? 2 : 16; const int m0 = seg ? MLAT + gw * 2 : gw * 16; const int r17 = seg ? 16 : (m0 >> 11);
            const float* xbase = seg ? ctx_in + (size_t)(m0 - MLAT) * D : x_in + (size_t)m0 * D;
            const float* msr = MS + (size_t)r17 * 6144;
            const ResP RP = ld_resp(gpost, msr + 2 * 1024, F.lane); const ModP MP = ld_modp(gpre, msr + 3 * 1024, msr + 4 * 1024, F.lane);
            Row xn = ld_row_f32(xbase, F.lane), on = ld_row_bf16(OY + (size_t)m0 * D, F.lane);
            for (int i = 0; i < nr; ++i) {
                Row x = xn; const Row o = on; if (i + 1 < nr) { xn = ld_row_f32(xbase + (size_t)(i + 1) * D, F.lane); on = ld_row_bf16(OY + (size_t)(m0 + i + 1) * D, F.lane); }
                row_residual2(x, o, RP);
                st_row_bf16(XB + (size_t)(m0 + i) * D, F.lane, x);
                st_row_bf16(HA + (size_t)(m0 + i) * D, F.lane, row_modulate2(x, MP));
            }
        }
    }
    RGN(4);
    SEAM(5);

    REP_6 if (IN(6)) {
        pg8::DenseSched S{(const char*)HA, (const char*)(ws + WS_W13), D, D, F.G, (int)blockIdx.x, MALL / 256, 22, 0, 0, 0, 0, 0, 0, PROBE_T_PHASE == 6};
#if FFN_DOWN_FP8
        pg8::EpiSwigluF8 E{(unsigned char*)HFF, DFF, -1.4426950408889634f, 4.f};
        pg8::gemm_phase<pg8::EpiSwigluF8, pg8::DenseSched, true>(F.lds, F.wave, D, S, E);
#else
        pg8::EpiSwiglu E{HFF, DFF};
        pg8::gemm_phase<pg8::EpiSwiglu, pg8::DenseSched, true>(F.lds, F.wave, D, S, E);
#endif
        TAIL_FILL(3168 - 12 * 256, TF_K, TF_B6);
    }
    SEAM(6);

    REP_7 if (IN(7)) {
#if FFN_DOWN_FP8
        pg8::DenseSchedF8 S{(const char*)HFF, (const char*)(ws + WS_W2), DFF, DFF, F.G, (int)blockIdx.x, MALL / 256, 4, 0};
        pg8::EpiPlain E{OY, D, 1.f / 512.f};
        pg8::gemm_phase<pg8::EpiPlain, pg8::DenseSchedF8, true, true>(F.lds, F.wave, DFF, S, E);
#else
        pg8::DenseSched S{(const char*)HFF, (const char*)(ws + WS_W2), DFF, DFF, F.G, (int)blockIdx.x, MALL / 256, 4, 0, 0, 0, 0, 0, 0};
        pg8::EpiPlain E{OY, D, 1.f};
        pg8::gemm_phase<pg8::EpiPlain, pg8::DenseSched, true>(F.lds, F.wave, DFF, S, E);
#endif
        TAIL_FILL(576 - 2 * 256, TF_K4, TF_B7);
    }
    SEAM(7);

    if (IN(8)) {
        KArgP AP = KARG();
        const float* gpost = AP->in[9]; const float* gpre = AP->in[6] + D;
#pragma unroll 1
        for (int seg = 0; seg < 2; ++seg) {
            const int nr = seg ? 2 : 16; const int m0 = seg ? MLAT + gw * 2 : gw * 16; const int r17 = seg ? 16 : (m0 >> 11);
            const float* msr = MS + (size_t)r17 * 6144; const float* msr1 = MS + (size_t)(17 + r17) * 6144;
            const ResP RP = ld_resp(gpost, msr + 5 * 1024, F.lane); const ModP MP = ld_modp(gpre, msr1, msr1 + 1024, F.lane);
            Row xn = ld_row_bf16(XB + (size_t)m0 * D, F.lane), yn = ld_row_bf16(OY + (size_t)m0 * D, F.lane);
            for (int i = 0; i < nr; ++i) {
                Row x = xn; const Row y = yn; if (i + 1 < nr) { xn = ld_row_bf16(XB + (size_t)(m0 + i + 1) * D, F.lane); yn = ld_row_bf16(OY + (size_t)(m0 + i + 1) * D, F.lane); }
                row_residual2(x, y, RP);
                if (!seg) st_row_bf16(XB + (size_t)(m0 + i) * D, F.lane, x);
                st_row_bf16(HA + (size_t)(m0 + i) * D, F.lane, row_modulate2(x, MP));
            }
        }
    }
    SEAM(8);

    REP_9 if (IN(9)) {
        pg8::DenseSched S{(const char*)HA, (const char*)(ws + WS_WIN + (size_t)NIN * D * 2), D, D, F.G, (int)blockIdx.x, MLAT / 256, 10, 0, 0, MCTX / 256, 4, MLAT, 4};
        LAS float* rl = (LAS float*)(F.lds + ROPE_LDS); for (int i = F.tid; i < 2048; i += NWAVES * 64) rl[i] = ropec[i]; __syncthreads();
        pg8::EpiInProj E{P, rl, rl + 1024};
        pg8::gemm_phase<pg8::EpiInProj, pg8::DenseSched, true>(F.lds, F.wave, D, S, E);
        TAIL_FILL(1344 - 5 * 256, TF_K, TF_B9);
    }
    SEAM(9);

    if (IN(10)) { ATTN_PHASE(1, false); }
    SEAM(10);

    REP_11 if (IN(11)) {
        pg8::DenseSched S{(const char*)P, (const char*)(ws + WS_WOUT + (size_t)D * D * 2), NIN, D, F.G, (int)blockIdx.x, MLAT / 256, 4, 0, 0, 0, 0, 0, 0};
        pg8::EpiPlain E{OY, D, 1.f};
        pg8::gemm_phase<pg8::EpiPlain, pg8::DenseSched, true>(F.lds, F.wave, D, S, E);
    }
    SEAM(11);

    RGN(0);
    if (IN(12)) {
        KArgP AP = KARG();
        const float* gpost = AP->in[7] + D; const float* gpre = AP->in[8] + D;
        LAS float* rw = (LAS float*)F.lds;
        LAS int* lcnt = (LAS int*)(F.lds + 32768);
        LAS int* rec = (LAS int*)(F.lds + 32768 + 256);
        for (int i = F.tid; i < 8192; i += 512) rw[(i & 7) * 1024 + (i >> 3)] = AP->in[24][i];
        if (F.tid < 16) lcnt[F.tid] = 0;
        __syncthreads();
        const int m0 = gw * 16; const int r17 = m0 >> 11; const float* msr1 = MS + (size_t)(17 + r17) * 6144;
        const ResP RP = ld_resp(gpost, msr1 + 2 * 1024, F.lane); const ModP MP = ld_modp(gpre, msr1 + 3 * 1024, msr1 + 4 * 1024, F.lane);
        Row xn = ld_row_bf16(XB + (size_t)m0 * D, F.lane), on = ld_row_bf16(OY + (size_t)m0 * D, F.lane);
        for (int i = 0; i < 16; ++i) {
            const int m = m0 + i;
            Row x = xn; const Row o = on; if (i + 1 < 16) { xn = ld_row_bf16(XB + (size_t)(m + 1) * D, F.lane); on = ld_row_bf16(OY + (size_t)(m + 1) * D, F.lane); }
            row_residual2(x, o, RP);
            st_row_bf16(XB + (size_t)m * D, F.lane, x);
            const Row f = row_modulate2(x, MP);
            { unsigned* fo = (unsigned*)(ws + WS_F8 + (size_t)m * D) + F.lane;
#pragma unroll
              for (int j = 0; j < 4; ++j) fo[64 * j] = pg8::pk_fp8x4(f.v[j][0] * 4.f, f.v[j][1] * 4.f, f.v[j][2] * 4.f, f.v[j][3] * 4.f); }
            float lg[8];
#pragma unroll
            for (int e = 0; e < 8; ++e) { float a = 0.f;
#pragma unroll
                for (int j = 0; j < 4; ++j) { const f32x4 w = *(const LAS f32x4*)(rw + e * 1024 + 4 * (F.lane + 64 * j)); a += (f.v[j][0] * w[0] + f.v[j][1] * w[1]) + (f.v[j][2] * w[2] + f.v[j][3] * w[3]); }
                lg[e] = wave_sum(a); }
            int e1 = 0; float v1 = lg[0];
#pragma unroll
            for (int e = 1; e < 8; ++e) if (lg[e] > v1) { v1 = lg[e]; e1 = e; }
            int e2 = -1; float v2 = -3.0e38f;
#pragma unroll
            for (int e = 0; e < 8; ++e) if (e != e1 && lg[e] > v2) { v2 = lg[e]; e2 = e; }
            if (F.lane == 0) {
                const float w1 = 1.f / (1.f + __expf(v2 - v1));
                tok_e[m * 2] = e1; tok_e[m * 2 + 1] = e2; tok_g[m * 2] = w1; tok_g[m * 2 + 1] = 1.f - w1;
                const int l1 = __hip_atomic_fetch_add(lcnt + e1, 1, __ATOMIC_RELAXED, __HIP_MEMORY_SCOPE_WORKGROUP), l2 = __hip_atomic_fetch_add(lcnt + e2, 1, __ATOMIC_RELAXED, __HIP_MEMORY_SCOPE_WORKGROUP);
                LAS int* rr = rec + (F.wave * 16 + i) * 4; rr[0] = e1; rr[1] = e2; rr[2] = l1; rr[3] = l2;
            }
        }
        __syncthreads();
        if (F.tid < 8) lcnt[8 + F.tid] = (int)__hip_atomic_fetch_add(F.ctl + CW_CNT + 64 * F.tid, (unsigned)lcnt[F.tid], RLX_AGENT);
        __syncthreads();
        if (F.lane < 16) { const int m = m0 + F.lane; const LAS int* rr = rec + (F.wave * 16 + F.lane) * 4;
            const int r1 = lcnt[8 + rr[0]] + rr[2], r2 = lcnt[8 + rr[1]] + rr[3];
            tok_rank[m * 2] = r1; tok_rank[m * 2 + 1] = r2; slot_token[rr[0] * 32768 + r1] = m; slot_token[rr[1] * 32768 + r2] = m; }
        __syncthreads();
        convert_range(F.lds, F.wave, lane_id_v(), KARG(), CV_L0 + TF_END + gw, NGW, CV_N);
    }
    RGN(5);
    SEAM(12);

    {
        MoeTab T; T.pbase[8] = 0;
        if (hi > 13 && lo < 23) moe_tab(F.ctl, T);
        const int ptot = T.pbase[8];
        REP_13 for (int ch = 0; ch < 2; ++ch) {
            const int p0 = ch * 128; const int nM = ch ? ptot - 128 : (ptot < 128 ? ptot : 128);
            REP_14 if (IN(13 + 2 * ch) && nM > 0) {
                MoeUpSched S{(const char*)(ws + WS_F8), (const char*)(ws + WS_MW13), slot_token, F.G, (int)blockIdx.x, p0, nM, T, PROBE_T_PHASE == 13};
                pg8::EpiSwigluF8 E{ws + WS_HF8 + (size_t)p0 * 256 * DEXP, DEXP, -1.4426950408889634f / 512.f, 4.f / (512.f * 512.f)};
                pg8::gemm_phase<pg8::EpiSwigluF8, MoeUpSched, true, true>(F.lds, F.wave, D, S, E);
            }
            if (IN(13 + 2 * ch) && IN(14 + 2 * ch) && nM > 0) xcd_barrier(bar, F.wave);
            REP_15 if (IN(14 + 2 * ch) && nM > 0) {
                MoeDownSched S{(const char*)(ws + WS_HF8 + (size_t)p0 * 256 * DEXP), (const char*)(ws + WS_MW2), F.G, (int)blockIdx.x, p0, nM, T, PROBE_T_PHASE == 14};
                pg8::EpiPlain E{YS, D, 1.f / 512.f};
                pg8::gemm_phase<pg8::EpiPlain, MoeDownSched, true, true>(F.lds, F.wave, DEXP, S, E);
            }
            if (ch == 1 && IN(14 + 2 * ch) && IN(15 + 2 * ch) && nM > 0) xcd_barrier(bar, F.wave);
        }
    }

    RGN(0);
    if (IN(23)) {
        MoeTab T; moe_tab(F.ctl, T);
        const float* gpost = KARG()->in[9] + D;
#define YS_ROWS(mm, S1, S2) do { const int e1_ = tok_e[(mm) * 2], e2_ = tok_e[(mm) * 2 + 1]; int pb1_ = 0, pb2_ = 0; \
            _Pragma("unroll") for (int e = 0; e < 8; ++e) { pb1_ = (e1_ == e) ? T.pbase[e] : pb1_; pb2_ = (e2_ == e) ? T.pbase[e] : pb2_; } \
            S1 = (size_t)pb1_ * 256 + tok_rank[(mm) * 2]; S2 = (size_t)pb2_ * 256 + tok_rank[(mm) * 2 + 1]; } while (0)
        const int m0 = gw * 16; const int r17 = m0 >> 11; const float* msr1 = MS + (size_t)(17 + r17) * 6144;
        const ResP RP = ld_resp(gpost, msr1 + 5 * 1024, F.lane);
        size_t s1, s2; YS_ROWS(m0, s1, s2);
        Row xn = ld_row_bf16(XB + (size_t)m0 * D, F.lane), yan = ld_row_bf16(YS + s1 * D, F.lane), ybn = ld_row_bf16(YS + s2 * D, F.lane);
        float* outp = KARG()->out;
        for (int i = 0; i < 16; ++i) {
            const int m = m0 + i;
            Row x = xn; const Row ya = yan, yb = ybn; const float g1 = tok_g[m * 2], g2 = tok_g[m * 2 + 1];
            if (i + 1 < 16) { YS_ROWS(m + 1, s1, s2); xn = ld_row_bf16(XB + (size_t)(m + 1) * D, F.lane); yan = ld_row_bf16(YS + s1 * D, F.lane); ybn = ld_row_bf16(YS + s2 * D, F.lane); }
            Row y;
#pragma unroll
            for (int j = 0; j < 4; ++j) y.v[j] = ya.v[j] * g1 + yb.v[j] * g2;
            row_residual2(x, y, RP);
            st_row_f32(outp + (size_t)m * D, F.lane, x);
        }
    }
    RGN(6);
#if PROBE_T
    if (blockIdx.x == 0 && F.wave == 0) { const unsigned ticks = ((volatile LAS unsigned*)(F.lds + MISC_OFF))[16 + PROBE_T]; const unsigned long long t0 = __builtin_amdgcn_s_memrealtime();
        while (__builtin_amdgcn_s_memrealtime() - t0 < (unsigned long long)ticks * 8ull) __builtin_amdgcn_s_sleep(8); }
#endif
#undef TAIL_FILL
#undef IN
#undef SEAM
#undef ATTN_PHASE
}

extern "C" void kernel_launch(void* const* d_in, const int* in_sizes, int n_in, void* d_out, int out_size, void* d_ws, size_t ws_size, hipStream_t stream) {
    static int grid = 0;
    if (grid == 0) {
        if (n_in != 28 || out_size != MLAT * D || ws_size < WS_END) { fprintf(stderr, "kernel_launch: unexpected shapes (n_in %d, out %d, ws %zu)\n", n_in, out_size, ws_size); grid = -1; return; }
        int dev = 0, cus = 0, per_cu = 0;
        if (hipGetDevice(&dev) != hipSuccess || hipDeviceGetAttribute(&cus, hipDeviceAttributeMultiprocessorCount, dev) != hipSuccess) { grid = -1; return; }
        if (hipFuncSetAttribute((const void*)mk_fwd, hipFuncAttributeMaxDynamicSharedMemorySize, LDS_BYTES) != hipSuccess) { fprintf(stderr, "kernel_launch: hipFuncSetAttribute failed\n"); grid = -1; return; }
        if (hipOccupancyMaxActiveBlocksPerMultiprocessor(&per_cu, (const void*)mk_fwd, NWAVES * 64, LDS_BYTES) != hipSuccess || per_cu < 1) { fprintf(stderr, "kernel_launch: occupancy query says %d\n", per_cu); (void)hipGetLastError(); }
        grid = cus;
        if (grid != 256) { fprintf(stderr, "kernel_launch: built for 256 CUs, found %d\n", grid); grid = -1; return; }
    }
    if (grid < 0) return;
    (void)hipMemsetAsync((char*)d_ws + WS_CTL, 0, CTL_ZERO_BYTES, stream);
    Args a{};
    for (int i = 0; i < 28; ++i) a.in[i] = (const float*)d_in[i];
    a.out = (float*)d_out; a.ws = (unsigned char*)d_ws;
#if MK_PER_PHASE
    for (int p = 0; p < N_PHASES; ++p) { a.ph_lo = p; a.ph_hi = p + 1; hipLaunchKernelGGL(mk_fwd, dim3(grid), dim3(NWAVES * 64), LDS_BYTES, stream, a); }
#else
    a.ph_lo = 0; a.ph_hi = N_PHASES;
    hipLaunchKernelGGL(mk_fwd, dim3(grid), dim3(NWAVES * 64), LDS_BYTES, stream, a);
#endif
}
```

```cpp
#include <hip/hip_runtime.h>
#include <cstdio>
#include <cstdint>

#ifndef DBG_NO_SG
#define DBG_NO_SG 0
#endif
#ifndef DBG_NO_CTX
#define DBG_NO_CTX 0
#endif
#ifndef DBG_NO_LAT
#define DBG_NO_LAT 0
#endif
#ifndef PROBE_T
#define PROBE_T 0
#endif
#ifndef PROBE_T_PHASE
#define PROBE_T_PHASE 6
#endif
#ifndef FFN_DOWN_FP8
#define FFN_DOWN_FP8 1
#endif
#ifndef MK_PER_PHASE
#define MK_PER_PHASE 0
#endif

#define LAS __attribute__((address_space(3)))
#define GAS __attribute__((address_space(1)))
typedef unsigned short bf16_t;
typedef short bf16x8 __attribute__((ext_vector_type(8)));
typedef short s16x4 __attribute__((ext_vector_type(4)));
typedef float f32x2 __attribute__((ext_vector_type(2)));
typedef float f32x4 __attribute__((ext_vector_type(4)));
typedef float f32x16 __attribute__((ext_vector_type(16)));
typedef unsigned u32x2 __attribute__((ext_vector_type(2)));
typedef unsigned u32x4 __attribute__((ext_vector_type(4)));
typedef GAS unsigned gu32;
typedef int v8i __attribute__((ext_vector_type(8)));
typedef int v4i __attribute__((ext_vector_type(4)));

constexpr int D = 1024, BATCH = 16, SEQ = 2048, CTX = 256;
constexpr int MLAT = BATCH * SEQ;
constexpr int MCTX = BATCH * CTX;
constexpr int MALL = MLAT + MCTX;
constexpr int NIN = 2560;
constexpr int COL_Q = 0, COL_U = 512, COL_K = 1024, COL_V = 1536, COL_G = 2048;
constexpr int DFF = 2816, DEXP = 3584, NEXP = 8;
constexpr float EPS = 1e-6f;
constexpr float LAMBDA_INIT0 = 0.2f, LAMBDA_INIT1 = 0.35550907f;

constexpr size_t MiB = 1u << 20;
constexpr size_t WS_CTL = 0, CTL_ZERO_BYTES = 1 * MiB;
constexpr size_t WS_MS = 1 * MiB;
constexpr size_t WS_ROPE = 2 * MiB;
constexpr size_t WS_ROUTE = 3 * MiB;
constexpr size_t WS_SLOT = 4 * MiB;
constexpr size_t WS_WIN = 5 * MiB;
constexpr size_t WS_WOUT = 15 * MiB;
constexpr size_t WS_SGW = 19 * MiB;
constexpr size_t WS_W13 = 20 * MiB;
constexpr size_t WS_W2 = 31 * MiB;
constexpr size_t WS_MW13 = 37 * MiB;
constexpr size_t WS_MW2 = 93 * MiB;
constexpr size_t WS_XB = 121 * MiB;
constexpr size_t WS_HA = 221 * MiB;
constexpr size_t WS_R1 = 293 * MiB;
constexpr size_t WS_OY = 491 * MiB;
constexpr size_t WS_F8 = 5 * MiB;
constexpr size_t WS_HF8 = 221 * MiB;
constexpr size_t WS_YS = 452 * MiB;
constexpr size_t WS_END = 584 * MiB;

constexpr int CW_BAR = 4096;
constexpr int CW_CNT = 64;

constexpr int RING_BYTES = 131072;
constexpr int LDSCTL_OFF = RING_BYTES, MISC_OFF = LDSCTL_OFF + 320;
constexpr int LDS_BYTES = 147456;
constexpr int ROPE_LDS = RING_BYTES + 6144;
static_assert(ROPE_LDS + 8192 <= LDS_BYTES, "LDS map");
constexpr int NWAVES = 8;

#define RLX_AGENT __ATOMIC_RELAXED, __HIP_MEMORY_SCOPE_AGENT
#define LDS_WAIT() asm volatile("s_waitcnt lgkmcnt(0)" ::: "memory")
#define VM_WAIT() asm volatile("s_waitcnt vmcnt(0)" ::: "memory")
#define SBAR() __builtin_amdgcn_sched_barrier(0)

__device__ __forceinline__ unsigned cvt_pk_bf16(float lo, float hi) { unsigned r; asm volatile("v_cvt_pk_bf16_f32 %0, %1, %2" : "=v"(r) : "v"(lo), "v"(hi)); return r; }
__device__ __forceinline__ float bf2f(unsigned short b) { return __builtin_bit_cast(float, (unsigned)b << 16); }
__device__ __forceinline__ float bflo(unsigned w) { return __builtin_bit_cast(float, w << 16); }
__device__ __forceinline__ float bfhi(unsigned w) { return __builtin_bit_cast(float, w & 0xffff0000u); }
__device__ __forceinline__ float wave_sum(float v) {
#pragma unroll
    for (int o = 1; o < 64; o <<= 1) v += __shfl_xor(v, o);
    return v;
}
__device__ __forceinline__ int lane_id_v() { int l; asm volatile("v_mbcnt_lo_u32_b32 %0, -1, 0\n\tv_mbcnt_hi_u32_b32 %0, -1, %0" : "=v"(l)); return l; }
__device__ __forceinline__ float silu_f(float v) { return v / (1.f + __expf(-v)); }

namespace pg8 {
constexpr int BM = 256, BK = 64, HALF = 128, HTB = HALF * BK * 2, STAGE_BYTES = 8 * HTB, NXCD = 8, WGM = 4;
constexpr int IDX_OFF = STAGE_BYTES + 4096;
__host__ __device__ __forceinline__ int lds_byte(int r, int c) { const int st = (r >> 4) * 2 + (c >> 5), rr = r & 15, cc = c & 31, ob = rr * 64 + cc * 2; return st * 1024 + (ob ^ (((ob >> 9) & 1) << 5)); }
__host__ __device__ __forceinline__ void stage_rc(int b, int& R, int& C) { const int st = b / 1024, sb = b % 1024, swz = sb ^ (((sb >> 9) & 1) << 5); R = (st >> 1) * 16 + swz / 64; C = (st & 1) * 32 + (swz % 64) / 2; }
__host__ __device__ __forceinline__ int perm32(int rho) { const int n = rho >> 4, i = rho & 15; return 8 * (i >> 2) + 4 * n + (i & 3); }

struct Unit { const char* Ap; const char* Bp; int pm, pn, aux, aux2; };

__device__ __forceinline__ void tile_of(int L, int nM, int nN, int& pm, int& pn) {
    const int nwg = nM * nN; int wgid = L;
    { const int q = nwg / NXCD, r = nwg % NXCD, xcd = wgid % NXCD, off = wgid / NXCD; wgid = (xcd < r ? xcd * (q + 1) : r * (q + 1) + (xcd - r) * q) + off; }
    const int nig = WGM * nN, gid = wgid / nig, fm = gid * WGM, gsz = (nM - fm) < WGM ? (nM - fm) : WGM;
    pm = fm + ((wgid % nig) % gsz); pn = (wgid % nig) / gsz;
}

template <class Epi, class Sched, bool ALIGN_EPI, bool FP8 = false>
__device__ __forceinline__ void gemm_phase(LAS unsigned char* lds, const int wid, const int K, const Sched& S, const Epi& E) {
    const int lane = lane_id_v(), tid = wid * 64 + lane;
    const int wr = wid >> 2, wc = wid & 3, fr = lane & 15, fq = lane >> 4;
    const int kbytes = FP8 ? K : 2 * K;
    const int nt = kbytes / 128;
    int R[2], C[2]; unsigned voffB[2];
#pragma unroll
    for (int i = 0; i < 2; ++i) { stage_rc(tid * 16 + i * 8192, R[i], C[i]); const int Rb = Epi::PERM ? ((R[i] & ~31) + perm32(R[i] & 31)) : R[i]; voffB[i] = (unsigned)(Rb * kbytes + C[i] * 2); }
    const size_t kstep = (size_t)(BK * 2);
    const size_t hstepB = (size_t)HALF * kbytes;
    const unsigned ldsw = (unsigned)wid * 1024u;
    const int aoff = lds_byte(wr * 64 + fr, fq * 8), boff = lds_byte(wc * 32 + fr, fq * 8);
#define PG8_SA(b, h) (((b) * 2 + (h)) * HTB)
#define PG8_SB(b, h) ((4 + (b) * 2 + (h)) * HTB)
#define PG8_STAGE(bufoff, gbase, voff) do { _Pragma("unroll") for (int _i = 0; _i < 2; ++_i) \
        __builtin_amdgcn_global_load_lds((const unsigned*)((const char*)(gbase) + (voff)[_i]), (LAS unsigned*)(lds + (bufoff) + ldsw + _i * 8192), 16, 0, 0); } while (0)
#define PG8_LDA(dst, b, h) do { _Pragma("unroll") for (int m = 0; m < 4; ++m) { const v4i _lo = *(const LAS v4i*)(lds + PG8_SA(b, h) + aoff + m * 2048), _hi = *(const LAS v4i*)(lds + PG8_SA(b, h) + aoff + m * 2048 + 1024); \
        dst[m] = __builtin_shufflevector(_lo, _hi, 0, 1, 2, 3, 4, 5, 6, 7); } } while (0)
#define PG8_LDB(dst, b, h) do { _Pragma("unroll") for (int n = 0; n < 2; ++n) { const v4i _lo = *(const LAS v4i*)(lds + PG8_SB(b, h) + boff + n * 2048), _hi = *(const LAS v4i*)(lds + PG8_SB(b, h) + boff + n * 2048 + 1024); \
        dst[n] = __builtin_shufflevector(_lo, _hi, 0, 1, 2, 3, 4, 5, 6, 7); } } while (0)
#define PG8_LO(x) __builtin_bit_cast(bf16x8, __builtin_shufflevector(x, x, 0, 1, 2, 3))
#define PG8_HI(x) __builtin_bit_cast(bf16x8, __builtin_shufflevector(x, x, 4, 5, 6, 7))
#define PG8_MMA(ai, bj, At, Bt) do { __builtin_amdgcn_s_setprio(1); \
        if constexpr (FP8) { _Pragma("unroll") for (int m = 0; m < 4; ++m) _Pragma("unroll") for (int n = 0; n < 2; ++n) \
            asm volatile("v_mfma_f32_16x16x128_f8f6f4 %0, %1, %2, %0" : "+v"(acc[ai][bj][m][n]) : "v"(Bt[n]), "v"(At[m])); } \
        else { _Pragma("unroll") for (int m = 0; m < 4; ++m) _Pragma("unroll") for (int n = 0; n < 2; ++n) { \
            acc[ai][bj][m][n] = __builtin_amdgcn_mfma_f32_16x16x32_bf16(PG8_LO(Bt[n]), PG8_LO(At[m]), acc[ai][bj][m][n], 0, 0, 0); \
            acc[ai][bj][m][n] = __builtin_amdgcn_mfma_f32_16x16x32_bf16(PG8_HI(Bt[n]), PG8_HI(At[m]), acc[ai][bj][m][n], 0, 0, 0); } } \
        __builtin_amdgcn_s_setprio(0); } while (0)
#define PG8_WAIT_V(n) asm volatile("s_waitcnt vmcnt(" #n ")" ::: "memory")
#define PG8_WAIT_L(n) asm volatile("s_waitcnt lgkmcnt(" #n ")" ::: "memory")
#define PG8_BAR __builtin_amdgcn_s_barrier()
#define PG8_SCHED __builtin_amdgcn_sched_barrier(0)
#if PROBE_T
    volatile LAS unsigned* tacc = (volatile LAS unsigned*)(lds + MISC_OFF) + 16;
#define PG8_T(n) do { if (S.tprobe && wid == 0 && blockIdx.x == 0 && lane == 0) { const unsigned _now = (unsigned)__builtin_amdgcn_s_memrealtime(); tacc[n] += _now - tacc[0]; tacc[0] = _now; } } while (0)
#else
#define PG8_T(n) do {} while (0)
#endif
    Unit cur, nxt; int ui = 0;
    if (!S.next(0, cur)) return;
    f32x4 acc[2][2][4][2];
#pragma unroll
    for (int a = 0; a < 2; ++a)
#pragma unroll
        for (int b = 0; b < 2; ++b)
#pragma unroll
            for (int m = 0; m < 4; ++m)
#pragma unroll
                for (int n = 0; n < 2; ++n) acc[a][b][m][n] = (f32x4){0.f, 0.f, 0.f, 0.f};
    v8i At[4], B0[2], B1[2];
    unsigned cO0[2], cO1[2], nO0[2], nO1[2];
    S.aoff(cur, R, C, cO0, cO1);
    const char* cA = cur.Ap; const char* cB = cur.Bp;
    PG8_STAGE(PG8_SB(0, 0), cB, voffB); PG8_STAGE(PG8_SB(0, 1), cB + hstepB, voffB); PG8_STAGE(PG8_SA(0, 0), cA, cO0); PG8_STAGE(PG8_SA(0, 1), cA, cO1);
    if (wr == 1) PG8_BAR;
    PG8_WAIT_V(2); PG8_BAR;
    PG8_STAGE(PG8_SB(1, 0), cB + kstep, voffB); PG8_STAGE(PG8_SA(1, 0), cA + kstep, cO0); PG8_STAGE(PG8_SB(1, 1), cB + hstepB + kstep, voffB);
    PG8_WAIT_V(6); PG8_BAR;
    PG8_T(7);
    for (;;) {
        const bool has_next = S.next(ui + 1, nxt);
        if constexpr (Sched::GATHER) { if (has_next) S.prefetch_idx(nxt, lds + IDX_OFF, wid, lane); nO0[0] = cO0[0]; nO0[1] = cO0[1]; nO1[0] = cO1[0]; nO1[1] = cO1[1]; }
        const char* nA = has_next ? nxt.Ap : cA; const char* nB = has_next ? nxt.Bp : cB;
        PG8_T(4);
        for (int t = 0; t < nt; t += 2) {
            const bool last = (t == nt - 2);
            const char* a1 = cA + (size_t)(t + 1) * kstep;
            const char* a2 = last ? nA : cA + (size_t)(t + 2) * kstep; const char* b2 = last ? nB : cB + (size_t)(t + 2) * kstep;
            const char* a3 = a2 + kstep; const char* b3 = b2 + kstep;
            unsigned xO0[2], xO1[2];
            if constexpr (Sched::GATHER) { if (last && has_next) S.aoff_lds(R, C, lds + IDX_OFF, nO0, nO1); }
            if constexpr (Sched::GATHER) { xO0[0] = last ? nO0[0] : cO0[0]; xO0[1] = last ? nO0[1] : cO0[1]; xO1[0] = last ? nO1[0] : cO1[0]; xO1[1] = last ? nO1[1] : cO1[1]; }
            else { xO0[0] = cO0[0]; xO0[1] = cO0[1]; xO1[0] = cO1[0]; xO1[1] = cO1[1]; }
            const int relax = __builtin_amdgcn_readfirstlane((t == 0 && ui > 0) ? 1 : 0);
#define PG8_WAIT_VR() do { if constexpr (Epi::NSTORES == 16) asm volatile("s_cmp_eq_u32 %0, 0\n\ts_cbranch_scc1 .Lwv%=\n\ts_waitcnt vmcnt(24)\n\ts_branch .Lwe%=\n.Lwv%=:\n\ts_waitcnt vmcnt(8)\n.Lwe%=:" :: "s"(relax) : "memory", "scc"); \
        else asm volatile("s_cmp_eq_u32 %0, 0\n\ts_cbranch_scc1 .Lwv%=\n\ts_waitcnt vmcnt(16)\n\ts_branch .Lwe%=\n.Lwv%=:\n\ts_waitcnt vmcnt(8)\n.Lwe%=:" :: "s"(relax) : "memory", "scc"); } while (0)
            PG8_LDB(B0, 0, 0); PG8_LDB(B1, 0, 1); PG8_SCHED; PG8_LDA(At, 0, 0); PG8_STAGE(PG8_SA(1, 1), a1, cO1);
            PG8_WAIT_VR(); PG8_WAIT_L(0); PG8_BAR; PG8_MMA(0, 0, At, B0); PG8_MMA(0, 1, At, B1); PG8_BAR; PG8_SCHED;
            PG8_LDA(At, 0, 1); PG8_STAGE(PG8_SB(0, 0), b2, voffB); PG8_STAGE(PG8_SB(0, 1), b2 + hstepB, voffB); PG8_STAGE(PG8_SA(0, 0), a2, xO0);
            PG8_WAIT_VR(); PG8_WAIT_L(0); PG8_BAR; PG8_MMA(1, 0, At, B0); PG8_MMA(1, 1, At, B1); PG8_BAR; PG8_SCHED;
            PG8_LDB(B0, 1, 0); PG8_LDB(B1, 1, 1); PG8_SCHED; PG8_LDA(At, 1, 0); PG8_STAGE(PG8_SA(0, 1), a2, xO1);
            PG8_WAIT_V(8); PG8_WAIT_L(0); PG8_BAR; PG8_MMA(0, 0, At, B0); PG8_MMA(0, 1, At, B1); PG8_BAR; PG8_SCHED;
#undef PG8_WAIT_VR
            PG8_LDA(At, 1, 1); PG8_STAGE(PG8_SB(1, 0), b3, voffB); PG8_STAGE(PG8_SB(1, 1), b3 + hstepB, voffB); PG8_STAGE(PG8_SA(1, 0), a3, xO0);
            PG8_WAIT_V(8); PG8_WAIT_L(0); PG8_BAR; PG8_MMA(1, 0, At, B0); PG8_MMA(1, 1, At, B1); PG8_BAR; PG8_SCHED;
        }
        PG8_T(1);
        if constexpr (ALIGN_EPI) { if (wr == 0) PG8_BAR; }
        PG8_T(2);
        if constexpr (FP8) asm volatile("s_nop 15\n\ts_nop 15\n\ts_nop 15\n\ts_nop 15\n\ts_nop 15\n\ts_nop 15" ::: "memory");
        E(acc, cur, wr, wc, fr, fq);
        PG8_T(3);
        if (!has_next) break;
#pragma unroll
        for (int a = 0; a < 2; ++a)
#pragma unroll
            for (int b = 0; b < 2; ++b)
#pragma unroll
                for (int m = 0; m < 4; ++m)
#pragma unroll
                    for (int n = 0; n < 2; ++n) acc[a][b][m][n] = (f32x4){0.f, 0.f, 0.f, 0.f};
        cur = nxt; cA = nA; cB = nB; ++ui;
        if constexpr (Sched::GATHER) { cO0[0] = nO0[0]; cO0[1] = nO0[1]; cO1[0] = nO1[0]; cO1[1] = nO1[1]; }
        if constexpr (ALIGN_EPI) { if (wr == 1) PG8_BAR; }
    }
    PG8_WAIT_V(0);
    if constexpr (!ALIGN_EPI) { if (wr == 0) PG8_BAR; }
    PG8_BAR;
#undef PG8_SA
#undef PG8_SB
#undef PG8_STAGE
#undef PG8_LDA
#undef PG8_LDB
#undef PG8_MMA
#undef PG8_LO
#undef PG8_HI
#undef PG8_WAIT_V
#undef PG8_WAIT_L
#undef PG8_BAR
#undef PG8_SCHED
#undef PG8_T
}

struct DenseSched {
    static constexpr bool GATHER = false;
    const char* A; const char* Bt; int lda, K, G, c;
    int nM0, nN0, arow0_0, pn0_0, nM1, nN1, arow0_1, pn0_1; int tprobe;
    __device__ __forceinline__ bool next(int i, Unit& u) const {
        int L = i * G + c; const int n0 = nM0 * nN0;
        int pm, pn;
        if (L < n0) { tile_of(L, nM0, nN0, pm, pn); u.pm = arow0_0 / 256 + pm; u.pn = pn0_0 + pn; }
        else { L -= n0; if (L >= nM1 * nN1) return false; tile_of(L, nM1, nN1, pm, pn); u.pm = arow0_1 / 256 + pm; u.pn = pn0_1 + pn; }
        u.Ap = A + (size_t)u.pm * 256 * lda * 2; u.Bp = Bt + (size_t)u.pn * 256 * K * 2; u.aux = 0; u.aux2 = 0; return true;
    }
    __device__ __forceinline__ void aoff(const Unit&, const int (&R)[2], const int (&C)[2], unsigned (&o0)[2], unsigned (&o1)[2]) const {
#pragma unroll
        for (int i = 0; i < 2; ++i) { o0[i] = (unsigned)(R[i] * lda + C[i]) * 2u; o1[i] = (unsigned)((HALF + R[i]) * lda + C[i]) * 2u; }
    }
};

struct DenseSchedF8 {
    static constexpr bool GATHER = false;
    const char* A; const char* Bt; int lda, K, G, c, nM, nN; int tprobe;
    __device__ __forceinline__ bool next(int i, Unit& u) const {
        const int L = i * G + c; if (L >= nM * nN) return false;
        int pm, pn; tile_of(L, nM, nN, pm, pn); u.pm = pm; u.pn = pn;
        u.Ap = A + (size_t)pm * 256 * lda; u.Bp = Bt + (size_t)pn * 256 * K; u.aux = 0; u.aux2 = 0; return true;
    }
    __device__ __forceinline__ void aoff(const Unit&, const int (&R)[2], const int (&C)[2], unsigned (&o0)[2], unsigned (&o1)[2]) const {
#pragma unroll
        for (int i = 0; i < 2; ++i) { o0[i] = (unsigned)(R[i] * lda + C[i] * 2); o1[i] = (unsigned)((HALF + R[i]) * lda + C[i] * 2); }
    }
};

struct EpiPlain {
    static constexpr bool PERM = true; static constexpr int NSTORES = 16;
    bf16_t* O; int ldc; float sc;
    __device__ __forceinline__ void operator()(const f32x4 (&acc)[2][2][4][2], const Unit& u, int wr, int wc, int fr, int fq) const {
        const int row0 = u.pm * BM + wr * 64 + fr, col0 = u.pn * BM + wc * 32 + 8 * fq;
#pragma unroll
        for (int ai = 0; ai < 2; ++ai)
#pragma unroll
            for (int m = 0; m < 4; ++m) { bf16_t* rowp = O + (size_t)(row0 + ai * HALF + m * 16) * ldc + col0;
#pragma unroll
                for (int bj = 0; bj < 2; ++bj) { const f32x4 v0 = acc[ai][bj][m][0] * sc, v1 = acc[ai][bj][m][1] * sc;
                    u32x4 w; w.x = cvt_pk_bf16(v0[0], v0[1]); w.y = cvt_pk_bf16(v0[2], v0[3]); w.z = cvt_pk_bf16(v1[0], v1[1]); w.w = cvt_pk_bf16(v1[2], v1[3]);
                    *(u32x4*)(rowp + bj * HALF) = w; } }
    }
};
struct EpiPlainMask {
    static constexpr bool PERM = true; static constexpr int NSTORES = 16;
    bf16_t* O; int ldc;
    __device__ __forceinline__ void operator()(const f32x4 (&acc)[2][2][4][2], const Unit& u, int wr, int wc, int fr, int fq) const {
        const int row0 = wr * 64 + fr, col0 = u.pn * BM + wc * 32 + 8 * fq;
#pragma unroll
        for (int ai = 0; ai < 2; ++ai)
#pragma unroll
            for (int m = 0; m < 4; ++m) { bf16_t* rowp = O + (size_t)(row0 + ai * HALF + m * 16) * ldc + col0;
#pragma unroll
                for (int bj = 0; bj < 2; ++bj) { const f32x4 v0 = acc[ai][bj][m][0], v1 = acc[ai][bj][m][1];
                    u32x4 w; w.x = cvt_pk_bf16(v0[0], v0[1]); w.y = cvt_pk_bf16(v0[2], v0[3]); w.z = cvt_pk_bf16(v1[0], v1[1]); w.w = cvt_pk_bf16(v1[2], v1[3]);
                    *(u32x4*)(rowp + bj * HALF) = w; } }
    }
};
struct EpiNull {
    static constexpr bool PERM = true; static constexpr int NSTORES = 8;
    __device__ __forceinline__ void operator()(const f32x4 (&acc)[2][2][4][2], const Unit&, int, int, int, int) const {
#pragma unroll
        for (int ai = 0; ai < 2; ++ai)
#pragma unroll
            for (int bj = 0; bj < 2; ++bj)
#pragma unroll
                for (int m = 0; m < 4; ++m) asm volatile("" :: "v"(acc[ai][bj][m][0]), "v"(acc[ai][bj][m][1]));
    }
};
struct EpiInProj {
    static constexpr bool PERM = true; static constexpr int NSTORES = 16;
    bf16_t* O; const LAS float* ropec; const LAS float* ropes;
    __device__ __forceinline__ void operator()(const f32x4 (&acc)[2][2][4][2], const Unit& u, int wr, int wc, int fr, int fq) const {
        const int row0 = u.pm * BM + wr * 64 + fr, col0 = u.pn * BM + wc * 32 + 8 * fq;
        const bool rope = (u.pm < MLAT / 256) && (u.pn < 2 || (u.pn >= 4 && u.pn < 6));
        const bool colpos = (wc & 1) != 0;
        const float qs = u.pn < 2 ? 0.18033688011112042f : 1.f;
#pragma unroll
        for (int ai = 0; ai < 2; ++ai)
#pragma unroll
            for (int m = 0; m < 4; ++m) { const int row = row0 + ai * HALF + m * 16; bf16_t* rowp = O + (size_t)row * NIN + col0;
                f32x4 cs = {1.f, 1.f, 1.f, 1.f}, sn = {0.f, 0.f, 0.f, 0.f};
                if (rope) { const int t = row & (SEQ - 1), pos = colpos ? (t & 63) : (t >> 6); cs = *(const LAS f32x4*)(ropec + pos * 16 + 4 * fq); sn = *(const LAS f32x4*)(ropes + pos * 16 + 4 * fq); }
#pragma unroll
                for (int bj = 0; bj < 2; ++bj) { const f32x4 a = acc[ai][bj][m][0] * qs, b = acc[ai][bj][m][1] * qs;
                    const f32x4 v0 = a * cs - b * sn, v1 = b * cs + a * sn;
                    u32x4 w; w.x = cvt_pk_bf16(v0[0], v0[1]); w.y = cvt_pk_bf16(v0[2], v0[3]); w.z = cvt_pk_bf16(v1[0], v1[1]); w.w = cvt_pk_bf16(v1[2], v1[3]);
                    *(u32x4*)(rowp + bj * HALF) = w; } }
    }
};
struct EpiSwiglu {
    static constexpr bool PERM = true; static constexpr int NSTORES = 8;
    bf16_t* O; int ldc;
    __device__ __forceinline__ void operator()(const f32x4 (&acc)[2][2][4][2], const Unit& u, int wr, int wc, int fr, int fq) const {
        const int row0 = u.pm * BM + wr * 64 + fr, col0 = u.pn * HALF + wc * 32 + 8 * fq;
#pragma unroll
        for (int ai = 0; ai < 2; ++ai)
#pragma unroll
            for (int m = 0; m < 4; ++m) { bf16_t* rowp = O + (size_t)(row0 + ai * HALF + m * 16) * ldc + col0;
                f32x2 v[2][2];
#pragma unroll
                for (int n = 0; n < 2; ++n)
#pragma unroll
                    for (int h2 = 0; h2 < 2; ++h2) { const f32x2 a2 = {acc[ai][0][m][n][2 * h2], acc[ai][0][m][n][2 * h2 + 1]}, b2 = {acc[ai][1][m][n][2 * h2], acc[ai][1][m][n][2 * h2 + 1]};
                        const f32x2 mm = a2 * (-1.4426950408889634f); f32x2 e; e.x = __builtin_amdgcn_exp2f(mm.x); e.y = __builtin_amdgcn_exp2f(mm.y);
                        const f32x2 d = e + 1.0f; f32x2 r; r.x = __builtin_amdgcn_rcpf(d.x); r.y = __builtin_amdgcn_rcpf(d.y);
                        v[n][h2] = (a2 * r) * b2; }
                u32x4 w; w.x = cvt_pk_bf16(v[0][0].x, v[0][0].y); w.y = cvt_pk_bf16(v[0][1].x, v[0][1].y); w.z = cvt_pk_bf16(v[1][0].x, v[1][0].y); w.w = cvt_pk_bf16(v[1][1].x, v[1][1].y);
                *(u32x4*)rowp = w; }
    }
};
__device__ __forceinline__ unsigned pk_fp8x4(float a, float b, float c, float d) {
    a = __builtin_amdgcn_fmed3f(a, -448.f, 448.f); b = __builtin_amdgcn_fmed3f(b, -448.f, 448.f); c = __builtin_amdgcn_fmed3f(c, -448.f, 448.f); d = __builtin_amdgcn_fmed3f(d, -448.f, 448.f);
    int p = __builtin_amdgcn_cvt_pk_fp8_f32(a, b, 0, false); p = __builtin_amdgcn_cvt_pk_fp8_f32(c, d, p, true); return (unsigned)p; }
struct EpiSwigluF8 {
    static constexpr bool PERM = true; static constexpr int NSTORES = 8;
    unsigned char* O; int ldc; float k1, k2;
    __device__ __forceinline__ void operator()(const f32x4 (&acc)[2][2][4][2], const Unit& u, int wr, int wc, int fr, int fq) const {
        const int row0 = u.pm * BM + wr * 64 + fr, col0 = u.pn * HALF + wc * 32 + 8 * fq;
#pragma unroll
        for (int ai = 0; ai < 2; ++ai)
#pragma unroll
            for (int m = 0; m < 4; ++m) { unsigned char* rowp = O + (size_t)(row0 + ai * HALF + m * 16) * ldc + col0;
                f32x2 v[2][2];
#pragma unroll
                for (int n = 0; n < 2; ++n)
#pragma unroll
                    for (int h2 = 0; h2 < 2; ++h2) { const f32x2 a2 = {acc[ai][0][m][n][2 * h2], acc[ai][0][m][n][2 * h2 + 1]}, b2 = {acc[ai][1][m][n][2 * h2], acc[ai][1][m][n][2 * h2 + 1]};
                        const f32x2 mm = a2 * k1; f32x2 e; e.x = __builtin_amdgcn_exp2f(mm.x); e.y = __builtin_amdgcn_exp2f(mm.y);
                        const f32x2 d = e + 1.0f; f32x2 r; r.x = __builtin_amdgcn_rcpf(d.x); r.y = __builtin_amdgcn_rcpf(d.y);
                        v[n][h2] = (a2 * r) * (b2 * k2); }
                u32x2 w; w.x = pk_fp8x4(v[0][0].x, v[0][0].y, v[0][1].x, v[0][1].y); w.y = pk_fp8x4(v[1][0].x, v[1][0].y, v[1][1].x, v[1][1].y);
                *(u32x2*)rowp = w; }
    }
};
}

namespace att {
constexpr int LDP = NIN;
constexpr int SHM_V = 64 * 128 * 2, SHM_K = 64 * 128 * 2;
constexpr int OFF_K = 0, OFF_V = 4 * SHM_K, OFF_WS = RING_BYTES + 14336, ATT_LDS = OFF_WS + NWAVES * 64 * 4;
constexpr int OFF_X = 0, OFF_OST = 65536;
static_assert(OFF_V + 4 * SHM_V <= RING_BYTES && ATT_LDS <= LDS_BYTES, "attention LDS");
constexpr float SCALE = 0.125f;
constexpr float THR = 8.f;
#define KSWZ(row, colB) ((row) * 256 + ((colB) ^ (((row) & 7) << 4)))
__device__ __forceinline__ int crow(int r, int hi) { return (r & 3) + 8 * (r >> 2) + 4 * hi; }

constexpr float THRL = 8.f;
template <bool FIRST>
__device__ __forceinline__ void partialSM(f32x16& p0, f32x16& p1, float& mhat, f32x16& negm, float& alpha) {
    float a = fmaxf(fmaxf(p0[0], p0[1]), p1[0]), b = fmaxf(fmaxf(p0[2], p0[3]), p1[1]); a = fmaxf(fmaxf(a, p1[2]), p1[3]);
#pragma unroll
    for (int r = 4; r < 16; r += 4) { a = fmaxf(fmaxf(a, p0[r]), p0[r + 1]); b = fmaxf(fmaxf(b, p0[r + 2]), p0[r + 3]); a = fmaxf(fmaxf(a, p1[r]), p1[r + 1]); b = fmaxf(fmaxf(b, p1[r + 2]), p1[r + 3]); }
    float rm = fmaxf(a, b);
    { auto rr = __builtin_amdgcn_permlane32_swap(__float_as_uint(rm), __float_as_uint(rm), false, false); rm = fmaxf(__uint_as_float(rr[0]), __uint_as_float(rr[1])); }
    alpha = 1.f;
    if (FIRST || __builtin_expect(__any(rm > THRL), 0)) {
        const float dl = FIRST ? rm : fmaxf(rm, 0.f); mhat += dl;
#pragma unroll
        for (int r = 0; r < 16; ++r) { p0[r] -= dl; p1[r] -= dl; }
#pragma unroll
        for (int r = 0; r < 16; ++r) negm[r] = -mhat;
        asm volatile("" : "+v"(negm));
        if (!FIRST) alpha = __builtin_amdgcn_exp2f(-dl);
    }
#pragma unroll
    for (int r = 0; r < 16; ++r) p0[r] = __builtin_amdgcn_exp2f(p0[r]);
}
__device__ __forceinline__ void finishSM(f32x16& p0, f32x16& p1, float alpha, float& l_reg, bf16x8& pa0, bf16x8& pa1, bf16x8& pa2, bf16x8& pa3) {
#pragma unroll
    for (int r = 0; r < 16; ++r) p1[r] = __builtin_amdgcn_exp2f(p1[r]);
    float ps = 0;
#pragma unroll
    for (int r = 0; r < 16; ++r) ps += p0[r];
#pragma unroll
    for (int r = 0; r < 16; ++r) ps += p1[r];
    { auto rr = __builtin_amdgcn_permlane32_swap(__float_as_uint(ps), __float_as_uint(ps), false, false);
      ps = __uint_as_float(rr[0]) + __uint_as_float(rr[1]); }
    l_reg = l_reg * alpha + ps;
#define PK4(P, BASE, OUT) do { u32x4 w = {cvt_pk_bf16(P[BASE + 0], P[BASE + 1]), cvt_pk_bf16(P[BASE + 2], P[BASE + 3]), cvt_pk_bf16(P[BASE + 4], P[BASE + 5]), cvt_pk_bf16(P[BASE + 6], P[BASE + 7])}; OUT = __builtin_bit_cast(bf16x8, w); } while (0)
    PK4(p0, 0, pa0); PK4(p0, 8, pa1); PK4(p1, 0, pa2); PK4(p1, 8, pa3);
#undef PK4
}
__device__ __forceinline__ void qkt(f32x16& p0, f32x16& p1, const char* Ks, const bf16x8 (&qr)[4], const f32x16& negm, int r32, int hi, int cb0) {
#pragma unroll
    for (int d0 = 0; d0 < 4; ++d0) { const int cb = cb0 + (d0 * 16 + hi * 8) * 2;
        const bf16x8 b0 = *reinterpret_cast<const bf16x8*>(Ks + KSWZ(r32, cb));
        const bf16x8 b1 = *reinterpret_cast<const bf16x8*>(Ks + KSWZ(32 + r32, cb));
        if (d0 == 0) { p0 = __builtin_amdgcn_mfma_f32_32x32x16_bf16(b0, qr[0], negm, 0, 0, 0); p1 = __builtin_amdgcn_mfma_f32_32x32x16_bf16(b1, qr[0], negm, 0, 0, 0); }
        else { p0 = __builtin_amdgcn_mfma_f32_32x32x16_bf16(b0, qr[d0], p0, 0, 0, 0); p1 = __builtin_amdgcn_mfma_f32_32x32x16_bf16(b1, qr[d0], p1, 0, 0, 0); } }
}
__device__ __forceinline__ int v_st(int k, int c) { const int kk = (k & ~0xC) | ((k & 4) << 1) | ((k & 8) >> 1); return ((kk >> 3) * 4 + (c >> 5)) * 512 + ((kk & 7) * 32 + (c & 31)) * 2; }
__device__ __forceinline__ int v_rd_base(int lane) { return ((lane & 3) << 3) | (((lane >> 2) & 3) << 6) | (((lane >> 4) & 1) << 5) | (((lane >> 5) & 1) << 11); }
constexpr int v_rd_off(int d0, int ks, int half) { return d0 * 512 + ks * 4096 + half * 256; }
template <int OFF> __device__ __forceinline__ s16x4 tr_read(int vb) {
    s16x4 r; asm volatile("ds_read_b64_tr_b16 %0, %1 offset:%2" : "=&v"(r) : "v"(vb), "i"(OFF) : "memory"); return r;
}
template <int D0> __device__ __forceinline__ void pv_one(f32x16& od, int vb, bf16x8 pa0, bf16x8 pa1, bf16x8 pa2, bf16x8 pa3) {
    const s16x4 l0 = tr_read<v_rd_off(D0, 0, 0)>(vb), h0 = tr_read<v_rd_off(D0, 0, 1)>(vb), l1 = tr_read<v_rd_off(D0, 1, 0)>(vb), h1 = tr_read<v_rd_off(D0, 1, 1)>(vb);
    const s16x4 l2 = tr_read<v_rd_off(D0, 2, 0)>(vb), h2 = tr_read<v_rd_off(D0, 2, 1)>(vb), l3 = tr_read<v_rd_off(D0, 3, 0)>(vb), h3 = tr_read<v_rd_off(D0, 3, 1)>(vb);
    asm volatile("s_waitcnt lgkmcnt(0)" ::: "memory"); SBAR();
#define PKV(L, H) (bf16x8){L[0], L[1], L[2], L[3], H[0], H[1], H[2], H[3]}
    od = __builtin_amdgcn_mfma_f32_32x32x16_bf16(pa0, PKV(l0, h0), od, 0, 0, 0);
    od = __builtin_amdgcn_mfma_f32_32x32x16_bf16(pa1, PKV(l1, h1), od, 0, 0, 0);
    od = __builtin_amdgcn_mfma_f32_32x32x16_bf16(pa2, PKV(l2, h2), od, 0, 0, 0);
    od = __builtin_amdgcn_mfma_f32_32x32x16_bf16(pa3, PKV(l3, h3), od, 0, 0, 0);
#undef PKV
}
struct VFrag { s16x4 l0, h0, l1, h1, l2, h2, l3, h3; };
template <int D0> __device__ __forceinline__ void v_reads(VFrag& f, int vb) {
    f.l0 = tr_read<v_rd_off(D0, 0, 0)>(vb); f.h0 = tr_read<v_rd_off(D0, 0, 1)>(vb); f.l1 = tr_read<v_rd_off(D0, 1, 0)>(vb); f.h1 = tr_read<v_rd_off(D0, 1, 1)>(vb);
    f.l2 = tr_read<v_rd_off(D0, 2, 0)>(vb); f.h2 = tr_read<v_rd_off(D0, 2, 1)>(vb); f.l3 = tr_read<v_rd_off(D0, 3, 0)>(vb); f.h3 = tr_read<v_rd_off(D0, 3, 1)>(vb);
}
__device__ __forceinline__ void v_mfmas(f32x16& od, const VFrag& f, bf16x8 pa0, bf16x8 pa1, bf16x8 pa2, bf16x8 pa3) {
#define PKV(L, H) (bf16x8){L[0], L[1], L[2], L[3], H[0], H[1], H[2], H[3]}
    od = __builtin_amdgcn_mfma_f32_32x32x16_bf16(pa0, PKV(f.l0, f.h0), od, 0, 0, 0);
    od = __builtin_amdgcn_mfma_f32_32x32x16_bf16(pa1, PKV(f.l1, f.h1), od, 0, 0, 0);
    od = __builtin_amdgcn_mfma_f32_32x32x16_bf16(pa2, PKV(f.l2, f.h2), od, 0, 0, 0);
    od = __builtin_amdgcn_mfma_f32_32x32x16_bf16(pa3, PKV(f.l3, f.h3), od, 0, 0, 0);
#undef PKV
}
__device__ __forceinline__ void pv_d0(f32x16* o, int vb, bf16x8 pa0, bf16x8 pa1, bf16x8 pa2, bf16x8 pa3) {
    VFrag fa, fb;
    v_reads<0>(fa, vb);
    v_reads<1>(fb, vb); asm volatile("s_waitcnt lgkmcnt(8)" ::: "memory"); SBAR(); v_mfmas(o[0], fa, pa0, pa1, pa2, pa3);
    v_reads<2>(fa, vb); asm volatile("s_waitcnt lgkmcnt(8)" ::: "memory"); SBAR(); v_mfmas(o[1], fb, pa0, pa1, pa2, pa3);
    v_reads<3>(fb, vb); asm volatile("s_waitcnt lgkmcnt(8)" ::: "memory"); SBAR(); v_mfmas(o[2], fa, pa0, pa1, pa2, pa3);
    asm volatile("s_waitcnt lgkmcnt(0)" ::: "memory"); SBAR(); v_mfmas(o[3], fb, pa0, pa1, pa2, pa3);
}

__device__ __forceinline__ void attn_unit(const bf16_t* __restrict__ Qb, const bf16_t* __restrict__ Ks0, int nt0, const bf16_t* __restrict__ Ks1, int nt1,
                                          bf16_t* Ob, float lam, float oscale, const float* __restrict__ subg, char* lds, const int wid) {
    const int lane = lane_id_v(), tid = wid * 64 + lane;
    const int r32 = lane & 31, hi = lane >> 5, map = wid >> 2, w4 = wid & 3; (void)tid;
    char* V_lds = lds + OFF_V; char* K_lds = lds + OFF_K;
    float* ws = (float*)(lds + OFF_WS) + wid * 64; float* li_l = ws; float* al_l = ws + 32;
    float zero_v; asm volatile("v_mov_b32 %0, 0" : "=v"(zero_v));
    float mhat = 0.f, l_reg = 0; f32x16 o[4] = {}; bf16x8 qr[4]; f32x16 negm;
#pragma unroll
    for (int r = 0; r < 16; ++r) negm[r] = zero_v;
    const bf16_t* Qw = Qb + (long)(w4 * 32 + r32) * LDP + map * 64 + hi * 8;
#pragma unroll
    for (int d0 = 0; d0 < 4; ++d0) qr[d0] = *reinterpret_cast<const bf16x8*>(Qw + d0 * 16);
    const int cb0 = map * 128;
    unsigned koff[2], voff[2];
#pragma unroll
    for (int i = 0; i < 2; ++i) { const int row = 4 * wid + 32 * i + (lane >> 4), ch = (lane & 15) ^ (row & 7); koff[i] = (unsigned)(row * LDP + ch * 8) * 2u;
        const int sub = 2 * wid + 16 * i + (lane >> 5), kk = (sub >> 2) * 8 + ((lane & 31) >> 2), k = (kk & ~0xC) | ((kk & 4) << 1) | ((kk & 8) >> 1), c = (sub & 3) * 32 + (lane & 3) * 8;
        voff[i] = (unsigned)(k * LDP + 512 + c) * 2u; }
    const unsigned ldsw = (unsigned)wid * 1024u;
    const int vb0 = (int)(uintptr_t)V_lds + v_rd_base(lane);
    const int NT = nt0 + nt1;
#define TILEP(j) ((const char*)((j) < nt0 ? Ks0 + (long)(j) * 64 * LDP : Ks1 + (long)((j) - nt0) * 64 * LDP))
#define DMA_K(j, slot) do { const char* _tb = TILEP(j); _Pragma("unroll") for (int _i = 0; _i < 2; ++_i) \
        __builtin_amdgcn_global_load_lds((const unsigned*)(_tb + koff[_i]), (LAS unsigned*)((LAS char*)(uintptr_t)(unsigned)(uintptr_t)K_lds + (slot) + ldsw + _i * 8192), 16, 0, 0); } while (0)
#define DMA_V(j, slot) do { const char* _tb = TILEP(j); _Pragma("unroll") for (int _i = 0; _i < 2; ++_i) \
        __builtin_amdgcn_global_load_lds((const unsigned*)(_tb + voff[_i]), (LAS unsigned*)((LAS char*)(uintptr_t)(unsigned)(uintptr_t)V_lds + (slot) + ldsw + _i * 8192), 16, 0, 0); } while (0)
#define WAIT_BAR(N) asm volatile("s_waitcnt vmcnt(" #N ") lgkmcnt(0)\n\ts_barrier" ::: "memory")
#define RESC(a) do { if (__any((a) < 1.f)) { if (hi == 0) al_l[r32] = (a); asm volatile("s_waitcnt lgkmcnt(0)" ::: "memory"); \
    _Pragma("unroll") for (int d = 0; d < 4; ++d) _Pragma("unroll") for (int r = 0; r < 16; ++r) o[d][r] *= al_l[crow(r, hi)]; } } while (0)
    f32x16 pA0, pA1, pB0, pB1; float alA, alB; bf16x8 pa0, pa1, pa2, pa3;
    DMA_K(0, 0); DMA_K(1, SHM_K); DMA_V(0, 0);
    WAIT_BAR(0);
#define HALF_STEP(C0, C1, P0, P1, alC, alP, t) do { \
        SBAR(); qkt(C0, C1, K_lds + (((t) >> 1) & 1) * 2 * SHM_K + ((t) & 1) * SHM_K, qr, negm, r32, hi, cb0); \
        finishSM(P0, P1, alP, l_reg, pa0, pa1, pa2, pa3); SBAR(); \
        pv_d0(o, vb0 + (((t) - 1) & 3) * SHM_V, pa0, pa1, pa2, pa3); partialSM<false>(C0, C1, mhat, negm, alC); \
        RESC(alC); } while (0)
    if (2 < NT) { DMA_K(2, 2 * SHM_K); DMA_K(3, 3 * SHM_K); } DMA_V(1, SHM_V); if (2 < NT) DMA_V(2, 2 * SHM_V);
    qkt(pA0, pA1, K_lds, qr, negm, r32, hi, cb0); partialSM<true>(pA0, pA1, mhat, negm, alA);
    HALF_STEP(pB0, pB1, pA0, pA1, alB, alA, 1);
    WAIT_BAR(0);
    for (int t = 2; t < NT; t += 2) {
        if (t + 2 < NT) { DMA_K(t + 2, (((t + 2) >> 1) & 1) * 2 * SHM_K); DMA_K(t + 3, (((t + 2) >> 1) & 1) * 2 * SHM_K + SHM_K); }
        DMA_V(t + 1, ((t + 1) & 3) * SHM_V); if (t + 2 < NT) DMA_V(t + 2, ((t + 2) & 3) * SHM_V);
        HALF_STEP(pA0, pA1, pB0, pB1, alA, alB, t);
        HALF_STEP(pB0, pB1, pA0, pA1, alB, alA, t + 1);
        WAIT_BAR(0);
    }
    finishSM(pB0, pB1, alB, l_reg, pa0, pa1, pa2, pa3); SBAR();
    pv_d0(o, vb0 + ((NT - 1) & 3) * SHM_V, pa0, pa1, pa2, pa3);
#undef HALF_STEP
    if (hi == 0) li_l[r32] = l_reg; asm volatile("s_waitcnt lgkmcnt(0)" ::: "memory");
    float rli[16];
#pragma unroll
    for (int r = 0; r < 16; ++r) rli[r] = __builtin_amdgcn_rcpf(li_l[crow(r, hi)]) * (map ? lam : 1.f);
    __syncthreads();
    float* X = (float*)(lds + OFF_X) + w4 * (32 * 128);
    if (map == 1) {
#pragma unroll
        for (int r = 0; r < 16; ++r)
#pragma unroll
            for (int d0 = 0; d0 < 4; ++d0) X[crow(r, hi) * 128 + d0 * 32 + r32] = o[d0][r] * rli[r];
    }
    __syncthreads();
    if (map == 0) {
        float ss[16];
#pragma unroll
        for (int r = 0; r < 16; ++r) { float s = 0.f;
#pragma unroll
            for (int d0 = 0; d0 < 4; ++d0) { const float v = o[d0][r] * rli[r] - X[crow(r, hi) * 128 + d0 * 32 + r32]; o[d0][r] = v; s += v * v; }
            ss[r] = s; }
#pragma unroll
        for (int r = 0; r < 16; ++r) { float s = ss[r]; s += __shfl_xor(s, 1); s += __shfl_xor(s, 2); s += __shfl_xor(s, 4); s += __shfl_xor(s, 8); s += __shfl_xor(s, 16);
            ss[r] = __builtin_amdgcn_rsqf(s * (1.f / 128.f) + EPS) * oscale; }
        bf16_t* Ost = (bf16_t*)(lds + OFF_OST) + w4 * 4096;
#pragma unroll
        for (int d0 = 0; d0 < 4; ++d0) { const float g = subg[d0 * 32 + r32];
#pragma unroll
            for (int r = 0; r < 16; ++r) Ost[crow(r, hi) * 128 + d0 * 32 + r32] = (bf16_t)(cvt_pk_bf16(o[d0][r] * ss[r] * g, 0.f) & 0xffffu); }
        asm volatile("s_waitcnt lgkmcnt(0)" ::: "memory");
#pragma unroll
        for (int it = 0; it < 8; ++it) { const int row = it * 4 + (lane >> 4), ch = lane & 15;
            const u32x4 w = *(const u32x4*)(Ost + row * 128 + ch * 8);
            *(u32x4*)(Ob + (long)(w4 * 32 + row) * LDP + ch * 8) = w; }
    }
    __syncthreads();
#undef TILEP
#undef DMA_K
#undef DMA_V
#undef WAIT_BAR
#undef RESC
}

__device__ __forceinline__ void sg_unit(bf16_t* P0, const bf16_t* __restrict__ sgw, const float* __restrict__ lng, const float* __restrict__ lnb, const float* __restrict__ sgb, char* lds, const int wid, const int g_lo, const int g_hi) {
    const int lane = lane_id_v(), tid = wid * 64 + lane;
    const int r32 = lane & 31, hi = lane >> 5;
    const int sr = tid >> 4, sc = (tid & 15) * 8;
    float* Mt = (float*)(lds + 65536);
    u32x4 gb[4][4];
#pragma unroll
    for (int q4 = 0; q4 < 4; ++q4)
#pragma unroll
        for (int g = 0; g < 4; ++g) gb[q4][g] = *(const u32x4*)(P0 + (long)(q4 * 32 + sr) * LDP + COL_G + g * 128 + sc);
    float mean[4], rstd[4];
#pragma unroll
    for (int q4 = 0; q4 < 4; ++q4) { float sm = 0.f;
#pragma unroll
        for (int g = 0; g < 4; ++g) { const u32x4 w = gb[q4][g]; sm += (bflo(w.x) + bfhi(w.x)) + (bflo(w.y) + bfhi(w.y)) + (bflo(w.z) + bfhi(w.z)) + (bflo(w.w) + bfhi(w.w)); }
        sm += __shfl_xor(sm, 1); sm += __shfl_xor(sm, 2); sm += __shfl_xor(sm, 4); sm += __shfl_xor(sm, 8);
        const float mu = sm * (1.f / 512.f); float q = 0.f;
#pragma unroll
        for (int g = 0; g < 4; ++g) { const u32x4 w = gb[q4][g]; const float x[8] = {bflo(w.x), bfhi(w.x), bflo(w.y), bfhi(w.y), bflo(w.z), bfhi(w.z), bflo(w.w), bfhi(w.w)};
#pragma unroll
            for (int k = 0; k < 8; ++k) { const float d = x[k] - mu; q += d * d; } }
        q += __shfl_xor(q, 1); q += __shfl_xor(q, 2); q += __shfl_xor(q, 4); q += __shfl_xor(q, 8);
        mean[q4] = mu; rstd[q4] = __builtin_amdgcn_rsqf(q * (1.f / 512.f) + EPS); }
    const int vb0 = (int)(uintptr_t)lds + v_rd_base(lane);
    const int mt = wid & 3, eh = wid >> 2;
#pragma unroll
    for (int g = 0; g < 4; ++g) {
        if (g < g_lo || g >= g_hi) continue;
        u32x4 ub[4];
#pragma unroll
        for (int q4 = 0; q4 < 4; ++q4) ub[q4] = *(const u32x4*)(P0 + (long)(q4 * 32 + sr) * LDP + COL_U + g * 128 + sc);
        const bf16_t* Wp = sgw + (size_t)g * 128 * 128 + (size_t)(mt * 32 + r32) * 128 + hi * 4;
        bf16x8 af[2][4];
#pragma unroll
        for (int tq = 0; tq < 2; ++tq)
#pragma unroll
            for (int ks = 0; ks < 4; ++ks) { const u32x2 lo_ = *(const u32x2*)(Wp + tq * 64 + ks * 16), hi_ = *(const u32x2*)(Wp + tq * 64 + ks * 16 + 8); u32x4 w_ = {lo_.x, lo_.y, hi_.x, hi_.y}; af[tq][ks] = __builtin_bit_cast(bf16x8, w_); }
        const f32x4 ga = *(const f32x4*)(lng + g * 128 + sc), gbv = *(const f32x4*)(lng + g * 128 + sc + 4), ba = *(const f32x4*)(lnb + g * 128 + sc), bb = *(const f32x4*)(lnb + g * 128 + sc + 4);
#pragma unroll
        for (int q4 = 0; q4 < 4; ++q4) { const int tkn = q4 * 32 + sr; const u32x4 w = gb[q4][g]; const float mu = mean[q4], rs = rstd[q4];
            const float x[8] = {bflo(w.x), bfhi(w.x), bflo(w.y), bfhi(w.y), bflo(w.z), bfhi(w.z), bflo(w.w), bfhi(w.w)};
            u32x4 ov;
            ov.x = cvt_pk_bf16((x[0] - mu) * rs * ga[0] + ba[0], (x[1] - mu) * rs * ga[1] + ba[1]);
            ov.y = cvt_pk_bf16((x[2] - mu) * rs * ga[2] + ba[2], (x[3] - mu) * rs * ga[3] + ba[3]);
            ov.z = cvt_pk_bf16((x[4] - mu) * rs * gbv[0] + bb[0], (x[5] - mu) * rs * gbv[1] + bb[1]);
            ov.w = cvt_pk_bf16((x[6] - mu) * rs * gbv[2] + bb[2], (x[7] - mu) * rs * gbv[3] + bb[3]);
            *(u32x4*)(lds + (tkn >> 6) * SHM_V + v_st(tkn & 63, sc)) = ov; }
        __syncthreads();
        f32x16 oa = {}, ob = {};
#pragma unroll
        for (int tq = 0; tq < 2; ++tq) {
            if (eh == 0) { pv_one<0>(oa, vb0 + tq * SHM_V, af[tq][0], af[tq][1], af[tq][2], af[tq][3]); pv_one<1>(ob, vb0 + tq * SHM_V, af[tq][0], af[tq][1], af[tq][2], af[tq][3]); }
            else         { pv_one<2>(oa, vb0 + tq * SHM_V, af[tq][0], af[tq][1], af[tq][2], af[tq][3]); pv_one<3>(ob, vb0 + tq * SHM_V, af[tq][0], af[tq][1], af[tq][2], af[tq][3]); }
        }
#pragma unroll
        for (int r = 0; r < 16; ++r) { const int pr = mt * 32 + crow(r, hi); const float bs = sgb[g * 128 + pr];
            Mt[pr * 128 + eh * 64 + r32] = oa[r] + bs; Mt[pr * 128 + eh * 64 + 32 + r32] = ob[r] + bs; }
        __syncthreads();
#pragma unroll
        for (int q4 = 0; q4 < 4; ++q4) { const int tkn = q4 * 32 + sr; const f32x4 m0 = *(const f32x4*)(Mt + tkn * 128 + sc), m1 = *(const f32x4*)(Mt + tkn * 128 + sc + 4); const u32x4 w = ub[q4];
            u32x4 ov;
            ov.x = cvt_pk_bf16(bflo(w.x) * m0[0], bfhi(w.x) * m0[1]); ov.y = cvt_pk_bf16(bflo(w.y) * m0[2], bfhi(w.y) * m0[3]);
            ov.z = cvt_pk_bf16(bflo(w.z) * m1[0], bfhi(w.z) * m1[1]); ov.w = cvt_pk_bf16(bflo(w.w) * m1[2], bfhi(w.w) * m1[3]);
            *(u32x4*)(P0 + (long)tkn * LDP + COL_U + g * 128 + sc) = ov; }
    }
    __syncthreads();
}
}

#define XB_TMO      128
#define XB_XCNT(j)  (256  + 64 * (j))
#define XB_XSUB(j)  (1280 + 64 * (j))
#define XB_XGEN(j)  (2304 + 64 * (j))
#define XB_TOP      3328
#define XB_TOPGEN   3392
#define XCD_BAR_WORDS 3456
#define XB_SPIN_CAP (1u << 18)
__device__ __forceinline__ unsigned xb_ld(unsigned* p)              { return __hip_atomic_load(p, __ATOMIC_RELAXED, __HIP_MEMORY_SCOPE_AGENT); }
__device__ __forceinline__ unsigned xb_add(unsigned* p, unsigned v) { return __hip_atomic_fetch_add(p, v, __ATOMIC_RELAXED, __HIP_MEMORY_SCOPE_AGENT); }
__device__ __forceinline__ unsigned xb_xcc_id() { return (unsigned)__builtin_amdgcn_s_getreg((3 << 11) | 20) & 0xFu; }
#define XB_SPIN(cond, bar) do { unsigned _sp = 0; while (cond) { __builtin_amdgcn_s_sleep(1); \
    if ((++_sp & 255u) == 0u) { if (xb_ld(&(bar)[XB_TMO])) break; if (_sp > XB_SPIN_CAP) { atomicAdd(&(bar)[XB_TMO], 1u); break; } } } } while (0)
struct XcdBarrier { unsigned* bar; unsigned x; volatile LAS unsigned* st; };
__device__ __forceinline__ XcdBarrier xcd_barrier_post(unsigned* bar, volatile LAS unsigned* st, int tid) {
    XcdBarrier b; b.bar = bar; b.x = xb_xcc_id(); b.st = st;
    if (tid == 0) (void)xb_add(&bar[XB_XCNT(b.x)], 1u);
    return b;
}
__device__ __forceinline__ void xcd_barrier_complete(unsigned* bar, unsigned x, unsigned& nloc, unsigned& nx) {
    const unsigned G = gridDim.x * gridDim.y * gridDim.z;
    unsigned sum, cnt, mine, sp = 0u;
    for (;;) {
        sum = 0u; cnt = 0u; mine = 0u;
#pragma unroll
        for (unsigned j = 0; j < 16; ++j) { const unsigned c = xb_ld(&bar[XB_XCNT(j)]); sum += c; cnt += (c > 0u) ? 1u : 0u; mine = (j == x) ? c : mine; }
        if (sum == G) break;
        __builtin_amdgcn_s_sleep(1);
        if ((++sp & 255u) == 0u) { if (xb_ld(&bar[XB_TMO])) break; if (sp > XB_SPIN_CAP) { atomicAdd(&bar[XB_TMO], 1u); break; } }
    }
    nloc = mine > 0u ? mine : 1u; nx = cnt > 0u ? cnt : 1u;
}
__device__ __forceinline__ void xcd_barrier(const XcdBarrier& b, int wave) {
    asm volatile("s_waitcnt vmcnt(0)" ::: "memory");
    __syncthreads();
    if (wave == 0 && lane_id_v() == 0) {
        unsigned* bar = b.bar;
        __builtin_amdgcn_s_waitcnt(0);
        unsigned nloc = b.st[0], nx = b.st[1];
        if (nloc == 0u) { xcd_barrier_complete(bar, b.x, nloc, nx); b.st[0] = nloc; b.st[1] = nx; }
        const unsigned old = xb_add(&bar[XB_XSUB(b.x)], 1u);
        const unsigned gen = old / nloc;
        if (old + 1u == (gen + 1u) * nloc) {
            __builtin_amdgcn_fence(__ATOMIC_RELEASE, "agent");
            asm volatile("s_waitcnt vmcnt(0)" ::: "memory");
            const unsigned og = xb_add(&bar[XB_TOP], 1u);
            const unsigned tg = og / nx;
            if (og + 1u == (tg + 1u) * nx) xb_add(&bar[XB_TOPGEN], 1u);
            else XB_SPIN(xb_ld(&bar[XB_TOPGEN]) == tg, bar);
            __builtin_amdgcn_fence(__ATOMIC_ACQUIRE, "agent");
            xb_add(&bar[XB_XGEN(b.x)], 1u);
            asm volatile("s_waitcnt vmcnt(0)" ::: "memory");
        } else {
            XB_SPIN(xb_ld(&bar[XB_XGEN(b.x)]) == gen, bar);
            __builtin_amdgcn_fence(__ATOMIC_ACQUIRE, "agent");
            asm volatile("s_waitcnt vmcnt(0)" ::: "memory");
        }
    }
    __syncthreads();
}

struct Args {
    const float* in[28]; float* out; unsigned char* ws; int ph_lo, ph_hi;
};
typedef const __attribute__((address_space(4))) Args* KArgP;
#define KARG() ({ KArgP _p = (KArgP)__builtin_amdgcn_kernarg_segment_ptr(); asm volatile("" : "+s"(_p)); _p; })
struct Frame {
    LAS unsigned char* lds; gu32* ctl; int tid, lane, wave, vcu, G;
};

constexpr int I_IN = 16 * 80, I_OUT = 16 * 32, I_F13 = 16 * 176, I_F2 = 44 * 32, I_M13 = 16 * 224, I_M2 = 56 * 32;
constexpr int CV_L0 = 2 * I_IN + 2 * I_OUT + I_F13 + I_F2, CV_N = CV_L0 + 8 * I_M13 + 8 * I_M2;
__device__ __forceinline__ void convert_range(LAS unsigned char* lds, int wave, int lane, KArgP ap, int first, int stride, int end) {
    const __attribute__((address_space(4))) Args& a = *ap; unsigned char* ws = a.ws;
    LAS float* scr = (LAS float*)(lds + wave * 16384);
    struct Item { const float* src; unsigned char* dst; int ldw, K, k0; bool rope, f8; };
#define DECODE(it_, I) do { int r = (it_); \
        if (r < 2 * I_IN) { const int l = r / I_IN; r %= I_IN; const int kb = r / 80, g = r % 80, seg = g >> 4, gi = g & 15; \
            const int sseg = seg == 0 ? 0 : seg == 1 ? 3 : seg == 2 ? 1 : seg == 3 ? 2 : 4;        \
            I.src = a.in[10] + (size_t)l * D * NIN + (size_t)kb * 64 * NIN + sseg * 512 + gi * 32; I.ldw = NIN; I.K = D; I.k0 = kb * 64; I.rope = (seg == 0 || seg == 2); I.f8 = false; \
            I.dst = ws + WS_WIN + ((size_t)l * NIN * D + (size_t)g * 32 * D + kb * 64) * 2; break; } \
        r -= 2 * I_IN; \
        if (r < 2 * I_OUT) { const int l = r / I_OUT; r %= I_OUT; const int kb = r / 32, g = r % 32; \
            I.src = a.in[11] + (size_t)l * D * D + (size_t)kb * 64 * D + g * 32; I.ldw = D; I.K = D; I.k0 = kb * 64; I.rope = false; I.f8 = false; \
            I.dst = ws + WS_WOUT + ((size_t)l * D * D + (size_t)g * 32 * D + kb * 64) * 2; break; } \
        r -= 2 * I_OUT; \
        if (r < I_F13) { const int kb = r / 176, g = r % 176, tile = g >> 3, gi = g & 7;            \
            I.src = (gi < 4 ? a.in[21] : a.in[22]) + (size_t)kb * 64 * DFF + tile * 128 + (gi & 3) * 32; I.ldw = DFF; I.K = D; I.k0 = kb * 64; I.rope = false; I.f8 = false; \
            I.dst = ws + WS_W13 + ((size_t)g * 32 * D + kb * 64) * 2; break; } \
        r -= I_F13; \
        if (r < I_F2) { const int kb = r / 32, g = r % 32; \
            I.src = a.in[23] + (size_t)kb * 64 * D + g * 32; I.ldw = D; I.K = DFF; I.k0 = kb * 64; I.rope = false; I.f8 = FFN_DOWN_FP8 != 0; \
            I.dst = ws + WS_W2 + ((size_t)g * 32 * DFF + kb * 64) * (FFN_DOWN_FP8 ? 1 : 2); break; } \
        r -= I_F2; \
        if (r < 8 * I_M13) { const int e = r / I_M13; r %= I_M13; const int kb = r / 224, g = r % 224, tile = g >> 3, gi = g & 7; \
            I.src = (gi < 4 ? a.in[25] : a.in[26]) + (size_t)e * D * DEXP + (size_t)kb * 64 * DEXP + tile * 128 + (gi & 3) * 32; I.ldw = DEXP; I.K = D; I.k0 = kb * 64; I.rope = false; I.f8 = true; \
            I.dst = ws + WS_MW13 + (size_t)e * 7168 * D + (size_t)g * 32 * D + kb * 64; break; } \
        r -= 8 * I_M13; \
        { const int e = r / I_M2; r %= I_M2; const int kb = r / 32, g = r % 32; \
            I.src = a.in[27] + (size_t)e * DEXP * D + (size_t)kb * 64 * D + g * 32; I.ldw = D; I.K = DEXP; I.k0 = kb * 64; I.rope = false; I.f8 = true; \
            I.dst = ws + WS_MW2 + (size_t)e * D * DEXP + (size_t)g * 32 * DEXP + kb * 64; } \
    } while (0)
#define LOADITEM(I, v) do { const int j_ = lane & 31, sj_ = I.rope ? ((j_ & 3) + 4 * (j_ >> 3) + 16 * ((j_ >> 2) & 1)) : j_; const float* sp_ = I.src + (size_t)(lane >> 5) * I.ldw + sj_; \
        _Pragma("unroll") for (int i = 0; i < 32; ++i) v[i] = sp_[(size_t)(2 * i) * I.ldw]; } while (0)
    if (first < end) {
        Item cur, nxt; float v[32], vn[32];
        DECODE(first, cur); LOADITEM(cur, v);
        for (int it = first; it < end; it += stride) {
            const int itn = it + stride; const bool has_next = itn < end;
            if (has_next) { DECODE(itn, nxt); LOADITEM(nxt, vn); }
            const int j = lane & 31; const float sc = cur.f8 ? 128.f : 1.f;
#pragma unroll
            for (int i = 0; i < 32; ++i) { const int kk = 2 * i + (lane >> 5); scr[kk * 33 + j] = v[i] * sc; }
            LDS_WAIT(); asm volatile("" ::: "memory");
            if (cur.f8) {
                const int n = lane >> 1, hf = lane & 1; const LAS float* s = scr + (32 * hf) * 33 + n;
                u32x4 o0, o1;
                o0.x = pg8::pk_fp8x4(s[0 * 33], s[1 * 33], s[2 * 33], s[3 * 33]);     o0.y = pg8::pk_fp8x4(s[4 * 33], s[5 * 33], s[6 * 33], s[7 * 33]);
                o0.z = pg8::pk_fp8x4(s[8 * 33], s[9 * 33], s[10 * 33], s[11 * 33]);   o0.w = pg8::pk_fp8x4(s[12 * 33], s[13 * 33], s[14 * 33], s[15 * 33]);
                o1.x = pg8::pk_fp8x4(s[16 * 33], s[17 * 33], s[18 * 33], s[19 * 33]); o1.y = pg8::pk_fp8x4(s[20 * 33], s[21 * 33], s[22 * 33], s[23 * 33]);
                o1.z = pg8::pk_fp8x4(s[24 * 33], s[25 * 33], s[26 * 33], s[27 * 33]); o1.w = pg8::pk_fp8x4(s[28 * 33], s[29 * 33], s[30 * 33], s[31 * 33]);
                unsigned char* d = cur.dst + (size_t)n * cur.K + 32 * hf;
                *(u32x4*)d = o0; *(u32x4*)(d + 16) = o1;
            } else {
                const int c = lane & 7;
#pragma unroll
                for (int jj = 0; jj < 4; ++jj) { const int n = (lane >> 3) + 8 * jj; const LAS float* s = scr + (8 * c) * 33 + n;
                    u32x4 o; o.x = cvt_pk_bf16(s[0 * 33], s[1 * 33]); o.y = cvt_pk_bf16(s[2 * 33], s[3 * 33]); o.z = cvt_pk_bf16(s[4 * 33], s[5 * 33]); o.w = cvt_pk_bf16(s[6 * 33], s[7 * 33]);
                    *(u32x4*)(cur.dst + ((size_t)n * cur.K + 8 * c) * 2) = o; }
            }
            LDS_WAIT(); asm volatile("" ::: "memory");
            if (has_next) { cur = nxt;
#pragma unroll
                for (int i = 0; i < 32; ++i) v[i] = vn[i]; }
        }
    }
#undef DECODE
#undef LOADITEM
}

#if PROBE_T && PROBE_T_PHASE == 40
#define P0T(n) do { if (F.wave == 0 && blockIdx.x == 0 && lane_id_v() == 0) { volatile LAS unsigned* tacc_ = (volatile LAS unsigned*)(F.lds + MISC_OFF) + 16; const unsigned _now = (unsigned)__builtin_amdgcn_s_memrealtime(); tacc_[n] += _now - tacc_[0]; tacc_[0] = _now; } } while (0)
#else
#define P0T(n) do {} while (0)
#endif
__device__ __forceinline__ void p0_prologue(Frame& F, KArgP ap) {
    const __attribute__((address_space(4))) Args& a = *ap;
    unsigned char* ws = a.ws;
    if (blockIdx.x < 192) {
        const int l = blockIdx.x / 96, n0 = (blockIdx.x % 96) * 64;
        LAS float* s = (LAS float*)F.lds;
        LAS float* red = (LAS float*)(F.lds + 69632);
        const float* c = a.in[1]; const float* cc = a.in[3];
        { float cv[34];
#pragma unroll
          for (int j = 0; j < 34; ++j) { const int i = F.tid + 512 * j; cv[j] = i < 16 * 1024 ? c[i] : cc[i - 16 * 1024]; }
#pragma unroll
          for (int j = 0; j < 34; ++j) s[F.tid + 512 * j] = silu_f(cv[j]); }
        __syncthreads();
        const float* W = a.in[4] + (size_t)l * D * 6144 + n0 + F.lane;
        float acc[17];
#pragma unroll
        for (int r = 0; r < 17; ++r) acc[r] = 0.f;
        const int kb = F.wave * 128;
        LAS float* wl = (LAS float*)(F.lds + 69632 + F.wave * 4096);
        float wa[16], wb[16];
#pragma unroll
        for (int k = 0; k < 16; ++k) wa[k] = W[(size_t)(kb + k) * 6144];
#pragma unroll 1
        for (int q = 0; q < 8; q += 2) {
#pragma unroll
            for (int k = 0; k < 16; ++k) wb[k] = W[(size_t)(kb + 16 * (q + 1) + k) * 6144];
#pragma unroll
            for (int hq = 0; hq < 2; ++hq) {
#pragma unroll
                for (int k = 0; k < 16; ++k) wl[k * 64 + F.lane] = hq ? wb[k] : wa[k];
                LDS_WAIT(); asm volatile("" ::: "memory");
                const int kq = kb + 16 * (q + hq);
#pragma unroll 1
                for (int k = 0; k < 16; k += 4) {
                    const float w0 = wl[k * 64 + F.lane], w1 = wl[(k + 1) * 64 + F.lane], w2 = wl[(k + 2) * 64 + F.lane], w3 = wl[(k + 3) * 64 + F.lane];
#pragma unroll
                    for (int r = 0; r < 17; ++r) { const f32x4 sv = *(const LAS f32x4*)(s + r * 1024 + kq + k); acc[r] += sv[0] * w0 + sv[1] * w1 + sv[2] * w2 + sv[3] * w3; }
                }
                LDS_WAIT(); asm volatile("" ::: "memory");
                if (hq == 0 && q + 2 < 8) {
#pragma unroll
                    for (int k = 0; k < 16; ++k) wa[k] = W[(size_t)(kb + 16 * (q + 2) + k) * 6144];
                }
            }
        }
        __syncthreads();
#pragma unroll
        for (int r = 0; r < 17; ++r) red[(F.wave * 17 + r) * 64 + F.lane] = acc[r];
        __syncthreads();
        float* ms = (float*)(ws + WS_MS) + (size_t)l * 17 * 6144;
        const float* bias = a.in[5] + (size_t)l * 6144;
        for (int i = F.tid; i < 17 * 64; i += 512) { const int r = i >> 6, col = i & 63; float v = bias[n0 + col];
#pragma unroll
            for (int w = 0; w < 8; ++w) v += red[(w * 17 + r) * 64 + col];
            ms[(size_t)r * 6144 + n0 + col] = v; }
        __syncthreads();
    }
    P0T(20);
    if (blockIdx.x == 255) {
        float* rc = (float*)(ws + WS_ROPE); float* rs = rc + 1024;
        for (int i = F.tid; i < 1024; i += 512) { const int pos = i >> 4, j = i & 15; const float inv = powf(10000.0f, -(float)(2 * j) / 32.0f); const float ang = (float)pos * inv; rc[i] = cosf(ang); rs[i] = sinf(ang); }
    }
    { const float* src = a.in[19]; bf16_t* dst = (bf16_t*)(ws + WS_SGW); const int n4 = 2 * 4 * 128 * 128 / 4;
      for (int i = blockIdx.x * 512 + F.tid; i < n4; i += F.G * 512) { const f32x4 v = *(const f32x4*)(src + (size_t)i * 4); u32x2 o; o.x = cvt_pk_bf16(v[0], v[1]); o.y = cvt_pk_bf16(v[2], v[3]); *(u32x2*)(dst + (size_t)i * 4) = o; } }
    P0T(21);
    convert_range(F.lds, F.wave, F.lane, ap, F.vcu * NWAVES + F.wave, F.G * NWAVES, CV_L0);
}

struct Row { f32x4 v[4]; };
__device__ __forceinline__ Row ld_row_f32(const float* p, int lane) { Row r; const f32x4* q = (const f32x4*)p + lane;
#pragma unroll
    for (int j = 0; j < 4; ++j) r.v[j] = q[64 * j]; return r; }
__device__ __forceinline__ void st_row_f32(float* p, int lane, const Row& r) { f32x4* q = (f32x4*)p + lane;
#pragma unroll
    for (int j = 0; j < 4; ++j) q[64 * j] = r.v[j]; }
__device__ __forceinline__ Row ld_row_bf16(const bf16_t* p, int lane) { Row r; const u32x2* q = (const u32x2*)p + lane;
#pragma unroll
    for (int j = 0; j < 4; ++j) { const u32x2 w = q[64 * j]; r.v[j] = (f32x4){bflo(w.x), bfhi(w.x), bflo(w.y), bfhi(w.y)}; } return r; }
__device__ __forceinline__ void st_row_bf16(bf16_t* p, int lane, const Row& r) { u32x2* q = (u32x2*)p + lane;
#pragma unroll
    for (int j = 0; j < 4; ++j) { u32x2 w; w.x = cvt_pk_bf16(r.v[j][0], r.v[j][1]); w.y = cvt_pk_bf16(r.v[j][2], r.v[j][3]); q[64 * j] = w; } }
__device__ __forceinline__ float row_rms_scale(const Row& r) { float s = 0.f;
#pragma unroll
    for (int j = 0; j < 4; ++j) s += (r.v[j][0] * r.v[j][0] + r.v[j][1] * r.v[j][1]) + (r.v[j][2] * r.v[j][2] + r.v[j][3] * r.v[j][3]);
    return __builtin_amdgcn_rsqf(wave_sum(s) * (1.f / D) + EPS); }
__device__ __forceinline__ Row row_modulate(const Row& x, const float* g, const float* shift, const float* scale, int lane) {
    const float rs = row_rms_scale(x); Row h; const f32x4* gq = (const f32x4*)g + lane; const f32x4* sh = (const f32x4*)shift + lane; const f32x4* sc = (const f32x4*)scale + lane;
#pragma unroll
    for (int j = 0; j < 4; ++j) h.v[j] = x.v[j] * rs * gq[64 * j] * (1.f + sc[64 * j]) + sh[64 * j];
    return h; }
__device__ __forceinline__ void row_residual(Row& x, const Row& y, const float* g, const float* gate, int lane) {
    const float rs = row_rms_scale(y); const f32x4* gq = (const f32x4*)g + lane; const f32x4* gt = (const f32x4*)gate + lane;
#pragma unroll
    for (int j = 0; j < 4; ++j) x.v[j] = x.v[j] + gt[64 * j] * (y.v[j] * rs * gq[64 * j]);
}

struct ResP { f32x4 a[4]; };
struct ModP { f32x4 b[4], sh[4]; };
__device__ __forceinline__ ResP ld_resp(const float* g, const float* gate, int lane) { ResP r; const f32x4* gq = (const f32x4*)g + lane; const f32x4* gt = (const f32x4*)gate + lane;
#pragma unroll
    for (int j = 0; j < 4; ++j) r.a[j] = gq[64 * j] * gt[64 * j]; return r; }
__device__ __forceinline__ ModP ld_modp(const float* g, const float* shift, const float* scale, int lane) { ModP r; const f32x4* gq = (const f32x4*)g + lane; const f32x4* sh = (const f32x4*)shift + lane; const f32x4* sc = (const f32x4*)scale + lane;
#pragma unroll
    for (int j = 0; j < 4; ++j) { r.b[j] = gq[64 * j] * (1.f + sc[64 * j]); r.sh[j] = sh[64 * j]; } return r; }
__device__ __forceinline__ void row_residual2(Row& x, const Row& y, const ResP& P) { const float rs = row_rms_scale(y);
#pragma unroll
    for (int j = 0; j < 4; ++j) x.v[j] = x.v[j] + P.a[j] * (y.v[j] * rs); }
__device__ __forceinline__ Row row_modulate2(const Row& x, const ModP& P) { const float rs = row_rms_scale(x); Row h;
#pragma unroll
    for (int j = 0; j < 4; ++j) h.v[j] = x.v[j] * rs * P.b[j] + P.sh[j]; return h; }

struct MoeTab { int cnt[8]; int pbase[9]; };
__device__ __forceinline__ void moe_tab(gu32* ctl, MoeTab& T) {
    int p = 0;
#pragma unroll
    for (int e = 0; e < 8; ++e) { const int c = (int)__builtin_amdgcn_readfirstlane(__hip_atomic_load(ctl + CW_CNT + 64 * e, RLX_AGENT)); T.cnt[e] = c; T.pbase[e] = p; p += (c + 255) >> 8; }
    T.pbase[8] = p;
}
__device__ __forceinline__ int moe_expert_of(const MoeTab& T, int panel) { int e = 0;
#pragma unroll
    for (int i = 1; i < 8; ++i) e += (panel >= T.pbase[i]) ? 1 : 0;
    return e; }

struct MoeUpSched {
    static constexpr bool GATHER = true;
    const char* A; const char* Bt; const int* slot_token; int G, c, p0, nM; MoeTab T; int tprobe;
    __device__ __forceinline__ bool next(int i, pg8::Unit& u) const {
        const int L = i * G + c; if (L >= nM * 28) return false;
        int pm, pn; pg8::tile_of(L, nM, 28, pm, pn);
        const int panel = p0 + pm, e = moe_expert_of(T, panel);
        u.pm = pm; u.pn = pn; u.aux = e; u.aux2 = panel; u.Ap = A; u.Bp = Bt + ((size_t)e * 7168 + (size_t)pn * 256) * D; return true;
    }
    __device__ __forceinline__ void aoff(const pg8::Unit& u, const int (&R)[2], const int (&C)[2], unsigned (&o0)[2], unsigned (&o1)[2]) const {
        int pb = 0, cn = 0;
#pragma unroll
        for (int e = 0; e < 8; ++e) { pb = (u.aux == e) ? T.pbase[e] : pb; cn = (u.aux == e) ? T.cnt[e] : cn; }
        const int rk0 = (u.aux2 - pb) * 256;
#pragma unroll
        for (int i = 0; i < 2; ++i) {
            const int ra = rk0 + R[i], rb = rk0 + pg8::HALF + R[i];
            const int ta = slot_token[u.aux * 32768 + (ra < cn ? ra : 0)], tb = slot_token[u.aux * 32768 + (rb < cn ? rb : 0)];
            o0[i] = (unsigned)(ta * D + C[i] * 2); o1[i] = (unsigned)(tb * D + C[i] * 2); }
    }
    __device__ __forceinline__ void prefetch_idx(const pg8::Unit& u, LAS unsigned char* idx, int wid, int lane) const {
        int pb = 0, cn = 0;
#pragma unroll
        for (int e = 0; e < 8; ++e) { pb = (u.aux == e) ? T.pbase[e] : pb; cn = (u.aux == e) ? T.cnt[e] : cn; }
        const int r = (u.aux2 - pb) * 256 + (wid & 3) * 64 + lane;
        __builtin_amdgcn_global_load_lds((const unsigned*)(slot_token + u.aux * 32768 + (r < cn ? r : 0)), (LAS unsigned*)(idx + (wid & 3) * 256), 4, 0, 0);
    }
    __device__ __forceinline__ void aoff_lds(const int (&R)[2], const int (&C)[2], const LAS unsigned char* idx, unsigned (&o0)[2], unsigned (&o1)[2]) const {
#pragma unroll
        for (int i = 0; i < 2; ++i) { const int ta = ((const LAS int*)idx)[R[i]], tb = ((const LAS int*)idx)[pg8::HALF + R[i]];
            o0[i] = (unsigned)(ta * D + C[i] * 2); o1[i] = (unsigned)(tb * D + C[i] * 2); }
    }
};
struct MoeDownSched {
    static constexpr bool GATHER = false;
    const char* A; const char* Bt; int G, c, p0, nM; MoeTab T; int tprobe;
    __device__ __forceinline__ bool next(int i, pg8::Unit& u) const {
        const int L = i * G + c; if (L >= nM * 4) return false;
        int pm, pn; pg8::tile_of(L, nM, 4, pm, pn);
        const int panel = p0 + pm, e = moe_expert_of(T, panel);
        u.pm = panel; u.pn = pn; u.aux = e; u.aux2 = 0; u.Ap = A + (size_t)pm * 256 * DEXP; u.Bp = Bt + ((size_t)e * D + (size_t)pn * 256) * DEXP; return true;
    }
    __device__ __forceinline__ void aoff(const pg8::Unit&, const int (&R)[2], const int (&C)[2], unsigned (&o0)[2], unsigned (&o1)[2]) const {
#pragma unroll
        for (int i = 0; i < 2; ++i) { o0[i] = (unsigned)(R[i] * DEXP + C[i] * 2); o1[i] = (unsigned)((pg8::HALF + R[i]) * DEXP + C[i] * 2); }
    }
};

constexpr int N_PHASES = 24;


__global__ void __launch_bounds__(NWAVES * 64, 2) mk_fwd(Args args) {
    extern __shared__ __attribute__((aligned(16))) unsigned char lds_raw[];
    Frame F;
    F.lds = (LAS unsigned char*)lds_raw;
    F.tid = threadIdx.x; F.lane = F.tid & 63; F.wave = __builtin_amdgcn_readfirstlane(F.tid >> 6);
    F.G = gridDim.x; { const int bx = blockIdx.x; F.vcu = (F.G % 8 == 0) ? (bx % 8) * (F.G / 8) + bx / 8 : bx; }
    unsigned char* ws = KARG()->ws;
    F.ctl = (gu32*)(ws + WS_CTL);
    volatile LAS unsigned* MISC = (volatile LAS unsigned*)(F.lds + MISC_OFF);
    for (int u = F.tid; u < (LDS_BYTES - LDSCTL_OFF) / 4; u += NWAVES * 64) ((LAS unsigned*)(F.lds + LDSCTL_OFF))[u] = 0u;
    __syncthreads();
    XcdBarrier bar; bar.bar = (unsigned*)(F.ctl + CW_BAR); bar.x = 0; bar.st = nullptr;
    if (!MK_PER_PHASE) bar = xcd_barrier_post((unsigned*)(F.ctl + CW_BAR), MISC + 8, F.tid);
    const int lo = KARG()->ph_lo, hi = KARG()->ph_hi;
#ifndef PROBE_NULL_G2
#define PROBE_NULL_G2 0
#endif
#ifndef DUP_MASK
#define DUP_MASK 0u
#endif
#if ((DUP_MASK) >> 0) & 1
#define REP_0 for (int _rep = 0; _rep < 2; ++_rep)
#else
#define REP_0
#endif
#if ((DUP_MASK) >> 1) & 1
#define REP_1 for (int _rep = 0; _rep < 2; ++_rep)
#else
#define REP_1
#endif
#if ((DUP_MASK) >> 2) & 1
#define REP_2 for (int _rep = 0; _rep < 2; ++_rep)
#else
#define REP_2
#endif
#if ((DUP_MASK) >> 4) & 1
#define REP_4 for (int _rep = 0; _rep < 2; ++_rep)
#else
#define REP_4
#endif
#if ((DUP_MASK) >> 5) & 1
#define REP_5 for (int _rep = 0; _rep < 2; ++_rep)
#else
#define REP_5
#endif
#if ((DUP_MASK) >> 6) & 1
#define REP_6 for (int _rep = 0; _rep < 2; ++_rep)
#else
#define REP_6
#endif
#if ((DUP_MASK) >> 7) & 1
#define REP_7 for (int _rep = 0; _rep < 2; ++_rep)
#else
#define REP_7
#endif
#if ((DUP_MASK) >> 9) & 1
#define REP_9 for (int _rep = 0; _rep < 2; ++_rep)
#else
#define REP_9
#endif
#if ((DUP_MASK) >> 11) & 1
#define REP_11 for (int _rep = 0; _rep < 2; ++_rep)
#else
#define REP_11
#endif
#if ((DUP_MASK) >> 13) & 1
#define REP_13 for (int _rep = 0; _rep < 2; ++_rep)
#else
#define REP_13
#endif
#if ((DUP_MASK) >> 14) & 1
#define REP_14 for (int _rep2 = 0; _rep2 < 2; ++_rep2)
#else
#define REP_14
#endif
#if ((DUP_MASK) >> 15) & 1
#define REP_15 for (int _rep2 = 0; _rep2 < 2; ++_rep2)
#else
#define REP_15
#endif
#ifndef PH_MASK
#define PH_MASK 0xffffffu
#endif
#define IN(k) ((((PH_MASK) >> (k)) & 1u) && lo <= (k) && (k) < hi)
#define SEAM(k) do { if (IN(k) && IN((k) + 1)) xcd_barrier(bar, F.wave); F.lane = lane_id_v(); F.tid = F.wave * 64 + F.lane; } while (0)

    bf16_t* XB = (bf16_t*)(ws + WS_XB);
    bf16_t* HA = (bf16_t*)(ws + WS_HA); bf16_t* P = (bf16_t*)(ws + WS_R1); bf16_t* HFF = (bf16_t*)(ws + WS_R1); bf16_t* OY = (bf16_t*)(ws + WS_OY); bf16_t* YS = (bf16_t*)(ws + WS_YS);
    const float* MS = (const float*)(ws + WS_MS);
    const float* ropec = (const float*)(ws + WS_ROPE); const float* ropes = ropec + 1024;
    int* tok_e = (int*)(ws + WS_ROUTE); float* tok_g = (float*)(ws + WS_ROUTE + 262144); int* tok_rank = (int*)(ws + WS_ROUTE + 524288);
    int* slot_token = (int*)(ws + WS_SLOT);
    const int gw = F.vcu * NWAVES + F.wave, NGW = F.G * NWAVES;
    char* ldsg = (char*)lds_raw;

#define TAIL_FILL(busy, kper, base) do { const int c_ = (int)blockIdx.x; if (c_ >= (busy)) { const int nfw_ = (256 - (busy)) * NWAVES, r_ = (c_ - (busy)) * NWAVES + F.wave; \
        convert_range(F.lds, F.wave, lane_id_v(), KARG(), CV_L0 + (base) + r_, nfw_, CV_L0 + (base) + (kper) * nfw_); } } while (0)
    constexpr int TF_K = 4, TF_K4 = 14;
    constexpr int TF_B2 = 0, TF_B4 = TF_B2 + 96 * NWAVES * TF_K, TF_B6 = TF_B4 + 192 * NWAVES * TF_K, TF_B7 = TF_B6 + 160 * NWAVES * TF_K, TF_B9 = TF_B7 + 192 * NWAVES * TF_K4, TF_END = TF_B9 + 192 * NWAVES * TF_K;
    static_assert(CV_L0 + TF_END <= CV_N, "tail fillers");
#if PROBE_T && PROBE_T_PHASE == 40
#define RGN(n) do { if (F.wave == 0 && blockIdx.x == 0 && lane_id_v() == 0) { volatile LAS unsigned* tacc_ = (volatile LAS unsigned*)(F.lds + MISC_OFF) + 16; const unsigned _now = (unsigned)__builtin_amdgcn_s_memrealtime(); tacc_[n] += _now - tacc_[0]; tacc_[0] = _now; } } while (0)
#else
#define RGN(n) do {} while (0)
#endif
    RGN(0);
    REP_0 if (IN(0)) { p0_prologue(F, KARG()); __syncthreads(); }
    RGN(1);
    SEAM(0);

    RGN(0);
    REP_1 if (IN(1)) {
        KArgP AP = KARG(); const float* x_in = AP->in[0]; const float* ctx_in = AP->in[2];
        const float* g = AP->in[6];
#pragma unroll 1
        for (int seg = 0; seg < 2; ++seg) {
            const int nr = seg ? 2 : 16; const int m0 = seg ? MLAT + gw * 2 : gw * 16; const int r17 = seg ? 16 : (m0 >> 11);
            const float* xbase = seg ? ctx_in + (size_t)(m0 - MLAT) * D : x_in + (size_t)m0 * D;
            const float* msr = MS + (size_t)r17 * 6144;
            const ModP MP = ld_modp(g, msr, msr + 1024, F.lane);
            Row xn = ld_row_f32(xbase, F.lane);
            for (int i = 0; i < nr; ++i) {
                const Row x = xn; if (i + 1 < nr) xn = ld_row_f32(xbase + (size_t)(i + 1) * D, F.lane);
                st_row_bf16(HA + (size_t)(m0 + i) * D, F.lane, row_modulate2(x, MP));
            }
        }
    }
    RGN(2);
    SEAM(1);

    REP_2 if (IN(2)) {
        pg8::DenseSched S{(const char*)HA, (const char*)(ws + WS_WIN), D, D, F.G, (int)blockIdx.x, MALL / 256, 10, 0, 0, 0, 0, 0, 0};
        LAS float* rl = (LAS float*)(F.lds + ROPE_LDS); for (int i = F.tid; i < 2048; i += NWAVES * 64) rl[i] = ropec[i]; __syncthreads();
        pg8::EpiInProj E{P, rl, rl + 1024};
        pg8::gemm_phase<pg8::EpiInProj, pg8::DenseSched, true>(F.lds, F.wave, D, S, E);
        TAIL_FILL(1440 - 5 * 256, TF_K, TF_B2);
    }
    SEAM(2);

#define ATTN_PHASE(LAYER, WITH_CTX) do { \
        KArgP AP = KARG(); \
        float lam; { const float a1 = AP->in[12][(LAYER) * 64 + F.lane] * AP->in[13][(LAYER) * 64 + F.lane], a2 = AP->in[14][(LAYER) * 64 + F.lane] * AP->in[15][(LAYER) * 64 + F.lane]; \
            lam = __expf(wave_sum(a1)) - __expf(wave_sum(a2)) + ((LAYER) ? LAMBDA_INIT1 : LAMBDA_INIT0); } \
        const float oscale = 1.f - ((LAYER) ? LAMBDA_INIT1 : LAMBDA_INIT0); \
        const float* subg = AP->in[16] + (LAYER) * 128; \
        const int c = (int)blockIdx.x, xcd = c & 7, jj = c >> 3; \
        for (int i = 0; i < 5; ++i) { \
            bf16_t* Qb; const bf16_t* K0; const bf16_t* K1; int n1; \
            if (i < 4) { const int bh = i * 16 + xcd * 2 + (jj >> 4), qb = jj & 15, b = bh >> 2, h = bh & 3; \
                Qb = P + ((size_t)b * SEQ + qb * 128) * NIN + COL_Q + h * 128; K0 = P + ((size_t)MLAT + b * CTX) * NIN + COL_K + h * 128; K1 = P + ((size_t)b * SEQ) * NIN + COL_K + h * 128; n1 = 32; } \
            else { if (!((WITH_CTX) && c < 128)) break; const int bh = c >> 1, qb = c & 1, b = bh >> 2, h = bh & 3;        \
                Qb = P + ((size_t)MLAT + b * CTX + qb * 128) * NIN + COL_Q + h * 128; K0 = P + ((size_t)MLAT + b * CTX) * NIN + COL_K + h * 128; K1 = K0; n1 = 0; } \
            att::attn_unit(Qb, K0, 4, K1, n1, Qb, lam, oscale, subg, ldsg, F.wave); } \
        int c1 = c; asm volatile("" : "+s"(c1)); \
        int c2 = c1; asm volatile("" : "+s"(c2)); \
        SGT(7); \
        if (!DBG_NO_SG) { const bf16_t* sgw = (const bf16_t*)(ws + WS_SGW) + (size_t)(LAYER) * 4 * 128 * 128; \
          att::sg_unit(P + (size_t)c2 * 128 * NIN, sgw, AP->in[17] + (LAYER) * 512, AP->in[18] + (LAYER) * 512, AP->in[20] + (LAYER) * 512, ldsg, F.wave, 0, 4); \
          int c3 = c2; asm volatile("" : "+s"(c3)); \
          if ((WITH_CTX) && c3 >= 128) { const int it_ = c3 - 128;          \
              att::sg_unit(P + ((size_t)MLAT + (it_ >> 2) * 128) * NIN, sgw, AP->in[17] + (LAYER) * 512, AP->in[18] + (LAYER) * 512, AP->in[20] + (LAYER) * 512, ldsg, F.wave, it_ & 3, (it_ & 3) + 1); } } \
        SGT(1); \
    } while (0)
#if PROBE_T && PROBE_T_PHASE == 30
#define SGT(n) do { if (F.wave == 0 && blockIdx.x == 0 && lane_id_v() == 0) { volatile LAS unsigned* tacc_ = (volatile LAS unsigned*)(F.lds + MISC_OFF) + 16; const unsigned _now = (unsigned)__builtin_amdgcn_s_memrealtime(); tacc_[n] += _now - tacc_[0]; tacc_[0] = _now; } } while (0)
#else
#define SGT(n) do {} while (0)
#endif
    RGN(0);
    if (IN(3)) { ATTN_PHASE(0, true); }
    RGN(3);
    SEAM(3);

    REP_4 if (IN(4)) {
        pg8::DenseSched S{(const char*)P, (const char*)(ws + WS_WOUT), NIN, D, F.G, (int)blockIdx.x, MALL / 256, 4, 0, 0, 0, 0, 0, 0};
        pg8::EpiPlain E{OY, D, 1.f};
        pg8::gemm_phase<pg8::EpiPlain, pg8::DenseSched, true>(F.lds, F.wave, D, S, E);
#if PROBE_NULL_G2 == 1
        { pg8::EpiNull E0; pg8::gemm_phase<pg8::EpiNull, pg8::DenseSched, true>(F.lds, F.wave, D, S, E0); }
#elif PROBE_NULL_G2 == 2
        { pg8::EpiPlainMask E0{HA, D}; pg8::gemm_phase<pg8::EpiPlainMask, pg8::DenseSched, true>(F.lds, F.wave, D, S, E0); }
#endif
        TAIL_FILL(576 - 2 * 256, TF_K, TF_B4);
    }
    SEAM(4);

    RGN(0);
    REP_5 if (IN(5)) {
        KArgP AP = KARG(); const float* x_in = AP->in[0]; const float* ctx_in = AP->in[2];
        const float* gpost = AP->in[7]; const float* gpre = AP->in[8];
#pragma unroll 1
        for (int seg = 0; seg < 2; ++seg) {
            const int nr = seg ? 2 : 16; const int m0 = seg ? MLAT + gw * 2 : gw * 16; const int r17 = seg ? 16 : (m0 >> 11);
            const float* xbase = seg ? ctx_in + (size_t)(m0 - MLAT) * D : x_in + (size_t)m0 * D;
            const float* msr = MS + (size_t)r17 * 6144;
            const ResP RP = ld_resp(gpost, msr + 2 * 1024, F.lane); const ModP MP = ld_modp(gpre, msr + 3 * 1024, msr + 4 * 1024, F.lane);
            Row xn = ld_row_f32(xbase, F.lane), on = ld_row_bf16(OY + (size_t)m0 * D, F.lane);
            for (int i = 0; i < nr; ++i) {
                Row x = xn; const Row o = on; if (i + 1 < nr) { xn = ld_row_f32(xbase + (size_t)(i + 1) * D, F.lane); on = ld_row_bf16(OY + (size_t)(m0 + i + 1) * D, F.lane); }
                row_residual2(x, o, RP);
                st_row_bf16(XB + (size_t)(m0 + i) * D, F.lane, x);
                st_row_bf16(HA + (size_t)(m0 + i) * D, F.lane, row_modulate2(x, MP));
            }
        }
    }
    RGN(4);
    SEAM(5);

    REP_6 if (IN(6)) {
        pg8::DenseSched S{(const char*)HA, (const char*)(ws + WS_W13), D, D, F.G, (int)blockIdx.x, MALL / 256, 22, 0, 0, 0, 0, 0, 0, PROBE_T_PHASE == 6};
#if FFN_DOWN_FP8
        pg8::EpiSwigluF8 E{(unsigned char*)HFF, DFF, -1.4426950408889634f, 4.f};
        pg8::gemm_phase<pg8::EpiSwigluF8, pg8::DenseSched, true>(F.lds, F.wave, D, S, E);
#else
        pg8::EpiSwiglu E{HFF, DFF};
        pg8::gemm_phase<pg8::EpiSwiglu, pg8::DenseSched, true>(F.lds, F.wave, D, S, E);
#endif
        TAIL_FILL(3168 - 12 * 256, TF_K, TF_B6);
    }
    SEAM(6);

    REP_7 if (IN(7)) {
#if FFN_DOWN_FP8
        pg8::DenseSchedF8 S{(const char*)HFF, (const char*)(ws + WS_W2), DFF, DFF, F.G, (int)blockIdx.x, MALL / 256, 4, 0};
        pg8::EpiPlain E{OY, D, 1.f / 512.f};
        pg8::gemm_phase<pg8::EpiPlain, pg8::DenseSchedF8, true, true>(F.lds, F.wave, DFF, S, E);
#else
        pg8::DenseSched S{(const char*)HFF, (const char*)(ws + WS_W2), DFF, DFF, F.G, (int)blockIdx.x, MALL / 256, 4, 0, 0, 0, 0, 0, 0};
        pg8::EpiPlain E{OY, D, 1.f};
        pg8::gemm_phase<pg8::EpiPlain, pg8::DenseSched, true>(F.lds, F.wave, DFF, S, E);
#endif
        TAIL_FILL(576 - 2 * 256, TF_K4, TF_B7);
    }
    SEAM(7);

    if (IN(8)) {
        KArgP AP = KARG();
        const float* gpost = AP->in[9]; const float* gpre = AP->in[6] + D;
#pragma unroll 1
        for (int seg = 0; seg < 2; ++seg) {
            const int nr = seg ? 2 : 16; const int m0 = seg ? MLAT + gw * 2 : gw * 16; const int r17 = seg ? 16 : (m0 >> 11);
            const float* msr = MS + (size_t)r17 * 6144; const float* msr1 = MS + (size_t)(17 + r17) * 6144;
            const ResP RP = ld_resp(gpost, msr + 5 * 1024, F.lane); const ModP MP = ld_modp(gpre, msr1, msr1 + 1024, F.lane);
            Row xn = ld_row_bf16(XB + (size_t)m0 * D, F.lane), yn = ld_row_bf16(OY + (size_t)m0 * D, F.lane);
            for (int i = 0; i < nr; ++i) {
                Row x = xn; const Row y = yn; if (i + 1 < nr) { xn = ld_row_bf16(XB + (size_t)(m0 + i + 1) * D, F.lane); yn = ld_row_bf16(OY + (size_t)(m0 + i + 1) * D, F.lane); }
                row_residual2(x, y, RP);
                if (!seg) st_row_bf16(XB + (size_t)(m0 + i) * D, F.lane, x);
                st_row_bf16(HA + (size_t)(m0 + i) * D, F.lane, row_modulate2(x, MP));
            }
        }
    }
    SEAM(8);

    REP_9 if (IN(9)) {
        pg8::DenseSched S{(const char*)HA, (const char*)(ws + WS_WIN + (size_t)NIN * D * 2), D, D, F.G, (int)blockIdx.x, MLAT / 256, 10, 0, 0, MCTX / 256, 4, MLAT, 4};
        LAS float* rl = (LAS float*)(F.lds + ROPE_LDS); for (int i = F.tid; i < 2048; i += NWAVES * 64) rl[i] = ropec[i]; __syncthreads();
        pg8::EpiInProj E{P, rl, rl + 1024};
        pg8::gemm_phase<pg8::EpiInProj, pg8::DenseSched, true>(F.lds, F.wave, D, S, E);
        TAIL_FILL(1344 - 5 * 256, TF_K, TF_B9);
    }
    SEAM(9);

    if (IN(10)) { ATTN_PHASE(1, false); }
    SEAM(10);

    REP_11 if (IN(11)) {
        pg8::DenseSched S{(const char*)P, (const char*)(ws + WS_WOUT + (size_t)D * D * 2), NIN, D, F.G, (int)blockIdx.x, MLAT / 256, 4, 0, 0, 0, 0, 0, 0};
        pg8::EpiPlain E{OY, D, 1.f};
        pg8::gemm_phase<pg8::EpiPlain, pg8::DenseSched, true>(F.lds, F.wave, D, S, E);
    }
    SEAM(11);

    RGN(0);
    if (IN(12)) {
        KArgP AP = KARG();
        const float* gpost = AP->in[7] + D; const float* gpre = AP->in[8] + D;
        LAS float* rw = (LAS float*)F.lds;
        LAS int* lcnt = (LAS int*)(F.lds + 32768);
        LAS int* rec = (LAS int*)(F.lds + 32768 + 256);
        for (int i = F.tid; i < 8192; i += 512) rw[(i & 7) * 1024 + (i >> 3)] = AP->in[24][i];
        if (F.tid < 16) lcnt[F.tid] = 0;
        __syncthreads();
        const int m0 = gw * 16; const int r17 = m0 >> 11; const float* msr1 = MS + (size_t)(17 + r17) * 6144;
        const ResP RP = ld_resp(gpost, msr1 + 2 * 1024, F.lane); const ModP MP = ld_modp(gpre, msr1 + 3 * 1024, msr1 + 4 * 1024, F.lane);
        Row xn = ld_row_bf16(XB + (size_t)m0 * D, F.lane), on = ld_row_bf16(OY + (size_t)m0 * D, F.lane);
        for (int i = 0; i < 16; ++i) {
            const int m = m0 + i;
            Row x = xn; const Row o = on; if (i + 1 < 16) { xn = ld_row_bf16(XB + (size_t)(m + 1) * D, F.lane); on = ld_row_bf16(OY + (size_t)(m + 1) * D, F.lane); }
            row_residual2(x, o, RP);
            st_row_bf16(XB + (size_t)m * D, F.lane, x);
            const Row f = row_modulate2(x, MP);
            { unsigned* fo = (unsigned*)(ws + WS_F8 + (size_t)m * D) + F.lane;
#pragma unroll
              for (int j = 0; j < 4; ++j) fo[64 * j] = pg8::pk_fp8x4(f.v[j][0] * 4.f, f.v[j][1] * 4.f, f.v[j][2] * 4.f, f.v[j][3] * 4.f); }
            float lg[8];
#pragma unroll
            for (int e = 0; e < 8; ++e) { float a = 0.f;
#pragma unroll
                for (int j = 0; j < 4; ++j) { const f32x4 w = *(const LAS f32x4*)(rw + e * 1024 + 4 * (F.lane + 64 * j)); a += (f.v[j][0] * w[0] + f.v[j][1] * w[1]) + (f.v[j][2] * w[2] + f.v[j][3] * w[3]); }
                lg[e] = wave_sum(a); }
            int e1 = 0; float v1 = lg[0];
#pragma unroll
            for (int e = 1; e < 8; ++e) if (lg[e] > v1) { v1 = lg[e]; e1 = e; }
            int e2 = -1; float v2 = -3.0e38f;
#pragma unroll
            for (int e = 0; e < 8; ++e) if (e != e1 && lg[e] > v2) { v2 = lg[e]; e2 = e; }
            if (F.lane == 0) {
                const float w1 = 1.f / (1.f + __expf(v2 - v1));
                tok_e[m * 2] = e1; tok_e[m * 2 + 1] = e2; tok_g[m * 2] = w1; tok_g[m * 2 + 1] = 1.f - w1;
                const int l1 = __hip_atomic_fetch_add(lcnt + e1, 1, __ATOMIC_RELAXED, __HIP_MEMORY_SCOPE_WORKGROUP), l2 = __hip_atomic_fetch_add(lcnt + e2, 1, __ATOMIC_RELAXED, __HIP_MEMORY_SCOPE_WORKGROUP);
                LAS int* rr = rec + (F.wave * 16 + i) * 4; rr[0] = e1; rr[1] = e2; rr[2] = l1; rr[3] = l2;
            }
        }
        __syncthreads();
        if (F.tid < 8) lcnt[8 + F.tid] = (int)__hip_atomic_fetch_add(F.ctl + CW_CNT + 64 * F.tid, (unsigned)lcnt[F.tid], RLX_AGENT);
        __syncthreads();
        if (F.lane < 16) { const int m = m0 + F.lane; const LAS int* rr = rec + (F.wave * 16 + F.lane) * 4;
            const int r1 = lcnt[8 + rr[0]] + rr[2], r2 = lcnt[8 + rr[1]] + rr[3];
            tok_rank[m * 2] = r1; tok_rank[m * 2 + 1] = r2; slot_token[rr[0] * 32768 + r1] = m; slot_token[rr[1] * 32768 + r2] = m; }
        __syncthreads();
        convert_range(F.lds, F.wave, lane_id_v(), KARG(), CV_L0 + TF_END + gw, NGW, CV_N);
    }
    RGN(5);
    SEAM(12);

    {
        MoeTab T; T.pbase[8] = 0;
        if (hi > 13 && lo < 23) moe_tab(F.ctl, T);
        const int ptot = T.pbase[8];
        REP_13 for (int ch = 0; ch < 2; ++ch) {
            const int p0 = ch * 128; const int nM = ch ? ptot - 128 : (ptot < 128 ? ptot : 128);
            REP_14 if (IN(13 + 2 * ch) && nM > 0) {
                MoeUpSched S{(const char*)(ws + WS_F8), (const char*)(ws + WS_MW13), slot_token, F.G, (int)blockIdx.x, p0, nM, T, PROBE_T_PHASE == 13};
                pg8::EpiSwigluF8 E{ws + WS_HF8 + (size_t)p0 * 256 * DEXP, DEXP, -1.4426950408889634f / 512.f, 4.f / (512.f * 512.f)};
                pg8::gemm_phase<pg8::EpiSwigluF8, MoeUpSched, true, true>(F.lds, F.wave, D, S, E);
            }
            if (IN(13 + 2 * ch) && IN(14 + 2 * ch) && nM > 0) xcd_barrier(bar, F.wave);
            REP_15 if (IN(14 + 2 * ch) && nM > 0) {
                MoeDownSched S{(const char*)(ws + WS_HF8 + (size_t)p0 * 256 * DEXP), (const char*)(ws + WS_MW2), F.G, (int)blockIdx.x, p0, nM, T, PROBE_T_PHASE == 14};
                pg8::EpiPlain E{YS, D, 1.f / 512.f};
                pg8::gemm_phase<pg8::EpiPlain, MoeDownSched, true, true>(F.lds, F.wave, DEXP, S, E);
            }
            if (ch == 1 && IN(14 + 2 * ch) && IN(15 + 2 * ch) && nM > 0) xcd_barrier(bar, F.wave);
        }
    }

    RGN(0);
    if (IN(23)) {
        MoeTab T; moe_tab(F.ctl, T);
        const float* gpost = KARG()->in[9] + D;
#define YS_ROWS(mm, S1, S2) do { const int e1_ = tok_e[(mm) * 2], e2_ = tok_e[(mm) * 2 + 1]; int pb1_ = 0, pb2_ = 0; \
            _Pragma("unroll") for (int e = 0; e < 8; ++e) { pb1_ = (e1_ == e) ? T.pbase[e] : pb1_; pb2_ = (e2_ == e) ? T.pbase[e] : pb2_; } \
            S1 = (size_t)pb1_ * 256 + tok_rank[(mm) * 2]; S2 = (size_t)pb2_ * 256 + tok_rank[(mm) * 2 + 1]; } while (0)
        const int m0 = gw * 16; const int r17 = m0 >> 11; const float* msr1 = MS + (size_t)(17 + r17) * 6144;
        const ResP RP = ld_resp(gpost, msr1 + 5 * 1024, F.lane);
        size_t s1, s2; YS_ROWS(m0, s1, s2);
        Row xn = ld_row_bf16(XB + (size_t)m0 * D, F.lane), yan = ld_row_bf16(YS + s1 * D, F.lane), ybn = ld_row_bf16(YS + s2 * D, F.lane);
        float* outp = KARG()->out;
        for (int i = 0; i < 16; ++i) {
            const int m = m0 + i;
            Row x = xn; const Row ya = yan, yb = ybn; const float g1 = tok_g[m * 2], g2 = tok_g[m * 2 + 1];
            if (i + 1 < 16) { YS_ROWS(m + 1, s1, s2); xn = ld_row_bf16(XB + (size_t)(m + 1) * D, F.lane); yan = ld_row_bf16(YS + s1 * D, F.lane); ybn = ld_row_bf16(YS + s2 * D, F.lane); }
            Row y;
#pragma unroll
            for (int j = 0; j < 4; ++j) y.v[j] = ya.v[j] * g1 + yb.v[j] * g2;
            row_residual2(x, y, RP);
            st_row_f32(outp + (size_t)m * D, F.lane, x);
        }
    }
    RGN(6);
#if PROBE_T
    if (blockIdx.x == 0 && F.wave == 0) { const unsigned ticks = ((volatile LAS unsigned*)(F.lds + MISC_OFF))[16 + PROBE_T]; const unsigned long long t0 = __builtin_amdgcn_s_memrealtime();
        while (__builtin_amdgcn_s_memrealtime() - t0 < (unsigned long long)ticks * 8ull) __builtin_amdgcn_s_sleep(8); }
#endif
#undef TAIL_FILL
#undef IN
#undef SEAM
#undef ATTN_PHASE
}

extern "C" void kernel_launch(void* const* d_in, const int* in_sizes, int n_in, void* d_out, int out_size, void* d_ws, size_t ws_size, hipStream_t stream) {
    static int grid = 0;
    if (grid == 0) {
        if (n_in != 28 || out_size != MLAT * D || ws_size < WS_END) { fprintf(stderr, "kernel_launch: unexpected shapes (n_in %d, out %d, ws %zu)\n", n_in, out_size, ws_size); grid = -1; return; }
        int dev = 0, cus = 0, per_cu = 0;
        if (hipGetDevice(&dev) != hipSuccess || hipDeviceGetAttribute(&cus, hipDeviceAttributeMultiprocessorCount, dev) != hipSuccess) { grid = -1; return; }
        if (hipFuncSetAttribute((const void*)mk_fwd, hipFuncAttributeMaxDynamicSharedMemorySize, LDS_BYTES) != hipSuccess) { fprintf(stderr, "kernel_launch: hipFuncSetAttribute failed\n"); grid = -1; return; }
        if (hipOccupancyMaxActiveBlocksPerMultiprocessor(&per_cu, (const void*)mk_fwd, NWAVES * 64, LDS_BYTES) != hipSuccess || per_cu < 1) { fprintf(stderr, "kernel_launch: occupancy query says %d\n", per_cu); (void)hipGetLastError(); }
        grid = cus;
        if (grid != 256) { fprintf(stderr, "kernel_launch: built for 256 CUs, found %d\n", grid); grid = -1; return; }
    }
    if (grid < 0) return;
    (void)hipMemsetAsync((char*)d_ws + WS_CTL, 0, CTL_ZERO_BYTES, stream);
    Args a{};
    for (int i = 0; i < 28; ++i) a.in[i] = (const float*)d_in[i];
    a.out = (float*)d_out; a.ws = (unsigned char*)d_ws;
#if MK_PER_PHASE
    for (int p = 0; p < N_PHASES; ++p) { a.ph_lo = p; a.ph_hi = p + 1; hipLaunchKernelGGL(mk_fwd, dim3(grid), dim3(NWAVES * 64), LDS_BYTES, stream, a); }
#else
    a.ph_lo = 0; a.ph_hi = N_PHASES;
    hipLaunchKernelGGL(mk_fwd, dim3(grid), dim3(NWAVES * 64), LDS_BYTES, stream, a);
#endif
}
```

```cpp
#include <hip/hip_runtime.h>
#include <cstdio>
#include <cstdint>

#ifndef DBG_NO_SG
#define DBG_NO_SG 0
#endif
#ifndef DBG_NO_CTX
#define DBG_NO_CTX 0
#endif
#ifndef DBG_NO_LAT
#define DBG_NO_LAT 0
#endif
#ifndef PROBE_T
#define PROBE_T 0
#endif
#ifndef PROBE_T_PHASE
#define PROBE_T_PHASE 6
#endif
#ifndef FFN_UP_FP8
#define FFN_UP_FP8 1
#endif
#ifndef FFN_DOWN_FP8
#define FFN_DOWN_FP8 1
#endif
#ifndef MK_PER_PHASE
#define MK_PER_PHASE 0
#endif

#define LAS __attribute__((address_space(3)))
#define GAS __attribute__((address_space(1)))
typedef unsigned short bf16_t;
typedef short bf16x8 __attribute__((ext_vector_type(8)));
typedef short s16x4 __attribute__((ext_vector_type(4)));
typedef float f32x2 __attribute__((ext_vector_type(2)));
typedef float f32x4 __attribute__((ext_vector_type(4)));
typedef float f32x16 __attribute__((ext_vector_type(16)));
typedef unsigned u32x2 __attribute__((ext_vector_type(2)));
typedef unsigned u32x4 __attribute__((ext_vector_type(4)));
typedef GAS unsigned gu32;
typedef int v8i __attribute__((ext_vector_type(8)));
typedef int v4i __attribute__((ext_vector_type(4)));

constexpr int D = 1024, BATCH = 16, SEQ = 2048, CTX = 256;
constexpr int MLAT = BATCH * SEQ;
constexpr int MCTX = BATCH * CTX;
constexpr int MALL = MLAT + MCTX;
constexpr int NIN = 2560;
constexpr int COL_Q = 0, COL_U = 512, COL_K = 1024, COL_V = 1536, COL_G = 2048;
constexpr int DFF = 2816, DEXP = 3584, NEXP = 8;
constexpr float EPS = 1e-6f;
constexpr float LAMBDA_INIT0 = 0.2f, LAMBDA_INIT1 = 0.35550907f;

constexpr size_t MiB = 1u << 20;
constexpr size_t WS_CTL = 0, CTL_ZERO_BYTES = 1 * MiB;
constexpr size_t WS_MS = 1 * MiB;
constexpr size_t WS_ROPE = 2 * MiB;
constexpr size_t WS_ROUTE = 3 * MiB;
constexpr size_t WS_SLOT = 4 * MiB;
constexpr size_t WS_WIN = 5 * MiB;
constexpr size_t WS_WOUT = 15 * MiB;
constexpr size_t WS_SGW = 19 * MiB;
constexpr size_t WS_W13 = 20 * MiB;
constexpr size_t WS_W2 = 31 * MiB;
constexpr size_t WS_MW13 = 37 * MiB;
constexpr size_t WS_MW2 = 93 * MiB;
constexpr size_t WS_XB = 121 * MiB;
constexpr size_t WS_HA = 221 * MiB;
constexpr size_t WS_R1 = 293 * MiB;
constexpr size_t WS_OY = 491 * MiB;
constexpr size_t WS_F8 = 5 * MiB;
constexpr size_t WS_HF8 = 221 * MiB;
constexpr size_t WS_YS = 452 * MiB;
constexpr size_t WS_END = 584 * MiB;

constexpr int CW_BAR = 4096;
constexpr int CW_CNT = 64;

constexpr int RING_BYTES = 131072;
constexpr int LDSCTL_OFF = RING_BYTES, MISC_OFF = LDSCTL_OFF + 320;
constexpr int LDS_BYTES = 147456;
constexpr int ROPE_LDS = RING_BYTES + 6144;
static_assert(ROPE_LDS + 8192 <= LDS_BYTES, "LDS map");
constexpr int NWAVES = 8;

#define RLX_AGENT __ATOMIC_RELAXED, __HIP_MEMORY_SCOPE_AGENT
#define LDS_WAIT() asm volatile("s_waitcnt lgkmcnt(0)" ::: "memory")
#define VM_WAIT() asm volatile("s_waitcnt vmcnt(0)" ::: "memory")
#define SBAR() __builtin_amdgcn_sched_barrier(0)

__device__ __forceinline__ unsigned cvt_pk_bf16(float lo, float hi) { unsigned r; asm volatile("v_cvt_pk_bf16_f32 %0, %1, %2" : "=v"(r) : "v"(lo), "v"(hi)); return r; }
__device__ __forceinline__ float bf2f(unsigned short b) { return __builtin_bit_cast(float, (unsigned)b << 16); }
__device__ __forceinline__ float bflo(unsigned w) { return __builtin_bit_cast(float, w << 16); }
__device__ __forceinline__ float bfhi(unsigned w) { return __builtin_bit_cast(float, w & 0xffff0000u); }
__device__ __forceinline__ float wave_sum(float v) {
#pragma unroll
    for (int o = 1; o < 64; o <<= 1) v += __shfl_xor(v, o);
    return v;
}
__device__ __forceinline__ int lane_id_v() { int l; asm volatile("v_mbcnt_lo_u32_b32 %0, -1, 0\n\tv_mbcnt_hi_u32_b32 %0, -1, %0" : "=v"(l)); return l; }
__device__ __forceinline__ float silu_f(float v) { return v / (1.f + __expf(-v)); }

namespace pg8 {
constexpr int BM = 256, BK = 64, HALF = 128, HTB = HALF * BK * 2, STAGE_BYTES = 8 * HTB, NXCD = 8, WGM = 4;
constexpr int IDX_OFF = STAGE_BYTES + 4096;
__host__ __device__ __forceinline__ int lds_byte(int r, int c) { const int st = (r >> 4) * 2 + (c >> 5), rr = r & 15, cc = c & 31, ob = rr * 64 + cc * 2; return st * 1024 + (ob ^ (((ob >> 9) & 1) << 5)); }
__host__ __device__ __forceinline__ void stage_rc(int b, int& R, int& C) { const int st = b / 1024, sb = b % 1024, swz = sb ^ (((sb >> 9) & 1) << 5); R = (st >> 1) * 16 + swz / 64; C = (st & 1) * 32 + (swz % 64) / 2; }
__host__ __device__ __forceinline__ int perm32(int rho) { const int n = rho >> 4, i = rho & 15; return 8 * (i >> 2) + 4 * n + (i & 3); }

struct Unit { const char* Ap; const char* Bp; int pm, pn, aux, aux2; };

__device__ __forceinline__ void tile_of(int L, int nM, int nN, int& pm, int& pn) {
    const int nwg = nM * nN; int wgid = L;
    { const int q = nwg / NXCD, r = nwg % NXCD, xcd = wgid % NXCD, off = wgid / NXCD; wgid = (xcd < r ? xcd * (q + 1) : r * (q + 1) + (xcd - r) * q) + off; }
    const int nig = WGM * nN, gid = wgid / nig, fm = gid * WGM, gsz = (nM - fm) < WGM ? (nM - fm) : WGM;
    pm = fm + ((wgid % nig) % gsz); pn = (wgid % nig) / gsz;
}

template <class Epi, class Sched, bool ALIGN_EPI, bool FP8 = false>
__device__ __forceinline__ void gemm_phase(LAS unsigned char* lds, const int wid, const int K, const Sched& S, const Epi& E) {
    const int lane = lane_id_v(), tid = wid * 64 + lane;
    const int wr = wid >> 2, wc = wid & 3, fr = lane & 15, fq = lane >> 4;
    const int kbytes = FP8 ? K : 2 * K;
    const int nt = kbytes / 128;
    int R[2], C[2]; unsigned voffB[2];
#pragma unroll
    for (int i = 0; i < 2; ++i) { stage_rc(tid * 16 + i * 8192, R[i], C[i]); const int Rb = Epi::PERM ? ((R[i] & ~31) + perm32(R[i] & 31)) : R[i]; voffB[i] = (unsigned)(Rb * kbytes + C[i] * 2); }
    const size_t kstep = (size_t)(BK * 2);
    const size_t hstepB = (size_t)HALF * kbytes;
    const unsigned ldsw = (unsigned)wid * 1024u;
    const int aoff = lds_byte(wr * 64 + fr, fq * 8), boff = lds_byte(wc * 32 + fr, fq * 8);
#define PG8_SA(b, h) (((b) * 2 + (h)) * HTB)
#define PG8_SB(b, h) ((4 + (b) * 2 + (h)) * HTB)
#define PG8_STAGE(bufoff, gbase, voff) do { _Pragma("unroll") for (int _i = 0; _i < 2; ++_i) \
        __builtin_amdgcn_global_load_lds((const unsigned*)((const char*)(gbase) + (voff)[_i]), (LAS unsigned*)(lds + (bufoff) + ldsw + _i * 8192), 16, 0, 0); } while (0)
#define PG8_LDA(dst, b, h) do { _Pragma("unroll") for (int m = 0; m < 4; ++m) { const v4i _lo = *(const LAS v4i*)(lds + PG8_SA(b, h) + aoff + m * 2048), _hi = *(const LAS v4i*)(lds + PG8_SA(b, h) + aoff + m * 2048 + 1024); \
        dst[m] = __builtin_shufflevector(_lo, _hi, 0, 1, 2, 3, 4, 5, 6, 7); } } while (0)
#define PG8_LDB(dst, b, h) do { _Pragma("unroll") for (int n = 0; n < 2; ++n) { const v4i _lo = *(const LAS v4i*)(lds + PG8_SB(b, h) + boff + n * 2048), _hi = *(const LAS v4i*)(lds + PG8_SB(b, h) + boff + n * 2048 + 1024); \
        dst[n] = __builtin_shufflevector(_lo, _hi, 0, 1, 2, 3, 4, 5, 6, 7); } } while (0)
#define PG8_LO(x) __builtin_bit_cast(bf16x8, __builtin_shufflevector(x, x, 0, 1, 2, 3))
#define PG8_HI(x) __builtin_bit_cast(bf16x8, __builtin_shufflevector(x, x, 4, 5, 6, 7))
#define PG8_MMA(ai, bj, At, Bt) do { __builtin_amdgcn_s_setprio(1); \
        if constexpr (FP8) { _Pragma("unroll") for (int m = 0; m < 4; ++m) _Pragma("unroll") for (int n = 0; n < 2; ++n) \
            asm volatile("v_mfma_f32_16x16x128_f8f6f4 %0, %1, %2, %0" : "+v"(acc[ai][bj][m][n]) : "v"(Bt[n]), "v"(At[m])); } \
        else { _Pragma("unroll") for (int m = 0; m < 4; ++m) _Pragma("unroll") for (int n = 0; n < 2; ++n) { \
            acc[ai][bj][m][n] = __builtin_amdgcn_mfma_f32_16x16x32_bf16(PG8_LO(Bt[n]), PG8_LO(At[m]), acc[ai][bj][m][n], 0, 0, 0); \
            acc[ai][bj][m][n] = __builtin_amdgcn_mfma_f32_16x16x32_bf16(PG8_HI(Bt[n]), PG8_HI(At[m]), acc[ai][bj][m][n], 0, 0, 0); } } \
        __builtin_amdgcn_s_setprio(0); } while (0)
#define PG8_WAIT_V(n) asm volatile("s_waitcnt vmcnt(" #n ")" ::: "memory")
#define PG8_WAIT_L(n) asm volatile("s_waitcnt lgkmcnt(" #n ")" ::: "memory")
#define PG8_BAR __builtin_amdgcn_s_barrier()
#define PG8_SCHED __builtin_amdgcn_sched_barrier(0)
#if PROBE_T
    volatile LAS unsigned* tacc = (volatile LAS unsigned*)(lds + MISC_OFF) + 16;
#define PG8_T(n) do { if (S.tprobe && wid == 0 && blockIdx.x == 0 && lane == 0) { const unsigned _now = (unsigned)__builtin_amdgcn_s_memrealtime(); tacc[n] += _now - tacc[0]; tacc[0] = _now; } } while (0)
#else
#define PG8_T(n) do {} while (0)
#endif
    Unit cur, nxt; int ui = 0;
    if (!S.next(0, cur)) return;
    f32x4 acc[2][2][4][2];
#pragma unroll
    for (int a = 0; a < 2; ++a)
#pragma unroll
        for (int b = 0; b < 2; ++b)
#pragma unroll
            for (int m = 0; m < 4; ++m)
#pragma unroll
                for (int n = 0; n < 2; ++n) acc[a][b][m][n] = (f32x4){0.f, 0.f, 0.f, 0.f};
    v8i At[4], B0[2], B1[2];
    unsigned cO0[2], cO1[2], nO0[2], nO1[2];
    S.aoff(cur, R, C, cO0, cO1);
    const char* cA = cur.Ap; const char* cB = cur.Bp;
    PG8_STAGE(PG8_SB(0, 0), cB, voffB); PG8_STAGE(PG8_SB(0, 1), cB + hstepB, voffB); PG8_STAGE(PG8_SA(0, 0), cA, cO0); PG8_STAGE(PG8_SA(0, 1), cA, cO1);
    if (wr == 1) PG8_BAR;
    PG8_WAIT_V(2); PG8_BAR;
    PG8_STAGE(PG8_SB(1, 0), cB + kstep, voffB); PG8_STAGE(PG8_SA(1, 0), cA + kstep, cO0); PG8_STAGE(PG8_SB(1, 1), cB + hstepB + kstep, voffB);
    PG8_WAIT_V(6); PG8_BAR;
    PG8_T(7);
    for (;;) {
        const bool has_next = S.next(ui + 1, nxt);
        if constexpr (Sched::GATHER) { if (has_next) S.prefetch_idx(nxt, lds + IDX_OFF, wid, lane); nO0[0] = cO0[0]; nO0[1] = cO0[1]; nO1[0] = cO1[0]; nO1[1] = cO1[1]; }
        const char* nA = has_next ? nxt.Ap : cA; const char* nB = has_next ? nxt.Bp : cB;
        PG8_T(4);
        for (int t = 0; t < nt; t += 2) {
            const bool last = (t == nt - 2);
            const char* a1 = cA + (size_t)(t + 1) * kstep;
            const char* a2 = last ? nA : cA + (size_t)(t + 2) * kstep; const char* b2 = last ? nB : cB + (size_t)(t + 2) * kstep;
            const char* a3 = a2 + kstep; const char* b3 = b2 + kstep;
            unsigned xO0[2], xO1[2];
            if constexpr (Sched::GATHER) { if (last && has_next) S.aoff_lds(R, C, lds + IDX_OFF, nO0, nO1); }
            if constexpr (Sched::GATHER) { xO0[0] = last ? nO0[0] : cO0[0]; xO0[1] = last ? nO0[1] : cO0[1]; xO1[0] = last ? nO1[0] : cO1[0]; xO1[1] = last ? nO1[1] : cO1[1]; }
            else { xO0[0] = cO0[0]; xO0[1] = cO0[1]; xO1[0] = cO1[0]; xO1[1] = cO1[1]; }
            const int relax = __builtin_amdgcn_readfirstlane((t == 0 && ui > 0) ? 1 : 0);
#define PG8_WAIT_VR() do { if constexpr (Epi::NSTORES == 16) asm volatile("s_cmp_eq_u32 %0, 0\n\ts_cbranch_scc1 .Lwv%=\n\ts_waitcnt vmcnt(24)\n\ts_branch .Lwe%=\n.Lwv%=:\n\ts_waitcnt vmcnt(8)\n.Lwe%=:" :: "s"(relax) : "memory", "scc"); \
        else asm volatile("s_cmp_eq_u32 %0, 0\n\ts_cbranch_scc1 .Lwv%=\n\ts_waitcnt vmcnt(16)\n\ts_branch .Lwe%=\n.Lwv%=:\n\ts_waitcnt vmcnt(8)\n.Lwe%=:" :: "s"(relax) : "memory", "scc"); } while (0)
            PG8_LDB(B0, 0, 0); PG8_LDB(B1, 0, 1); PG8_SCHED; PG8_LDA(At, 0, 0); PG8_STAGE(PG8_SA(1, 1), a1, cO1);
            PG8_WAIT_VR(); PG8_WAIT_L(0); PG8_BAR; PG8_MMA(0, 0, At, B0); PG8_MMA(0, 1, At, B1); PG8_BAR; PG8_SCHED;
            PG8_LDA(At, 0, 1); PG8_STAGE(PG8_SB(0, 0), b2, voffB); PG8_STAGE(PG8_SB(0, 1), b2 + hstepB, voffB); PG8_STAGE(PG8_SA(0, 0), a2, xO0);
            PG8_WAIT_VR(); PG8_WAIT_L(0); PG8_BAR; PG8_MMA(1, 0, At, B0); PG8_MMA(1, 1, At, B1); PG8_BAR; PG8_SCHED;
            PG8_LDB(B0, 1, 0); PG8_LDB(B1, 1, 1); PG8_SCHED; PG8_LDA(At, 1, 0); PG8_STAGE(PG8_SA(0, 1), a2, xO1);
            PG8_WAIT_V(8); PG8_WAIT_L(0); PG8_BAR; PG8_MMA(0, 0, At, B0); PG8_MMA(0, 1, At, B1); PG8_BAR; PG8_SCHED;
#undef PG8_WAIT_VR
            PG8_LDA(At, 1, 1); PG8_STAGE(PG8_SB(1, 0), b3, voffB); PG8_STAGE(PG8_SB(1, 1), b3 + hstepB, voffB); PG8_STAGE(PG8_SA(1, 0), a3, xO0);
            PG8_WAIT_V(8); PG8_WAIT_L(0); PG8_BAR; PG8_MMA(1, 0, At, B0); PG8_MMA(1, 1, At, B1); PG8_BAR; PG8_SCHED;
        }
        PG8_T(1);
        if constexpr (ALIGN_EPI) { if (wr == 0) PG8_BAR; }
        PG8_T(2);
        if constexpr (FP8) asm volatile("s_nop 15\n\ts_nop 15\n\ts_nop 15\n\ts_nop 15\n\ts_nop 15\n\ts_nop 15" ::: "memory");
        E(acc, cur, wr, wc, fr, fq);
        PG8_T(3);
        if (!has_next) break;
#pragma unroll
        for (int a = 0; a < 2; ++a)
#pragma unroll
            for (int b = 0; b < 2; ++b)
#pragma unroll
                for (int m = 0; m < 4; ++m)
#pragma unroll
                    for (int n = 0; n < 2; ++n) acc[a][b][m][n] = (f32x4){0.f, 0.f, 0.f, 0.f};
        cur = nxt; cA = nA; cB = nB; ++ui;
        if constexpr (Sched::GATHER) { cO0[0] = nO0[0]; cO0[1] = nO0[1]; cO1[0] = nO1[0]; cO1[1] = nO1[1]; }
        if constexpr (ALIGN_EPI) { if (wr == 1) PG8_BAR; }
    }
    PG8_WAIT_V(0);
    if constexpr (!ALIGN_EPI) { if (wr == 0) PG8_BAR; }
    PG8_BAR;
#undef PG8_SA
#undef PG8_SB
#undef PG8_STAGE
#undef PG8_LDA
#undef PG8_LDB
#undef PG8_MMA
#undef PG8_LO
#undef PG8_HI
#undef PG8_WAIT_V
#undef PG8_WAIT_L
#undef PG8_BAR
#undef PG8_SCHED
#undef PG8_T
}

struct DenseSched {
    static constexpr bool GATHER = false;
    const char* A; const char* Bt; int lda, K, G, c;
    int nM0, nN0, arow0_0, pn0_0, nM1, nN1, arow0_1, pn0_1; int tprobe;
    __device__ __forceinline__ bool next(int i, Unit& u) const {
        int L = i * G + c; const int n0 = nM0 * nN0;
        int pm, pn;
        if (L < n0) { tile_of(L, nM0, nN0, pm, pn); u.pm = arow0_0 / 256 + pm; u.pn = pn0_0 + pn; }
        else { L -= n0; if (L >= nM1 * nN1) return false; tile_of(L, nM1, nN1, pm, pn); u.pm = arow0_1 / 256 + pm; u.pn = pn0_1 + pn; }
        u.Ap = A + (size_t)u.pm * 256 * lda * 2; u.Bp = Bt + (size_t)u.pn * 256 * K * 2; u.aux = 0; u.aux2 = 0; return true;
    }
    __device__ __forceinline__ void aoff(const Unit&, const int (&R)[2], const int (&C)[2], unsigned (&o0)[2], unsigned (&o1)[2]) const {
#pragma unroll
        for (int i = 0; i < 2; ++i) { o0[i] = (unsigned)(R[i] * lda + C[i]) * 2u; o1[i] = (unsigned)((HALF + R[i]) * lda + C[i]) * 2u; }
    }
};

struct DenseSchedF8 {
    static constexpr bool GATHER = false;
    const char* A; const char* Bt; int lda, K, G, c, nM, nN; int tprobe;
    __device__ __forceinline__ bool next(int i, Unit& u) const {
        const int L = i * G + c; if (L >= nM * nN) return false;
        int pm, pn; tile_of(L, nM, nN, pm, pn); u.pm = pm; u.pn = pn;
        u.Ap = A + (size_t)pm * 256 * lda; u.Bp = Bt + (size_t)pn * 256 * K; u.aux = 0; u.aux2 = 0; return true;
    }
    __device__ __forceinline__ void aoff(const Unit&, const int (&R)[2], const int (&C)[2], unsigned (&o0)[2], unsigned (&o1)[2]) const {
#pragma unroll
        for (int i = 0; i < 2; ++i) { o0[i] = (unsigned)(R[i] * lda + C[i] * 2); o1[i] = (unsigned)((HALF + R[i]) * lda + C[i] * 2); }
    }
};

struct EpiPlain {
    static constexpr bool PERM = true; static constexpr int NSTORES = 16;
    bf16_t* O; int ldc; float sc;
    __device__ __forceinline__ void operator()(const f32x4 (&acc)[2][2][4][2], const Unit& u, int wr, int wc, int fr, int fq) const {
        const int row0 = u.pm * BM + wr * 64 + fr, col0 = u.pn * BM + wc * 32 + 8 * fq;
#pragma unroll
        for (int ai = 0; ai < 2; ++ai)
#pragma unroll
            for (int m = 0; m < 4; ++m) { bf16_t* rowp = O + (size_t)(row0 + ai * HALF + m * 16) * ldc + col0;
#pragma unroll
                for (int bj = 0; bj < 2; ++bj) { const f32x4 v0 = acc[ai][bj][m][0] * sc, v1 = acc[ai][bj][m][1] * sc;
                    u32x4 w; w.x = cvt_pk_bf16(v0[0], v0[1]); w.y = cvt_pk_bf16(v0[2], v0[3]); w.z = cvt_pk_bf16(v1[0], v1[1]); w.w = cvt_pk_bf16(v1[2], v1[3]);
                    *(u32x4*)(rowp + bj * HALF) = w; } }
    }
};
struct EpiPlainMask {
    static constexpr bool PERM = true; static constexpr int NSTORES = 16;
    bf16_t* O; int ldc;
    __device__ __forceinline__ void operator()(const f32x4 (&acc)[2][2][4][2], const Unit& u, int wr, int wc, int fr, int fq) const {
        const int row0 = wr * 64 + fr, col0 = u.pn * BM + wc * 32 + 8 * fq;
#pragma unroll
        for (int ai = 0; ai < 2; ++ai)
#pragma unroll
            for (int m = 0; m < 4; ++m) { bf16_t* rowp = O + (size_t)(row0 + ai * HALF + m * 16) * ldc + col0;
#pragma unroll
                for (int bj = 0; bj < 2; ++bj) { const f32x4 v0 = acc[ai][bj][m][0], v1 = acc[ai][bj][m][1];
                    u32x4 w; w.x = cvt_pk_bf16(v0[0], v0[1]); w.y = cvt_pk_bf16(v0[2], v0[3]); w.z = cvt_pk_bf16(v1[0], v1[1]); w.w = cvt_pk_bf16(v1[2], v1[3]);
                    *(u32x4*)(rowp + bj * HALF) = w; } }
    }
};
struct EpiNull {
    static constexpr bool PERM = true; static constexpr int NSTORES = 8;
    __device__ __forceinline__ void operator()(const f32x4 (&acc)[2][2][4][2], const Unit&, int, int, int, int) const {
#pragma unroll
        for (int ai = 0; ai < 2; ++ai)
#pragma unroll
            for (int bj = 0; bj < 2; ++bj)
#pragma unroll
                for (int m = 0; m < 4; ++m) asm volatile("" :: "v"(acc[ai][bj][m][0]), "v"(acc[ai][bj][m][1]));
    }
};
struct EpiInProj {
    static constexpr bool PERM = true; static constexpr int NSTORES = 16;
    bf16_t* O; const LAS float* ropec; const LAS float* ropes;
    __device__ __forceinline__ void operator()(const f32x4 (&acc)[2][2][4][2], const Unit& u, int wr, int wc, int fr, int fq) const {
        const int row0 = u.pm * BM + wr * 64 + fr, col0 = u.pn * BM + wc * 32 + 8 * fq;
        const bool rope = (u.pm < MLAT / 256) && (u.pn < 2 || (u.pn >= 4 && u.pn < 6));
        const bool colpos = (wc & 1) != 0;
        const float qs = u.pn < 2 ? 0.18033688011112042f : 1.f;
#pragma unroll
        for (int ai = 0; ai < 2; ++ai)
#pragma unroll
            for (int m = 0; m < 4; ++m) { const int row = row0 + ai * HALF + m * 16; bf16_t* rowp = O + (size_t)row * NIN + col0;
                f32x4 cs = {1.f, 1.f, 1.f, 1.f}, sn = {0.f, 0.f, 0.f, 0.f};
                if (rope) { const int t = row & (SEQ - 1), pos = colpos ? (t & 63) : (t >> 6); cs = *(const LAS f32x4*)(ropec + pos * 16 + 4 * fq); sn = *(const LAS f32x4*)(ropes + pos * 16 + 4 * fq); }
#pragma unroll
                for (int bj = 0; bj < 2; ++bj) { const f32x4 a = acc[ai][bj][m][0] * qs, b = acc[ai][bj][m][1] * qs;
                    const f32x4 v0 = a * cs - b * sn, v1 = b * cs + a * sn;
                    u32x4 w; w.x = cvt_pk_bf16(v0[0], v0[1]); w.y = cvt_pk_bf16(v0[2], v0[3]); w.z = cvt_pk_bf16(v1[0], v1[1]); w.w = cvt_pk_bf16(v1[2], v1[3]);
                    *(u32x4*)(rowp + bj * HALF) = w; } }
    }
};
struct EpiSwiglu {
    static constexpr bool PERM = true; static constexpr int NSTORES = 8;
    bf16_t* O; int ldc; float k1, k2;
    __device__ __forceinline__ void operator()(const f32x4 (&acc)[2][2][4][2], const Unit& u, int wr, int wc, int fr, int fq) const {
        const int row0 = u.pm * BM + wr * 64 + fr, col0 = u.pn * HALF + wc * 32 + 8 * fq;
#pragma unroll
        for (int ai = 0; ai < 2; ++ai)
#pragma unroll
            for (int m = 0; m < 4; ++m) { bf16_t* rowp = O + (size_t)(row0 + ai * HALF + m * 16) * ldc + col0;
                f32x2 v[2][2];
#pragma unroll
                for (int n = 0; n < 2; ++n)
#pragma unroll
                    for (int h2 = 0; h2 < 2; ++h2) { const f32x2 a2 = {acc[ai][0][m][n][2 * h2], acc[ai][0][m][n][2 * h2 + 1]}, b2 = {acc[ai][1][m][n][2 * h2], acc[ai][1][m][n][2 * h2 + 1]};
                        const f32x2 mm = a2 * k1; f32x2 e; e.x = __builtin_amdgcn_exp2f(mm.x); e.y = __builtin_amdgcn_exp2f(mm.y);
                        const f32x2 d = e + 1.0f; f32x2 r; r.x = __builtin_amdgcn_rcpf(d.x); r.y = __builtin_amdgcn_rcpf(d.y);
                        v[n][h2] = (a2 * r) * (b2 * k2); }
                u32x4 w; w.x = cvt_pk_bf16(v[0][0].x, v[0][0].y); w.y = cvt_pk_bf16(v[0][1].x, v[0][1].y); w.z = cvt_pk_bf16(v[1][0].x, v[1][0].y); w.w = cvt_pk_bf16(v[1][1].x, v[1][1].y);
                *(u32x4*)rowp = w; }
    }
};
__device__ __forceinline__ unsigned pk_fp8x4(float a, float b, float c, float d) {
    a = __builtin_amdgcn_fmed3f(a, -448.f, 448.f); b = __builtin_amdgcn_fmed3f(b, -448.f, 448.f); c = __builtin_amdgcn_fmed3f(c, -448.f, 448.f); d = __builtin_amdgcn_fmed3f(d, -448.f, 448.f);
    int p = __builtin_amdgcn_cvt_pk_fp8_f32(a, b, 0, false); p = __builtin_amdgcn_cvt_pk_fp8_f32(c, d, p, true); return (unsigned)p; }
struct EpiSwigluF8 {
    static constexpr bool PERM = true; static constexpr int NSTORES = 8;
    unsigned char* O; int ldc; float k1, k2;
    __device__ __forceinline__ void operator()(const f32x4 (&acc)[2][2][4][2], const Unit& u, int wr, int wc, int fr, int fq) const {
        const int row0 = u.pm * BM + wr * 64 + fr, col0 = u.pn * HALF + wc * 32 + 8 * fq;
#pragma unroll
        for (int ai = 0; ai < 2; ++ai)
#pragma unroll
            for (int m = 0; m < 4; ++m) { unsigned char* rowp = O + (size_t)(row0 + ai * HALF + m * 16) * ldc + col0;
                f32x2 v[2][2];
#pragma unroll
                for (int n = 0; n < 2; ++n)
#pragma unroll
                    for (int h2 = 0; h2 < 2; ++h2) { const f32x2 a2 = {acc[ai][0][m][n][2 * h2], acc[ai][0][m][n][2 * h2 + 1]}, b2 = {acc[ai][1][m][n][2 * h2], acc[ai][1][m][n][2 * h2 + 1]};
                        const f32x2 mm = a2 * k1; f32x2 e; e.x = __builtin_amdgcn_exp2f(mm.x); e.y = __builtin_amdgcn_exp2f(mm.y);
                        const f32x2 d = e + 1.0f; f32x2 r; r.x = __builtin_amdgcn_rcpf(d.x); r.y = __builtin_amdgcn_rcpf(d.y);
                        v[n][h2] = (a2 * r) * (b2 * k2); }
                u32x2 w; w.x = pk_fp8x4(v[0][0].x, v[0][0].y, v[0][1].x, v[0][1].y); w.y = pk_fp8x4(v[1][0].x, v[1][0].y, v[1][1].x, v[1][1].y);
                *(u32x2*)rowp = w; }
    }
};
}

namespace att {
constexpr int LDP = NIN;
constexpr int SHM_V = 64 * 128 * 2, SHM_K = 64 * 128 * 2;
constexpr int OFF_K = 0, OFF_V = 4 * SHM_K, OFF_WS = RING_BYTES + 14336, ATT_LDS = OFF_WS + NWAVES * 64 * 4;
constexpr int OFF_X = 0, OFF_OST = 65536;
static_assert(OFF_V + 4 * SHM_V <= RING_BYTES && ATT_LDS <= LDS_BYTES, "attention LDS");
constexpr float SCALE = 0.125f;
constexpr float THR = 8.f;
#define KSWZ(row, colB) ((row) * 256 + ((colB) ^ (((row) & 7) << 4)))
__device__ __forceinline__ int crow(int r, int hi) { return (r & 3) + 8 * (r >> 2) + 4 * hi; }

constexpr float THRL = 8.f;
template <bool FIRST>
__device__ __forceinline__ void partialSM(f32x16& p0, f32x16& p1, float& mhat, f32x16& negm, float& alpha) {
    float a = fmaxf(fmaxf(p0[0], p0[1]), p1[0]), b = fmaxf(fmaxf(p0[2], p0[3]), p1[1]); a = fmaxf(fmaxf(a, p1[2]), p1[3]);
#pragma unroll
    for (int r = 4; r < 16; r += 4) { a = fmaxf(fmaxf(a, p0[r]), p0[r + 1]); b = fmaxf(fmaxf(b, p0[r + 2]), p0[r + 3]); a = fmaxf(fmaxf(a, p1[r]), p1[r + 1]); b = fmaxf(fmaxf(b, p1[r + 2]), p1[r + 3]); }
    float rm = fmaxf(a, b);
    { auto rr = __builtin_amdgcn_permlane32_swap(__float_as_uint(rm), __float_as_uint(rm), false, false); rm = fmaxf(__uint_as_float(rr[0]), __uint_as_float(rr[1])); }
    alpha = 1.f;
    if (FIRST || __builtin_expect(__any(rm > THRL), 0)) {
        const float dl = FIRST ? rm : fmaxf(rm, 0.f); mhat += dl;
#pragma unroll
        for (int r = 0; r < 16; ++r) { p0[r] -= dl; p1[r] -= dl; }
#pragma unroll
        for (int r = 0; r < 16; ++r) negm[r] = -mhat;
        asm volatile("" : "+v"(negm));
        if (!FIRST) alpha = __builtin_amdgcn_exp2f(-dl);
    }
#pragma unroll
    for (int r = 0; r < 16; ++r) p0[r] = __builtin_amdgcn_exp2f(p0[r]);
}
__device__ __forceinline__ void finishSM(f32x16& p0, f32x16& p1, float alpha, float& l_reg, bf16x8& pa0, bf16x8& pa1, bf16x8& pa2, bf16x8& pa3) {
#pragma unroll
    for (int r = 0; r < 16; ++r) p1[r] = __builtin_amdgcn_exp2f(p1[r]);
    float ps = 0;
#pragma unroll
    for (int r = 0; r < 16; ++r) ps += p0[r];
#pragma unroll
    for (int r = 0; r < 16; ++r) ps += p1[r];
    { auto rr = __builtin_amdgcn_permlane32_swap(__float_as_uint(ps), __float_as_uint(ps), false, false);
      ps = __uint_as_float(rr[0]) + __uint_as_float(rr[1]); }
    l_reg = l_reg * alpha + ps;
#define PK4(P, BASE, OUT) do { u32x4 w = {cvt_pk_bf16(P[BASE + 0], P[BASE + 1]), cvt_pk_bf16(P[BASE + 2], P[BASE + 3]), cvt_pk_bf16(P[BASE + 4], P[BASE + 5]), cvt_pk_bf16(P[BASE + 6], P[BASE + 7])}; OUT = __builtin_bit_cast(bf16x8, w); } while (0)
    PK4(p0, 0, pa0); PK4(p0, 8, pa1); PK4(p1, 0, pa2); PK4(p1, 8, pa3);
#undef PK4
}
__device__ __forceinline__ void qkt(f32x16& p0, f32x16& p1, const char* Ks, const bf16x8 (&qr)[4], const f32x16& negm, int r32, int hi, int cb0) {
#pragma unroll
    for (int d0 = 0; d0 < 4; ++d0) { const int cb = cb0 + (d0 * 16 + hi * 8) * 2;
        const bf16x8 b0 = *reinterpret_cast<const bf16x8*>(Ks + KSWZ(r32, cb));
        const bf16x8 b1 = *reinterpret_cast<const bf16x8*>(Ks + KSWZ(32 + r32, cb));
        if (d0 == 0) { p0 = __builtin_amdgcn_mfma_f32_32x32x16_bf16(b0, qr[0], negm, 0, 0, 0); p1 = __builtin_amdgcn_mfma_f32_32x32x16_bf16(b1, qr[0], negm, 0, 0, 0); }
        else { p0 = __builtin_amdgcn_mfma_f32_32x32x16_bf16(b0, qr[d0], p0, 0, 0, 0); p1 = __builtin_amdgcn_mfma_f32_32x32x16_bf16(b1, qr[d0], p1, 0, 0, 0); } }
}
__device__ __forceinline__ int v_st(int k, int c) { const int kk = (k & ~0xC) | ((k & 4) << 1) | ((k & 8) >> 1); return ((kk >> 3) * 4 + (c >> 5)) * 512 + ((kk & 7) * 32 + (c & 31)) * 2; }
__device__ __forceinline__ int v_rd_base(int lane) { return ((lane & 3) << 3) | (((lane >> 2) & 3) << 6) | (((lane >> 4) & 1) << 5) | (((lane >> 5) & 1) << 11); }
constexpr int v_rd_off(int d0, int ks, int half) { return d0 * 512 + ks * 4096 + half * 256; }
template <int OFF> __device__ __forceinline__ s16x4 tr_read(int vb) {
    s16x4 r; asm volatile("ds_read_b64_tr_b16 %0, %1 offset:%2" : "=&v"(r) : "v"(vb), "i"(OFF) : "memory"); return r;
}
template <int D0> __device__ __forceinline__ void pv_one(f32x16& od, int vb, bf16x8 pa0, bf16x8 pa1, bf16x8 pa2, bf16x8 pa3) {
    const s16x4 l0 = tr_read<v_rd_off(D0, 0, 0)>(vb), h0 = tr_read<v_rd_off(D0, 0, 1)>(vb), l1 = tr_read<v_rd_off(D0, 1, 0)>(vb), h1 = tr_read<v_rd_off(D0, 1, 1)>(vb);
    const s16x4 l2 = tr_read<v_rd_off(D0, 2, 0)>(vb), h2 = tr_read<v_rd_off(D0, 2, 1)>(vb), l3 = tr_read<v_rd_off(D0, 3, 0)>(vb), h3 = tr_read<v_rd_off(D0, 3, 1)>(vb);
    asm volatile("s_waitcnt lgkmcnt(0)" ::: "memory"); SBAR();
#define PKV(L, H) (bf16x8){L[0], L[1], L[2], L[3], H[0], H[1], H[2], H[3]}
    od = __builtin_amdgcn_mfma_f32_32x32x16_bf16(pa0, PKV(l0, h0), od, 0, 0, 0);
    od = __builtin_amdgcn_mfma_f32_32x32x16_bf16(pa1, PKV(l1, h1), od, 0, 0, 0);
    od = __builtin_amdgcn_mfma_f32_32x32x16_bf16(pa2, PKV(l2, h2), od, 0, 0, 0);
    od = __builtin_amdgcn_mfma_f32_32x32x16_bf16(pa3, PKV(l3, h3), od, 0, 0, 0);
#undef PKV
}
struct VFrag { s16x4 l0, h0, l1, h1, l2, h2, l3, h3; };
template <int D0> __device__ __forceinline__ void v_reads(VFrag& f, int vb) {
    f.l0 = tr_read<v_rd_off(D0, 0, 0)>(vb); f.h0 = tr_read<v_rd_off(D0, 0, 1)>(vb); f.l1 = tr_read<v_rd_off(D0, 1, 0)>(vb); f.h1 = tr_read<v_rd_off(D0, 1, 1)>(vb);
    f.l2 = tr_read<v_rd_off(D0, 2, 0)>(vb); f.h2 = tr_read<v_rd_off(D0, 2, 1)>(vb); f.l3 = tr_read<v_rd_off(D0, 3, 0)>(vb); f.h3 = tr_read<v_rd_off(D0, 3, 1)>(vb);
}
__device__ __forceinline__ void v_mfmas(f32x16& od, const VFrag& f, bf16x8 pa0, bf16x8 pa1, bf16x8 pa2, bf16x8 pa3) {
#define PKV(L, H) (bf16x8){L[0], L[1], L[2], L[3], H[0], H[1], H[2], H[3]}
    od = __builtin_amdgcn_mfma_f32_32x32x16_bf16(pa0, PKV(f.l0, f.h0), od, 0, 0, 0);
    od = __builtin_amdgcn_mfma_f32_32x32x16_bf16(pa1, PKV(f.l1, f.h1), od, 0, 0, 0);
    od = __builtin_amdgcn_mfma_f32_32x32x16_bf16(pa2, PKV(f.l2, f.h2), od, 0, 0, 0);
    od = __builtin_amdgcn_mfma_f32_32x32x16_bf16(pa3, PKV(f.l3, f.h3), od, 0, 0, 0);
#undef PKV
}
__device__ __forceinline__ void pv_d0(f32x16* o, int vb, bf16x8 pa0, bf16x8 pa1, bf16x8 pa2, bf16x8 pa3) {
    VFrag fa, fb;
    v_reads<0>(fa, vb);
    v_reads<1>(fb, vb); asm volatile("s_waitcnt lgkmcnt(8)" ::: "memory"); SBAR(); v_mfmas(o[0], fa, pa0, pa1, pa2, pa3);
    v_reads<2>(fa, vb); asm volatile("s_waitcnt lgkmcnt(8)" ::: "memory"); SBAR(); v_mfmas(o[1], fb, pa0, pa1, pa2, pa3);
    v_reads<3>(fb, vb); asm volatile("s_waitcnt lgkmcnt(8)" ::: "memory"); SBAR(); v_mfmas(o[2], fa, pa0, pa1, pa2, pa3);
    asm volatile("s_waitcnt lgkmcnt(0)" ::: "memory"); SBAR(); v_mfmas(o[3], fb, pa0, pa1, pa2, pa3);
}

__device__ __forceinline__ void attn_unit(const bf16_t* __restrict__ Qb, const bf16_t* __restrict__ Ks0, int nt0, const bf16_t* __restrict__ Ks1, int nt1,
                                          bf16_t* Ob, float lam, float oscale, const float* __restrict__ subg, char* lds, const int wid) {
    const int lane = lane_id_v(), tid = wid * 64 + lane;
    const int r32 = lane & 31, hi = lane >> 5, map = wid >> 2, w4 = wid & 3; (void)tid;
    char* V_lds = lds + OFF_V; char* K_lds = lds + OFF_K;
    float* ws = (float*)(lds + OFF_WS) + wid * 64; float* li_l = ws; float* al_l = ws + 32;
    float zero_v; asm volatile("v_mov_b32 %0, 0" : "=v"(zero_v));
    float mhat = 0.f, l_reg = 0; f32x16 o[4] = {}; bf16x8 qr[4]; f32x16 negm;
#pragma unroll
    for (int r = 0; r < 16; ++r) negm[r] = zero_v;
    const bf16_t* Qw = Qb + (long)(w4 * 32 + r32) * LDP + map * 64 + hi * 8;
#pragma unroll
    for (int d0 = 0; d0 < 4; ++d0) qr[d0] = *reinterpret_cast<const bf16x8*>(Qw + d0 * 16);
    const int cb0 = map * 128;
    unsigned koff[2], voff[2];
#pragma unroll
    for (int i = 0; i < 2; ++i) { const int row = 4 * wid + 32 * i + (lane >> 4), ch = (lane & 15) ^ (row & 7); koff[i] = (unsigned)(row * LDP + ch * 8) * 2u;
        const int sub = 2 * wid + 16 * i + (lane >> 5), kk = (sub >> 2) * 8 + ((lane & 31) >> 2), k = (kk & ~0xC) | ((kk & 4) << 1) | ((kk & 8) >> 1), c = (sub & 3) * 32 + (lane & 3) * 8;
        voff[i] = (unsigned)(k * LDP + 512 + c) * 2u; }
    const unsigned ldsw = (unsigned)wid * 1024u;
    const int vb0 = (int)(uintptr_t)V_lds + v_rd_base(lane);
    const int NT = nt0 + nt1;
#define TILEP(j) ((const char*)((j) < nt0 ? Ks0 + (long)(j) * 64 * LDP : Ks1 + (long)((j) - nt0) * 64 * LDP))
#define DMA_K(j, slot) do { const char* _tb = TILEP(j); _Pragma("unroll") for (int _i = 0; _i < 2; ++_i) \
        __builtin_amdgcn_global_load_lds((const unsigned*)(_tb + koff[_i]), (LAS unsigned*)((LAS char*)(uintptr_t)(unsigned)(uintptr_t)K_lds + (slot) + ldsw + _i * 8192), 16, 0, 0); } while (0)
#define DMA_V(j, slot) do { const char* _tb = TILEP(j); _Pragma("unroll") for (int _i = 0; _i < 2; ++_i) \
        __builtin_amdgcn_global_load_lds((const unsigned*)(_tb + voff[_i]), (LAS unsigned*)((LAS char*)(uintptr_t)(unsigned)(uintptr_t)V_lds + (slot) + ldsw + _i * 8192), 16, 0, 0); } while (0)
#define WAIT_BAR(N) asm volatile("s_waitcnt vmcnt(" #N ") lgkmcnt(0)\n\ts_barrier" ::: "memory")
#define RESC(a) do { if (__any((a) < 1.f)) { if (hi == 0) al_l[r32] = (a); asm volatile("s_waitcnt lgkmcnt(0)" ::: "memory"); \
    _Pragma("unroll") for (int d = 0; d < 4; ++d) _Pragma("unroll") for (int r = 0; r < 16; ++r) o[d][r] *= al_l[crow(r, hi)]; } } while (0)
    f32x16 pA0, pA1, pB0, pB1; float alA, alB; bf16x8 pa0, pa1, pa2, pa3;
    DMA_K(0, 0); DMA_K(1, SHM_K); DMA_V(0, 0);
    WAIT_BAR(0);
#define HALF_STEP(C0, C1, P0, P1, alC, alP, t) do { \
        SBAR(); qkt(C0, C1, K_lds + (((t) >> 1) & 1) * 2 * SHM_K + ((t) & 1) * SHM_K, qr, negm, r32, hi, cb0); \
        finishSM(P0, P1, alP, l_reg, pa0, pa1, pa2, pa3); SBAR(); \
        pv_d0(o, vb0 + (((t) - 1) & 3) * SHM_V, pa0, pa1, pa2, pa3); partialSM<false>(C0, C1, mhat, negm, alC); \
        RESC(alC); } while (0)
    if (2 < NT) { DMA_K(2, 2 * SHM_K); DMA_K(3, 3 * SHM_K); } DMA_V(1, SHM_V); if (2 < NT) DMA_V(2, 2 * SHM_V);
    qkt(pA0, pA1, K_lds, qr, negm, r32, hi, cb0); partialSM<true>(pA0, pA1, mhat, negm, alA);
    HALF_STEP(pB0, pB1, pA0, pA1, alB, alA, 1);
    WAIT_BAR(0);
    for (int t = 2; t < NT; t += 2) {
        if (t + 2 < NT) { DMA_K(t + 2, (((t + 2) >> 1) & 1) * 2 * SHM_K); DMA_K(t + 3, (((t + 2) >> 1) & 1) * 2 * SHM_K + SHM_K); }
        DMA_V(t + 1, ((t + 1) & 3) * SHM_V); if (t + 2 < NT) DMA_V(t + 2, ((t + 2) & 3) * SHM_V);
        HALF_STEP(pA0, pA1, pB0, pB1, alA, alB, t);
        HALF_STEP(pB0, pB1, pA0, pA1, alB, alA, t + 1);
        WAIT_BAR(0);
    }
    finishSM(pB0, pB1, alB, l_reg, pa0, pa1, pa2, pa3); SBAR();
    pv_d0(o, vb0 + ((NT - 1) & 3) * SHM_V, pa0, pa1, pa2, pa3);
#undef HALF_STEP
    if (hi == 0) li_l[r32] = l_reg; asm volatile("s_waitcnt lgkmcnt(0)" ::: "memory");
    float rli[16];
#pragma unroll
    for (int r = 0; r < 16; ++r) rli[r] = __builtin_amdgcn_rcpf(li_l[crow(r, hi)]) * (map ? lam : 1.f);
    __syncthreads();
    float* X = (float*)(lds + OFF_X) + w4 * (32 * 128);
    if (map == 1) {
#pragma unroll
        for (int r = 0; r < 16; ++r)
#pragma unroll
            for (int d0 = 0; d0 < 4; ++d0) X[crow(r, hi) * 128 + d0 * 32 + r32] = o[d0][r] * rli[r];
    }
    __syncthreads();
    if (map == 0) {
        float ss[16];
#pragma unroll
        for (int r = 0; r < 16; ++r) { float s = 0.f;
#pragma unroll
            for (int d0 = 0; d0 < 4; ++d0) { const float v = o[d0][r] * rli[r] - X[crow(r, hi) * 128 + d0 * 32 + r32]; o[d0][r] = v; s += v * v; }
            ss[r] = s; }
#pragma unroll
        for (int r = 0; r < 16; ++r) { float s = ss[r]; s += __shfl_xor(s, 1); s += __shfl_xor(s, 2); s += __shfl_xor(s, 4); s += __shfl_xor(s, 8); s += __shfl_xor(s, 16);
            ss[r] = __builtin_amdgcn_rsqf(s * (1.f / 128.f) + EPS) * oscale; }
        bf16_t* Ost = (bf16_t*)(lds + OFF_OST) + w4 * 4096;
#pragma unroll
        for (int d0 = 0; d0 < 4; ++d0) { const float g = subg[d0 * 32 + r32];
#pragma unroll
            for (int r = 0; r < 16; ++r) Ost[crow(r, hi) * 128 + d0 * 32 + r32] = (bf16_t)(cvt_pk_bf16(o[d0][r] * ss[r] * g, 0.f) & 0xffffu); }
        asm volatile("s_waitcnt lgkmcnt(0)" ::: "memory");
#pragma unroll
        for (int it = 0; it < 8; ++it) { const int row = it * 4 + (lane >> 4), ch = lane & 15;
            const u32x4 w = *(const u32x4*)(Ost + row * 128 + ch * 8);
            *(u32x4*)(Ob + (long)(w4 * 32 + row) * LDP + ch * 8) = w; }
    }
    __syncthreads();
#undef TILEP
#undef DMA_K
#undef DMA_V
#undef WAIT_BAR
#undef RESC
}

__device__ __forceinline__ void sg_unit(bf16_t* P0, const bf16_t* __restrict__ sgw, const float* __restrict__ lng, const float* __restrict__ lnb, const float* __restrict__ sgb, char* lds, const int wid, const int g_lo, const int g_hi) {
    const int lane = lane_id_v(), tid = wid * 64 + lane;
    const int r32 = lane & 31, hi = lane >> 5;
    const int sr = tid >> 4, sc = (tid & 15) * 8;
    float* Mt = (float*)(lds + 65536);
    u32x4 gb[4][4];
#pragma unroll
    for (int q4 = 0; q4 < 4; ++q4)
#pragma unroll
        for (int g = 0; g < 4; ++g) gb[q4][g] = *(const u32x4*)(P0 + (long)(q4 * 32 + sr) * LDP + COL_G + g * 128 + sc);
    float mean[4], rstd[4];
#pragma unroll
    for (int q4 = 0; q4 < 4; ++q4) { float sm = 0.f;
#pragma unroll
        for (int g = 0; g < 4; ++g) { const u32x4 w = gb[q4][g]; sm += (bflo(w.x) + bfhi(w.x)) + (bflo(w.y) + bfhi(w.y)) + (bflo(w.z) + bfhi(w.z)) + (bflo(w.w) + bfhi(w.w)); }
        sm += __shfl_xor(sm, 1); sm += __shfl_xor(sm, 2); sm += __shfl_xor(sm, 4); sm += __shfl_xor(sm, 8);
        const float mu = sm * (1.f / 512.f); float q = 0.f;
#pragma unroll
        for (int g = 0; g < 4; ++g) { const u32x4 w = gb[q4][g]; const float x[8] = {bflo(w.x), bfhi(w.x), bflo(w.y), bfhi(w.y), bflo(w.z), bfhi(w.z), bflo(w.w), bfhi(w.w)};
#pragma unroll
            for (int k = 0; k < 8; ++k) { const float d = x[k] - mu; q += d * d; } }
        q += __shfl_xor(q, 1); q += __shfl_xor(q, 2); q += __shfl_xor(q, 4); q += __shfl_xor(q, 8);
        mean[q4] = mu; rstd[q4] = __builtin_amdgcn_rsqf(q * (1.f / 512.f) + EPS); }
    const int vb0 = (int)(uintptr_t)lds + v_rd_base(lane);
    const int mt = wid & 3, eh = wid >> 2;
#pragma unroll
    for (int g = 0; g < 4; ++g) {
        if (g < g_lo || g >= g_hi) continue;
        u32x4 ub[4];
#pragma unroll
        for (int q4 = 0; q4 < 4; ++q4) ub[q4] = *(const u32x4*)(P0 + (long)(q4 * 32 + sr) * LDP + COL_U + g * 128 + sc);
        const bf16_t* Wp = sgw + (size_t)g * 128 * 128 + (size_t)(mt * 32 + r32) * 128 + hi * 4;
        bf16x8 af[2][4];
#pragma unroll
        for (int tq = 0; tq < 2; ++tq)
#pragma unroll
            for (int ks = 0; ks < 4; ++ks) { const u32x2 lo_ = *(const u32x2*)(Wp + tq * 64 + ks * 16), hi_ = *(const u32x2*)(Wp + tq * 64 + ks * 16 + 8); u32x4 w_ = {lo_.x, lo_.y, hi_.x, hi_.y}; af[tq][ks] = __builtin_bit_cast(bf16x8, w_); }
        const f32x4 ga = *(const f32x4*)(lng + g * 128 + sc), gbv = *(const f32x4*)(lng + g * 128 + sc + 4), ba = *(const f32x4*)(lnb + g * 128 + sc), bb = *(const f32x4*)(lnb + g * 128 + sc + 4);
#pragma unroll
        for (int q4 = 0; q4 < 4; ++q4) { const int tkn = q4 * 32 + sr; const u32x4 w = gb[q4][g]; const float mu = mean[q4], rs = rstd[q4];
            const float x[8] = {bflo(w.x), bfhi(w.x), bflo(w.y), bfhi(w.y), bflo(w.z), bfhi(w.z), bflo(w.w), bfhi(w.w)};
            u32x4 ov;
            ov.x = cvt_pk_bf16((x[0] - mu) * rs * ga[0] + ba[0], (x[1] - mu) * rs * ga[1] + ba[1]);
            ov.y = cvt_pk_bf16((x[2] - mu) * rs * ga[2] + ba[2], (x[3] - mu) * rs * ga[3] + ba[3]);
            ov.z = cvt_pk_bf16((x[4] - mu) * rs * gbv[0] + bb[0], (x[5] - mu) * rs * gbv[1] + bb[1]);
            ov.w = cvt_pk_bf16((x[6] - mu) * rs * gbv[2] + bb[2], (x[7] - mu) * rs * gbv[3] + bb[3]);
            *(u32x4*)(lds + (tkn >> 6) * SHM_V + v_st(tkn & 63, sc)) = ov; }
        __syncthreads();
        f32x16 oa = {}, ob = {};
#pragma unroll
        for (int tq = 0; tq < 2; ++tq) {
            if (eh == 0) { pv_one<0>(oa, vb0 + tq * SHM_V, af[tq][0], af[tq][1], af[tq][2], af[tq][3]); pv_one<1>(ob, vb0 + tq * SHM_V, af[tq][0], af[tq][1], af[tq][2], af[tq][3]); }
            else         { pv_one<2>(oa, vb0 + tq * SHM_V, af[tq][0], af[tq][1], af[tq][2], af[tq][3]); pv_one<3>(ob, vb0 + tq * SHM_V, af[tq][0], af[tq][1], af[tq][2], af[tq][3]); }
        }
#pragma unroll
        for (int r = 0; r < 16; ++r) { const int pr = mt * 32 + crow(r, hi); const float bs = sgb[g * 128 + pr];
            Mt[pr * 128 + eh * 64 + r32] = oa[r] + bs; Mt[pr * 128 + eh * 64 + 32 + r32] = ob[r] + bs; }
        __syncthreads();
#pragma unroll
        for (int q4 = 0; q4 < 4; ++q4) { const int tkn = q4 * 32 + sr; const f32x4 m0 = *(const f32x4*)(Mt + tkn * 128 + sc), m1 = *(const f32x4*)(Mt + tkn * 128 + sc + 4); const u32x4 w = ub[q4];
            u32x4 ov;
            ov.x = cvt_pk_bf16(bflo(w.x) * m0[0], bfhi(w.x) * m0[1]); ov.y = cvt_pk_bf16(bflo(w.y) * m0[2], bfhi(w.y) * m0[3]);
            ov.z = cvt_pk_bf16(bflo(w.z) * m1[0], bfhi(w.z) * m1[1]); ov.w = cvt_pk_bf16(bflo(w.w) * m1[2], bfhi(w.w) * m1[3]);
            *(u32x4*)(P0 + (long)tkn * LDP + COL_U + g * 128 + sc) = ov; }
    }
    __syncthreads();
}
}

#define XB_TMO      128
#define XB_XCNT(j)  (256  + 64 * (j))
#define XB_XSUB(j)  (1280 + 64 * (j))
#define XB_XGEN(j)  (2304 + 64 * (j))
#define XB_TOP      3328
#define XB_TOPGEN   3392
#define XCD_BAR_WORDS 3456
#define XB_SPIN_CAP (1u << 18)
__device__ __forceinline__ unsigned xb_ld(unsigned* p)              { return __hip_atomic_load(p, __ATOMIC_RELAXED, __HIP_MEMORY_SCOPE_AGENT); }
__device__ __forceinline__ unsigned xb_add(unsigned* p, unsigned v) { return __hip_atomic_fetch_add(p, v, __ATOMIC_RELAXED, __HIP_MEMORY_SCOPE_AGENT); }
__device__ __forceinline__ unsigned xb_xcc_id() { return (unsigned)__builtin_amdgcn_s_getreg((3 << 11) | 20) & 0xFu; }
#define XB_SPIN(cond, bar) do { unsigned _sp = 0; while (cond) { __builtin_amdgcn_s_sleep(1); \
    if ((++_sp & 255u) == 0u) { if (xb_ld(&(bar)[XB_TMO])) break; if (_sp > XB_SPIN_CAP) { atomicAdd(&(bar)[XB_TMO], 1u); break; } } } } while (0)
struct XcdBarrier { unsigned* bar; unsigned x; volatile LAS unsigned* st; };
__device__ __forceinline__ XcdBarrier xcd_barrier_post(unsigned* bar, volatile LAS unsigned* st, int tid) {
    XcdBarrier b; b.bar = bar; b.x = xb_xcc_id(); b.st = st;
    if (tid == 0) (void)xb_add(&bar[XB_XCNT(b.x)], 1u);
    return b;
}
__device__ __forceinline__ void xcd_barrier_complete(unsigned* bar, unsigned x, unsigned& nloc, unsigned& nx) {
    const unsigned G = gridDim.x * gridDim.y * gridDim.z;
    unsigned sum, cnt, mine, sp = 0u;
    for (;;) {
        sum = 0u; cnt = 0u; mine = 0u;
#pragma unroll
        for (unsigned j = 0; j < 16; ++j) { const unsigned c = xb_ld(&bar[XB_XCNT(j)]); sum += c; cnt += (c > 0u) ? 1u : 0u; mine = (j == x) ? c : mine; }
        if (sum == G) break;
        __builtin_amdgcn_s_sleep(1);
        if ((++sp & 255u) == 0u) { if (xb_ld(&bar[XB_TMO])) break; if (sp > XB_SPIN_CAP) { atomicAdd(&bar[XB_TMO], 1u); break; } }
    }
    nloc = mine > 0u ? mine : 1u; nx = cnt > 0u ? cnt : 1u;
}
__device__ __forceinline__ void xcd_barrier(const XcdBarrier& b, int wave) {
    asm volatile("s_waitcnt vmcnt(0)" ::: "memory");
    __syncthreads();
    if (wave == 0 && lane_id_v() == 0) {
        unsigned* bar = b.bar;
        __builtin_amdgcn_s_waitcnt(0);
        unsigned nloc = b.st[0], nx = b.st[1];
        if (nloc == 0u) { xcd_barrier_complete(bar, b.x, nloc, nx); b.st[0] = nloc; b.st[1] = nx; }
        const unsigned old = xb_add(&bar[XB_XSUB(b.x)], 1u);
        const unsigned gen = old / nloc;
        if (old + 1u == (gen + 1u) * nloc) {
            __builtin_amdgcn_fence(__ATOMIC_RELEASE, "agent");
            asm volatile("s_waitcnt vmcnt(0)" ::: "memory");
            const unsigned og = xb_add(&bar[XB_TOP], 1u);
            const unsigned tg = og / nx;
            if (og + 1u == (tg + 1u) * nx) xb_add(&bar[XB_TOPGEN], 1u);
            else XB_SPIN(xb_ld(&bar[XB_TOPGEN]) == tg, bar);
            __builtin_amdgcn_fence(__ATOMIC_ACQUIRE, "agent");
            xb_add(&bar[XB_XGEN(b.x)], 1u);
            asm volatile("s_waitcnt vmcnt(0)" ::: "memory");
        } else {
            XB_SPIN(xb_ld(&bar[XB_XGEN(b.x)]) == gen, bar);
            __builtin_amdgcn_fence(__ATOMIC_ACQUIRE, "agent");
            asm volatile("s_waitcnt vmcnt(0)" ::: "memory");
        }
    }
    __syncthreads();
}

struct Args {
    const float* in[28]; float* out; unsigned char* ws; int ph_lo, ph_hi;
};
typedef const __attribute__((address_space(4))) Args* KArgP;
#define KARG() ({ KArgP _p = (KArgP)__builtin_amdgcn_kernarg_segment_ptr(); asm volatile("" : "+s"(_p)); _p; })
struct Frame {
    LAS unsigned char* lds; gu32* ctl; int tid, lane, wave, vcu, G;
};

constexpr int I_IN = 16 * 80, I_OUT = 16 * 32, I_F13 = 16 * 176, I_F2 = 44 * 32, I_M13 = 16 * 224, I_M2 = 56 * 32;
constexpr int CV_L0 = 2 * I_IN + 2 * I_OUT + I_F13 + I_F2, CV_N = CV_L0 + 8 * I_M13 + 8 * I_M2;
__device__ __forceinline__ void convert_range(LAS unsigned char* lds, int wave, int lane, KArgP ap, int first, int stride, int end) {
    const __attribute__((address_space(4))) Args& a = *ap; unsigned char* ws = a.ws;
    LAS float* scr = (LAS float*)(lds + wave * 16384);
    struct Item { const float* src; unsigned char* dst; int ldw, K, k0; bool rope, f8; };
#define DECODE(it_, I) do { int r = (it_); \
        if (r < 2 * I_IN) { const int l = r / I_IN; r %= I_IN; const int kb = r / 80, g = r % 80, seg = g >> 4, gi = g & 15; \
            const int sseg = seg == 0 ? 0 : seg == 1 ? 3 : seg == 2 ? 1 : seg == 3 ? 2 : 4;        \
            I.src = a.in[10] + (size_t)l * D * NIN + (size_t)kb * 64 * NIN + sseg * 512 + gi * 32; I.ldw = NIN; I.K = D; I.k0 = kb * 64; I.rope = (seg == 0 || seg == 2); I.f8 = false; \
            I.dst = ws + WS_WIN + ((size_t)l * NIN * D + (size_t)g * 32 * D + kb * 64) * 2; break; } \
        r -= 2 * I_IN; \
        if (r < 2 * I_OUT) { const int l = r / I_OUT; r %= I_OUT; const int kb = r / 32, g = r % 32; \
            I.src = a.in[11] + (size_t)l * D * D + (size_t)kb * 64 * D + g * 32; I.ldw = D; I.K = D; I.k0 = kb * 64; I.rope = false; I.f8 = false; \
            I.dst = ws + WS_WOUT + ((size_t)l * D * D + (size_t)g * 32 * D + kb * 64) * 2; break; } \
        r -= 2 * I_OUT; \
        if (r < I_F13) { const int kb = r / 176, g = r % 176, tile = g >> 3, gi = g & 7;            \
            I.src = (gi < 4 ? a.in[21] : a.in[22]) + (size_t)kb * 64 * DFF + tile * 128 + (gi & 3) * 32; I.ldw = DFF; I.K = D; I.k0 = kb * 64; I.rope = false; I.f8 = FFN_UP_FP8 != 0; \
            I.dst = ws + WS_W13 + ((size_t)g * 32 * D + kb * 64) * (FFN_UP_FP8 ? 1 : 2); break; } \
        r -= I_F13; \
        if (r < I_F2) { const int kb = r / 32, g = r % 32; \
            I.src = a.in[23] + (size_t)kb * 64 * D + g * 32; I.ldw = D; I.K = DFF; I.k0 = kb * 64; I.rope = false; I.f8 = FFN_DOWN_FP8 != 0; \
            I.dst = ws + WS_W2 + ((size_t)g * 32 * DFF + kb * 64) * (FFN_DOWN_FP8 ? 1 : 2); break; } \
        r -= I_F2; \
        if (r < 8 * I_M13) { const int e = r / I_M13; r %= I_M13; const int kb = r / 224, g = r % 224, tile = g >> 3, gi = g & 7; \
            I.src = (gi < 4 ? a.in[25] : a.in[26]) + (size_t)e * D * DEXP + (size_t)kb * 64 * DEXP + tile * 128 + (gi & 3) * 32; I.ldw = DEXP; I.K = D; I.k0 = kb * 64; I.rope = false; I.f8 = true; \
            I.dst = ws + WS_MW13 + (size_t)e * 7168 * D + (size_t)g * 32 * D + kb * 64; break; } \
        r -= 8 * I_M13; \
        { const int e = r / I_M2; r %= I_M2; const int kb = r / 32, g = r % 32; \
            I.src = a.in[27] + (size_t)e * DEXP * D + (size_t)kb * 64 * D + g * 32; I.ldw = D; I.K = DEXP; I.k0 = kb * 64; I.rope = false; I.f8 = true; \
            I.dst = ws + WS_MW2 + (size_t)e * D * DEXP + (size_t)g * 32 * DEXP + kb * 64; } \
    } while (0)
#define LOADITEM(I, v) do { const int j_ = lane & 31, sj_ = I.rope ? ((j_ & 3) + 4 * (j_ >> 3) + 16 * ((j_ >> 2) & 1)) : j_; const float* sp_ = I.src + (size_t)(lane >> 5) * I.ldw + sj_; \
        _Pragma("unroll") for (int i = 0; i < 32; ++i) v[i] = sp_[(size_t)(2 * i) * I.ldw]; } while (0)
    if (first < end) {
        Item cur, nxt; float v[32], vn[32];
        DECODE(first, cur); LOADITEM(cur, v);
        for (int it = first; it < end; it += stride) {
            const int itn = it + stride; const bool has_next = itn < end;
            if (has_next) { DECODE(itn, nxt); LOADITEM(nxt, vn); }
            const int j = lane & 31; const float sc = cur.f8 ? 128.f : 1.f;
#pragma unroll
            for (int i = 0; i < 32; ++i) { const int kk = 2 * i + (lane >> 5); scr[kk * 33 + j] = v[i] * sc; }
            LDS_WAIT(); asm volatile("" ::: "memory");
            if (cur.f8) {
                const int n = lane >> 1, hf = lane & 1; const LAS float* s = scr + (32 * hf) * 33 + n;
                u32x4 o0, o1;
                o0.x = pg8::pk_fp8x4(s[0 * 33], s[1 * 33], s[2 * 33], s[3 * 33]);     o0.y = pg8::pk_fp8x4(s[4 * 33], s[5 * 33], s[6 * 33], s[7 * 33]);
                o0.z = pg8::pk_fp8x4(s[8 * 33], s[9 * 33], s[10 * 33], s[11 * 33]);   o0.w = pg8::pk_fp8x4(s[12 * 33], s[13 * 33], s[14 * 33], s[15 * 33]);
                o1.x = pg8::pk_fp8x4(s[16 * 33], s[17 * 33], s[18 * 33], s[19 * 33]); o1.y = pg8::pk_fp8x4(s[20 * 33], s[21 * 33], s[22 * 33], s[23 * 33]);
                o1.z = pg8::pk_fp8x4(s[24 * 33], s[25 * 33], s[26 * 33], s[27 * 33]); o1.w = pg8::pk_fp8x4(s[28 * 33], s[29 * 33], s[30 * 33], s[31 * 33]);
                unsigned char* d = cur.dst + (size_t)n * cur.K + 32 * hf;
                *(u32x4*)d = o0; *(u32x4*)(d + 16) = o1;
            } else {
                const int c = lane & 7;
#pragma unroll
                for (int jj = 0; jj < 4; ++jj) { const int n = (lane >> 3) + 8 * jj; const LAS float* s = scr + (8 * c) * 33 + n;
                    u32x4 o; o.x = cvt_pk_bf16(s[0 * 33], s[1 * 33]); o.y = cvt_pk_bf16(s[2 * 33], s[3 * 33]); o.z = cvt_pk_bf16(s[4 * 33], s[5 * 33]); o.w = cvt_pk_bf16(s[6 * 33], s[7 * 33]);
                    *(u32x4*)(cur.dst + ((size_t)n * cur.K + 8 * c) * 2) = o; }
            }
            LDS_WAIT(); asm volatile("" ::: "memory");
            if (has_next) { cur = nxt;
#pragma unroll
                for (int i = 0; i < 32; ++i) v[i] = vn[i]; }
        }
    }
#undef DECODE
#undef LOADITEM
}

#if PROBE_T && PROBE_T_PHASE == 40
#define P0T(n) do { if (F.wave == 0 && blockIdx.x == 0 && lane_id_v() == 0) { volatile LAS unsigned* tacc_ = (volatile LAS unsigned*)(F.lds + MISC_OFF) + 16; const unsigned _now = (unsigned)__builtin_amdgcn_s_memrealtime(); tacc_[n] += _now - tacc_[0]; tacc_[0] = _now; } } while (0)
#else
#define P0T(n) do {} while (0)
#endif
__device__ __forceinline__ void p0_prologue(Frame& F, KArgP ap) {
    const __attribute__((address_space(4))) Args& a = *ap;
    unsigned char* ws = a.ws;
    if (blockIdx.x < 192) {
        const int l = blockIdx.x / 96, n0 = (blockIdx.x % 96) * 64;
        LAS float* s = (LAS float*)F.lds;
        LAS float* red = (LAS float*)(F.lds + 69632);
        const float* c = a.in[1]; const float* cc = a.in[3];
        { float cv[34];
#pragma unroll
          for (int j = 0; j < 34; ++j) { const int i = F.tid + 512 * j; cv[j] = i < 16 * 1024 ? c[i] : cc[i - 16 * 1024]; }
#pragma unroll
          for (int j = 0; j < 34; ++j) s[F.tid + 512 * j] = silu_f(cv[j]); }
        __syncthreads();
        const float* W = a.in[4] + (size_t)l * D * 6144 + n0 + F.lane;
        float acc[17];
#pragma unroll
        for (int r = 0; r < 17; ++r) acc[r] = 0.f;
        const int kb = F.wave * 128;
        LAS float* wl = (LAS float*)(F.lds + 69632 + F.wave * 4096);
        float wa[16], wb[16];
#pragma unroll
        for (int k = 0; k < 16; ++k) wa[k] = W[(size_t)(kb + k) * 6144];
#pragma unroll 1
        for (int q = 0; q < 8; q += 2) {
#pragma unroll
            for (int k = 0; k < 16; ++k) wb[k] = W[(size_t)(kb + 16 * (q + 1) + k) * 6144];
#pragma unroll
            for (int hq = 0; hq < 2; ++hq) {
#pragma unroll
                for (int k = 0; k < 16; ++k) wl[k * 64 + F.lane] = hq ? wb[k] : wa[k];
                LDS_WAIT(); asm volatile("" ::: "memory");
                const int kq = kb + 16 * (q + hq);
#pragma unroll 1
                for (int k = 0; k < 16; k += 4) {
                    const float w0 = wl[k * 64 + F.lane], w1 = wl[(k + 1) * 64 + F.lane], w2 = wl[(k + 2) * 64 + F.lane], w3 = wl[(k + 3) * 64 + F.lane];
#pragma unroll
                    for (int r = 0; r < 17; ++r) { const f32x4 sv = *(const LAS f32x4*)(s + r * 1024 + kq + k); acc[r] += sv[0] * w0 + sv[1] * w1 + sv[2] * w2 + sv[3] * w3; }
                }
                LDS_WAIT(); asm volatile("" ::: "memory");
                if (hq == 0 && q + 2 < 8) {
#pragma unroll
                    for (int k = 0; k < 16; ++k) wa[k] = W[(size_t)(kb + 16 * (q + 2) + k) * 6144];
                }
            }
        }
        __syncthreads();
#pragma unroll
        for (int r = 0; r < 17; ++r) red[(F.wave * 17 + r) * 64 + F.lane] = acc[r];
        __syncthreads();
        float* ms = (float*)(ws + WS_MS) + (size_t)l * 17 * 6144;
        const float* bias = a.in[5] + (size_t)l * 6144;
        for (int i = F.tid; i < 17 * 64; i += 512) { const int r = i >> 6, col = i & 63; float v = bias[n0 + col];
#pragma unroll
            for (int w = 0; w < 8; ++w) v += red[(w * 17 + r) * 64 + col];
            ms[(size_t)r * 6144 + n0 + col] = v; }
        __syncthreads();
    }
    P0T(20);
    if (blockIdx.x == 255) {
        float* rc = (float*)(ws + WS_ROPE); float* rs = rc + 1024;
        for (int i = F.tid; i < 1024; i += 512) { const int pos = i >> 4, j = i & 15; const float inv = powf(10000.0f, -(float)(2 * j) / 32.0f); const float ang = (float)pos * inv; rc[i] = cosf(ang); rs[i] = sinf(ang); }
    }
    { const float* src = a.in[19]; bf16_t* dst = (bf16_t*)(ws + WS_SGW); const int n4 = 2 * 4 * 128 * 128 / 4;
      for (int i = blockIdx.x * 512 + F.tid; i < n4; i += F.G * 512) { const f32x4 v = *(const f32x4*)(src + (size_t)i * 4); u32x2 o; o.x = cvt_pk_bf16(v[0], v[1]); o.y = cvt_pk_bf16(v[2], v[3]); *(u32x2*)(dst + (size_t)i * 4) = o; } }
    P0T(21);
    convert_range(F.lds, F.wave, F.lane, ap, F.vcu * NWAVES + F.wave, F.G * NWAVES, CV_L0);
}

struct Row { f32x4 v[4]; };
__device__ __forceinline__ Row ld_row_f32(const float* p, int lane) { Row r; const f32x4* q = (const f32x4*)p + lane;
#pragma unroll
    for (int j = 0; j < 4; ++j) r.v[j] = q[64 * j]; return r; }
__device__ __forceinline__ void st_row_f32(float* p, int lane, const Row& r) { f32x4* q = (f32x4*)p + lane;
#pragma unroll
    for (int j = 0; j < 4; ++j) q[64 * j] = r.v[j]; }
__device__ __forceinline__ Row ld_row_bf16(const bf16_t* p, int lane) { Row r; const u32x2* q = (const u32x2*)p + lane;
#pragma unroll
    for (int j = 0; j < 4; ++j) { const u32x2 w = q[64 * j]; r.v[j] = (f32x4){bflo(w.x), bfhi(w.x), bflo(w.y), bfhi(w.y)}; } return r; }
__device__ __forceinline__ void st_row_bf16(bf16_t* p, int lane, const Row& r) { u32x2* q = (u32x2*)p + lane;
#pragma unroll
    for (int j = 0; j < 4; ++j) { u32x2 w; w.x = cvt_pk_bf16(r.v[j][0], r.v[j][1]); w.y = cvt_pk_bf16(r.v[j][2], r.v[j][3]); q[64 * j] = w; } }
__device__ __forceinline__ float row_rms_scale(const Row& r) { float s = 0.f;
#pragma unroll
    for (int j = 0; j < 4; ++j) s += (r.v[j][0] * r.v[j][0] + r.v[j][1] * r.v[j][1]) + (r.v[j][2] * r.v[j][2] + r.v[j][3] * r.v[j][3]);
    return __builtin_amdgcn_rsqf(wave_sum(s) * (1.f / D) + EPS); }
__device__ __forceinline__ Row row_modulate(const Row& x, const float* g, const float* shift, const float* scale, int lane) {
    const float rs = row_rms_scale(x); Row h; const f32x4* gq = (const f32x4*)g + lane; const f32x4* sh = (const f32x4*)shift + lane; const f32x4* sc = (const f32x4*)scale + lane;
#pragma unroll
    for (int j = 0; j < 4; ++j) h.v[j] = x.v[j] * rs * gq[64 * j] * (1.f + sc[64 * j]) + sh[64 * j];
    return h; }
__device__ __forceinline__ void row_residual(Row& x, const Row& y, const float* g, const float* gate, int lane) {
    const float rs = row_rms_scale(y); const f32x4* gq = (const f32x4*)g + lane; const f32x4* gt = (const f32x4*)gate + lane;
#pragma unroll
    for (int j = 0; j < 4; ++j) x.v[j] = x.v[j] + gt[64 * j] * (y.v[j] * rs * gq[64 * j]);
}

struct ResP { f32x4 a[4]; };
struct ModP { f32x4 b[4], sh[4]; };
__device__ __forceinline__ ResP ld_resp(const float* g, const float* gate, int lane) { ResP r; const f32x4* gq = (const f32x4*)g + lane; const f32x4* gt = (const f32x4*)gate + lane;
#pragma unroll
    for (int j = 0; j < 4; ++j) r.a[j] = gq[64 * j] * gt[64 * j]; return r; }
__device__ __forceinline__ ModP ld_modp(const float* g, const float* shift, const float* scale, int lane) { ModP r; const f32x4* gq = (const f32x4*)g + lane; const f32x4* sh = (const f32x4*)shift + lane; const f32x4* sc = (const f32x4*)scale + lane;
#pragma unroll
    for (int j = 0; j < 4; ++j) { r.b[j] = gq[64 * j] * (1.f + sc[64 * j]); r.sh[j] = sh[64 * j]; } return r; }
__device__ __forceinline__ void row_residual2(Row& x, const Row& y, const ResP& P) { const float rs = row_rms_scale(y);
#pragma unroll
    for (int j = 0; j < 4; ++j) x.v[j] = x.v[j] + P.a[j] * (y.v[j] * rs); }
__device__ __forceinline__ Row row_modulate2(const Row& x, const ModP& P) { const float rs = row_rms_scale(x); Row h;
#pragma unroll
    for (int j = 0; j < 4; ++j) h.v[j] = x.v[j] * rs * P.b[j] + P.sh[j]; return h; }

struct MoeTab { int cnt[8]; int pbase[9]; };
__device__ __forceinline__ void moe_tab(gu32* ctl, MoeTab& T) {
    int p = 0;
#pragma unroll
    for (int e = 0; e < 8; ++e) { const int c = (int)__builtin_amdgcn_readfirstlane(__hip_atomic_load(ctl + CW_CNT + 64 * e, RLX_AGENT)); T.cnt[e] = c; T.pbase[e] = p; p += (c + 255) >> 8; }
    T.pbase[8] = p;
}
__device__ __forceinline__ int moe_expert_of(const MoeTab& T, int panel) { int e = 0;
#pragma unroll
    for (int i = 1; i < 8; ++i) e += (panel >= T.pbase[i]) ? 1 : 0;
    return e; }

struct MoeUpSched {
    static constexpr bool GATHER = true;
    const char* A; const char* Bt; const int* slot_token; int G, c, p0, nM; MoeTab T; int tprobe;
    __device__ __forceinline__ bool next(int i, pg8::Unit& u) const {
        const int L = i * G + c; if (L >= nM * 28) return false;
        int pm, pn; pg8::tile_of(L, nM, 28, pm, pn);
        const int panel = p0 + pm, e = moe_expert_of(T, panel);
        u.pm = pm; u.pn = pn; u.aux = e; u.aux2 = panel; u.Ap = A; u.Bp = Bt + ((size_t)e * 7168 + (size_t)pn * 256) * D; return true;
    }
    __device__ __forceinline__ void aoff(const pg8::Unit& u, const int (&R)[2], const int (&C)[2], unsigned (&o0)[2], unsigned (&o1)[2]) const {
        int pb = 0, cn = 0;
#pragma unroll
        for (int e = 0; e < 8; ++e) { pb = (u.aux == e) ? T.pbase[e] : pb; cn = (u.aux == e) ? T.cnt[e] : cn; }
        const int rk0 = (u.aux2 - pb) * 256;
#pragma unroll
        for (int i = 0; i < 2; ++i) {
            const int ra = rk0 + R[i], rb = rk0 + pg8::HALF + R[i];
            const int ta = slot_token[u.aux * 32768 + (ra < cn ? ra : 0)], tb = slot_token[u.aux * 32768 + (rb < cn ? rb : 0)];
            o0[i] = (unsigned)(ta * D + C[i] * 2); o1[i] = (unsigned)(tb * D + C[i] * 2); }
    }
    __device__ __forceinline__ void prefetch_idx(const pg8::Unit& u, LAS unsigned char* idx, int wid, int lane) const {
        int pb = 0, cn = 0;
#pragma unroll
        for (int e = 0; e < 8; ++e) { pb = (u.aux == e) ? T.pbase[e] : pb; cn = (u.aux == e) ? T.cnt[e] : cn; }
        const int r = (u.aux2 - pb) * 256 + (wid & 3) * 64 + lane;
        __builtin_amdgcn_global_load_lds((const unsigned*)(slot_token + u.aux * 32768 + (r < cn ? r : 0)), (LAS unsigned*)(idx + (wid & 3) * 256), 4, 0, 0);
    }
    __device__ __forceinline__ void aoff_lds(const int (&R)[2], const int (&C)[2], const LAS unsigned char* idx, unsigned (&o0)[2], unsigned (&o1)[2]) const {
#pragma unroll
        for (int i = 0; i < 2; ++i) { const int ta = ((const LAS int*)idx)[R[i]], tb = ((const LAS int*)idx)[pg8::HALF + R[i]];
            o0[i] = (unsigned)(ta * D + C[i] * 2); o1[i] = (unsigned)(tb * D + C[i] * 2); }
    }
};
struct MoeDownSched {
    static constexpr bool GATHER = false;
    const char* A; const char* Bt; int G, c, p0, nM; MoeTab T; int tprobe;
    __device__ __forceinline__ bool next(int i, pg8::Unit& u) const {
        const int L = i * G + c; if (L >= nM * 4) return false;
        int pm, pn; pg8::tile_of(L, nM, 4, pm, pn);
        const int panel = p0 + pm, e = moe_expert_of(T, panel);
        u.pm = panel; u.pn = pn; u.aux = e; u.aux2 = 0; u.Ap = A + (size_t)pm * 256 * DEXP; u.Bp = Bt + ((size_t)e * D + (size_t)pn * 256) * DEXP; return true;
    }
    __device__ __forceinline__ void aoff(const pg8::Unit&, const int (&R)[2], const int (&C)[2], unsigned (&o0)[2], unsigned (&o1)[2]) const {
#pragma unroll
        for (int i = 0; i < 2; ++i) { o0[i] = (unsigned)(R[i] * DEXP + C[i] * 2); o1[i] = (unsigned)((pg8::HALF + R[i]) * DEXP + C[i] * 2); }
    }
};

constexpr int N_PHASES = 24;


__global__ void __launch_bounds__(NWAVES * 64, 2) mk_fwd(Args args) {
    extern __shared__ __attribute__((aligned(16))) unsigned char lds_raw[];
    Frame F;
    F.lds = (LAS unsigned char*)lds_raw;
    F.tid = threadIdx.x; F.lane = F.tid & 63; F.wave = __builtin_amdgcn_readfirstlane(F.tid >> 6);
    F.G = gridDim.x; { const int bx = blockIdx.x; F.vcu = (F.G % 8 == 0) ? (bx % 8) * (F.G / 8) + bx / 8 : bx; }
    unsigned char* ws = KARG()->ws;
    F.ctl = (gu32*)(ws + WS_CTL);
    volatile LAS unsigned* MISC = (volatile LAS unsigned*)(F.lds + MISC_OFF);
    for (int u = F.tid; u < (LDS_BYTES - LDSCTL_OFF) / 4; u += NWAVES * 64) ((LAS unsigned*)(F.lds + LDSCTL_OFF))[u] = 0u;
    __syncthreads();
    XcdBarrier bar; bar.bar = (unsigned*)(F.ctl + CW_BAR); bar.x = 0; bar.st = nullptr;
    if (!MK_PER_PHASE) bar = xcd_barrier_post((unsigned*)(F.ctl + CW_BAR), MISC + 8, F.tid);
    const int lo = KARG()->ph_lo, hi = KARG()->ph_hi;
#ifndef PROBE_NULL_G2
#define PROBE_NULL_G2 0
#endif
#ifndef DUP_MASK
#define DUP_MASK 0u
#endif
#if ((DUP_MASK) >> 0) & 1
#define REP_0 for (int _rep = 0; _rep < 2; ++_rep)
#else
#define REP_0
#endif
#if ((DUP_MASK) >> 1) & 1
#define REP_1 for (int _rep = 0; _rep < 2; ++_rep)
#else
#define REP_1
#endif
#if ((DUP_MASK) >> 2) & 1
#define REP_2 for (int _rep = 0; _rep < 2; ++_rep)
#else
#define REP_2
#endif
#if ((DUP_MASK) >> 4) & 1
#define REP_4 for (int _rep = 0; _rep < 2; ++_rep)
#else
#define REP_4
#endif
#if ((DUP_MASK) >> 5) & 1
#define REP_5 for (int _rep = 0; _rep < 2; ++_rep)
#else
#define REP_5
#endif
#if ((DUP_MASK) >> 6) & 1
#define REP_6 for (int _rep = 0; _rep < 2; ++_rep)
#else
#define REP_6
#endif
#if ((DUP_MASK) >> 7) & 1
#define REP_7 for (int _rep = 0; _rep < 2; ++_rep)
#else
#define REP_7
#endif
#if ((DUP_MASK) >> 9) & 1
#define REP_9 for (int _rep = 0; _rep < 2; ++_rep)
#else
#define REP_9
#endif
#if ((DUP_MASK) >> 11) & 1
#define REP_11 for (int _rep = 0; _rep < 2; ++_rep)
#else
#define REP_11
#endif
#if ((DUP_MASK) >> 13) & 1
#define REP_13 for (int _rep = 0; _rep < 2; ++_rep)
#else
#define REP_13
#endif
#if ((DUP_MASK) >> 14) & 1
#define REP_14 for (int _rep2 = 0; _rep2 < 2; ++_rep2)
#else
#define REP_14
#endif
#if ((DUP_MASK) >> 15) & 1
#define REP_15 for (int _rep2 = 0; _rep2 < 2; ++_rep2)
#else
#define REP_15
#endif
#ifndef PH_MASK
#define PH_MASK 0xffffffu
#endif
#define IN(k) ((((PH_MASK) >> (k)) & 1u) && lo <= (k) && (k) < hi)
#define SEAM(k) do { if (IN(k) && IN((k) + 1)) xcd_barrier(bar, F.wave); F.lane = lane_id_v(); F.tid = F.wave * 64 + F.lane; } while (0)

    bf16_t* XB = (bf16_t*)(ws + WS_XB);
    bf16_t* HA = (bf16_t*)(ws + WS_HA); bf16_t* P = (bf16_t*)(ws + WS_R1); bf16_t* HFF = (bf16_t*)(ws + WS_R1); bf16_t* OY = (bf16_t*)(ws + WS_OY); bf16_t* YS = (bf16_t*)(ws + WS_YS);
    const float* MS = (const float*)(ws + WS_MS);
    const float* ropec = (const float*)(ws + WS_ROPE); const float* ropes = ropec + 1024;
    int* tok_e = (int*)(ws + WS_ROUTE); float* tok_g = (float*)(ws + WS_ROUTE + 262144); int* tok_rank = (int*)(ws + WS_ROUTE + 524288);
    int* slot_token = (int*)(ws + WS_SLOT);
    const int gw = F.vcu * NWAVES + F.wave, NGW = F.G * NWAVES;
    char* ldsg = (char*)lds_raw;

#define TAIL_FILL(busy, kper, base) do { const int c_ = (int)blockIdx.x; if (c_ >= (busy)) { const int nfw_ = (256 - (busy)) * NWAVES, r_ = (c_ - (busy)) * NWAVES + F.wave; \
        convert_range(F.lds, F.wave, lane_id_v(), KARG(), CV_L0 + (base) + r_, nfw_, CV_L0 + (base) + (kper) * nfw_); } } while (0)
    constexpr int TF_K2 = 4, TF_K4 = 4, TF_K6 = 4, TF_K7 = 14, TF_K9 = 4;
    constexpr int TF_B2 = 0, TF_B4 = TF_B2 + 96 * NWAVES * TF_K2, TF_B6 = TF_B4 + 192 * NWAVES * TF_K4, TF_B7 = TF_B6 + 160 * NWAVES * TF_K6, TF_B9 = TF_B7 + 192 * NWAVES * TF_K7, TF_END = TF_B9 + 192 * NWAVES * TF_K9;
    static_assert(CV_L0 + TF_END <= CV_N, "tail fillers");
#if PROBE_T && PROBE_T_PHASE == 40
#define RGN(n) do { if (F.wave == 0 && blockIdx.x == 0 && lane_id_v() == 0) { volatile LAS unsigned* tacc_ = (volatile LAS unsigned*)(F.lds + MISC_OFF) + 16; const unsigned _now = (unsigned)__builtin_amdgcn_s_memrealtime(); tacc_[n] += _now - tacc_[0]; tacc_[0] = _now; } } while (0)
#else
#define RGN(n) do {} while (0)
#endif
    RGN(0);
    REP_0 if (IN(0)) { p0_prologue(F, KARG()); __syncthreads(); }
    RGN(1);
    SEAM(0);

    RGN(0);
    REP_1 if (IN(1)) {
        KArgP AP = KARG(); const float* x_in = AP->in[0]; const float* ctx_in = AP->in[2];
        const float* g = AP->in[6];
#pragma unroll 1
        for (int seg = 0; seg < 2; ++seg) {
            const int nr = seg ? 2 : 16; const int m0 = seg ? MLAT + gw * 2 : gw * 16; const int r17 = seg ? 16 : (m0 >> 11);
            const float* xbase = seg ? ctx_in + (size_t)(m0 - MLAT) * D : x_in + (size_t)m0 * D;
            const float* msr = MS + (size_t)r17 * 6144;
            const ModP MP = ld_modp(g, msr, msr + 1024, F.lane);
            Row xn = ld_row_f32(xbase, F.lane);
            for (int i = 0; i < nr; ++i) {
                const Row x = xn; if (i + 1 < nr) xn = ld_row_f32(xbase + (size_t)(i + 1) * D, F.lane);
                st_row_bf16(HA + (size_t)(m0 + i) * D, F.lane, row_modulate2(x, MP));
            }
        }
    }
    RGN(2);
    SEAM(1);

    REP_2 if (IN(2)) {
        pg8::DenseSched S{(const char*)HA, (const char*)(ws + WS_WIN), D, D, F.G, (int)blockIdx.x, MALL / 256, 10, 0, 0, 0, 0, 0, 0};
        LAS float* rl = (LAS float*)(F.lds + ROPE_LDS); for (int i = F.tid; i < 2048; i += NWAVES * 64) rl[i] = ropec[i]; __syncthreads();
        pg8::EpiInProj E{P, rl, rl + 1024};
        pg8::gemm_phase<pg8::EpiInProj, pg8::DenseSched, true>(F.lds, F.wave, D, S, E);
        TAIL_FILL(1440 - 5 * 256, TF_K2, TF_B2);
    }
    SEAM(2);

#define ATTN_PHASE(LAYER, WITH_CTX) do { \
        KArgP AP = KARG(); \
        float lam; { const float a1 = AP->in[12][(LAYER) * 64 + F.lane] * AP->in[13][(LAYER) * 64 + F.lane], a2 = AP->in[14][(LAYER) * 64 + F.lane] * AP->in[15][(LAYER) * 64 + F.lane]; \
            lam = __expf(wave_sum(a1)) - __expf(wave_sum(a2)) + ((LAYER) ? LAMBDA_INIT1 : LAMBDA_INIT0); } \
        const float oscale = 1.f - ((LAYER) ? LAMBDA_INIT1 : LAMBDA_INIT0); \
        const float* subg = AP->in[16] + (LAYER) * 128; \
        const int c = (int)blockIdx.x, xcd = c & 7, jj = c >> 3; \
        for (int i = 0; i < 5; ++i) { \
            bf16_t* Qb; const bf16_t* K0; const bf16_t* K1; int n1; \
            if (i < 4) { const int bh = i * 16 + xcd * 2 + (jj >> 4), qb = jj & 15, b = bh >> 2, h = bh & 3; \
                Qb = P + ((size_t)b * SEQ + qb * 128) * NIN + COL_Q + h * 128; K0 = P + ((size_t)MLAT + b * CTX) * NIN + COL_K + h * 128; K1 = P + ((size_t)b * SEQ) * NIN + COL_K + h * 128; n1 = 32; } \
            else { if (!((WITH_CTX) && c < 128)) break; const int bh = c >> 1, qb = c & 1, b = bh >> 2, h = bh & 3;        \
                Qb = P + ((size_t)MLAT + b * CTX + qb * 128) * NIN + COL_Q + h * 128; K0 = P + ((size_t)MLAT + b * CTX) * NIN + COL_K + h * 128; K1 = K0; n1 = 0; } \
            att::attn_unit(Qb, K0, 4, K1, n1, Qb, lam, oscale, subg, ldsg, F.wave); } \
        int c1 = c; asm volatile("" : "+s"(c1)); \
        int c2 = c1; asm volatile("" : "+s"(c2)); \
        SGT(7); \
        if (!DBG_NO_SG) { const bf16_t* sgw = (const bf16_t*)(ws + WS_SGW) + (size_t)(LAYER) * 4 * 128 * 128; \
          att::sg_unit(P + (size_t)c2 * 128 * NIN, sgw, AP->in[17] + (LAYER) * 512, AP->in[18] + (LAYER) * 512, AP->in[20] + (LAYER) * 512, ldsg, F.wave, 0, 4); \
          int c3 = c2; asm volatile("" : "+s"(c3)); \
          if ((WITH_CTX) && c3 >= 128) { const int it_ = c3 - 128;          \
              att::sg_unit(P + ((size_t)MLAT + (it_ >> 2) * 128) * NIN, sgw, AP->in[17] + (LAYER) * 512, AP->in[18] + (LAYER) * 512, AP->in[20] + (LAYER) * 512, ldsg, F.wave, it_ & 3, (it_ & 3) + 1); } } \
        SGT(1); \
    } while (0)
#if PROBE_T && PROBE_T_PHASE == 30
#define SGT(n) do { if (F.wave == 0 && blockIdx.x == 0 && lane_id_v() == 0) { volatile LAS unsigned* tacc_ = (volatile LAS unsigned*)(F.lds + MISC_OFF) + 16; const unsigned _now = (unsigned)__builtin_amdgcn_s_memrealtime(); tacc_[n] += _now - tacc_[0]; tacc_[0] = _now; } } while (0)
#else
#define SGT(n) do {} while (0)
#endif
    RGN(0);
    if (IN(3)) { ATTN_PHASE(0, true); }
    RGN(3);
    SEAM(3);

    REP_4 if (IN(4)) {
        pg8::DenseSched S{(const char*)P, (const char*)(ws + WS_WOUT), NIN, D, F.G, (int)blockIdx.x, MALL / 256, 4, 0, 0, 0, 0, 0, 0};
        pg8::EpiPlain E{OY, D, 1.f};
        pg8::gemm_phase<pg8::EpiPlain, pg8::DenseSched, true>(F.lds, F.wave, D, S, E);
#if PROBE_NULL_G2 == 1
        { pg8::EpiNull E0; pg8::gemm_phase<pg8::EpiNull, pg8::DenseSched, true>(F.lds, F.wave, D, S, E0); }
#elif PROBE_NULL_G2 == 2
        { pg8::EpiPlainMask E0{HA, D}; pg8::gemm_phase<pg8::EpiPlainMask, pg8::DenseSched, true>(F.lds, F.wave, D, S, E0); }
#endif
        TAIL_FILL(576 - 2 * 256, TF_K4, TF_B4);
    }
    SEAM(4);

    RGN(0);
    REP_5 if (IN(5)) {
        KArgP AP = KARG(); const float* x_in = AP->in[0]; const float* ctx_in = AP->in[2];
        const float* gpost = AP->in[7]; const float* gpre = AP->in[8];
#pragma unroll 1
        for (int seg = 0; seg < 2; ++seg) {
            const int nr = seg ? 2 : 16; const int m0 = seg ? MLAT + gw * 2 : gw * 16; const int r17 = seg ? 16 : (m0 >> 11);
            const float* xbase = seg ? ctx_in + (size_t)(m0 - MLAT) * D : x_in + (size_t)m0 * D;
            const float* msr = MS + (size_t)r17 * 6144;
            const ResP RP = ld_resp(gpost, msr + 2 * 1024, F.lane); const ModP MP = ld_modp(gpre, msr + 3 * 1024, msr + 4 * 1024, F.lane);
            Row xn = ld_row_f32(xbase, F.lane), on = ld_row_bf16(OY + (size_t)m0 * D, F.lane);
            for (int i = 0; i < nr; ++i) {
                Row x = xn; const Row o = on; if (i + 1 < nr) { xn = ld_row_f32(xbase + (size_t)(i + 1) * D, F.lane); on = ld_row_bf16(OY + (size_t)(m0 + i + 1) * D, F.lane); }
                row_residual2(x, o, RP);
                st_row_bf16(XB + (size_t)(m0 + i) * D, F.lane, x);
#if FFN_UP_FP8
                { const Row f = row_modulate2(x, MP); unsigned* fo = (unsigned*)((unsigned char*)HA + (size_t)(m0 + i) * D) + F.lane;
#pragma unroll
                  for (int j = 0; j < 4; ++j) fo[64 * j] = pg8::pk_fp8x4(f.v[j][0] * 4.f, f.v[j][1] * 4.f, f.v[j][2] * 4.f, f.v[j][3] * 4.f); }
#else
                st_row_bf16(HA + (size_t)(m0 + i) * D, F.lane, row_modulate2(x, MP));
#endif
            }
        }
    }
    RGN(4);
    SEAM(5);

    REP_6 if (IN(6)) {
#if FFN_UP_FP8 && FFN_DOWN_FP8
        pg8::DenseSchedF8 S{(const char*)HA, (const char*)(ws + WS_W13), D, D, F.G, (int)blockIdx.x, MALL / 256, 22, PROBE_T_PHASE == 6};
        pg8::EpiSwigluF8 E{(unsigned char*)HFF, DFF, -1.4426950408889634f / 512.f, 4.f / (512.f * 512.f)};
        pg8::gemm_phase<pg8::EpiSwigluF8, pg8::DenseSchedF8, true, true>(F.lds, F.wave, D, S, E);
#elif FFN_UP_FP8
        pg8::DenseSchedF8 S{(const char*)HA, (const char*)(ws + WS_W13), D, D, F.G, (int)blockIdx.x, MALL / 256, 22, PROBE_T_PHASE == 6};
        pg8::EpiSwiglu E{HFF, DFF, -1.4426950408889634f / 512.f, 1.f / (512.f * 512.f)};
        pg8::gemm_phase<pg8::EpiSwiglu, pg8::DenseSchedF8, true, true>(F.lds, F.wave, D, S, E);
#elif FFN_DOWN_FP8
        pg8::DenseSched S{(const char*)HA, (const char*)(ws + WS_W13), D, D, F.G, (int)blockIdx.x, MALL / 256, 22, 0, 0, 0, 0, 0, 0, PROBE_T_PHASE == 6};
        pg8::EpiSwigluF8 E{(unsigned char*)HFF, DFF, -1.4426950408889634f, 4.f};
        pg8::gemm_phase<pg8::EpiSwigluF8, pg8::DenseSched, true>(F.lds, F.wave, D, S, E);
#else
        pg8::DenseSched S{(const char*)HA, (const char*)(ws + WS_W13), D, D, F.G, (int)blockIdx.x, MALL / 256, 22, 0, 0, 0, 0, 0, 0, PROBE_T_PHASE == 6};
        pg8::EpiSwiglu E{HFF, DFF, -1.4426950408889634f, 1.f};
        pg8::gemm_phase<pg8::EpiSwiglu, pg8::DenseSched, true>(F.lds, F.wave, D, S, E);
#endif
        TAIL_FILL(3168 - 12 * 256, TF_K6, TF_B6);
    }
    SEAM(6);

    REP_7 if (IN(7)) {
#if FFN_DOWN_FP8
        pg8::DenseSchedF8 S{(const char*)HFF, (const char*)(ws + WS_W2), DFF, DFF, F.G, (int)blockIdx.x, MALL / 256, 4, 0};
        pg8::EpiPlain E{OY, D, 1.f / 512.f};
        pg8::gemm_phase<pg8::EpiPlain, pg8::DenseSchedF8, true, true>(F.lds, F.wave, DFF, S, E);
#else
        pg8::DenseSched S{(const char*)HFF, (const char*)(ws + WS_W2), DFF, DFF, F.G, (int)blockIdx.x, MALL / 256, 4, 0, 0, 0, 0, 0, 0};
        pg8::EpiPlain E{OY, D, 1.f};
        pg8::gemm_phase<pg8::EpiPlain, pg8::DenseSched, true>(F.lds, F.wave, DFF, S, E);
#endif
        TAIL_FILL(576 - 2 * 256, TF_K7, TF_B7);
    }
    SEAM(7);

    if (IN(8)) {
        KArgP AP = KARG();
        const float* gpost = AP->in[9]; const float* gpre = AP->in[6] + D;
#pragma unroll 1
        for (int seg = 0; seg < 2; ++seg) {
            const int nr = seg ? 2 : 16; const int m0 = seg ? MLAT + gw * 2 : gw * 16; const int r17 = seg ? 16 : (m0 >> 11);
            const float* msr = MS + (size_t)r17 * 6144; const float* msr1 = MS + (size_t)(17 + r17) * 6144;
            const ResP RP = ld_resp(gpost, msr + 5 * 1024, F.lane); const ModP MP = ld_modp(gpre, msr1, msr1 + 1024, F.lane);
            Row xn = ld_row_bf16(XB + (size_t)m0 * D, F.lane), yn = ld_row_bf16(OY + (size_t)m0 * D, F.lane);
            for (int i = 0; i < nr; ++i) {
                Row x = xn; const Row y = yn; if (i + 1 < nr) { xn = ld_row_bf16(XB + (size_t)(m0 + i + 1) * D, F.lane); yn = ld_row_bf16(OY + (size_t)(m0 + i + 1) * D, F.lane); }
                row_residual2(x, y, RP);
                if (!seg) st_row_bf16(XB + (size_t)(m0 + i) * D, F.lane, x);
                st_row_bf16(HA + (size_t)(m0 + i) * D, F.lane, row_modulate2(x, MP));
            }
        }
    }
    SEAM(8);

    REP_9 if (IN(9)) {
        pg8::DenseSched S{(const char*)HA, (const char*)(ws + WS_WIN + (size_t)NIN * D * 2), D, D, F.G, (int)blockIdx.x, MLAT / 256, 10, 0, 0, MCTX / 256, 4, MLAT, 4};
        LAS float* rl = (LAS float*)(F.lds + ROPE_LDS); for (int i = F.tid; i < 2048; i += NWAVES * 64) rl[i] = ropec[i]; __syncthreads();
        pg8::EpiInProj E{P, rl, rl + 1024};
        pg8::gemm_phase<pg8::EpiInProj, pg8::DenseSched, true>(F.lds, F.wave, D, S, E);
        TAIL_FILL(1344 - 5 * 256, TF_K9, TF_B9);
    }
    SEAM(9);

    if (IN(10)) { ATTN_PHASE(1, false); }
    SEAM(10);

    REP_11 if (IN(11)) {
        pg8::DenseSched S{(const char*)P, (const char*)(ws + WS_WOUT + (size_t)D * D * 2), NIN, D, F.G, (int)blockIdx.x, MLAT / 256, 4, 0, 0, 0, 0, 0, 0};
        pg8::EpiPlain E{OY, D, 1.f};
        pg8::gemm_phase<pg8::EpiPlain, pg8::DenseSched, true>(F.lds, F.wave, D, S, E);
    }
    SEAM(11);

    RGN(0);
    if (IN(12)) {
        KArgP AP = KARG();
        const float* gpost = AP->in[7] + D; const float* gpre = AP->in[8] + D;
        LAS float* rw = (LAS float*)F.lds;
        LAS int* lcnt = (LAS int*)(F.lds + 32768);
        LAS int* rec = (LAS int*)(F.lds + 32768 + 256);
        for (int i = F.tid; i < 8192; i += 512) rw[(i & 7) * 1024 + (i >> 3)] = AP->in[24][i];
        if (F.tid < 16) lcnt[F.tid] = 0;
        __syncthreads();
        const int m0 = gw * 16; const int r17 = m0 >> 11; const float* msr1 = MS + (size_t)(17 + r17) * 6144;
        const ResP RP = ld_resp(gpost, msr1 + 2 * 1024, F.lane); const ModP MP = ld_modp(gpre, msr1 + 3 * 1024, msr1 + 4 * 1024, F.lane);
        Row xn = ld_row_bf16(XB + (size_t)m0 * D, F.lane), on = ld_row_bf16(OY + (size_t)m0 * D, F.lane);
        for (int i = 0; i < 16; ++i) {
            const int m = m0 + i;
            Row x = xn; const Row o = on; if (i + 1 < 16) { xn = ld_row_bf16(XB + (size_t)(m + 1) * D, F.lane); on = ld_row_bf16(OY + (size_t)(m + 1) * D, F.lane); }
            row_residual2(x, o, RP);
            st_row_bf16(XB + (size_t)m * D, F.lane, x);
            const Row f = row_modulate2(x, MP);
            { unsigned* fo = (unsigned*)(ws + WS_F8 + (size_t)m * D) + F.lane;
#pragma unroll
              for (int j = 0; j < 4; ++j) fo[64 * j] = pg8::pk_fp8x4(f.v[j][0] * 4.f, f.v[j][1] * 4.f, f.v[j][2] * 4.f, f.v[j][3] * 4.f); }
            float lg[8];
#pragma unroll
            for (int e = 0; e < 8; ++e) { float a = 0.f;
#pragma unroll
                for (int j = 0; j < 4; ++j) { const f32x4 w = *(const LAS f32x4*)(rw + e * 1024 + 4 * (F.lane + 64 * j)); a += (f.v[j][0] * w[0] + f.v[j][1] * w[1]) + (f.v[j][2] * w[2] + f.v[j][3] * w[3]); }
                lg[e] = wave_sum(a); }
            int e1 = 0; float v1 = lg[0];
#pragma unroll
            for (int e = 1; e < 8; ++e) if (lg[e] > v1) { v1 = lg[e]; e1 = e; }
            int e2 = -1; float v2 = -3.0e38f;
#pragma unroll
            for (int e = 0; e < 8; ++e) if (e != e1 && lg[e] > v2) { v2 = lg[e]; e2 = e; }
            if (F.lane == 0) {
                const float w1 = 1.f / (1.f + __expf(v2 - v1));
                tok_e[m * 2] = e1; tok_e[m * 2 + 1] = e2; tok_g[m * 2] = w1; tok_g[m * 2 + 1] = 1.f - w1;
                const int l1 = __hip_atomic_fetch_add(lcnt + e1, 1, __ATOMIC_RELAXED, __HIP_MEMORY_SCOPE_WORKGROUP), l2 = __hip_atomic_fetch_add(lcnt + e2, 1, __ATOMIC_RELAXED, __HIP_MEMORY_SCOPE_WORKGROUP);
                LAS int* rr = rec + (F.wave * 16 + i) * 4; rr[0] = e1; rr[1] = e2; rr[2] = l1; rr[3] = l2;
            }
        }
        __syncthreads();
        if (F.tid < 8) lcnt[8 + F.tid] = (int)__hip_atomic_fetch_add(F.ctl + CW_CNT + 64 * F.tid, (unsigned)lcnt[F.tid], RLX_AGENT);
        __syncthreads();
        if (F.lane < 16) { const int m = m0 + F.lane; const LAS int* rr = rec + (F.wave * 16 + F.lane) * 4;
            const int r1 = lcnt[8 + rr[0]] + rr[2], r2 = lcnt[8 + rr[1]] + rr[3];
            tok_rank[m * 2] = r1; tok_rank[m * 2 + 1] = r2; slot_token[rr[0] * 32768 + r1] = m; slot_token[rr[1] * 32768 + r2] = m; }
        __syncthreads();
        convert_range(F.lds, F.wave, lane_id_v(), KARG(), CV_L0 + TF_END + gw, NGW, CV_N);
    }
    RGN(5);
    SEAM(12);

    {
        MoeTab T; T.pbase[8] = 0;
        if (hi > 13 && lo < 23) moe_tab(F.ctl, T);
        const int ptot = T.pbase[8];
        REP_13 for (int ch = 0; ch < 2; ++ch) {
            const int p0 = ch * 128; const int nM = ch ? ptot - 128 : (ptot < 128 ? ptot : 128);
            REP_14 if (IN(13 + 2 * ch) && nM > 0) {
                MoeUpSched S{(const char*)(ws + WS_F8), (const char*)(ws + WS_MW13), slot_token, F.G, (int)blockIdx.x, p0, nM, T, PROBE_T_PHASE == 13};
                pg8::EpiSwigluF8 E{ws + WS_HF8 + (size_t)p0 * 256 * DEXP, DEXP, -1.4426950408889634f / 512.f, 4.f / (512.f * 512.f)};
                pg8::gemm_phase<pg8::EpiSwigluF8, MoeUpSched, true, true>(F.lds, F.wave, D, S, E);
            }
            if (IN(13 + 2 * ch) && IN(14 + 2 * ch) && nM > 0) xcd_barrier(bar, F.wave);
            REP_15 if (IN(14 + 2 * ch) && nM > 0) {
                MoeDownSched S{(const char*)(ws + WS_HF8 + (size_t)p0 * 256 * DEXP), (const char*)(ws + WS_MW2), F.G, (int)blockIdx.x, p0, nM, T, PROBE_T_PHASE == 14};
                pg8::EpiPlain E{YS, D, 1.f / 512.f};
                pg8::gemm_phase<pg8::EpiPlain, MoeDownSched, true, true>(F.lds, F.wave, DEXP, S, E);
            }
            if (ch == 1 && IN(14 + 2 * ch) && IN(15 + 2 * ch) && nM > 0) xcd_barrier(bar, F.wave);
        }
    }

    RGN(0);
    if (IN(23)) {
        MoeTab T; moe_tab(F.ctl, T);
        const float* gpost = KARG()->in[9] + D;
#define YS_ROWS(mm, S1, S2) do { const int e1_ = tok_e[(mm) * 2], e2_ = tok_e[(mm) * 2 + 1]; int pb1_ = 0, pb2_ = 0; \
            _Pragma("unroll") for (int e = 0; e < 8; ++e) { pb1_ = (e1_ == e) ? T.pbase[e] : pb1_; pb2_ = (e2_ == e) ? T.pbase[e] : pb2_; } \
            S1 = (size_t)pb1_ * 256 + tok_rank[(mm) * 2]; S2 = (size_t)pb2_ * 256 + tok_rank[(mm) * 2 + 1]; } while (0)
        const int m0 = gw * 16; const int r17 = m0 >> 11; const float* msr1 = MS + (size_t)(17 + r17) * 6144;
        const ResP RP = ld_resp(gpost, msr1 + 5 * 1024, F.lane);
        size_t s1, s2; YS_ROWS(m0, s1, s2);
        Row xn = ld_row_bf16(XB + (size_t)m0 * D, F.lane), yan = ld_row_bf16(YS + s1 * D, F.lane), ybn = ld_row_bf16(YS + s2 * D, F.lane);
        float* outp = KARG()->out;
        for (int i = 0; i < 16; ++i) {
            const int m = m0 + i;
            Row x = xn; const Row ya = yan, yb = ybn; const float g1 = tok_g[m * 2], g2 = tok_g[m * 2 + 1];
            if (i + 1 < 16) { YS_ROWS(m + 1, s1, s2); xn = ld_row_bf16(XB + (size_t)(m + 1) * D, F.lane); yan = ld_row_bf16(YS + s1 * D, F.lane); ybn = ld_row_bf16(YS + s2 * D, F.lane); }
            Row y;
#pragma unroll
            for (int j = 0; j < 4; ++j) y.v[j] = ya.v[j] * g1 + yb.v[j] * g2;
            row_residual2(x, y, RP);
            st_row_f32(outp + (size_t)m * D, F.lane, x);
        }
    }
    RGN(6);
#if PROBE_T
    if (blockIdx.x == 0 && F.wave == 0) { const unsigned ticks = ((volatile LAS unsigned*)(F.lds + MISC_OFF))[16 + PROBE_T]; const unsigned long long t0 = __builtin_amdgcn_s_memrealtime();
        while (__builtin_amdgcn_s_memrealtime() - t0 < (unsigned long long)ticks * 8ull) __builtin_amdgcn_s_sleep(8); }
#endif
#undef TAIL_FILL
#undef IN
#undef SEAM
#undef ATTN_PHASE
}

extern "C" void kernel_launch(void* const* d_in, const int* in_sizes, int n_in, void* d_out, int out_size, void* d_ws, size_t ws_size, hipStream_t stream) {
    static int grid = 0;
    if (grid == 0) {
        if (n_in != 28 || out_size != MLAT * D || ws_size < WS_END) { fprintf(stderr, "kernel_launch: unexpected shapes (n_in %d, out %d, ws %zu)\n", n_in, out_size, ws_size); grid = -1; return; }
        int dev = 0, cus = 0, per_cu = 0;
        if (hipGetDevice(&dev) != hipSuccess || hipDeviceGetAttribute(&cus, hipDeviceAttributeMultiprocessorCount, dev) != hipSuccess) { grid = -1; return; }
        if (hipFuncSetAttribute((const void*)mk_fwd, hipFuncAttributeMaxDynamicSharedMemorySize, LDS_BYTES) != hipSuccess) { fprintf(stderr, "kernel_launch: hipFuncSetAttribute failed\n"); grid = -1; return; }
        if (hipOccupancyMaxActiveBlocksPerMultiprocessor(&per_cu, (const void*)mk_fwd, NWAVES * 64, LDS_BYTES) != hipSuccess || per_cu < 1) { fprintf(stderr, "kernel_launch: occupancy query says %d\n", per_cu); (void)hipGetLastError(); }
        grid = cus;
        if (grid != 256) { fprintf(stderr, "kernel_launch: built for 256 CUs, found %d\n", grid); grid = -1; return; }
    }
    if (grid < 0) return;
    (void)hipMemsetAsync((char*)d_ws + WS_CTL, 0, CTL_ZERO_BYTES, stream);
    Args a{};
    for (int i = 0; i < 28; ++i) a.in[i] = (const float*)d_in[i];
    a.out = (float*)d_out; a.ws = (unsigned char*)d_ws;
#if MK_PER_PHASE
    for (int p = 0; p < N_PHASES; ++p) { a.ph_lo = p; a.ph_hi = p + 1; hipLaunchKernelGGL(mk_fwd, dim3(grid), dim3(NWAVES * 64), LDS_BYTES, stream, a); }
#else
    a.ph_lo = 0; a.ph_hi = N_PHASES;
    hipLaunchKernelGGL(mk_fwd, dim3(grid), dim3(NWAVES * 64), LDS_BYTES, stream, a);
#endif
}
```

```cpp
#include <hip/hip_runtime.h>
#include <cstdio>
#include <cstdint>

#ifndef DBG_NO_SG
#define DBG_NO_SG 0
#endif
#ifndef DBG_NO_CTX
#define DBG_NO_CTX 0
#endif
#ifndef DBG_NO_LAT
#define DBG_NO_LAT 0
#endif
#ifndef PROBE_T
#define PROBE_T 0
#endif
#ifndef PROBE_T_PHASE
#define PROBE_T_PHASE 6
#endif
#ifndef FFN_UP_FP8
#define FFN_UP_FP8 1
#endif
#ifndef FFN_DOWN_FP8
#define FFN_DOWN_FP8 1
#endif
#ifndef MK_PER_PHASE
#define MK_PER_PHASE 0
#endif

#define LAS __attribute__((address_space(3)))
#define GAS __attribute__((address_space(1)))
typedef unsigned short bf16_t;
typedef short bf16x8 __attribute__((ext_vector_type(8)));
typedef short s16x4 __attribute__((ext_vector_type(4)));
typedef float f32x2 __attribute__((ext_vector_type(2)));
typedef float f32x4 __attribute__((ext_vector_type(4)));
typedef float f32x16 __attribute__((ext_vector_type(16)));
typedef unsigned u32x2 __attribute__((ext_vector_type(2)));
typedef unsigned u32x4 __attribute__((ext_vector_type(4)));
typedef GAS unsigned gu32;
typedef int v8i __attribute__((ext_vector_type(8)));
typedef int v4i __attribute__((ext_vector_type(4)));

constexpr int D = 1024, BATCH = 16, SEQ = 2048, CTX = 256;
constexpr int MLAT = BATCH * SEQ;
constexpr int MCTX = BATCH * CTX;
constexpr int MALL = MLAT + MCTX;
constexpr int NIN = 2560;
constexpr int COL_Q = 0, COL_U = 512, COL_K = 1024, COL_V = 1536, COL_G = 2048;
constexpr int DFF = 2816, DEXP = 3584, NEXP = 8;
constexpr float EPS = 1e-6f;
constexpr float LAMBDA_INIT0 = 0.2f, LAMBDA_INIT1 = 0.35550907f;

constexpr size_t MiB = 1u << 20;
constexpr size_t WS_CTL = 0, CTL_ZERO_BYTES = 1 * MiB;
constexpr size_t WS_MS = 1 * MiB;
constexpr size_t WS_ROPE = 2 * MiB;
constexpr size_t WS_ROUTE = 3 * MiB;
constexpr size_t WS_SLOT = 4 * MiB;
constexpr size_t WS_WIN = 5 * MiB;
constexpr size_t WS_WOUT = 15 * MiB;
constexpr size_t WS_SGW = 19 * MiB;
constexpr size_t WS_W13 = 20 * MiB;
constexpr size_t WS_W2 = 31 * MiB;
constexpr size_t WS_MW13 = 37 * MiB;
constexpr size_t WS_MW2 = 93 * MiB;
constexpr size_t WS_XB = 121 * MiB;
constexpr size_t WS_HA = 221 * MiB;
constexpr size_t WS_R1 = 293 * MiB;
constexpr size_t WS_OY = 491 * MiB;
constexpr size_t WS_F8 = 5 * MiB;
constexpr size_t WS_HF8 = 221 * MiB;
constexpr size_t WS_YS = 452 * MiB;
constexpr size_t WS_END = 584 * MiB;

constexpr int CW_BAR = 4096;
constexpr int CW_CNT = 64;

constexpr int RING_BYTES = 131072;
constexpr int LDSCTL_OFF = RING_BYTES, MISC_OFF = LDSCTL_OFF + 320;
constexpr int LDS_BYTES = 147456;
constexpr int ROPE_LDS = RING_BYTES + 6144;
static_assert(ROPE_LDS + 8192 <= LDS_BYTES, "LDS map");
constexpr int NWAVES = 8;

#define RLX_AGENT __ATOMIC_RELAXED, __HIP_MEMORY_SCOPE_AGENT
#define LDS_WAIT() asm volatile("s_waitcnt lgkmcnt(0)" ::: "memory")
#define VM_WAIT() asm volatile("s_waitcnt vmcnt(0)" ::: "memory")
#define SBAR() __builtin_amdgcn_sched_barrier(0)

__device__ __forceinline__ unsigned cvt_pk_bf16(float lo, float hi) { unsigned r; asm volatile("v_cvt_pk_bf16_f32 %0, %1, %2" : "=v"(r) : "v"(lo), "v"(hi)); return r; }
__device__ __forceinline__ float bf2f(unsigned short b) { return __builtin_bit_cast(float, (unsigned)b << 16); }
__device__ __forceinline__ float bflo(unsigned w) { return __builtin_bit_cast(float, w << 16); }
__device__ __forceinline__ float bfhi(unsigned w) { return __builtin_bit_cast(float, w & 0xffff0000u); }
__device__ __forceinline__ float wave_sum(float v) {
#pragma unroll
    for (int o = 1; o < 64; o <<= 1) v += __shfl_xor(v, o);
    return v;
}
__device__ __forceinline__ int lane_id_v() { int l; asm volatile("v_mbcnt_lo_u32_b32 %0, -1, 0\n\tv_mbcnt_hi_u32_b32 %0, -1, %0" : "=v"(l)); return l; }
__device__ __forceinline__ float silu_f(float v) { return v / (1.f + __expf(-v)); }

namespace pg8 {
constexpr int BM = 256, BK = 64, HALF = 128, HTB = HALF * BK * 2, STAGE_BYTES = 8 * HTB, NXCD = 8, WGM = 4;
constexpr int IDX_OFF = STAGE_BYTES + 4096;
__host__ __device__ __forceinline__ int lds_byte(int r, int c) { const int st = (r >> 4) * 2 + (c >> 5), rr = r & 15, cc = c & 31, ob = rr * 64 + cc * 2; return st * 1024 + (ob ^ (((ob >> 9) & 1) << 5)); }
__host__ __device__ __forceinline__ void stage_rc(int b, int& R, int& C) { const int st = b / 1024, sb = b % 1024, swz = sb ^ (((sb >> 9) & 1) << 5); R = (st >> 1) * 16 + swz / 64; C = (st & 1) * 32 + (swz % 64) / 2; }
__host__ __device__ __forceinline__ int perm32(int rho) { const int n = rho >> 4, i = rho & 15; return 8 * (i >> 2) + 4 * n + (i & 3); }

struct Unit { const char* Ap; const char* Bp; int pm, pn, aux, aux2; };

__device__ __forceinline__ void tile_of(int L, int nM, int nN, int& pm, int& pn) {
    const int nwg = nM * nN; int wgid = L;
    { const int q = nwg / NXCD, r = nwg % NXCD, xcd = wgid % NXCD, off = wgid / NXCD; wgid = (xcd < r ? xcd * (q + 1) : r * (q + 1) + (xcd - r) * q) + off; }
    const int nig = WGM * nN, gid = wgid / nig, fm = gid * WGM, gsz = (nM - fm) < WGM ? (nM - fm) : WGM;
    pm = fm + ((wgid % nig) % gsz); pn = (wgid % nig) / gsz;
}

template <class Epi, class Sched, bool ALIGN_EPI, bool FP8 = false>
__device__ __forceinline__ void gemm_phase(LAS unsigned char* lds, const int wid, const int K, const Sched& S, const Epi& E) {
    const int lane = lane_id_v(), tid = wid * 64 + lane;
    const int wr = wid >> 2, wc = wid & 3, fr = lane & 15, fq = lane >> 4;
    const int kbytes = FP8 ? K : 2 * K;
    const int nt = kbytes / 128;
    int R[2], C[2]; unsigned voffB[2];
#pragma unroll
    for (int i = 0; i < 2; ++i) { stage_rc(tid * 16 + i * 8192, R[i], C[i]); const int Rb = Epi::PERM ? ((R[i] & ~31) + perm32(R[i] & 31)) : R[i]; voffB[i] = (unsigned)(Rb * kbytes + C[i] * 2); }
    const size_t kstep = (size_t)(BK * 2);
    const size_t hstepB = (size_t)HALF * kbytes;
    const unsigned ldsw = (unsigned)wid * 1024u;
    const int aoff = lds_byte(wr * 64 + fr, fq * 8), boff = lds_byte(wc * 32 + fr, fq * 8);
#define PG8_SA(b, h) (((b) * 2 + (h)) * HTB)
#define PG8_SB(b, h) ((4 + (b) * 2 + (h)) * HTB)
#define PG8_STAGE(bufoff, gbase, voff) do { _Pragma("unroll") for (int _i = 0; _i < 2; ++_i) \
        __builtin_amdgcn_global_load_lds((const unsigned*)((const char*)(gbase) + (voff)[_i]), (LAS unsigned*)(lds + (bufoff) + ldsw + _i * 8192), 16, 0, 0); } while (0)
#define PG8_LDA(dst, b, h) do { _Pragma("unroll") for (int m = 0; m < 4; ++m) { const v4i _lo = *(const LAS v4i*)(lds + PG8_SA(b, h) + aoff + m * 2048), _hi = *(const LAS v4i*)(lds + PG8_SA(b, h) + aoff + m * 2048 + 1024); \
        dst[m] = __builtin_shufflevector(_lo, _hi, 0, 1, 2, 3, 4, 5, 6, 7); } } while (0)
#define PG8_LDB(dst, b, h) do { _Pragma("unroll") for (int n = 0; n < 2; ++n) { const v4i _lo = *(const LAS v4i*)(lds + PG8_SB(b, h) + boff + n * 2048), _hi = *(const LAS v4i*)(lds + PG8_SB(b, h) + boff + n * 2048 + 1024); \
        dst[n] = __builtin_shufflevector(_lo, _hi, 0, 1, 2, 3, 4, 5, 6, 7); } } while (0)
#define PG8_LO(x) __builtin_bit_cast(bf16x8, __builtin_shufflevector(x, x, 0, 1, 2, 3))
#define PG8_HI(x) __builtin_bit_cast(bf16x8, __builtin_shufflevector(x, x, 4, 5, 6, 7))
#define PG8_MMA(ai, bj, At, Bt) do { __builtin_amdgcn_s_setprio(1); \
        if constexpr (FP8) { _Pragma("unroll") for (int m = 0; m < 4; ++m) _Pragma("unroll") for (int n = 0; n < 2; ++n) \
            asm volatile("v_mfma_f32_16x16x128_f8f6f4 %0, %1, %2, %0" : "+v"(acc[ai][bj][m][n]) : "v"(Bt[n]), "v"(At[m])); } \
        else { _Pragma("unroll") for (int m = 0; m < 4; ++m) _Pragma("unroll") for (int n = 0; n < 2; ++n) { \
            acc[ai][bj][m][n] = __builtin_amdgcn_mfma_f32_16x16x32_bf16(PG8_LO(Bt[n]), PG8_LO(At[m]), acc[ai][bj][m][n], 0, 0, 0); \
            acc[ai][bj][m][n] = __builtin_amdgcn_mfma_f32_16x16x32_bf16(PG8_HI(Bt[n]), PG8_HI(At[m]), acc[ai][bj][m][n], 0, 0, 0); } } \
        __builtin_amdgcn_s_setprio(0); } while (0)
#define PG8_WAIT_V(n) asm volatile("s_waitcnt vmcnt(" #n ")" ::: "memory")
#define PG8_WAIT_L(n) asm volatile("s_waitcnt lgkmcnt(" #n ")" ::: "memory")
#define PG8_BAR __builtin_amdgcn_s_barrier()
#define PG8_SCHED __builtin_amdgcn_sched_barrier(0)
#if PROBE_T
    volatile LAS unsigned* tacc = (volatile LAS unsigned*)(lds + MISC_OFF) + 16;
#define PG8_T(n) do { if (S.tprobe && wid == 0 && blockIdx.x == 0 && lane == 0) { const unsigned _now = (unsigned)__builtin_amdgcn_s_memrealtime(); tacc[n] += _now - tacc[0]; tacc[0] = _now; } } while (0)
#else
#define PG8_T(n) do {} while (0)
#endif
    Unit cur, nxt; int ui = 0;
    if (!S.next(0, cur)) return;
    f32x4 acc[2][2][4][2];
#pragma unroll
    for (int a = 0; a < 2; ++a)
#pragma unroll
        for (int b = 0; b < 2; ++b)
#pragma unroll
            for (int m = 0; m < 4; ++m)
#pragma unroll
                for (int n = 0; n < 2; ++n) acc[a][b][m][n] = (f32x4){0.f, 0.f, 0.f, 0.f};
    v8i At[4], B0[2], B1[2];
    unsigned cO0[2], cO1[2], nO0[2], nO1[2];
    S.aoff(cur, R, C, cO0, cO1);
    const char* cA = cur.Ap; const char* cB = cur.Bp;
    PG8_STAGE(PG8_SB(0, 0), cB, voffB); PG8_STAGE(PG8_SB(0, 1), cB + hstepB, voffB); PG8_STAGE(PG8_SA(0, 0), cA, cO0); PG8_STAGE(PG8_SA(0, 1), cA, cO1);
    if (wr == 1) PG8_BAR;
    PG8_WAIT_V(2); PG8_BAR;
    PG8_STAGE(PG8_SB(1, 0), cB + kstep, voffB); PG8_STAGE(PG8_SA(1, 0), cA + kstep, cO0); PG8_STAGE(PG8_SB(1, 1), cB + hstepB + kstep, voffB);
    PG8_WAIT_V(6); PG8_BAR;
    PG8_T(7);
    for (;;) {
        const bool has_next = S.next(ui + 1, nxt);
        if constexpr (Sched::GATHER) { if (has_next) S.prefetch_idx(nxt, lds + IDX_OFF, wid, lane); nO0[0] = cO0[0]; nO0[1] = cO0[1]; nO1[0] = cO1[0]; nO1[1] = cO1[1]; }
        const char* nA = has_next ? nxt.Ap : cA; const char* nB = has_next ? nxt.Bp : cB;
        PG8_T(4);
        for (int t = 0; t < nt; t += 2) {
            const bool last = (t == nt - 2);
            const char* a1 = cA + (size_t)(t + 1) * kstep;
            const char* a2 = last ? nA : cA + (size_t)(t + 2) * kstep; const char* b2 = last ? nB : cB + (size_t)(t + 2) * kstep;
            const char* a3 = a2 + kstep; const char* b3 = b2 + kstep;
            unsigned xO0[2], xO1[2];
            if constexpr (Sched::GATHER) { if (last && has_next) S.aoff_lds(R, C, lds + IDX_OFF, nO0, nO1); }
            if constexpr (Sched::GATHER) { xO0[0] = last ? nO0[0] : cO0[0]; xO0[1] = last ? nO0[1] : cO0[1]; xO1[0] = last ? nO1[0] : cO1[0]; xO1[1] = last ? nO1[1] : cO1[1]; }
            else { xO0[0] = cO0[0]; xO0[1] = cO0[1]; xO1[0] = cO1[0]; xO1[1] = cO1[1]; }
            const int relax = __builtin_amdgcn_readfirstlane((t == 0 && ui > 0) ? 1 : 0);
#define PG8_WAIT_VR() do { if constexpr (Epi::NSTORES == 16) asm volatile("s_cmp_eq_u32 %0, 0\n\ts_cbranch_scc1 .Lwv%=\n\ts_waitcnt vmcnt(24)\n\ts_branch .Lwe%=\n.Lwv%=:\n\ts_waitcnt vmcnt(8)\n.Lwe%=:" :: "s"(relax) : "memory", "scc"); \
        else asm volatile("s_cmp_eq_u32 %0, 0\n\ts_cbranch_scc1 .Lwv%=\n\ts_waitcnt vmcnt(16)\n\ts_branch .Lwe%=\n.Lwv%=:\n\ts_waitcnt vmcnt(8)\n.Lwe%=:" :: "s"(relax) : "memory", "scc"); } while (0)
            PG8_LDB(B0, 0, 0); PG8_LDB(B1, 0, 1); PG8_SCHED; PG8_LDA(At, 0, 0); PG8_STAGE(PG8_SA(1, 1), a1, cO1);
            PG8_WAIT_VR(); PG8_WAIT_L(0); PG8_BAR; PG8_MMA(0, 0, At, B0); PG8_MMA(0, 1, At, B1); PG8_BAR; PG8_SCHED;
            PG8_LDA(At, 0, 1); PG8_STAGE(PG8_SB(0, 0), b2, voffB); PG8_STAGE(PG8_SB(0, 1), b2 + hstepB, voffB); PG8_STAGE(PG8_SA(0, 0), a2, xO0);
            PG8_WAIT_VR(); PG8_WAIT_L(0); PG8_BAR; PG8_MMA(1, 0, At, B0); PG8_MMA(1, 1, At, B1); PG8_BAR; PG8_SCHED;
            PG8_LDB(B0, 1, 0); PG8_LDB(B1, 1, 1); PG8_SCHED; PG8_LDA(At, 1, 0); PG8_STAGE(PG8_SA(0, 1), a2, xO1);
            PG8_WAIT_V(8); PG8_WAIT_L(0); PG8_BAR; PG8_MMA(0, 0, At, B0); PG8_MMA(0, 1, At, B1); PG8_BAR; PG8_SCHED;
#undef PG8_WAIT_VR
            PG8_LDA(At, 1, 1); PG8_STAGE(PG8_SB(1, 0), b3, voffB); PG8_STAGE(PG8_SB(1, 1), b3 + hstepB, voffB); PG8_STAGE(PG8_SA(1, 0), a3, xO0);
            PG8_WAIT_V(8); PG8_WAIT_L(0); PG8_BAR; PG8_MMA(1, 0, At, B0); PG8_MMA(1, 1, At, B1); PG8_BAR; PG8_SCHED;
        }
        PG8_T(1);
        if constexpr (ALIGN_EPI) { if (wr == 0) PG8_BAR; }
        PG8_T(2);
        if constexpr (FP8) asm volatile("s_nop 15\n\ts_nop 15\n\ts_nop 15\n\ts_nop 15\n\ts_nop 15\n\ts_nop 15" ::: "memory");
        E(acc, cur, wr, wc, fr, fq);
        PG8_T(3);
        if (!has_next) break;
#pragma unroll
        for (int a = 0; a < 2; ++a)
#pragma unroll
            for (int b = 0; b < 2; ++b)
#pragma unroll
                for (int m = 0; m < 4; ++m)
#pragma unroll
                    for (int n = 0; n < 2; ++n) acc[a][b][m][n] = (f32x4){0.f, 0.f, 0.f, 0.f};
        cur = nxt; cA = nA; cB = nB; ++ui;
        if constexpr (Sched::GATHER) { cO0[0] = nO0[0]; cO0[1] = nO0[1]; cO1[0] = nO1[0]; cO1[1] = nO1[1]; }
        if constexpr (ALIGN_EPI) { if (wr == 1) PG8_BAR; }
    }
    PG8_WAIT_V(0);
    if constexpr (!ALIGN_EPI) { if (wr == 0) PG8_BAR; }
    PG8_BAR;
#undef PG8_SA
#undef PG8_SB
#undef PG8_STAGE
#undef PG8_LDA
#undef PG8_LDB
#undef PG8_MMA
#undef PG8_LO
#undef PG8_HI
#undef PG8_WAIT_V
#undef PG8_WAIT_L
#undef PG8_BAR
#undef PG8_SCHED
#undef PG8_T
}

struct DenseSched {
    static constexpr bool GATHER = false;
    const char* A; const char* Bt; int lda, K, G, c;
    int nM0, nN0, arow0_0, pn0_0, nM1, nN1, arow0_1, pn0_1; int tprobe;
    __device__ __forceinline__ bool next(int i, Unit& u) const {
        int L = i * G + c; const int n0 = nM0 * nN0;
        int pm, pn;
        if (L < n0) { tile_of(L, nM0, nN0, pm, pn); u.pm = arow0_0 / 256 + pm; u.pn = pn0_0 + pn; }
        else { L -= n0; if (L >= nM1 * nN1) return false; tile_of(L, nM1, nN1, pm, pn); u.pm = arow0_1 / 256 + pm; u.pn = pn0_1 + pn; }
        u.Ap = A + (size_t)u.pm * 256 * lda * 2; u.Bp = Bt + (size_t)u.pn * 256 * K * 2; u.aux = 0; u.aux2 = 0; return true;
    }
    __device__ __forceinline__ void aoff(const Unit&, const int (&R)[2], const int (&C)[2], unsigned (&o0)[2], unsigned (&o1)[2]) const {
#pragma unroll
        for (int i = 0; i < 2; ++i) { o0[i] = (unsigned)(R[i] * lda + C[i]) * 2u; o1[i] = (unsigned)((HALF + R[i]) * lda + C[i]) * 2u; }
    }
};

struct DenseSchedF8 {
    static constexpr bool GATHER = false;
    const char* A; const char* Bt; int lda, K, G, c, nM, nN; int tprobe;
    __device__ __forceinline__ bool next(int i, Unit& u) const {
        const int L = i * G + c; if (L >= nM * nN) return false;
        int pm, pn; tile_of(L, nM, nN, pm, pn); u.pm = pm; u.pn = pn;
        u.Ap = A + (size_t)pm * 256 * lda; u.Bp = Bt + (size_t)pn * 256 * K; u.aux = 0; u.aux2 = 0; return true;
    }
    __device__ __forceinline__ void aoff(const Unit&, const int (&R)[2], const int (&C)[2], unsigned (&o0)[2], unsigned (&o1)[2]) const {
#pragma unroll
        for (int i = 0; i < 2; ++i) { o0[i] = (unsigned)(R[i] * lda + C[i] * 2); o1[i] = (unsigned)((HALF + R[i]) * lda + C[i] * 2); }
    }
};

struct EpiPlain {
    static constexpr bool PERM = true; static constexpr int NSTORES = 16;
    bf16_t* O; int ldc; float sc;
    __device__ __forceinline__ void operator()(const f32x4 (&acc)[2][2][4][2], const Unit& u, int wr, int wc, int fr, int fq) const {
        const int row0 = u.pm * BM + wr * 64 + fr, col0 = u.pn * BM + wc * 32 + 8 * fq;
#pragma unroll
        for (int ai = 0; ai < 2; ++ai)
#pragma unroll
            for (int m = 0; m < 4; ++m) { bf16_t* rowp = O + (size_t)(row0 + ai * HALF + m * 16) * ldc + col0;
#pragma unroll
                for (int bj = 0; bj < 2; ++bj) { const f32x4 v0 = acc[ai][bj][m][0] * sc, v1 = acc[ai][bj][m][1] * sc;
                    u32x4 w; w.x = cvt_pk_bf16(v0[0], v0[1]); w.y = cvt_pk_bf16(v0[2], v0[3]); w.z = cvt_pk_bf16(v1[0], v1[1]); w.w = cvt_pk_bf16(v1[2], v1[3]);
                    *(u32x4*)(rowp + bj * HALF) = w; } }
    }
};
struct EpiPlainMask {
    static constexpr bool PERM = true; static constexpr int NSTORES = 16;
    bf16_t* O; int ldc;
    __device__ __forceinline__ void operator()(const f32x4 (&acc)[2][2][4][2], const Unit& u, int wr, int wc, int fr, int fq) const {
        const int row0 = wr * 64 + fr, col0 = u.pn * BM + wc * 32 + 8 * fq;
#pragma unroll
        for (int ai = 0; ai < 2; ++ai)
#pragma unroll
            for (int m = 0; m < 4; ++m) { bf16_t* rowp = O + (size_t)(row0 + ai * HALF + m * 16) * ldc + col0;
#pragma unroll
                for (int bj = 0; bj < 2; ++bj) { const f32x4 v0 = acc[ai][bj][m][0], v1 = acc[ai][bj][m][1];
                    u32x4 w; w.x = cvt_pk_bf16(v0[0], v0[1]); w.y = cvt_pk_bf16(v0[2], v0[3]); w.z = cvt_pk_bf16(v1[0], v1[1]); w.w = cvt_pk_bf16(v1[2], v1[3]);
                    *(u32x4*)(rowp + bj * HALF) = w; } }
    }
};
struct EpiNull {
    static constexpr bool PERM = true; static constexpr int NSTORES = 8;
    __device__ __forceinline__ void operator()(const f32x4 (&acc)[2][2][4][2], const Unit&, int, int, int, int) const {
#pragma unroll
        for (int ai = 0; ai < 2; ++ai)
#pragma unroll
            for (int bj = 0; bj < 2; ++bj)
#pragma unroll
                for (int m = 0; m < 4; ++m) asm volatile("" :: "v"(acc[ai][bj][m][0]), "v"(acc[ai][bj][m][1]));
    }
};
struct EpiInProj {
    static constexpr bool PERM = true; static constexpr int NSTORES = 16;
    bf16_t* O; const LAS float* ropec; const LAS float* ropes;
    __device__ __forceinline__ void operator()(const f32x4 (&acc)[2][2][4][2], const Unit& u, int wr, int wc, int fr, int fq) const {
        const int row0 = u.pm * BM + wr * 64 + fr, col0 = u.pn * BM + wc * 32 + 8 * fq;
        const bool rope = (u.pm < MLAT / 256) && (u.pn < 2 || (u.pn >= 4 && u.pn < 6));
        const bool colpos = (wc & 1) != 0;
        const float qs = u.pn < 2 ? 0.18033688011112042f : 1.f;
#pragma unroll
        for (int ai = 0; ai < 2; ++ai)
#pragma unroll
            for (int m = 0; m < 4; ++m) { const int row = row0 + ai * HALF + m * 16; bf16_t* rowp = O + (size_t)row * NIN + col0;
                f32x4 cs = {1.f, 1.f, 1.f, 1.f}, sn = {0.f, 0.f, 0.f, 0.f};
                if (rope) { const int t = row & (SEQ - 1), pos = colpos ? (t & 63) : (t >> 6); cs = *(const LAS f32x4*)(ropec + pos * 16 + 4 * fq); sn = *(const LAS f32x4*)(ropes + pos * 16 + 4 * fq); }
#pragma unroll
                for (int bj = 0; bj < 2; ++bj) { const f32x4 a = acc[ai][bj][m][0] * qs, b = acc[ai][bj][m][1] * qs;
                    const f32x4 v0 = a * cs - b * sn, v1 = b * cs + a * sn;
                    u32x4 w; w.x = cvt_pk_bf16(v0[0], v0[1]); w.y = cvt_pk_bf16(v0[2], v0[3]); w.z = cvt_pk_bf16(v1[0], v1[1]); w.w = cvt_pk_bf16(v1[2], v1[3]);
                    *(u32x4*)(rowp + bj * HALF) = w; } }
    }
};
struct EpiSwiglu {
    static constexpr bool PERM = true; static constexpr int NSTORES = 8;
    bf16_t* O; int ldc; float k1, k2;
    __device__ __forceinline__ void operator()(const f32x4 (&acc)[2][2][4][2], const Unit& u, int wr, int wc, int fr, int fq) const {
        const int row0 = u.pm * BM + wr * 64 + fr, col0 = u.pn * HALF + wc * 32 + 8 * fq;
#pragma unroll
        for (int ai = 0; ai < 2; ++ai)
#pragma unroll
            for (int m = 0; m < 4; ++m) { bf16_t* rowp = O + (size_t)(row0 + ai * HALF + m * 16) * ldc + col0;
                f32x2 v[2][2];
#pragma unroll
                for (int n = 0; n < 2; ++n)
#pragma unroll
                    for (int h2 = 0; h2 < 2; ++h2) { const f32x2 a2 = {acc[ai][0][m][n][2 * h2], acc[ai][0][m][n][2 * h2 + 1]}, b2 = {acc[ai][1][m][n][2 * h2], acc[ai][1][m][n][2 * h2 + 1]};
                        const f32x2 mm = a2 * k1; f32x2 e; e.x = __builtin_amdgcn_exp2f(mm.x); e.y = __builtin_amdgcn_exp2f(mm.y);
                        const f32x2 d = e + 1.0f; f32x2 r; r.x = __builtin_amdgcn_rcpf(d.x); r.y = __builtin_amdgcn_rcpf(d.y);
                        v[n][h2] = (a2 * r) * (b2 * k2); }
                u32x4 w; w.x = cvt_pk_bf16(v[0][0].x, v[0][0].y); w.y = cvt_pk_bf16(v[0][1].x, v[0][1].y); w.z = cvt_pk_bf16(v[1][0].x, v[1][0].y); w.w = cvt_pk_bf16(v[1][1].x, v[1][1].y);
                *(u32x4*)rowp = w; }
    }
};
__device__ __forceinline__ unsigned pk_fp8x4(float a, float b, float c, float d) {
    a = __builtin_amdgcn_fmed3f(a, -448.f, 448.f); b = __builtin_amdgcn_fmed3f(b, -448.f, 448.f); c = __builtin_amdgcn_fmed3f(c, -448.f, 448.f); d = __builtin_amdgcn_fmed3f(d, -448.f, 448.f);
    int p = __builtin_amdgcn_cvt_pk_fp8_f32(a, b, 0, false); p = __builtin_amdgcn_cvt_pk_fp8_f32(c, d, p, true); return (unsigned)p; }
struct EpiSwigluF8 {
    static constexpr bool PERM = true; static constexpr int NSTORES = 8;
    unsigned char* O; int ldc; float k1, k2;
    __device__ __forceinline__ void operator()(const f32x4 (&acc)[2][2][4][2], const Unit& u, int wr, int wc, int fr, int fq) const {
        const int row0 = u.pm * BM + wr * 64 + fr, col0 = u.pn * HALF + wc * 32 + 8 * fq;
#pragma unroll
        for (int ai = 0; ai < 2; ++ai)
#pragma unroll
            for (int m = 0; m < 4; ++m) { unsigned char* rowp = O + (size_t)(row0 + ai * HALF + m * 16) * ldc + col0;
                f32x2 v[2][2];
#pragma unroll
                for (int n = 0; n < 2; ++n)
#pragma unroll
                    for (int h2 = 0; h2 < 2; ++h2) { const f32x2 a2 = {acc[ai][0][m][n][2 * h2], acc[ai][0][m][n][2 * h2 + 1]}, b2 = {acc[ai][1][m][n][2 * h2], acc[ai][1][m][n][2 * h2 + 1]};
                        const f32x2 mm = a2 * k1; f32x2 e; e.x = __builtin_amdgcn_exp2f(mm.x); e.y = __builtin_amdgcn_exp2f(mm.y);
                        const f32x2 d = e + 1.0f; f32x2 r; r.x = __builtin_amdgcn_rcpf(d.x); r.y = __builtin_amdgcn_rcpf(d.y);
                        v[n][h2] = (a2 * r) * (b2 * k2); }
                u32x2 w; w.x = pk_fp8x4(v[0][0].x, v[0][0].y, v[0][1].x, v[0][1].y); w.y = pk_fp8x4(v[1][0].x, v[1][0].y, v[1][1].x, v[1][1].y);
                *(u32x2*)rowp = w; }
    }
};
}

namespace att {
constexpr int LDP = NIN;
constexpr int SHM_V = 64 * 128 * 2, SHM_K = 64 * 128 * 2;
constexpr int OFF_K = 0, OFF_V = 4 * SHM_K, OFF_WS = RING_BYTES + 14336, ATT_LDS = OFF_WS + NWAVES * 64 * 4;
constexpr int OFF_X = 0, OFF_OST = 65536;
static_assert(OFF_V + 4 * SHM_V <= RING_BYTES && ATT_LDS <= LDS_BYTES, "attention LDS");
constexpr float SCALE = 0.125f;
constexpr float THR = 8.f;
#define KSWZ(row, colB) ((row) * 256 + ((colB) ^ (((row) & 7) << 4)))
__device__ __forceinline__ int crow(int r, int hi) { return (r & 3) + 8 * (r >> 2) + 4 * hi; }

constexpr float THRL = 8.f;
template <bool FIRST>
__device__ __forceinline__ void partialSM(f32x16& p0, f32x16& p1, float& mhat, f32x16& negm, float& alpha) {
    float a = fmaxf(fmaxf(p0[0], p0[1]), p1[0]), b = fmaxf(fmaxf(p0[2], p0[3]), p1[1]); a = fmaxf(fmaxf(a, p1[2]), p1[3]);
#pragma unroll
    for (int r = 4; r < 16; r += 4) { a = fmaxf(fmaxf(a, p0[r]), p0[r + 1]); b = fmaxf(fmaxf(b, p0[r + 2]), p0[r + 3]); a = fmaxf(fmaxf(a, p1[r]), p1[r + 1]); b = fmaxf(fmaxf(b, p1[r + 2]), p1[r + 3]); }
    float rm = fmaxf(a, b);
    { auto rr = __builtin_amdgcn_permlane32_swap(__float_as_uint(rm), __float_as_uint(rm), false, false); rm = fmaxf(__uint_as_float(rr[0]), __uint_as_float(rr[1])); }
    alpha = 1.f;
    if (FIRST || __builtin_expect(__any(rm > THRL), 0)) {
        const float dl = FIRST ? rm : fmaxf(rm, 0.f); mhat += dl;
#pragma unroll
        for (int r = 0; r < 16; ++r) { p0[r] -= dl; p1[r] -= dl; }
#pragma unroll
        for (int r = 0; r < 16; ++r) negm[r] = -mhat;
        asm volatile("" : "+v"(negm));
        if (!FIRST) alpha = __builtin_amdgcn_exp2f(-dl);
    }
#pragma unroll
    for (int r = 0; r < 16; ++r) p0[r] = __builtin_amdgcn_exp2f(p0[r]);
}
__device__ __forceinline__ void finishSM(f32x16& p0, f32x16& p1, float alpha, float& l_reg, bf16x8& pa0, bf16x8& pa1, bf16x8& pa2, bf16x8& pa3) {
#pragma unroll
    for (int r = 0; r < 16; ++r) p1[r] = __builtin_amdgcn_exp2f(p1[r]);
    float ps = 0;
#pragma unroll
    for (int r = 0; r < 16; ++r) ps += p0[r];
#pragma unroll
    for (int r = 0; r < 16; ++r) ps += p1[r];
    { auto rr = __builtin_amdgcn_permlane32_swap(__float_as_uint(ps), __float_as_uint(ps), false, false);
      ps = __uint_as_float(rr[0]) + __uint_as_float(rr[1]); }
    l_reg = l_reg * alpha + ps;
#define PK4(P, BASE, OUT) do { u32x4 w = {cvt_pk_bf16(P[BASE + 0], P[BASE + 1]), cvt_pk_bf16(P[BASE + 2], P[BASE + 3]), cvt_pk_bf16(P[BASE + 4], P[BASE + 5]), cvt_pk_bf16(P[BASE + 6], P[BASE + 7])}; OUT = __builtin_bit_cast(bf16x8, w); } while (0)
    PK4(p0, 0, pa0); PK4(p0, 8, pa1); PK4(p1, 0, pa2); PK4(p1, 8, pa3);
#undef PK4
}
__device__ __forceinline__ void qkt(f32x16& p0, f32x16& p1, const char* Ks, const bf16x8 (&qr)[4], const f32x16& negm, int r32, int hi, int cb0) {
#pragma unroll
    for (int d0 = 0; d0 < 4; ++d0) { const int cb = cb0 + (d0 * 16 + hi * 8) * 2;
        const bf16x8 b0 = *reinterpret_cast<const bf16x8*>(Ks + KSWZ(r32, cb));
        const bf16x8 b1 = *reinterpret_cast<const bf16x8*>(Ks + KSWZ(32 + r32, cb));
        if (d0 == 0) { p0 = __builtin_amdgcn_mfma_f32_32x32x16_bf16(b0, qr[0], negm, 0, 0, 0); p1 = __builtin_amdgcn_mfma_f32_32x32x16_bf16(b1, qr[0], negm, 0, 0, 0); }
        else { p0 = __builtin_amdgcn_mfma_f32_32x32x16_bf16(b0, qr[d0], p0, 0, 0, 0); p1 = __builtin_amdgcn_mfma_f32_32x32x16_bf16(b1, qr[d0], p1, 0, 0, 0); } }
}
__device__ __forceinline__ int v_st(int k, int c) { const int kk = (k & ~0xC) | ((k & 4) << 1) | ((k & 8) >> 1); return ((kk >> 3) * 4 + (c >> 5)) * 512 + ((kk & 7) * 32 + (c & 31)) * 2; }
__device__ __forceinline__ int v_rd_base(int lane) { return ((lane & 3) << 3) | (((lane >> 2) & 3) << 6) | (((lane >> 4) & 1) << 5) | (((lane >> 5) & 1) << 11); }
constexpr int v_rd_off(int d0, int ks, int half) { return d0 * 512 + ks * 4096 + half * 256; }
template <int OFF> __device__ __forceinline__ s16x4 tr_read(int vb) {
    s16x4 r; asm volatile("ds_read_b64_tr_b16 %0, %1 offset:%2" : "=&v"(r) : "v"(vb), "i"(OFF) : "memory"); return r;
}
template <int D0> __device__ __forceinline__ void pv_one(f32x16& od, int vb, bf16x8 pa0, bf16x8 pa1, bf16x8 pa2, bf16x8 pa3) {
    const s16x4 l0 = tr_read<v_rd_off(D0, 0, 0)>(vb), h0 = tr_read<v_rd_off(D0, 0, 1)>(vb), l1 = tr_read<v_rd_off(D0, 1, 0)>(vb), h1 = tr_read<v_rd_off(D0, 1, 1)>(vb);
    const s16x4 l2 = tr_read<v_rd_off(D0, 2, 0)>(vb), h2 = tr_read<v_rd_off(D0, 2, 1)>(vb), l3 = tr_read<v_rd_off(D0, 3, 0)>(vb), h3 = tr_read<v_rd_off(D0, 3, 1)>(vb);
    asm volatile("s_waitcnt lgkmcnt(0)" ::: "memory"); SBAR();
#define PKV(L, H) (bf16x8){L[0], L[1], L[2], L[3], H[0], H[1], H[2], H[3]}
    od = __builtin_amdgcn_mfma_f32_32x32x16_bf16(pa0, PKV(l0, h0), od, 0, 0, 0);
    od = __builtin_amdgcn_mfma_f32_32x32x16_bf16(pa1, PKV(l1, h1), od, 0, 0, 0);
    od = __builtin_amdgcn_mfma_f32_32x32x16_bf16(pa2, PKV(l2, h2), od, 0, 0, 0);
    od = __builtin_amdgcn_mfma_f32_32x32x16_bf16(pa3, PKV(l3, h3), od, 0, 0, 0);
#undef PKV
}
struct VFrag { s16x4 l0, h0, l1, h1, l2, h2, l3, h3; };
template <int D0> __device__ __forceinline__ void v_reads(VFrag& f, int vb) {
    f.l0 = tr_read<v_rd_off(D0, 0, 0)>(vb); f.h0 = tr_read<v_rd_off(D0, 0, 1)>(vb); f.l1 = tr_read<v_rd_off(D0, 1, 0)>(vb); f.h1 = tr_read<v_rd_off(D0, 1, 1)>(vb);
    f.l2 = tr_read<v_rd_off(D0, 2, 0)>(vb); f.h2 = tr_read<v_rd_off(D0, 2, 1)>(vb); f.l3 = tr_read<v_rd_off(D0, 3, 0)>(vb); f.h3 = tr_read<v_rd_off(D0, 3, 1)>(vb);
}
__device__ __forceinline__ void v_mfmas(f32x16& od, const VFrag& f, bf16x8 pa0, bf16x8 pa1, bf16x8 pa2, bf16x8 pa3) {
#define PKV(L, H) (bf16x8){L[0], L[1], L[2], L[3], H[0], H[1], H[2], H[3]}
    od = __builtin_amdgcn_mfma_f32_32x32x16_bf16(pa0, PKV(f.l0, f.h0), od, 0, 0, 0);
    od = __builtin_amdgcn_mfma_f32_32x32x16_bf16(pa1, PKV(f.l1, f.h1), od, 0, 0, 0);
    od = __builtin_amdgcn_mfma_f32_32x32x16_bf16(pa2, PKV(f.l2, f.h2), od, 0, 0, 0);
    od = __builtin_amdgcn_mfma_f32_32x32x16_bf16(pa3, PKV(f.l3, f.h3), od, 0, 0, 0);
#undef PKV
}
__device__ __forceinline__ void pv_d0(f32x16* o, int vb, bf16x8 pa0, bf16x8 pa1, bf16x8 pa2, bf16x8 pa3) {
    VFrag fa, fb;
    v_reads<0>(fa, vb);
    v_reads<1>(fb, vb); asm volatile("s_waitcnt lgkmcnt(8)" ::: "memory"); SBAR(); v_mfmas(o[0], fa, pa0, pa1, pa2, pa3);
    v_reads<2>(fa, vb); asm volatile("s_waitcnt lgkmcnt(8)" ::: "memory"); SBAR(); v_mfmas(o[1], fb, pa0, pa1, pa2, pa3);
    v_reads<3>(fb, vb); asm volatile("s_waitcnt lgkmcnt(8)" ::: "memory"); SBAR(); v_mfmas(o[2], fa, pa0, pa1, pa2, pa3);
    asm volatile("s_waitcnt lgkmcnt(0)" ::: "memory"); SBAR(); v_mfmas(o[3], fb, pa0, pa1, pa2, pa3);
}

__device__ __forceinline__ void attn_unit(const bf16_t* __restrict__ Qb, const bf16_t* __restrict__ Ks0, int nt0, const bf16_t* __restrict__ Ks1, int nt1,
                                          bf16_t* Ob, float lam, float oscale, const float* __restrict__ subg, char* lds, const int wid) {
    const int lane = lane_id_v(), tid = wid * 64 + lane;
    const int r32 = lane & 31, hi = lane >> 5, map = wid >> 2, w4 = wid & 3; (void)tid;
    char* V_lds = lds + OFF_V; char* K_lds = lds + OFF_K;
    float* ws = (float*)(lds + OFF_WS) + wid * 64; float* li_l = ws; float* al_l = ws + 32;
    float zero_v; asm volatile("v_mov_b32 %0, 0" : "=v"(zero_v));
    float mhat = 0.f, l_reg = 0; f32x16 o[4] = {}; bf16x8 qr[4]; f32x16 negm;
#pragma unroll
    for (int r = 0; r < 16; ++r) negm[r] = zero_v;
    const bf16_t* Qw = Qb + (long)(w4 * 32 + r32) * LDP + map * 64 + hi * 8;
#pragma unroll
    for (int d0 = 0; d0 < 4; ++d0) qr[d0] = *reinterpret_cast<const bf16x8*>(Qw + d0 * 16);
    const int cb0 = map * 128;
    unsigned koff[2], voff[2];
#pragma unroll
    for (int i = 0; i < 2; ++i) { const int row = 4 * wid + 32 * i + (lane >> 4), ch = (lane & 15) ^ (row & 7); koff[i] = (unsigned)(row * LDP + ch * 8) * 2u;
        const int sub = 2 * wid + 16 * i + (lane >> 5), kk = (sub >> 2) * 8 + ((lane & 31) >> 2), k = (kk & ~0xC) | ((kk & 4) << 1) | ((kk & 8) >> 1), c = (sub & 3) * 32 + (lane & 3) * 8;
        voff[i] = (unsigned)(k * LDP + 512 + c) * 2u; }
    const unsigned ldsw = (unsigned)wid * 1024u;
    const int vb0 = (int)(uintptr_t)V_lds + v_rd_base(lane);
    const int NT = nt0 + nt1;
#define TILEP(j) ((const char*)((j) < nt0 ? Ks0 + (long)(j) * 64 * LDP : Ks1 + (long)((j) - nt0) * 64 * LDP))
#define DMA_K(j, slot) do { const char* _tb = TILEP(j); _Pragma("unroll") for (int _i = 0; _i < 2; ++_i) \
        __builtin_amdgcn_global_load_lds((const unsigned*)(_tb + koff[_i]), (LAS unsigned*)((LAS char*)(uintptr_t)(unsigned)(uintptr_t)K_lds + (slot) + ldsw + _i * 8192), 16, 0, 0); } while (0)
#define DMA_V(j, slot) do { const char* _tb = TILEP(j); _Pragma("unroll") for (int _i = 0; _i < 2; ++_i) \
        __builtin_amdgcn_global_load_lds((const unsigned*)(_tb + voff[_i]), (LAS unsigned*)((LAS char*)(uintptr_t)(unsigned)(uintptr_t)V_lds + (slot) + ldsw + _i * 8192), 16, 0, 0); } while (0)
#define WAIT_BAR(N) asm volatile("s_waitcnt vmcnt(" #N ") lgkmcnt(0)\n\ts_barrier" ::: "memory")
#define RESC(a) do { if (__any((a) < 1.f)) { if (hi == 0) al_l[r32] = (a); asm volatile("s_waitcnt lgkmcnt(0)" ::: "memory"); \
    _Pragma("unroll") for (int d = 0; d < 4; ++d) _Pragma("unroll") for (int r = 0; r < 16; ++r) o[d][r] *= al_l[crow(r, hi)]; } } while (0)
    f32x16 pA0, pA1, pB0, pB1; float alA, alB; bf16x8 pa0, pa1, pa2, pa3;
#define BAR_L()  do { asm volatile("s_waitcnt lgkmcnt(0)\n\ts_barrier" ::: "memory"); SBAR(); } while (0)
#define BAR_V2() do { asm volatile("s_waitcnt vmcnt(2) lgkmcnt(0)\n\ts_barrier" ::: "memory"); SBAR(); } while (0)
#define BAR_V0() do { asm volatile("s_waitcnt vmcnt(0) lgkmcnt(0)\n\ts_barrier" ::: "memory"); SBAR(); } while (0)
#define KSLOT(t) ((((t) >> 1) & 1) * 2 * SHM_K + ((t) & 1) * SHM_K)
#define VSLOT(t) (((t) & 3) * SHM_V)
    DMA_K(0, 0); DMA_K(1, SHM_K); DMA_V(0, 0);
    BAR_V0();
    if (map == 1) BAR_L();
    if (2 < NT) { DMA_K(2, KSLOT(2)); DMA_K(3, KSLOT(3)); } DMA_V(1, VSLOT(1));
    qkt(pA0, pA1, K_lds + KSLOT(0), qr, negm, r32, hi, cb0);
    BAR_L();
    if (2 < NT) DMA_V(2, VSLOT(2));
    partialSM<true>(pA0, pA1, mhat, negm, alA);
    BAR_L();
    qkt(pB0, pB1, K_lds + KSLOT(1), qr, negm, r32, hi, cb0); finishSM(pA0, pA1, alA, l_reg, pa0, pa1, pa2, pa3);
    BAR_V2();
    pv_d0(o, vb0 + VSLOT(0), pa0, pa1, pa2, pa3); partialSM<false>(pB0, pB1, mhat, negm, alB); RESC(alB);
    BAR_V0();
    for (int a = 2; a < NT; a += 2) {
        if (a + 2 < NT) { DMA_K(a + 2, KSLOT(a + 2)); DMA_K(a + 3, KSLOT(a + 3)); } DMA_V(a + 1, VSLOT(a + 1));
        qkt(pA0, pA1, K_lds + KSLOT(a), qr, negm, r32, hi, cb0); finishSM(pB0, pB1, alB, l_reg, pa0, pa1, pa2, pa3);
        BAR_L();
        if (a + 2 < NT) DMA_V(a + 2, VSLOT(a + 2));
        pv_d0(o, vb0 + VSLOT(a - 1), pa0, pa1, pa2, pa3); partialSM<false>(pA0, pA1, mhat, negm, alA); RESC(alA);
        BAR_L();
        qkt(pB0, pB1, K_lds + KSLOT(a + 1), qr, negm, r32, hi, cb0); finishSM(pA0, pA1, alA, l_reg, pa0, pa1, pa2, pa3);
        BAR_V2();
        pv_d0(o, vb0 + VSLOT(a), pa0, pa1, pa2, pa3); partialSM<false>(pB0, pB1, mhat, negm, alB); RESC(alB);
        BAR_V0();
    }
    finishSM(pB0, pB1, alB, l_reg, pa0, pa1, pa2, pa3);
    BAR_L();
    pv_d0(o, vb0 + VSLOT(NT - 1), pa0, pa1, pa2, pa3);
    BAR_L();
    if (map == 0) BAR_L();
#undef BAR_L
#undef BAR_V2
#undef BAR_V0
#undef KSLOT
#undef VSLOT
    if (hi == 0) li_l[r32] = l_reg; asm volatile("s_waitcnt lgkmcnt(0)" ::: "memory");
    float rli[16];
#pragma unroll
    for (int r = 0; r < 16; ++r) rli[r] = __builtin_amdgcn_rcpf(li_l[crow(r, hi)]) * (map ? lam : 1.f);
    __syncthreads();
    float* X = (float*)(lds + OFF_X) + w4 * (32 * 128);
    if (map == 1) {
#pragma unroll
        for (int r = 0; r < 16; ++r)
#pragma unroll
            for (int d0 = 0; d0 < 4; ++d0) X[crow(r, hi) * 128 + d0 * 32 + r32] = o[d0][r] * rli[r];
    }
    __syncthreads();
    if (map == 0) {
        float ss[16];
#pragma unroll
        for (int r = 0; r < 16; ++r) { float s = 0.f;
#pragma unroll
            for (int d0 = 0; d0 < 4; ++d0) { const float v = o[d0][r] * rli[r] - X[crow(r, hi) * 128 + d0 * 32 + r32]; o[d0][r] = v; s += v * v; }
            ss[r] = s; }
#pragma unroll
        for (int r = 0; r < 16; ++r) { float s = ss[r]; s += __shfl_xor(s, 1); s += __shfl_xor(s, 2); s += __shfl_xor(s, 4); s += __shfl_xor(s, 8); s += __shfl_xor(s, 16);
            ss[r] = __builtin_amdgcn_rsqf(s * (1.f / 128.f) + EPS) * oscale; }
        bf16_t* Ost = (bf16_t*)(lds + OFF_OST) + w4 * 4096;
#pragma unroll
        for (int d0 = 0; d0 < 4; ++d0) { const float g = subg[d0 * 32 + r32];
#pragma unroll
            for (int r = 0; r < 16; ++r) Ost[crow(r, hi) * 128 + d0 * 32 + r32] = (bf16_t)(cvt_pk_bf16(o[d0][r] * ss[r] * g, 0.f) & 0xffffu); }
        asm volatile("s_waitcnt lgkmcnt(0)" ::: "memory");
#pragma unroll
        for (int it = 0; it < 8; ++it) { const int row = it * 4 + (lane >> 4), ch = lane & 15;
            const u32x4 w = *(const u32x4*)(Ost + row * 128 + ch * 8);
            *(u32x4*)(Ob + (long)(w4 * 32 + row) * LDP + ch * 8) = w; }
    }
    __syncthreads();
#undef TILEP
#undef DMA_K
#undef DMA_V
#undef WAIT_BAR
#undef RESC
}

__device__ __forceinline__ void sg_unit(bf16_t* P0, const bf16_t* __restrict__ sgw, const float* __restrict__ lng, const float* __restrict__ lnb, const float* __restrict__ sgb, char* lds, const int wid, const int g_lo, const int g_hi) {
    const int lane = lane_id_v(), tid = wid * 64 + lane;
    const int r32 = lane & 31, hi = lane >> 5;
    const int sr = tid >> 4, sc = (tid & 15) * 8;
    float* Mt = (float*)(lds + 65536);
    u32x4 gb[4][4];
#pragma unroll
    for (int q4 = 0; q4 < 4; ++q4)
#pragma unroll
        for (int g = 0; g < 4; ++g) gb[q4][g] = *(const u32x4*)(P0 + (long)(q4 * 32 + sr) * LDP + COL_G + g * 128 + sc);
    float mean[4], rstd[4];
#pragma unroll
    for (int q4 = 0; q4 < 4; ++q4) { float sm = 0.f;
#pragma unroll
        for (int g = 0; g < 4; ++g) { const u32x4 w = gb[q4][g]; sm += (bflo(w.x) + bfhi(w.x)) + (bflo(w.y) + bfhi(w.y)) + (bflo(w.z) + bfhi(w.z)) + (bflo(w.w) + bfhi(w.w)); }
        sm += __shfl_xor(sm, 1); sm += __shfl_xor(sm, 2); sm += __shfl_xor(sm, 4); sm += __shfl_xor(sm, 8);
        const float mu = sm * (1.f / 512.f); float q = 0.f;
#pragma unroll
        for (int g = 0; g < 4; ++g) { const u32x4 w = gb[q4][g]; const float x[8] = {bflo(w.x), bfhi(w.x), bflo(w.y), bfhi(w.y), bflo(w.z), bfhi(w.z), bflo(w.w), bfhi(w.w)};
#pragma unroll
            for (int k = 0; k < 8; ++k) { const float d = x[k] - mu; q += d * d; } }
        q += __shfl_xor(q, 1); q += __shfl_xor(q, 2); q += __shfl_xor(q, 4); q += __shfl_xor(q, 8);
        mean[q4] = mu; rstd[q4] = __builtin_amdgcn_rsqf(q * (1.f / 512.f) + EPS); }
    const int vb0 = (int)(uintptr_t)lds + v_rd_base(lane);
    const int mt = wid & 3, eh = wid >> 2;
#pragma unroll
    for (int g = 0; g < 4; ++g) {
        if (g < g_lo || g >= g_hi) continue;
        u32x4 ub[4];
#pragma unroll
        for (int q4 = 0; q4 < 4; ++q4) ub[q4] = *(const u32x4*)(P0 + (long)(q4 * 32 + sr) * LDP + COL_U + g * 128 + sc);
        const bf16_t* Wp = sgw + (size_t)g * 128 * 128 + (size_t)(mt * 32 + r32) * 128 + hi * 4;
        bf16x8 af[2][4];
#pragma unroll
        for (int tq = 0; tq < 2; ++tq)
#pragma unroll
            for (int ks = 0; ks < 4; ++ks) { const u32x2 lo_ = *(const u32x2*)(Wp + tq * 64 + ks * 16), hi_ = *(const u32x2*)(Wp + tq * 64 + ks * 16 + 8); u32x4 w_ = {lo_.x, lo_.y, hi_.x, hi_.y}; af[tq][ks] = __builtin_bit_cast(bf16x8, w_); }
        const f32x4 ga = *(const f32x4*)(lng + g * 128 + sc), gbv = *(const f32x4*)(lng + g * 128 + sc + 4), ba = *(const f32x4*)(lnb + g * 128 + sc), bb = *(const f32x4*)(lnb + g * 128 + sc + 4);
#pragma unroll
        for (int q4 = 0; q4 < 4; ++q4) { const int tkn = q4 * 32 + sr; const u32x4 w = gb[q4][g]; const float mu = mean[q4], rs = rstd[q4];
            const float x[8] = {bflo(w.x), bfhi(w.x), bflo(w.y), bfhi(w.y), bflo(w.z), bfhi(w.z), bflo(w.w), bfhi(w.w)};
            u32x4 ov;
            ov.x = cvt_pk_bf16((x[0] - mu) * rs * ga[0] + ba[0], (x[1] - mu) * rs * ga[1] + ba[1]);
            ov.y = cvt_pk_bf16((x[2] - mu) * rs * ga[2] + ba[2], (x[3] - mu) * rs * ga[3] + ba[3]);
            ov.z = cvt_pk_bf16((x[4] - mu) * rs * gbv[0] + bb[0], (x[5] - mu) * rs * gbv[1] + bb[1]);
            ov.w = cvt_pk_bf16((x[6] - mu) * rs * gbv[2] + bb[2], (x[7] - mu) * rs * gbv[3] + bb[3]);
            *(u32x4*)(lds + (tkn >> 6) * SHM_V + v_st(tkn & 63, sc)) = ov; }
        __syncthreads();
        f32x16 oa = {}, ob = {};
#pragma unroll
        for (int tq = 0; tq < 2; ++tq) {
            if (eh == 0) { pv_one<0>(oa, vb0 + tq * SHM_V, af[tq][0], af[tq][1], af[tq][2], af[tq][3]); pv_one<1>(ob, vb0 + tq * SHM_V, af[tq][0], af[tq][1], af[tq][2], af[tq][3]); }
            else         { pv_one<2>(oa, vb0 + tq * SHM_V, af[tq][0], af[tq][1], af[tq][2], af[tq][3]); pv_one<3>(ob, vb0 + tq * SHM_V, af[tq][0], af[tq][1], af[tq][2], af[tq][3]); }
        }
#pragma unroll
        for (int r = 0; r < 16; ++r) { const int pr = mt * 32 + crow(r, hi); const float bs = sgb[g * 128 + pr];
            Mt[pr * 128 + eh * 64 + r32] = oa[r] + bs; Mt[pr * 128 + eh * 64 + 32 + r32] = ob[r] + bs; }
        __syncthreads();
#pragma unroll
        for (int q4 = 0; q4 < 4; ++q4) { const int tkn = q4 * 32 + sr; const f32x4 m0 = *(const f32x4*)(Mt + tkn * 128 + sc), m1 = *(const f32x4*)(Mt + tkn * 128 + sc + 4); const u32x4 w = ub[q4];
            u32x4 ov;
            ov.x = cvt_pk_bf16(bflo(w.x) * m0[0], bfhi(w.x) * m0[1]); ov.y = cvt_pk_bf16(bflo(w.y) * m0[2], bfhi(w.y) * m0[3]);
            ov.z = cvt_pk_bf16(bflo(w.z) * m1[0], bfhi(w.z) * m1[1]); ov.w = cvt_pk_bf16(bflo(w.w) * m1[2], bfhi(w.w) * m1[3]);
            *(u32x4*)(P0 + (long)tkn * LDP + COL_U + g * 128 + sc) = ov; }
    }
    __syncthreads();
}
}

#define XB_TMO      128
#define XB_XCNT(j)  (256  + 64 * (j))
#define XB_XSUB(j)  (1280 + 64 * (j))
#define XB_XGEN(j)  (2304 + 64 * (j))
#define XB_TOP      3328
#define XB_TOPGEN   3392
#define XCD_BAR_WORDS 3456
#define XB_SPIN_CAP (1u << 18)
__device__ __forceinline__ unsigned xb_ld(unsigned* p)              { return __hip_atomic_load(p, __ATOMIC_RELAXED, __HIP_MEMORY_SCOPE_AGENT); }
__device__ __forceinline__ unsigned xb_add(unsigned* p, unsigned v) { return __hip_atomic_fetch_add(p, v, __ATOMIC_RELAXED, __HIP_MEMORY_SCOPE_AGENT); }
__device__ __forceinline__ unsigned xb_xcc_id() { return (unsigned)__builtin_amdgcn_s_getreg((3 << 11) | 20) & 0xFu; }
#define XB_SPIN(cond, bar) do { unsigned _sp = 0; while (cond) { __builtin_amdgcn_s_sleep(1); \
    if ((++_sp & 255u) == 0u) { if (xb_ld(&(bar)[XB_TMO])) break; if (_sp > XB_SPIN_CAP) { atomicAdd(&(bar)[XB_TMO], 1u); break; } } } } while (0)
struct XcdBarrier { unsigned* bar; unsigned x; volatile LAS unsigned* st; };
__device__ __forceinline__ XcdBarrier xcd_barrier_post(unsigned* bar, volatile LAS unsigned* st, int tid) {
    XcdBarrier b; b.bar = bar; b.x = xb_xcc_id(); b.st = st;
    if (tid == 0) (void)xb_add(&bar[XB_XCNT(b.x)], 1u);
    return b;
}
__device__ __forceinline__ void xcd_barrier_complete(unsigned* bar, unsigned x, unsigned& nloc, unsigned& nx) {
    const unsigned G = gridDim.x * gridDim.y * gridDim.z;
    unsigned sum, cnt, mine, sp = 0u;
    for (;;) {
        sum = 0u; cnt = 0u; mine = 0u;
#pragma unroll
        for (unsigned j = 0; j < 16; ++j) { const unsigned c = xb_ld(&bar[XB_XCNT(j)]); sum += c; cnt += (c > 0u) ? 1u : 0u; mine = (j == x) ? c : mine; }
        if (sum == G) break;
        __builtin_amdgcn_s_sleep(1);
        if ((++sp & 255u) == 0u) { if (xb_ld(&bar[XB_TMO])) break; if (sp > XB_SPIN_CAP) { atomicAdd(&bar[XB_TMO], 1u); break; } }
    }
    nloc = mine > 0u ? mine : 1u; nx = cnt > 0u ? cnt : 1u;
}
__device__ __forceinline__ void xcd_barrier(const XcdBarrier& b, int wave) {
    asm volatile("s_waitcnt vmcnt(0)" ::: "memory");
    __syncthreads();
    if (wave == 0 && lane_id_v() == 0) {
        unsigned* bar = b.bar;
        __builtin_amdgcn_s_waitcnt(0);
        unsigned nloc = b.st[0], nx = b.st[1];
        if (nloc == 0u) { xcd_barrier_complete(bar, b.x, nloc, nx); b.st[0] = nloc; b.st[1] = nx; }
        const unsigned old = xb_add(&bar[XB_XSUB(b.x)], 1u);
        const unsigned gen = old / nloc;
        if (old + 1u == (gen + 1u) * nloc) {
            __builtin_amdgcn_fence(__ATOMIC_RELEASE, "agent");
            asm volatile("s_waitcnt vmcnt(0)" ::: "memory");
            const unsigned og = xb_add(&bar[XB_TOP], 1u);
            const unsigned tg = og / nx;
            if (og + 1u == (tg + 1u) * nx) xb_add(&bar[XB_TOPGEN], 1u);
            else XB_SPIN(xb_ld(&bar[XB_TOPGEN]) == tg, bar);
            __builtin_amdgcn_fence(__ATOMIC_ACQUIRE, "agent");
            xb_add(&bar[XB_XGEN(b.x)], 1u);
            asm volatile("s_waitcnt vmcnt(0)" ::: "memory");
        } else {
            XB_SPIN(xb_ld(&bar[XB_XGEN(b.x)]) == gen, bar);
            __builtin_amdgcn_fence(__ATOMIC_ACQUIRE, "agent");
            asm volatile("s_waitcnt vmcnt(0)" ::: "memory");
        }
    }
    __syncthreads();
}

struct Args {
    const float* in[28]; float* out; unsigned char* ws; int ph_lo, ph_hi;
};
typedef const __attribute__((address_space(4))) Args* KArgP;
#define KARG() ({ KArgP _p = (KArgP)__builtin_amdgcn_kernarg_segment_ptr(); asm volatile("" : "+s"(_p)); _p; })
struct Frame {
    LAS unsigned char* lds; gu32* ctl; int tid, lane, wave, vcu, G;
};

constexpr int I_IN = 16 * 80, I_OUT = 16 * 32, I_F13 = 16 * 176, I_F2 = 44 * 32, I_M13 = 16 * 224, I_M2 = 56 * 32;
constexpr int CV_L0 = 2 * I_IN + 2 * I_OUT + I_F13 + I_F2, CV_N = CV_L0 + 8 * I_M13 + 8 * I_M2;
__device__ __forceinline__ void convert_range(LAS unsigned char* lds, int wave, int lane, KArgP ap, int first, int stride, int end) {
    const __attribute__((address_space(4))) Args& a = *ap; unsigned char* ws = a.ws;
    LAS float* scr = (LAS float*)(lds + wave * 16384);
    struct Item { const float* src; unsigned char* dst; int ldw, K, k0; bool rope, f8; };
#define DECODE(it_, I) do { int r = (it_); \
        if (r < 2 * I_IN) { const int l = r / I_IN; r %= I_IN; const int kb = r / 80, g = r % 80, seg = g >> 4, gi = g & 15; \
            const int sseg = seg == 0 ? 0 : seg == 1 ? 3 : seg == 2 ? 1 : seg == 3 ? 2 : 4;        \
            I.src = a.in[10] + (size_t)l * D * NIN + (size_t)kb * 64 * NIN + sseg * 512 + gi * 32; I.ldw = NIN; I.K = D; I.k0 = kb * 64; I.rope = (seg == 0 || seg == 2); I.f8 = false; \
            I.dst = ws + WS_WIN + ((size_t)l * NIN * D + (size_t)g * 32 * D + kb * 64) * 2; break; } \
        r -= 2 * I_IN; \
        if (r < 2 * I_OUT) { const int l = r / I_OUT; r %= I_OUT; const int kb = r / 32, g = r % 32; \
            I.src = a.in[11] + (size_t)l * D * D + (size_t)kb * 64 * D + g * 32; I.ldw = D; I.K = D; I.k0 = kb * 64; I.rope = false; I.f8 = false; \
            I.dst = ws + WS_WOUT + ((size_t)l * D * D + (size_t)g * 32 * D + kb * 64) * 2; break; } \
        r -= 2 * I_OUT; \
        if (r < I_F13) { const int kb = r / 176, g = r % 176, tile = g >> 3, gi = g & 7;            \
            I.src = (gi < 4 ? a.in[21] : a.in[22]) + (size_t)kb * 64 * DFF + tile * 128 + (gi & 3) * 32; I.ldw = DFF; I.K = D; I.k0 = kb * 64; I.rope = false; I.f8 = FFN_UP_FP8 != 0; \
            I.dst = ws + WS_W13 + ((size_t)g * 32 * D + kb * 64) * (FFN_UP_FP8 ? 1 : 2); break; } \
        r -= I_F13; \
        if (r < I_F2) { const int kb = r / 32, g = r % 32; \
            I.src = a.in[23] + (size_t)kb * 64 * D + g * 32; I.ldw = D; I.K = DFF; I.k0 = kb * 64; I.rope = false; I.f8 = FFN_DOWN_FP8 != 0; \
            I.dst = ws + WS_W2 + ((size_t)g * 32 * DFF + kb * 64) * (FFN_DOWN_FP8 ? 1 : 2); break; } \
        r -= I_F2; \
        if (r < 8 * I_M13) { const int e = r / I_M13; r %= I_M13; const int kb = r / 224, g = r % 224, tile = g >> 3, gi = g & 7; \
            I.src = (gi < 4 ? a.in[25] : a.in[26]) + (size_t)e * D * DEXP + (size_t)kb * 64 * DEXP + tile * 128 + (gi & 3) * 32; I.ldw = DEXP; I.K = D; I.k0 = kb * 64; I.rope = false; I.f8 = true; \
            I.dst = ws + WS_MW13 + (size_t)e * 7168 * D + (size_t)g * 32 * D + kb * 64; break; } \
        r -= 8 * I_M13; \
        { const int e = r / I_M2; r %= I_M2; const int kb = r / 32, g = r % 32; \
            I.src = a.in[27] + (size_t)e * DEXP * D + (size_t)kb * 64 * D + g * 32; I.ldw = D; I.K = DEXP; I.k0 = kb * 64; I.rope = false; I.f8 = true; \
            I.dst = ws + WS_MW2 + (size_t)e * D * DEXP + (size_t)g * 32 * DEXP + kb * 64; } \
    } while (0)
#define LOADITEM(I, v) do { const int j_ = lane & 31, sj_ = I.rope ? ((j_ & 3) + 4 * (j_ >> 3) + 16 * ((j_ >> 2) & 1)) : j_; const float* sp_ = I.src + (size_t)(lane >> 5) * I.ldw + sj_; \
        _Pragma("unroll") for (int i = 0; i < 32; ++i) v[i] = sp_[(size_t)(2 * i) * I.ldw]; } while (0)
    if (first < end) {
        Item cur, nxt; float v[32], vn[32];
        DECODE(first, cur); LOADITEM(cur, v);
        for (int it = first; it < end; it += stride) {
            const int itn = it + stride; const bool has_next = itn < end;
            if (has_next) { DECODE(itn, nxt); LOADITEM(nxt, vn); }
            const int j = lane & 31; const float sc = cur.f8 ? 128.f : 1.f;
#pragma unroll
            for (int i = 0; i < 32; ++i) { const int kk = 2 * i + (lane >> 5); scr[kk * 33 + j] = v[i] * sc; }
            LDS_WAIT(); asm volatile("" ::: "memory");
            if (cur.f8) {
                const int n = lane >> 1, hf = lane & 1; const LAS float* s = scr + (32 * hf) * 33 + n;
                u32x4 o0, o1;
                o0.x = pg8::pk_fp8x4(s[0 * 33], s[1 * 33], s[2 * 33], s[3 * 33]);     o0.y = pg8::pk_fp8x4(s[4 * 33], s[5 * 33], s[6 * 33], s[7 * 33]);
                o0.z = pg8::pk_fp8x4(s[8 * 33], s[9 * 33], s[10 * 33], s[11 * 33]);   o0.w = pg8::pk_fp8x4(s[12 * 33], s[13 * 33], s[14 * 33], s[15 * 33]);
                o1.x = pg8::pk_fp8x4(s[16 * 33], s[17 * 33], s[18 * 33], s[19 * 33]); o1.y = pg8::pk_fp8x4(s[20 * 33], s[21 * 33], s[22 * 33], s[23 * 33]);
                o1.z = pg8::pk_fp8x4(s[24 * 33], s[25 * 33], s[26 * 33], s[27 * 33]); o1.w = pg8::pk_fp8x4(s[28 * 33], s[29 * 33], s[30 * 33], s[31 * 33]);
                unsigned char* d = cur.dst + (size_t)n * cur.K + 32 * hf;
                *(u32x4*)d = o0; *(u32x4*)(d + 16) = o1;
            } else {
                const int c = lane & 7;
#pragma unroll
                for (int jj = 0; jj < 4; ++jj) { const int n = (lane >> 3) + 8 * jj; const LAS float* s = scr + (8 * c) * 33 + n;
                    u32x4 o; o.x = cvt_pk_bf16(s[0 * 33], s[1 * 33]); o.y = cvt_pk_bf16(s[2 * 33], s[3 * 33]); o.z = cvt_pk_bf16(s[4 * 33], s[5 * 33]); o.w = cvt_pk_bf16(s[6 * 33], s[7 * 33]);
                    *(u32x4*)(cur.dst + ((size_t)n * cur.K + 8 * c) * 2) = o; }
            }
            LDS_WAIT(); asm volatile("" ::: "memory");
            if (has_next) { cur = nxt;
#pragma unroll
                for (int i = 0; i < 32; ++i) v[i] = vn[i]; }
        }
    }
#undef DECODE
#undef LOADITEM
}

#if PROBE_T && PROBE_T_PHASE == 40
#define P0T(n) do { if (F.wave == 0 && blockIdx.x == 0 && lane_id_v() == 0) { volatile LAS unsigned* tacc_ = (volatile LAS unsigned*)(F.lds + MISC_OFF) + 16; const unsigned _now = (unsigned)__builtin_amdgcn_s_memrealtime(); tacc_[n] += _now - tacc_[0]; tacc_[0] = _now; } } while (0)
#else
#define P0T(n) do {} while (0)
#endif
__device__ __forceinline__ void p0_prologue(Frame& F, KArgP ap) {
    const __attribute__((address_space(4))) Args& a = *ap;
    unsigned char* ws = a.ws;
    if (blockIdx.x < 192) {
        const int l = blockIdx.x / 96, n0 = (blockIdx.x % 96) * 64;
        LAS float* s = (LAS float*)F.lds;
        LAS float* red = (LAS float*)(F.lds + 69632);
        const float* c = a.in[1]; const float* cc = a.in[3];
        { float cv[34];
#pragma unroll
          for (int j = 0; j < 34; ++j) { const int i = F.tid + 512 * j; cv[j] = i < 16 * 1024 ? c[i] : cc[i - 16 * 1024]; }
#pragma unroll
          for (int j = 0; j < 34; ++j) s[F.tid + 512 * j] = silu_f(cv[j]); }
        __syncthreads();
        const float* W = a.in[4] + (size_t)l * D * 6144 + n0 + F.lane;
        float acc[17];
#pragma unroll
        for (int r = 0; r < 17; ++r) acc[r] = 0.f;
        const int kb = F.wave * 128;
        LAS float* wl = (LAS float*)(F.lds + 69632 + F.wave * 4096);
        float wa[16], wb[16];
#pragma unroll
        for (int k = 0; k < 16; ++k) wa[k] = W[(size_t)(kb + k) * 6144];
#pragma unroll 1
        for (int q = 0; q < 8; q += 2) {
#pragma unroll
            for (int k = 0; k < 16; ++k) wb[k] = W[(size_t)(kb + 16 * (q + 1) + k) * 6144];
#pragma unroll
            for (int hq = 0; hq < 2; ++hq) {
#pragma unroll
                for (int k = 0; k < 16; ++k) wl[k * 64 + F.lane] = hq ? wb[k] : wa[k];
                LDS_WAIT(); asm volatile("" ::: "memory");
                const int kq = kb + 16 * (q + hq);
#pragma unroll 1
                for (int k = 0; k < 16; k += 4) {
                    const float w0 = wl[k * 64 + F.lane], w1 = wl[(k + 1) * 64 + F.lane], w2 = wl[(k + 2) * 64 + F.lane], w3 = wl[(k + 3) * 64 + F.lane];
#pragma unroll
                    for (int r = 0; r < 17; ++r) { const f32x4 sv = *(const LAS f32x4*)(s + r * 1024 + kq + k); acc[r] += sv[0] * w0 + sv[1] * w1 + sv[2] * w2 + sv[3] * w3; }
                }
                LDS_WAIT(); asm volatile("" ::: "memory");
                if (hq == 0 && q + 2 < 8) {
#pragma unroll
                    for (int k = 0; k < 16; ++k) wa[k] = W[(size_t)(kb + 16 * (q + 2) + k) * 6144];
                }
            }
        }
        __syncthreads();
#pragma unroll
        for (int r = 0; r < 17; ++r) red[(F.wave * 17 + r) * 64 + F.lane] = acc[r];
        __syncthreads();
        float* ms = (float*)(ws + WS_MS) + (size_t)l * 17 * 6144;
        const float* bias = a.in[5] + (size_t)l * 6144;
        for (int i = F.tid; i < 17 * 64; i += 512) { const int r = i >> 6, col = i & 63; float v = bias[n0 + col];
#pragma unroll
            for (int w = 0; w < 8; ++w) v += red[(w * 17 + r) * 64 + col];
            ms[(size_t)r * 6144 + n0 + col] = v; }
        __syncthreads();
    }
    P0T(20);
    if (blockIdx.x == 255) {
        float* rc = (float*)(ws + WS_ROPE); float* rs = rc + 1024;
        for (int i = F.tid; i < 1024; i += 512) { const int pos = i >> 4, j = i & 15; const float inv = powf(10000.0f, -(float)(2 * j) / 32.0f); const float ang = (float)pos * inv; rc[i] = cosf(ang); rs[i] = sinf(ang); }
    }
    { const float* src = a.in[19]; bf16_t* dst = (bf16_t*)(ws + WS_SGW); const int n4 = 2 * 4 * 128 * 128 / 4;
      for (int i = blockIdx.x * 512 + F.tid; i < n4; i += F.G * 512) { const f32x4 v = *(const f32x4*)(src + (size_t)i * 4); u32x2 o; o.x = cvt_pk_bf16(v[0], v[1]); o.y = cvt_pk_bf16(v[2], v[3]); *(u32x2*)(dst + (size_t)i * 4) = o; } }
    P0T(21);
    convert_range(F.lds, F.wave, F.lane, ap, F.vcu * NWAVES + F.wave, F.G * NWAVES, CV_L0);
}

struct Row { f32x4 v[4]; };
__device__ __forceinline__ Row ld_row_f32(const float* p, int lane) { Row r; const f32x4* q = (const f32x4*)p + lane;
#pragma unroll
    for (int j = 0; j < 4; ++j) r.v[j] = q[64 * j]; return r; }
__device__ __forceinline__ void st_row_f32(float* p, int lane, const Row& r) { f32x4* q = (f32x4*)p + lane;
#pragma unroll
    for (int j = 0; j < 4; ++j) q[64 * j] = r.v[j]; }
__device__ __forceinline__ Row ld_row_bf16(const bf16_t* p, int lane) { Row r; const u32x2* q = (const u32x2*)p + lane;
#pragma unroll
    for (int j = 0; j < 4; ++j) { const u32x2 w = q[64 * j]; r.v[j] = (f32x4){bflo(w.x), bfhi(w.x), bflo(w.y), bfhi(w.y)}; } return r; }
__device__ __forceinline__ void st_row_bf16(bf16_t* p, int lane, const Row& r) { u32x2* q = (u32x2*)p + lane;
#pragma unroll
    for (int j = 0; j < 4; ++j) { u32x2 w; w.x = cvt_pk_bf16(r.v[j][0], r.v[j][1]); w.y = cvt_pk_bf16(r.v[j][2], r.v[j][3]); q[64 * j] = w; } }
__device__ __forceinline__ float row_rms_scale(const Row& r) { float s = 0.f;
#pragma unroll
    for (int j = 0; j < 4; ++j) s += (r.v[j][0] * r.v[j][0] + r.v[j][1] * r.v[j][1]) + (r.v[j][2] * r.v[j][2] + r.v[j][3] * r.v[j][3]);
    return __builtin_amdgcn_rsqf(wave_sum(s) * (1.f / D) + EPS); }
__device__ __forceinline__ Row row_modulate(const Row& x, const float* g, const float* shift, const float* scale, int lane) {
    const float rs = row_rms_scale(x); Row h; const f32x4* gq = (const f32x4*)g + lane; const f32x4* sh = (const f32x4*)shift + lane; const f32x4* sc = (const f32x4*)scale + lane;
#pragma unroll
    for (int j = 0; j < 4; ++j) h.v[j] = x.v[j] * rs * gq[64 * j] * (1.f + sc[64 * j]) + sh[64 * j];
    return h; }
__device__ __forceinline__ void row_residual(Row& x, const Row& y, const float* g, const float* gate, int lane) {
    const float rs = row_rms_scale(y); const f32x4* gq = (const f32x4*)g + lane; const f32x4* gt = (const f32x4*)gate + lane;
#pragma unroll
    for (int j = 0; j < 4; ++j) x.v[j] = x.v[j] + gt[64 * j] * (y.v[j] * rs * gq[64 * j]);
}

struct ResP { f32x4 a[4]; };
struct ModP { f32x4 b[4], sh[4]; };
__device__ __forceinline__ ResP ld_resp(const float* g, const float* gate, int lane) { ResP r; const f32x4* gq = (const f32x4*)g + lane; const f32x4* gt = (const f32x4*)gate + lane;
#pragma unroll
    for (int j = 0; j < 4; ++j) r.a[j] = gq[64 * j] * gt[64 * j]; return r; }
__device__ __forceinline__ ModP ld_modp(const float* g, const float* shift, const float* scale, int lane) { ModP r; const f32x4* gq = (const f32x4*)g + lane; const f32x4* sh = (const f32x4*)shift + lane; const f32x4* sc = (const f32x4*)scale + lane;
#pragma unroll
    for (int j = 0; j < 4; ++j) { r.b[j] = gq[64 * j] * (1.f + sc[64 * j]); r.sh[j] = sh[64 * j]; } return r; }
__device__ __forceinline__ void row_residual2(Row& x, const Row& y, const ResP& P) { const float rs = row_rms_scale(y);
#pragma unroll
    for (int j = 0; j < 4; ++j) x.v[j] = x.v[j] + P.a[j] * (y.v[j] * rs); }
__device__ __forceinline__ Row row_modulate2(const Row& x, const ModP& P) { const float rs = row_rms_scale(x); Row h;
#pragma unroll
    for (int j = 0; j < 4; ++j) h.v[j] = x.v[j] * rs * P.b[j] + P.sh[j]; return h; }

struct MoeTab { int cnt[8]; int pbase[9]; };
__device__ __forceinline__ void moe_tab(gu32* ctl, MoeTab& T) {
    int p = 0;
#pragma unroll
    for (int e = 0; e < 8; ++e) { const int c = (int)__builtin_amdgcn_readfirstlane(__hip_atomic_load(ctl + CW_CNT + 64 * e, RLX_AGENT)); T.cnt[e] = c; T.pbase[e] = p; p += (c + 255) >> 8; }
    T.pbase[8] = p;
}
__device__ __forceinline__ int moe_expert_of(const MoeTab& T, int panel) { int e = 0;
#pragma unroll
    for (int i = 1; i < 8; ++i) e += (panel >= T.pbase[i]) ? 1 : 0;
    return e; }

struct MoeUpSched {
    static constexpr bool GATHER = true;
    const char* A; const char* Bt; const int* slot_token; int G, c, p0, nM; MoeTab T; int tprobe;
    __device__ __forceinline__ bool next(int i, pg8::Unit& u) const {
        const int L = i * G + c; if (L >= nM * 28) return false;
        int pm, pn; pg8::tile_of(L, nM, 28, pm, pn);
        const int panel = p0 + pm, e = moe_expert_of(T, panel);
        u.pm = pm; u.pn = pn; u.aux = e; u.aux2 = panel; u.Ap = A; u.Bp = Bt + ((size_t)e * 7168 + (size_t)pn * 256) * D; return true;
    }
    __device__ __forceinline__ void aoff(const pg8::Unit& u, const int (&R)[2], const int (&C)[2], unsigned (&o0)[2], unsigned (&o1)[2]) const {
        int pb = 0, cn = 0;
#pragma unroll
        for (int e = 0; e < 8; ++e) { pb = (u.aux == e) ? T.pbase[e] : pb; cn = (u.aux == e) ? T.cnt[e] : cn; }
        const int rk0 = (u.aux2 - pb) * 256;
#pragma unroll
        for (int i = 0; i < 2; ++i) {
            const int ra = rk0 + R[i], rb = rk0 + pg8::HALF + R[i];
            const int ta = slot_token[u.aux * 32768 + (ra < cn ? ra : 0)], tb = slot_token[u.aux * 32768 + (rb < cn ? rb : 0)];
            o0[i] = (unsigned)(ta * D + C[i] * 2); o1[i] = (unsigned)(tb * D + C[i] * 2); }
    }
    __device__ __forceinline__ void prefetch_idx(const pg8::Unit& u, LAS unsigned char* idx, int wid, int lane) const {
        int pb = 0, cn = 0;
#pragma unroll
        for (int e = 0; e < 8; ++e) { pb = (u.aux == e) ? T.pbase[e] : pb; cn = (u.aux == e) ? T.cnt[e] : cn; }
        const int r = (u.aux2 - pb) * 256 + (wid & 3) * 64 + lane;
        __builtin_amdgcn_global_load_lds((const unsigned*)(slot_token + u.aux * 32768 + (r < cn ? r : 0)), (LAS unsigned*)(idx + (wid & 3) * 256), 4, 0, 0);
    }
    __device__ __forceinline__ void aoff_lds(const int (&R)[2], const int (&C)[2], const LAS unsigned char* idx, unsigned (&o0)[2], unsigned (&o1)[2]) const {
#pragma unroll
        for (int i = 0; i < 2; ++i) { const int ta = ((const LAS int*)idx)[R[i]], tb = ((const LAS int*)idx)[pg8::HALF + R[i]];
            o0[i] = (unsigned)(ta * D + C[i] * 2); o1[i] = (unsigned)(tb * D + C[i] * 2); }
    }
};
struct MoeDownSched {
    static constexpr bool GATHER = false;
    const char* A; const char* Bt; int G, c, p0, nM; MoeTab T; int tprobe;
    __device__ __forceinline__ bool next(int i, pg8::Unit& u) const {
        const int L = i * G + c; if (L >= nM * 4) return false;
        int pm, pn; pg8::tile_of(L, nM, 4, pm, pn);
        const int panel = p0 + pm, e = moe_expert_of(T, panel);
        u.pm = panel; u.pn = pn; u.aux = e; u.aux2 = 0; u.Ap = A + (size_t)pm * 256 * DEXP; u.Bp = Bt + ((size_t)e * D + (size_t)pn * 256) * DEXP; return true;
    }
    __device__ __forceinline__ void aoff(const pg8::Unit&, const int (&R)[2], const int (&C)[2], unsigned (&o0)[2], unsigned (&o1)[2]) const {
#pragma unroll
        for (int i = 0; i < 2; ++i) { o0[i] = (unsigned)(R[i] * DEXP + C[i] * 2); o1[i] = (unsigned)((pg8::HALF + R[i]) * DEXP + C[i] * 2); }
    }
};

constexpr int N_PHASES = 24;


__global__ void __launch_bounds__(NWAVES * 64, 2) mk_fwd(Args args) {
    extern __shared__ __attribute__((aligned(16))) unsigned char lds_raw[];
    Frame F;
    F.lds = (LAS unsigned char*)lds_raw;
    F.tid = threadIdx.x; F.lane = F.tid & 63; F.wave = __builtin_amdgcn_readfirstlane(F.tid >> 6);
    F.G = gridDim.x; { const int bx = blockIdx.x; F.vcu = (F.G % 8 == 0) ? (bx % 8) * (F.G / 8) + bx / 8 : bx; }
    unsigned char* ws = KARG()->ws;
    F.ctl = (gu32*)(ws + WS_CTL);
    volatile LAS unsigned* MISC = (volatile LAS unsigned*)(F.lds + MISC_OFF);
    for (int u = F.tid; u < (LDS_BYTES - LDSCTL_OFF) / 4; u += NWAVES * 64) ((LAS unsigned*)(F.lds + LDSCTL_OFF))[u] = 0u;
    __syncthreads();
    XcdBarrier bar; bar.bar = (unsigned*)(F.ctl + CW_BAR); bar.x = 0; bar.st = nullptr;
    if (!MK_PER_PHASE) bar = xcd_barrier_post((unsigned*)(F.ctl + CW_BAR), MISC + 8, F.tid);
    const int lo = KARG()->ph_lo, hi = KARG()->ph_hi;
#ifndef PROBE_NULL_G2
#define PROBE_NULL_G2 0
#endif
#ifndef DUP_MASK
#define DUP_MASK 0u
#endif
#if ((DUP_MASK) >> 0) & 1
#define REP_0 for (int _rep = 0; _rep < 2; ++_rep)
#else
#define REP_0
#endif
#if ((DUP_MASK) >> 1) & 1
#define REP_1 for (int _rep = 0; _rep < 2; ++_rep)
#else
#define REP_1
#endif
#if ((DUP_MASK) >> 2) & 1
#define REP_2 for (int _rep = 0; _rep < 2; ++_rep)
#else
#define REP_2
#endif
#if ((DUP_MASK) >> 4) & 1
#define REP_4 for (int _rep = 0; _rep < 2; ++_rep)
#else
#define REP_4
#endif
#if ((DUP_MASK) >> 5) & 1
#define REP_5 for (int _rep = 0; _rep < 2; ++_rep)
#else
#define REP_5
#endif
#if ((DUP_MASK) >> 6) & 1
#define REP_6 for (int _rep = 0; _rep < 2; ++_rep)
#else
#define REP_6
#endif
#if ((DUP_MASK) >> 7) & 1
#define REP_7 for (int _rep = 0; _rep < 2; ++_rep)
#else
#define REP_7
#endif
#if ((DUP_MASK) >> 9) & 1
#define REP_9 for (int _rep = 0; _rep < 2; ++_rep)
#else
#define REP_9
#endif
#if ((DUP_MASK) >> 11) & 1
#define REP_11 for (int _rep = 0; _rep < 2; ++_rep)
#else
#define REP_11
#endif
#if ((DUP_MASK) >> 13) & 1
#define REP_13 for (int _rep = 0; _rep < 2; ++_rep)
#else
#define REP_13
#endif
#if ((DUP_MASK) >> 14) & 1
#define REP_14 for (int _rep2 = 0; _rep2 < 2; ++_rep2)
#else
#define REP_14
#endif
#if ((DUP_MASK) >> 15) & 1
#define REP_15 for (int _rep2 = 0; _rep2 < 2; ++_rep2)
#else
#define REP_15
#endif
#ifndef PH_MASK
#define PH_MASK 0xffffffu
#endif
#define IN(k) ((((PH_MASK) >> (k)) & 1u) && lo <= (k) && (k) < hi)
#define SEAM(k) do { if (IN(k) && IN((k) + 1)) xcd_barrier(bar, F.wave); F.lane = lane_id_v(); F.tid = F.wave * 64 + F.lane; } while (0)

    bf16_t* XB = (bf16_t*)(ws + WS_XB);
    bf16_t* HA = (bf16_t*)(ws + WS_HA); bf16_t* P = (bf16_t*)(ws + WS_R1); bf16_t* HFF = (bf16_t*)(ws + WS_R1); bf16_t* OY = (bf16_t*)(ws + WS_OY); bf16_t* YS = (bf16_t*)(ws + WS_YS);
    const float* MS = (const float*)(ws + WS_MS);
    const float* ropec = (const float*)(ws + WS_ROPE); const float* ropes = ropec + 1024;
    int* tok_e = (int*)(ws + WS_ROUTE); float* tok_g = (float*)(ws + WS_ROUTE + 262144); int* tok_rank = (int*)(ws + WS_ROUTE + 524288);
    int* slot_token = (int*)(ws + WS_SLOT);
    const int gw = F.vcu * NWAVES + F.wave, NGW = F.G * NWAVES;
    char* ldsg = (char*)lds_raw;

#define TAIL_FILL(busy, kper, base) do { const int c_ = (int)blockIdx.x; if (c_ >= (busy)) { const int nfw_ = (256 - (busy)) * NWAVES, r_ = (c_ - (busy)) * NWAVES + F.wave; \
        convert_range(F.lds, F.wave, lane_id_v(), KARG(), CV_L0 + (base) + r_, nfw_, CV_L0 + (base) + (kper) * nfw_); } } while (0)
    constexpr int TF_K2 = 4, TF_K4 = 4, TF_K6 = 4, TF_K7 = 14, TF_K9 = 4;
    constexpr int TF_B2 = 0, TF_B4 = TF_B2 + 96 * NWAVES * TF_K2, TF_B6 = TF_B4 + 192 * NWAVES * TF_K4, TF_B7 = TF_B6 + 160 * NWAVES * TF_K6, TF_B9 = TF_B7 + 192 * NWAVES * TF_K7, TF_END = TF_B9 + 192 * NWAVES * TF_K9;
    static_assert(CV_L0 + TF_END <= CV_N, "tail fillers");
#if PROBE_T && PROBE_T_PHASE == 40
#define RGN(n) do { if (F.wave == 0 && blockIdx.x == 0 && lane_id_v() == 0) { volatile LAS unsigned* tacc_ = (volatile LAS unsigned*)(F.lds + MISC_OFF) + 16; const unsigned _now = (unsigned)__builtin_amdgcn_s_memrealtime(); tacc_[n] += _now - tacc_[0]; tacc_[0] = _now; } } while (0)
#else
#define RGN(n) do {} while (0)
#endif
    RGN(0);
    REP_0 if (IN(0)) { p0_prologue(F, KARG()); __syncthreads(); }
    RGN(1);
    SEAM(0);

    RGN(0);
    REP_1 if (IN(1)) {
        KArgP AP = KARG(); const float* x_in = AP->in[0]; const float* ctx_in = AP->in[2];
        const float* g = AP->in[6];
#pragma unroll 1
        for (int seg = 0; seg < 2; ++seg) {
            const int nr = seg ? 2 : 16; const int m0 = seg ? MLAT + gw * 2 : gw * 16; const int r17 = seg ? 16 : (m0 >> 11);
            const float* xbase = seg ? ctx_in + (size_t)(m0 - MLAT) * D : x_in + (size_t)m0 * D;
            const float* msr = MS + (size_t)r17 * 6144;
            const ModP MP = ld_modp(g, msr, msr + 1024, F.lane);
            Row xn = ld_row_f32(xbase, F.lane);
            for (int i = 0; i < nr; ++i) {
                const Row x = xn; if (i + 1 < nr) xn = ld_row_f32(xbase + (size_t)(i + 1) * D, F.lane);
                st_row_bf16(HA + (size_t)(m0 + i) * D, F.lane, row_modulate2(x, MP));
            }
        }
    }
    RGN(2);
    SEAM(1);

    REP_2 if (IN(2)) {
        pg8::DenseSched S{(const char*)HA, (const char*)(ws + WS_WIN), D, D, F.G, (int)blockIdx.x, MALL / 256, 10, 0, 0, 0, 0, 0, 0};
        LAS float* rl = (LAS float*)(F.lds + ROPE_LDS); for (int i = F.tid; i < 2048; i += NWAVES * 64) rl[i] = ropec[i]; __syncthreads();
        pg8::EpiInProj E{P, rl, rl + 1024};
        pg8::gemm_phase<pg8::EpiInProj, pg8::DenseSched, true>(F.lds, F.wave, D, S, E);
        TAIL_FILL(1440 - 5 * 256, TF_K2, TF_B2);
    }
    SEAM(2);

#define ATTN_PHASE(LAYER, WITH_CTX) do { \
        KArgP AP = KARG(); \
        float lam; { const float a1 = AP->in[12][(LAYER) * 64 + F.lane] * AP->in[13][(LAYER) * 64 + F.lane], a2 = AP->in[14][(LAYER) * 64 + F.lane] * AP->in[15][(LAYER) * 64 + F.lane]; \
            lam = __expf(wave_sum(a1)) - __expf(wave_sum(a2)) + ((LAYER) ? LAMBDA_INIT1 : LAMBDA_INIT0); } \
        const float oscale = 1.f - ((LAYER) ? LAMBDA_INIT1 : LAMBDA_INIT0); \
        const float* subg = AP->in[16] + (LAYER) * 128; \
        const int c = (int)blockIdx.x, xcd = c & 7, jj = c >> 3; \
        for (int i = 0; i < 5; ++i) { \
            bf16_t* Qb; const bf16_t* K0; const bf16_t* K1; int n1; \
            if (i < 4) { const int bh = i * 16 + xcd * 2 + (jj >> 4), qb = jj & 15, b = bh >> 2, h = bh & 3; \
                Qb = P + ((size_t)b * SEQ + qb * 128) * NIN + COL_Q + h * 128; K0 = P + ((size_t)MLAT + b * CTX) * NIN + COL_K + h * 128; K1 = P + ((size_t)b * SEQ) * NIN + COL_K + h * 128; n1 = 32; } \
            else { if (!((WITH_CTX) && c < 128)) break; const int bh = c >> 1, qb = c & 1, b = bh >> 2, h = bh & 3;        \
                Qb = P + ((size_t)MLAT + b * CTX + qb * 128) * NIN + COL_Q + h * 128; K0 = P + ((size_t)MLAT + b * CTX) * NIN + COL_K + h * 128; K1 = K0; n1 = 0; } \
            att::attn_unit(Qb, K0, 4, K1, n1, Qb, lam, oscale, subg, ldsg, F.wave); } \
        int c1 = c; asm volatile("" : "+s"(c1)); \
        int c2 = c1; asm volatile("" : "+s"(c2)); \
        SGT(7); \
        if (!DBG_NO_SG) { const bf16_t* sgw = (const bf16_t*)(ws + WS_SGW) + (size_t)(LAYER) * 4 * 128 * 128; \
          att::sg_unit(P + (size_t)c2 * 128 * NIN, sgw, AP->in[17] + (LAYER) * 512, AP->in[18] + (LAYER) * 512, AP->in[20] + (LAYER) * 512, ldsg, F.wave, 0, 4); \
          int c3 = c2; asm volatile("" : "+s"(c3)); \
          if ((WITH_CTX) && c3 >= 128) { const int it_ = c3 - 128;          \
              att::sg_unit(P + ((size_t)MLAT + (it_ >> 2) * 128) * NIN, sgw, AP->in[17] + (LAYER) * 512, AP->in[18] + (LAYER) * 512, AP->in[20] + (LAYER) * 512, ldsg, F.wave, it_ & 3, (it_ & 3) + 1); } } \
        SGT(1); \
    } while (0)
#if PROBE_T && PROBE_T_PHASE == 30
#define SGT(n) do { if (F.wave == 0 && blockIdx.x == 0 && lane_id_v() == 0) { volatile LAS unsigned* tacc_ = (volatile LAS unsigned*)(F.lds + MISC_OFF) + 16; const unsigned _now = (unsigned)__builtin_amdgcn_s_memrealtime(); tacc_[n] += _now - tacc_[0]; tacc_[0] = _now; } } while (0)
#else
#define SGT(n) do {} while (0)
#endif
    RGN(0);
    if (IN(3)) { ATTN_PHASE(0, true); }
    RGN(3);
    SEAM(3);

    REP_4 if (IN(4)) {
        pg8::DenseSched S{(const char*)P, (const char*)(ws + WS_WOUT), NIN, D, F.G, (int)blockIdx.x, MALL / 256, 4, 0, 0, 0, 0, 0, 0};
        pg8::EpiPlain E{OY, D, 1.f};
        pg8::gemm_phase<pg8::EpiPlain, pg8::DenseSched, true>(F.lds, F.wave, D, S, E);
#if PROBE_NULL_G2 == 1
        { pg8::EpiNull E0; pg8::gemm_phase<pg8::EpiNull, pg8::DenseSched, true>(F.lds, F.wave, D, S, E0); }
#elif PROBE_NULL_G2 == 2
        { pg8::EpiPlainMask E0{HA, D}; pg8::gemm_phase<pg8::EpiPlainMask, pg8::DenseSched, true>(F.lds, F.wave, D, S, E0); }
#endif
        TAIL_FILL(576 - 2 * 256, TF_K4, TF_B4);
    }
    SEAM(4);

    RGN(0);
    REP_5 if (IN(5)) {
        KArgP AP = KARG(); const float* x_in = AP->in[0]; const float* ctx_in = AP->in[2];
        const float* gpost = AP->in[7]; const float* gpre = AP->in[8];
#pragma unroll 1
        for (int seg = 0; seg < 2; ++seg) {
            const int nr = seg ? 2 : 16; const int m0 = seg ? MLAT + gw * 2 : gw * 16; const int r17 = seg ? 16 : (m0 >> 11);
            const float* xbase = seg ? ctx_in + (size_t)(m0 - MLAT) * D : x_in + (size_t)m0 * D;
            const float* msr = MS + (size_t)r17 * 6144;
            const ResP RP = ld_resp(gpost, msr + 2 * 1024, F.lane); const ModP MP = ld_modp(gpre, msr + 3 * 1024, msr + 4 * 1024, F.lane);
            Row xn = ld_row_f32(xbase, F.lane), on = ld_row_bf16(OY + (size_t)m0 * D, F.lane);
            for (int i = 0; i < nr; ++i) {
                Row x = xn; const Row o = on; if (i + 1 < nr) { xn = ld_row_f32(xbase + (size_t)(i + 1) * D, F.lane); on = ld_row_bf16(OY + (size_t)(m0 + i + 1) * D, F.lane); }
                row_residual2(x, o, RP);
                st_row_bf16(XB + (size_t)(m0 + i) * D, F.lane, x);
#if FFN_UP_FP8
                { const Row f = row_modulate2(x, MP); unsigned* fo = (unsigned*)((unsigned char*)HA + (size_t)(m0 + i) * D) + F.lane;
#pragma unroll
                  for (int j = 0; j < 4; ++j) fo[64 * j] = pg8::pk_fp8x4(f.v[j][0] * 4.f, f.v[j][1] * 4.f, f.v[j][2] * 4.f, f.v[j][3] * 4.f); }
#else
                st_row_bf16(HA + (size_t)(m0 + i) * D, F.lane, row_modulate2(x, MP));
#endif
            }
        }
    }
    RGN(4);
    SEAM(5);

    REP_6 if (IN(6)) {
#if FFN_UP_FP8 && FFN_DOWN_FP8
        pg8::DenseSchedF8 S{(const char*)HA, (const char*)(ws + WS_W13), D, D, F.G, (int)blockIdx.x, MALL / 256, 22, PROBE_T_PHASE == 6};
        pg8::EpiSwigluF8 E{(unsigned char*)HFF, DFF, -1.4426950408889634f / 512.f, 4.f / (512.f * 512.f)};
        pg8::gemm_phase<pg8::EpiSwigluF8, pg8::DenseSchedF8, true, true>(F.lds, F.wave, D, S, E);
#elif FFN_UP_FP8
        pg8::DenseSchedF8 S{(const char*)HA, (const char*)(ws + WS_W13), D, D, F.G, (int)blockIdx.x, MALL / 256, 22, PROBE_T_PHASE == 6};
        pg8::EpiSwiglu E{HFF, DFF, -1.4426950408889634f / 512.f, 1.f / (512.f * 512.f)};
        pg8::gemm_phase<pg8::EpiSwiglu, pg8::DenseSchedF8, true, true>(F.lds, F.wave, D, S, E);
#elif FFN_DOWN_FP8
        pg8::DenseSched S{(const char*)HA, (const char*)(ws + WS_W13), D, D, F.G, (int)blockIdx.x, MALL / 256, 22, 0, 0, 0, 0, 0, 0, PROBE_T_PHASE == 6};
        pg8::EpiSwigluF8 E{(unsigned char*)HFF, DFF, -1.4426950408889634f, 4.f};
        pg8::gemm_phase<pg8::EpiSwigluF8, pg8::DenseSched, true>(F.lds, F.wave, D, S, E);
#else
        pg8::DenseSched S{(const char*)HA, (const char*)(ws + WS_W13), D, D, F.G, (int)blockIdx.x, MALL / 256, 22, 0, 0, 0, 0, 0, 0, PROBE_T_PHASE == 6};
        pg8::EpiSwiglu E{HFF, DFF, -1.4426950408889634f, 1.f};
        pg8::gemm_phase<pg8::EpiSwiglu, pg8::DenseSched, true>(F.lds, F.wave, D, S, E);
#endif
        TAIL_FILL(3168 - 12 * 256, TF_K6, TF_B6);
    }
    SEAM(6);

    REP_7 if (IN(7)) {
#if FFN_DOWN_FP8
        pg8::DenseSchedF8 S{(const char*)HFF, (const char*)(ws + WS_W2), DFF, DFF, F.G, (int)blockIdx.x, MALL / 256, 4, 0};
        pg8::EpiPlain E{OY, D, 1.f / 512.f};
        pg8::gemm_phase<pg8::EpiPlain, pg8::DenseSchedF8, true, true>(F.lds, F.wave, DFF, S, E);
#else
        pg8::DenseSched S{(const char*)HFF, (const char*)(ws + WS_W2), DFF, DFF, F.G, (int)blockIdx.x, MALL / 256, 4, 0, 0, 0, 0, 0, 0};
        pg8::EpiPlain E{OY, D, 1.f};
        pg8::gemm_phase<pg8::EpiPlain, pg8::DenseSched, true>(F.lds, F.wave, DFF, S, E);
#endif
        TAIL_FILL(576 - 2 * 256, TF_K7, TF_B7);
    }
    SEAM(7);

    if (IN(8)) {
        KArgP AP = KARG();
        const float* gpost = AP->in[9]; const float* gpre = AP->in[6] + D;
#pragma unroll 1
        for (int seg = 0; seg < 2; ++seg) {
            const int nr = seg ? 2 : 16; const int m0 = seg ? MLAT + gw * 2 : gw * 16; const int r17 = seg ? 16 : (m0 >> 11);
            const float* msr = MS + (size_t)r17 * 6144; const float* msr1 = MS + (size_t)(17 + r17) * 6144;
            const ResP RP = ld_resp(gpost, msr + 5 * 1024, F.lane); const ModP MP = ld_modp(gpre, msr1, msr1 + 1024, F.lane);
            Row xn = ld_row_bf16(XB + (size_t)m0 * D, F.lane), yn = ld_row_bf16(OY + (size_t)m0 * D, F.lane);
            for (int i = 0; i < nr; ++i) {
                Row x = xn; const Row y = yn; if (i + 1 < nr) { xn = ld_row_bf16(XB + (size_t)(m0 + i + 1) * D, F.lane); yn = ld_row_bf16(OY + (size_t)(m0 + i + 1) * D, F.lane); }
                row_residual2(x, y, RP);
                if (!seg) st_row_bf16(XB + (size_t)(m0 + i) * D, F.lane, x);
                st_row_bf16(HA + (size_t)(m0 + i) * D, F.lane, row_modulate2(x, MP));
            }
        }
    }
    SEAM(8);

    REP_9 if (IN(9)) {
        pg8::DenseSched S{(const char*)HA, (const char*)(ws + WS_WIN + (size_t)NIN * D * 2), D, D, F.G, (int)blockIdx.x, MLAT / 256, 10, 0, 0, MCTX / 256, 4, MLAT, 4};
        LAS float* rl = (LAS float*)(F.lds + ROPE_LDS); for (int i = F.tid; i < 2048; i += NWAVES * 64) rl[i] = ropec[i]; __syncthreads();
        pg8::EpiInProj E{P, rl, rl + 1024};
        pg8::gemm_phase<pg8::EpiInProj, pg8::DenseSched, true>(F.lds, F.wave, D, S, E);
        TAIL_FILL(1344 - 5 * 256, TF_K9, TF_B9);
    }
    SEAM(9);

    if (IN(10)) { ATTN_PHASE(1, false); }
    SEAM(10);

    REP_11 if (IN(11)) {
        pg8::DenseSched S{(const char*)P, (const char*)(ws + WS_WOUT + (size_t)D * D * 2), NIN, D, F.G, (int)blockIdx.x, MLAT / 256, 4, 0, 0, 0, 0, 0, 0};
        pg8::EpiPlain E{OY, D, 1.f};
        pg8::gemm_phase<pg8::EpiPlain, pg8::DenseSched, true>(F.lds, F.wave, D, S, E);
    }
    SEAM(11);

    RGN(0);
    if (IN(12)) {
        KArgP AP = KARG();
        const float* gpost = AP->in[7] + D; const float* gpre = AP->in[8] + D;
        LAS float* rw = (LAS float*)F.lds;
        LAS int* lcnt = (LAS int*)(F.lds + 32768);
        LAS int* rec = (LAS int*)(F.lds + 32768 + 256);
        for (int i = F.tid; i < 8192; i += 512) rw[(i & 7) * 1024 + (i >> 3)] = AP->in[24][i];
        if (F.tid < 16) lcnt[F.tid] = 0;
        __syncthreads();
        const int m0 = gw * 16; const int r17 = m0 >> 11; const float* msr1 = MS + (size_t)(17 + r17) * 6144;
        const ResP RP = ld_resp(gpost, msr1 + 2 * 1024, F.lane); const ModP MP = ld_modp(gpre, msr1 + 3 * 1024, msr1 + 4 * 1024, F.lane);
        Row xn = ld_row_bf16(XB + (size_t)m0 * D, F.lane), on = ld_row_bf16(OY + (size_t)m0 * D, F.lane);
        for (int i = 0; i < 16; ++i) {
            const int m = m0 + i;
            Row x = xn; const Row o = on; if (i + 1 < 16) { xn = ld_row_bf16(XB + (size_t)(m + 1) * D, F.lane); on = ld_row_bf16(OY + (size_t)(m + 1) * D, F.lane); }
            row_residual2(x, o, RP);
            st_row_bf16(XB + (size_t)m * D, F.lane, x);
            const Row f = row_modulate2(x, MP);
            { unsigned* fo = (unsigned*)(ws + WS_F8 + (size_t)m * D) + F.lane;
#pragma unroll
              for (int j = 0; j < 4; ++j) fo[64 * j] = pg8::pk_fp8x4(f.v[j][0] * 4.f, f.v[j][1] * 4.f, f.v[j][2] * 4.f, f.v[j][3] * 4.f); }
            float lg[8];
#pragma unroll
            for (int e = 0; e < 8; ++e) { float a = 0.f;
#pragma unroll
                for (int j = 0; j < 4; ++j) { const f32x4 w = *(const LAS f32x4*)(rw + e * 1024 + 4 * (F.lane + 64 * j)); a += (f.v[j][0] * w[0] + f.v[j][1] * w[1]) + (f.v[j][2] * w[2] + f.v[j][3] * w[3]); }
                lg[e] = wave_sum(a); }
            int e1 = 0; float v1 = lg[0];
#pragma unroll
            for (int e = 1; e < 8; ++e) if (lg[e] > v1) { v1 = lg[e]; e1 = e; }
            int e2 = -1; float v2 = -3.0e38f;
#pragma unroll
            for (int e = 0; e < 8; ++e) if (e != e1 && lg[e] > v2) { v2 = lg[e]; e2 = e; }
            if (F.lane == 0) {
                const float w1 = 1.f / (1.f + __expf(v2 - v1));
                tok_e[m * 2] = e1; tok_e[m * 2 + 1] = e2; tok_g[m * 2] = w1; tok_g[m * 2 + 1] = 1.f - w1;
                const int l1 = __hip_atomic_fetch_add(lcnt + e1, 1, __ATOMIC_RELAXED, __HIP_MEMORY_SCOPE_WORKGROUP), l2 = __hip_atomic_fetch_add(lcnt + e2, 1, __ATOMIC_RELAXED, __HIP_MEMORY_SCOPE_WORKGROUP);
                LAS int* rr = rec + (F.wave * 16 + i) * 4; rr[0] = e1; rr[1] = e2; rr[2] = l1; rr[3] = l2;
            }
        }
        __syncthreads();
        if (F.tid < 8) lcnt[8 + F.tid] = (int)__hip_atomic_fetch_add(F.ctl + CW_CNT + 64 * F.tid, (unsigned)lcnt[F.tid], RLX_AGENT);
        __syncthreads();
        if (F.lane < 16) { const int m = m0 + F.lane; const LAS int* rr = rec + (F.wave * 16 + F.lane) * 4;
            const int r1 = lcnt[8 + rr[0]] + rr[2], r2 = lcnt[8 + rr[1]] + rr[3];
            tok_rank[m * 2] = r1; tok_rank[m * 2 + 1] = r2; slot_token[rr[0] * 32768 + r1] = m; slot_token[rr[1] * 32768 + r2] = m; }
        __syncthreads();
        convert_range(F.lds, F.wave, lane_id_v(), KARG(), CV_L0 + TF_END + gw, NGW, CV_N);
    }
    RGN(5);
    SEAM(12);

    {
        MoeTab T; T.pbase[8] = 0;
        if (hi > 13 && lo < 23) moe_tab(F.ctl, T);
        const int ptot = T.pbase[8];
        REP_13 for (int ch = 0; ch < 2; ++ch) {
            const int p0 = ch * 128; const int nM = ch ? ptot - 128 : (ptot < 128 ? ptot : 128);
            REP_14 if (IN(13 + 2 * ch) && nM > 0) {
                MoeUpSched S{(const char*)(ws + WS_F8), (const char*)(ws + WS_MW13), slot_token, F.G, (int)blockIdx.x, p0, nM, T, PROBE_T_PHASE == 13};
                pg8::EpiSwigluF8 E{ws + WS_HF8 + (size_t)p0 * 256 * DEXP, DEXP, -1.4426950408889634f / 512.f, 4.f / (512.f * 512.f)};
                pg8::gemm_phase<pg8::EpiSwigluF8, MoeUpSched, true, true>(F.lds, F.wave, D, S, E);
            }
            if (IN(13 + 2 * ch) && IN(14 + 2 * ch) && nM > 0) xcd_barrier(bar, F.wave);
            REP_15 if (IN(14 + 2 * ch) && nM > 0) {
                MoeDownSched S{(const char*)(ws + WS_HF8 + (size_t)p0 * 256 * DEXP), (const char*)(ws + WS_MW2), F.G, (int)blockIdx.x, p0, nM, T, PROBE_T_PHASE == 14};
                pg8::EpiPlain E{YS, D, 1.f / 512.f};
                pg8::gemm_phase<pg8::EpiPlain, MoeDownSched, true, true>(F.lds, F.wave, DEXP, S, E);
            }
            if (ch == 1 && IN(14 + 2 * ch) && IN(15 + 2 * ch) && nM > 0) xcd_barrier(bar, F.wave);
        }
    }

    RGN(0);
    if (IN(23)) {
        MoeTab T; moe_tab(F.ctl, T);
        const float* gpost = KARG()->in[9] + D;
#define YS_ROWS(mm, S1, S2) do { const int e1_ = tok_e[(mm) * 2], e2_ = tok_e[(mm) * 2 + 1]; int pb1_ = 0, pb2_ = 0; \
            _Pragma("unroll") for (int e = 0; e < 8; ++e) { pb1_ = (e1_ == e) ? T.pbase[e] : pb1_; pb2_ = (e2_ == e) ? T.pbase[e] : pb2_; } \
            S1 = (size_t)pb1_ * 256 + tok_rank[(mm) * 2]; S2 = (size_t)pb2_ * 256 + tok_rank[(mm) * 2 + 1]; } while (0)
        const int m0 = gw * 16; const int r17 = m0 >> 11; const float* msr1 = MS + (size_t)(17 + r17) * 6144;
        const ResP RP = ld_resp(gpost, msr1 + 5 * 1024, F.lane);
        size_t s1, s2; YS_ROWS(m0, s1, s2);
        Row xn = ld_row_bf16(XB + (size_t)m0 * D, F.lane), yan = ld_row_bf16(YS + s1 * D, F.lane), ybn = ld_row_bf16(YS + s2 * D, F.lane);
        float* outp = KARG()->out;
        for (int i = 0; i < 16; ++i) {
            const int m = m0 + i;
            Row x = xn; const Row ya = yan, yb = ybn; const float g1 = tok_g[m * 2], g2 = tok_g[m * 2 + 1];
            if (i + 1 < 16) { YS_ROWS(m + 1, s1, s2); xn = ld_row_bf16(XB + (size_t)(m + 1) * D, F.lane); yan = ld_row_bf16(YS + s1 * D, F.lane); ybn = ld_row_bf16(YS + s2 * D, F.lane); }
            Row y;
#pragma unroll
            for (int j = 0; j < 4; ++j) y.v[j] = ya.v[j] * g1 + yb.v[j] * g2;
            row_residual2(x, y, RP);
            st_row_f32(outp + (size_t)m * D, F.lane, x);
        }
    }
    RGN(6);
#if PROBE_T
    if (blockIdx.x == 0 && F.wave == 0) { const unsigned ticks = ((volatile LAS unsigned*)(F.lds + MISC_OFF))[16 + PROBE_T]; const unsigned long long t0 = __builtin_amdgcn_s_memrealtime();
        while (__builtin_amdgcn_s_memrealtime() - t0 < (unsigned long long)ticks * 8ull) __builtin_amdgcn_s_sleep(8); }
#endif
#undef TAIL_FILL
#undef IN
#undef SEAM
#undef ATTN_PHASE
}

extern "C" void kernel_launch(void* const* d_in, const int* in_sizes, int n_in, void* d_out, int out_size, void* d_ws, size_t ws_size, hipStream_t stream) {
    static int grid = 0;
    if (grid == 0) {
        if (n_in != 28 || out_size != MLAT * D || ws_size < WS_END) { fprintf(stderr, "kernel_launch: unexpected shapes (n_in %d, out %d, ws %zu)\n", n_in, out_size, ws_size); grid = -1; return; }
        int dev = 0, cus = 0, per_cu = 0;
        if (hipGetDevice(&dev) != hipSuccess || hipDeviceGetAttribute(&cus, hipDeviceAttributeMultiprocessorCount, dev) != hipSuccess) { grid = -1; return; }
        if (hipFuncSetAttribute((const void*)mk_fwd, hipFuncAttributeMaxDynamicSharedMemorySize, LDS_BYTES) != hipSuccess) { fprintf(stderr, "kernel_launch: hipFuncSetAttribute failed\n"); grid = -1; return; }
        if (hipOccupancyMaxActiveBlocksPerMultiprocessor(&per_cu, (const void*)mk_fwd, NWAVES * 64, LDS_BYTES) != hipSuccess || per_cu < 1) { fprintf(stderr, "kernel_launch: occupancy query says %d\n", per_cu); (void)hipGetLastError(); }
        grid = cus;
        if (grid != 256) { fprintf(stderr, "kernel_launch: built for 256 CUs, found %d\n", grid); grid = -1; return; }
    }
    if (grid < 0) return;
    (void)hipMemsetAsync((char*)d_ws + WS_CTL, 0, CTL_ZERO_BYTES, stream);
    Args a{};
    for (int i = 0; i < 28; ++i) a.in[i] = (const float*)d_in[i];
    a.out = (float*)d_out; a.ws = (unsigned char*)d_ws;
#if MK_PER_PHASE
    for (int p = 0; p < N_PHASES; ++p) { a.ph_lo = p; a.ph_hi = p + 1; hipLaunchKernelGGL(mk_fwd, dim3(grid), dim3(NWAVES * 64), LDS_BYTES, stream, a); }
#else
    a.ph_lo = 0; a.ph_hi = N_PHASES;
    hipLaunchKernelGGL(mk_fwd, dim3(grid), dim3(NWAVES * 64), LDS_BYTES, stream, a);
#endif
}
```
